# Optimizing an MI355X kernel written in HIP

```python
import jax, jax.numpy as jnp
from jax import lax
import numpy as np

D_MODEL = 1024
BATCH = 16
SEQ = 4096
DEPTH = 4

CTX_LEN = 256
GRID_W = 64
HEAD_DIM = 64
A_Q_HEADS = 8
A_KV_HEADS = 2
A_GROUP = A_Q_HEADS // A_KV_HEADS
WINDOW = 128
ATTN_BLOCK = 128
ROPE_BASE = 10000.0
GLA_HEADS = 4
GLA_DK = 64
GLA_DV = 128
GLA_RANK = 16
GLA_TAU = 16.0
GLA_CHUNK = 64
A_Q_W = A_Q_HEADS * HEAD_DIM
A_KV_W = A_KV_HEADS * HEAD_DIM
GLA_K_W = GLA_HEADS * GLA_DK
GLA_V_W = GLA_HEADS * GLA_DV
EVEN_SPLITS = (A_Q_W, A_KV_W, A_KV_W, GLA_K_W, GLA_K_W, GLA_V_W, GLA_V_W, 2 * GLA_RANK)
EVEN_IN = sum(EVEN_SPLITS)
MIX_W = A_Q_W + GLA_V_W
CONV_W = 3
N_GROUPS = 4
EXPERTS_PER_GROUP = 8
N_EXPERTS = N_GROUPS * EXPERTS_PER_GROUP
TOP_K = 2
D_EXPERT = 512
MOE_BLOCK = 128
N_EVEN = (DEPTH + 1) // 2
N_ODD = DEPTH // 2
DEEPNORM_ALPHA = (2.0 * DEPTH) ** 0.25
DEEPNORM_BETA = (8.0 * DEPTH) ** -0.25
LN_EPS = 1e-5
RMS_EPS = 1e-6

kernel_name = 'hybrid_dit_swa_gla_shortconv_hmoe'


def layer_norm(x, w, b):
    xf = x.astype(jnp.float32)
    mu = jnp.mean(xf, -1, keepdims=True)
    var = jnp.mean(jnp.square(xf - mu), -1, keepdims=True)
    return ((xf - mu) * lax.rsqrt(var + LN_EPS) * w.astype(jnp.float32) + b.astype(jnp.float32)).astype(x.dtype)


def post_norm(x, y, w, b):
    return layer_norm(DEEPNORM_ALPHA * x + y, w, b)


def ada_modulation(cond, w, b):
    m = jax.nn.silu(cond) @ w + b
    return m.reshape(m.shape[:-1] + (6, D_MODEL))


def modulate(x, shift, scale):
    return x * (1 + scale) + shift


def axial_rope_tables(n_tok):
    n_rows = n_tok // GRID_W
    row = jnp.repeat(jnp.arange(n_rows), GRID_W).astype(jnp.float32)
    col = jnp.tile(jnp.arange(GRID_W), n_rows).astype(jnp.float32)
    axis_dim = HEAD_DIM // 2
    inv_freq = ROPE_BASE ** (-jnp.arange(0, axis_dim, 2, dtype=jnp.float32) / axis_dim)
    ang = jnp.concatenate([row[:, None] * inv_freq, col[:, None] * inv_freq], -1)
    return jnp.cos(ang), jnp.sin(ang)


def apply_rope(x, cos, sin):
    nf = HEAD_DIM // 4
    xs = x.astype(jnp.float32).reshape(x.shape[:-1] + (2, 2, nf))
    x1, x2 = xs[..., 0, :], xs[..., 1, :]
    c = cos.reshape(cos.shape[0], 1, 2, nf)
    s = sin.reshape(sin.shape[0], 1, 2, nf)
    out = jnp.stack([x1 * c - x2 * s, x2 * c + x1 * s], axis=-2)
    return out.reshape(x.shape).astype(x.dtype)


def split_even(p):
    idx = [sum(EVEN_SPLITS[:n]) for n in range(1, len(EVEN_SPLITS))]
    return jnp.split(p, idx, axis=-1)


def sink_attend(qg, k, v, sink, mask):
    s = jnp.einsum('bqgrd,bkgd->bgrqk', qg, k, preferred_element_type=jnp.float32) * (HEAD_DIM ** -0.5)
    if mask is not None:
        s = jnp.where(mask, s, -jnp.inf)
    s_sink = jnp.broadcast_to(sink.astype(jnp.float32).reshape(1, A_KV_HEADS, A_GROUP, 1, 1), s.shape[:-1] + (1,))
    p = jax.nn.softmax(jnp.concatenate([s, s_sink], -1), axis=-1)[..., :-1]
    return jnp.einsum('bgrqk,bkgd->bqgrd', p.astype(v.dtype), v)


def window_attention(q, k, v, k_ctx, v_ctx, sink):
    B, S = q.shape[:2]
    L = k_ctx.shape[1]
    nb = S // ATTN_BLOCK
    qb = q.reshape(B, nb, ATTN_BLOCK, A_KV_HEADS, A_GROUP, HEAD_DIM).transpose(1, 0, 2, 3, 4, 5)
    pad = ((0, 0), (ATTN_BLOCK, ATTN_BLOCK), (0, 0), (0, 0))

    def band(t):
        tp = jnp.pad(t, pad).reshape(B, nb + 2, ATTN_BLOCK, A_KV_HEADS, HEAD_DIM)
        return jnp.concatenate([tp[:, :-2], tp[:, 1:-1], tp[:, 2:]], axis=2).transpose(1, 0, 2, 3, 4)

    kwin, vwin = band(k), band(v)
    blk = jnp.arange(nb)[:, None] * ATTN_BLOCK
    q_pos = blk + jnp.arange(ATTN_BLOCK)[None]
    k_pos = blk - ATTN_BLOCK + jnp.arange(3 * ATTN_BLOCK)[None]
    band_mask = ((jnp.abs(q_pos[:, :, None] - k_pos[:, None, :]) <= WINDOW)
                 & (k_pos[:, None, :] >= 0) & (k_pos[:, None, :] < S))
    ctx_mask = jnp.ones((ATTN_BLOCK, L), bool)

    def one_block(args):
        qi, ki, vi, mi = args
        keys = jnp.concatenate([ki, k_ctx], axis=1)
        vals = jnp.concatenate([vi, v_ctx], axis=1)
        return sink_attend(qi, keys, vals, sink, jnp.concatenate([mi, ctx_mask], -1))

    o = lax.map(one_block, (qb, kwin, vwin, band_mask))
    return o.transpose(1, 0, 2, 3, 4, 5).reshape(B, S, A_Q_W)


def gla_inputs(q, k, v, g_lr, wa2_d, ba_d, d):
    B, T = q.shape[:2]
    g = g_lr[..., d * GLA_RANK:(d + 1) * GLA_RANK] @ wa2_d + ba_d
    log_a = jax.nn.log_sigmoid(g.astype(jnp.float32)) / GLA_TAU
    shp = (B, T, GLA_HEADS, -1)
    return [q.reshape(shp).astype(jnp.float32) * (GLA_DK ** -0.5), k.reshape(shp).astype(jnp.float32),
            v.reshape(shp).astype(jnp.float32), log_a.reshape(shp)]


def gla_chunked(q, k, v, log_a, s0):
    B, T, H, _ = q.shape
    dv = v.shape[-1]
    n = T // GLA_CHUNK

    def chunks(t):
        return t.reshape(B, n, GLA_CHUNK, H, t.shape[-1]).transpose(1, 0, 2, 3, 4)

    qc, kc, vc, ac = chunks(q), chunks(k), chunks(v), chunks(log_a)
    b = jnp.cumsum(ac, axis=2)
    b_last = b[:, :, -1:]
    q_in = qc * jnp.exp(b)
    k_in = kc * jnp.exp(-b)
    k_st = kc * jnp.exp(b_last - b)
    causal = jnp.tril(jnp.ones((GLA_CHUNK, GLA_CHUNK), bool))
    attn = jnp.where(causal, jnp.einsum('nbihd,nbjhd->nbhij', q_in, k_in), 0.0)
    o_intra = jnp.einsum('nbhij,nbjhv->nbihv', attn, vc)

    def step(s, xs):
        qi, ksi, vi, dl = xs
        o_inter = jnp.einsum('bihd,bhdv->bihv', qi, s)
        s = dl[:, 0, :, :, None] * s + jnp.einsum('bjhd,bjhv->bhdv', ksi, vi)
        return s, o_inter

    s_fin, o_inter = lax.scan(step, s0, (q_in, k_st, vc, jnp.exp(b_last)))
    o = (o_intra + o_inter).transpose(1, 0, 2, 3, 4).reshape(B, T, H, dv)
    return o, s_fin


def gla_final_state(k, v, log_a):
    b = jnp.cumsum(log_a, axis=1)
    return jnp.einsum('bthd,bthv->bhdv', k * jnp.exp(b[:, -1:] - b), v)


def gla_bidirectional(lat, ctx, wa2, ba, need_ctx):
    B = lat[0].shape[0]
    s0 = jnp.zeros((B, GLA_HEADS, GLA_DK, GLA_DV), jnp.float32)
    o_lat, o_ctx = 0.0, 0.0
    for d in range(2):
        lat_in = gla_inputs(*lat, wa2[d], ba[d], d)
        ctx_in = gla_inputs(*ctx, wa2[d], ba[d], d)
        if d == 1:
            lat_in = [jnp.flip(t, 1) for t in lat_in]
            ctx_in = [jnp.flip(t, 1) for t in ctx_in]
        if need_ctx:
            oc, s_ctx = gla_chunked(*ctx_in, s0)
            o_ctx = o_ctx + (jnp.flip(oc, 1) if d == 1 else oc)
        else:
            s_ctx = gla_final_state(*ctx_in[1:])
        ol, _ = gla_chunked(*lat_in, s_ctx)
        o_lat = o_lat + (jnp.flip(ol, 1) if d == 1 else ol)
    return o_lat, o_ctx


def gla_output(o, r, norm_w):
    o = o * lax.rsqrt(jnp.mean(jnp.square(o), -1, keepdims=True) + RMS_EPS)
    o = o.reshape(o.shape[:2] + (GLA_V_W,)).astype(r.dtype) * norm_w
    return o * jax.nn.silu(r)


def attn_gla_mixer(u_lat, u_ctx, cos, sin, w_in, w_out, sink, wa2, ba, norm_w, need_ctx):
    B, S, _ = u_lat.shape
    L = u_ctx.shape[1]
    qa, ka, va, qg, kg, vg, rg, gg = split_even(u_lat @ w_in)
    qa_c, ka_c, va_c, qg_c, kg_c, vg_c, rg_c, gg_c = split_even(u_ctx @ w_in)

    def heads(t, h):
        return t.reshape(t.shape[:2] + (h, HEAD_DIM))

    k_ctx, v_ctx = heads(ka_c, A_KV_HEADS), heads(va_c, A_KV_HEADS)
    a_lat = window_attention(apply_rope(heads(qa, A_Q_HEADS), cos, sin), apply_rope(heads(ka, A_KV_HEADS), cos, sin),
                             heads(va, A_KV_HEADS), k_ctx, v_ctx, sink)
    o_lat, o_ctx = gla_bidirectional((qg, kg, vg, gg), (qg_c, kg_c, vg_c, gg_c), wa2, ba, need_ctx)
    y_lat = jnp.concatenate([a_lat, gla_output(o_lat, rg, norm_w)], -1) @ w_out
    if not need_ctx:
        return y_lat, None
    qc = qa_c.reshape(B, L, A_KV_HEADS, A_GROUP, HEAD_DIM)
    a_ctx = sink_attend(qc, k_ctx, v_ctx, sink, None).reshape(B, L, A_Q_W)
    y_ctx = jnp.concatenate([a_ctx, gla_output(o_ctx, rg_c, norm_w)], -1) @ w_out
    return y_lat, y_ctx


def short_conv_mixer(h, w_in, conv_w, conv_b, w_out):
    gb, gc, u = jnp.split(h @ w_in, 3, axis=-1)
    up = jnp.pad(gc * u, ((0, 0), (1, 1), (0, 0)))
    y = up[:, :-2] * conv_w[0] + up[:, 1:-1] * conv_w[1] + up[:, 2:] * conv_w[2] + conv_b
    return (gb * y) @ w_out


def routed_expert_ffn(h, expert, weights, w1, w3, w2):
    N, D = h.shape
    A = N * TOP_K
    flat_e = expert.reshape(A)
    flat_tok = jnp.repeat(jnp.arange(N), TOP_K)
    flat_w = weights.reshape(A)
    order = jnp.argsort(flat_e)
    e_sorted, tok_sorted, w_sorted = flat_e[order], flat_tok[order], flat_w[order]
    counts = jnp.bincount(flat_e, length=N_EXPERTS)
    start = jnp.cumsum(counts) - counts
    padded = (counts + MOE_BLOCK - 1) // MOE_BLOCK * MOE_BLOCK
    pad_end = jnp.cumsum(padded)
    pad_start = pad_end - padded
    dest = pad_start[e_sorted] + jnp.arange(A) - start[e_sorted]
    n_blocks = -(-A // MOE_BLOCK) + N_EXPERTS
    buf = jnp.zeros((n_blocks * MOE_BLOCK, D), h.dtype).at[dest].set(h[tok_sorted])
    blk_expert = jnp.minimum(jnp.searchsorted(pad_end, jnp.arange(n_blocks) * MOE_BLOCK, side='right'), N_EXPERTS - 1)

    def expert_block(args):
        xb, e = args
        return (jax.nn.silu(xb @ w1[e]) * (xb @ w3[e])) @ w2[e]

    y = lax.map(expert_block, (buf.reshape(n_blocks, MOE_BLOCK, D), blk_expert)).reshape(-1, D)
    return jnp.zeros((N, D), h.dtype).at[tok_sorted].add(y[dest] * w_sorted[:, None].astype(h.dtype))


def hier_moe(h, wg, bg, we, be, w1, w3, w2):
    N = h.shape[0]
    hf = h.astype(jnp.float32)
    g_logits = hf @ wg.astype(jnp.float32) + bg.astype(jnp.float32)
    _, g_sel = lax.top_k(g_logits, 1)
    p_group = jnp.take_along_axis(jax.nn.softmax(g_logits, -1), g_sel, -1)
    e_logits = (hf @ we.astype(jnp.float32) + be.astype(jnp.float32)).reshape(N, N_GROUPS, EXPERTS_PER_GROUP)
    e_logits = jnp.take_along_axis(e_logits, g_sel[:, :, None], 1)[:, 0]
    top_p, top_i = lax.top_k(jax.nn.softmax(e_logits, -1), TOP_K)
    weights = p_group * top_p / jnp.sum(top_p, -1, keepdims=True)
    expert = g_sel * EXPERTS_PER_GROUP + top_i
    return routed_expert_ffn(h, expert, weights, w1, w3, w2)


def setup_inputs(seed: int = 0) -> dict:
    key = jax.random.key(seed)
    ks = jax.random.split(key, 25)
    D = D_MODEL

    def nrm(k, shape, s):
        return jax.random.normal(k, shape, jnp.float32) * s

    return {
        'x': nrm(ks[0], (BATCH, SEQ, D), 1.0),
        'c': nrm(ks[1], (BATCH, D), 1.0),
        'ctx': nrm(ks[2], (BATCH, CTX_LEN, D), 1.0),
        'c_ctx': nrm(ks[3], (D,), 1.0),
        'w_in_even': nrm(ks[4], (N_EVEN, D, EVEN_IN), D ** -0.5),
        'w_out_even': nrm(ks[5], (N_EVEN, MIX_W, D), MIX_W ** -0.5 * DEEPNORM_BETA),
        'attn_sink': nrm(ks[6], (N_EVEN, A_Q_HEADS), 1.0),
        'gla_wa2': nrm(ks[7], (N_EVEN, 2, GLA_RANK, GLA_K_W), GLA_RANK ** -0.5),
        'gla_ba': nrm(ks[8], (N_EVEN, 2, GLA_K_W), 0.1),
        'gla_norm_w': 1.0 + nrm(ks[9], (N_EVEN, GLA_V_W), 0.02),
        'w_in_odd': nrm(ks[10], (N_ODD, D, 3 * D), D ** -0.5),
        'conv_w': nrm(ks[11], (N_ODD, CONV_W, D), CONV_W ** -0.5),
        'conv_b': nrm(ks[12], (N_ODD, D), 0.02),
        'w_out_odd': nrm(ks[13], (N_ODD, D, D), D ** -0.5 * DEEPNORM_BETA),
        'ada_w': nrm(ks[14], (DEPTH, D, 6 * D), 0.5 * D ** -0.5),
        'ada_b': nrm(ks[15], (DEPTH, 6 * D), 0.02),
        'ln_w': 1.0 + nrm(ks[16], (DEPTH, 2, D), 0.02),
        'ln_b': nrm(ks[17], (DEPTH, 2, D), 0.02),
        'router_wg': nrm(ks[18], (DEPTH, D, N_GROUPS), D ** -0.5),
        'router_bg': nrm(ks[19], (DEPTH, N_GROUPS), 0.01),
        'router_we': nrm(ks[20], (DEPTH, D, N_EXPERTS), D ** -0.5),
        'router_be': nrm(ks[21], (DEPTH, N_EXPERTS), 0.01),
        'moe_w1': nrm(ks[22], (DEPTH, N_EXPERTS, D, D_EXPERT), D ** -0.5),
        'moe_w3': nrm(ks[23], (DEPTH, N_EXPERTS, D, D_EXPERT), D ** -0.5),
        'moe_w2': nrm(ks[24], (DEPTH, N_EXPERTS, D_EXPERT, D), D_EXPERT ** -0.5 * DEEPNORM_BETA),
    }


def reference(x, c, ctx, c_ctx, w_in_even, w_out_even, attn_sink, gla_wa2, gla_ba, gla_norm_w,
              w_in_odd, conv_w, conv_b, w_out_odd, ada_w, ada_b, ln_w, ln_b,
              router_wg, router_bg, router_we, router_be, moe_w1, moe_w3, moe_w2):
    B, S, D = x.shape
    L = ctx.shape[1]
    cos, sin = axial_rope_tables(S)
    h_lat, h_ctx = x, ctx
    for l in range(DEPTH):
        i = l // 2
        need_ctx = any(j % 2 == 0 for j in range(l + 1, DEPTH))
        mod = ada_modulation(c, ada_w[l], ada_b[l])
        m = [mod[:, n, None] for n in range(6)]
        u_lat = modulate(h_lat, m[0], m[1])
        if need_ctx or l % 2 == 0:
            mc = ada_modulation(c_ctx, ada_w[l], ada_b[l])
            u_ctx = modulate(h_ctx, mc[0], mc[1])
        if l % 2 == 0:
            y_lat, y_ctx = attn_gla_mixer(u_lat, u_ctx, cos, sin, w_in_even[i], w_out_even[i], attn_sink[i],
                                          gla_wa2[i], gla_ba[i], gla_norm_w[i], need_ctx)
        else:
            y_lat = short_conv_mixer(u_lat, w_in_odd[i], conv_w[i], conv_b[i], w_out_odd[i])
            y_ctx = short_conv_mixer(u_ctx, w_in_odd[i], conv_w[i], conv_b[i], w_out_odd[i]) if need_ctx else None
        h_lat = post_norm(h_lat, m[2] * y_lat, ln_w[l, 0], ln_b[l, 0])
        tokens = modulate(h_lat, m[3], m[4]).reshape(B * S, D)
        if need_ctx:
            h_ctx = post_norm(h_ctx, mc[2] * y_ctx, ln_w[l, 0], ln_b[l, 0])
            tokens = jnp.concatenate([tokens, modulate(h_ctx, mc[3], mc[4]).reshape(B * L, D)], 0)
        y = hier_moe(tokens, router_wg[l], router_bg[l], router_we[l], router_be[l], moe_w1[l], moe_w3[l], moe_w2[l])
        h_lat = post_norm(h_lat, m[5] * y[:B * S].reshape(B, S, D), ln_w[l, 1], ln_b[l, 1])
        if need_ctx:
            h_ctx = post_norm(h_ctx, mc[5] * y[B * S:].reshape(B, L, D), ln_w[l, 1], ln_b[l, 1])
    return h_lat
```

```cpp
#include <hip/hip_runtime.h>
#define N_LAUNCH_MODE 1
#define KO_MASK 0
#define DUP_MASK 0
#include <cstdio>
#include <cstdint>

#ifndef KO_MASK
#define KO_MASK 0
#endif
#ifndef N_LAUNCH_MODE
#define N_LAUNCH_MODE 1
#endif

#define GAS __attribute__((address_space(1)))
#define LAS __attribute__((address_space(3)))
typedef unsigned short bf16;
typedef short bf16x8 __attribute__((ext_vector_type(8)));
typedef short s16x4 __attribute__((ext_vector_type(4)));
typedef float f32x2 __attribute__((ext_vector_type(2)));
typedef float f32x4 __attribute__((ext_vector_type(4)));
typedef float f32x16 __attribute__((ext_vector_type(16)));
typedef unsigned u32x2 __attribute__((ext_vector_type(2)));
typedef unsigned u32x4 __attribute__((ext_vector_type(4)));
typedef __bf16 bf16x2_t __attribute__((ext_vector_type(2)));
typedef int i32x8 __attribute__((ext_vector_type(8)));
typedef int i32x4_t __attribute__((ext_vector_type(4)));

constexpr int D = 1024, NB = 16, SEQ = 4096, CTXL = 256, DEPTH = 4;
constexpr int NLAT = NB * SEQ, NCTX = NB * CTXL, NTOK = NLAT + NCTX;
constexpr int EVEN_IN = 2336, EN = 2560, ON = 3072;
constexpr int NEXP = 32, DEXP = 512;
constexpr int SLOT_ROWS = 2 * NTOK + NEXP * 256;
constexpr float DN_ALPHA = 1.6817928305074290f;
constexpr float LN_EPS = 1e-5f, RMS_EPS = 1e-6f;
constexpr float LOG2E = 1.4426950408889634f;
constexpr int PC_Q = 0, PC_K = 512, PC_V = 640, PC_QG = 768, PC_KG = 1024, PC_VG = 1280, PC_RG = 1792, PC_GG = 2304;
constexpr int NCHUNK = 68;

constexpr size_t MiB = 1u << 20;
constexpr size_t WS_CTL = 0, CTL_BYTES = 1 * MiB;
constexpr size_t WS_MOD = 1 * MiB;
constexpr size_t WS_ROPE = 3 * MiB;
constexpr size_t WS_TOKINFO = 4 * MiB;
constexpr size_t WS_ROWTOK = 7 * MiB;
constexpr size_t WS_WINE = 16 * MiB, WS_WOUTE = 26 * MiB, WS_WINO = 30 * MiB, WS_WOUTO = 42 * MiB;
constexpr size_t WS_W13 = 46 * MiB, WS_W2 = 110 * MiB;
constexpr size_t WS_HCTX = 142 * MiB;
constexpr size_t WS_U = 158 * MiB;
constexpr size_t WS_P = 294 * MiB;
constexpr size_t WS_Q = 634 * MiB;
constexpr size_t WS_GATT = 778 * MiB, WS_GQIN = 846 * MiB, WS_GKST = 914 * MiB, WS_GVT = 982 * MiB, WS_GDEC = 1050 * MiB;
constexpr size_t WS_U8 = 1053 * MiB;
constexpr size_t WS_END = 1121 * MiB;
constexpr int CW_BAR = 4096;
constexpr int CW_CNT = 16384;
constexpr int CW_WQ = 20480;

constexpr int RING_BYTES = 131072;
constexpr int LDSX_OFF = RING_BYTES;
constexpr int MISC_OFF = LDSX_OFF + 8192;
constexpr int LDS_BYTES = 147456;

__device__ __forceinline__ unsigned pk2(float a, float b) { bf16x2_t r = __builtin_convertvector((f32x2){a, b}, bf16x2_t); return __builtin_bit_cast(unsigned, r); }
__device__ __forceinline__ unsigned pk4_fp8(float a, float b, float c, float d) { int r = __builtin_amdgcn_cvt_pk_fp8_f32(a, b, 0, false); r = __builtin_amdgcn_cvt_pk_fp8_f32(c, d, r, true); return (unsigned)r; }
__device__ __forceinline__ float bf2f(unsigned short h) { return __uint_as_float(((unsigned)h) << 16); }
__device__ __forceinline__ float bflo(unsigned w) { return __uint_as_float(w << 16); }
__device__ __forceinline__ float bfhi(unsigned w) { return __uint_as_float(w & 0xffff0000u); }
template <int CTRL> __device__ __forceinline__ float dppf(float v) { return __builtin_bit_cast(float, __builtin_amdgcn_update_dpp(0, __builtin_bit_cast(int, v), CTRL, 0xf, 0xf, false)); }
__device__ __forceinline__ float row16_sum(float v) { v += dppf<0xB1>(v); v += dppf<0x4E>(v); v += dppf<0x141>(v); v += dppf<0x140>(v); return v; }
__device__ __forceinline__ float wave_sum(float v) {
    v = row16_sum(v);
    const float s0 = __builtin_bit_cast(float, __builtin_amdgcn_readlane(__builtin_bit_cast(int, v), 0)), s1 = __builtin_bit_cast(float, __builtin_amdgcn_readlane(__builtin_bit_cast(int, v), 16));
    const float s2 = __builtin_bit_cast(float, __builtin_amdgcn_readlane(__builtin_bit_cast(int, v), 32)), s3 = __builtin_bit_cast(float, __builtin_amdgcn_readlane(__builtin_bit_cast(int, v), 48));
    return (s0 + s1) + (s2 + s3);
}
__device__ __forceinline__ float fast_silu(float x) { return x * __builtin_amdgcn_rcpf(1.0f + __builtin_amdgcn_exp2f(-x * LOG2E)); }

#define XB_TMO      128
#define XB_XCNT(j)  (256  + 64 * (j))
#define XB_XSUB(j)  (1280 + 64 * (j))
#define XB_XGEN(j)  (2304 + 64 * (j))
#define XB_TOP      3328
#define XB_TOPGEN   3392
#define XCD_BAR_WORDS 3456
#define XB_SPIN_CAP (1u << 22)
__device__ __forceinline__ unsigned xb_ld(unsigned* p)              { return __hip_atomic_load(p, __ATOMIC_RELAXED, __HIP_MEMORY_SCOPE_AGENT); }
__device__ __forceinline__ unsigned xb_add(unsigned* p, unsigned v) { return __hip_atomic_fetch_add(p, v, __ATOMIC_RELAXED, __HIP_MEMORY_SCOPE_AGENT); }
__device__ __forceinline__ unsigned xb_xcc_id() { return (unsigned)__builtin_amdgcn_s_getreg((3 << 11) | 20) & 0xFu; }
#define XB_SPIN(cond, bar) do { unsigned _sp = 0; while (cond) { __builtin_amdgcn_s_sleep(1); \
    if ((++_sp & 255u) == 0u) { if (xb_ld(&(bar)[XB_TMO])) break; if (_sp > XB_SPIN_CAP) { atomicAdd(&(bar)[XB_TMO], 1u); break; } } } } while (0)
struct XcdBarrier { unsigned* bar; unsigned x; volatile LAS unsigned* st; };
__device__ __forceinline__ XcdBarrier xcd_barrier_post(unsigned* bar, volatile LAS unsigned* st) {
    XcdBarrier b; b.bar = bar; b.x = xb_xcc_id(); b.st = st;
    if (threadIdx.x == 0) (void)xb_add(&bar[XB_XCNT(b.x)], 1u);
    return b;
}
__device__ __forceinline__ void xcd_barrier_complete(unsigned* bar, unsigned x, unsigned& nloc, unsigned& nx) {
    const unsigned G = gridDim.x * gridDim.y * gridDim.z;
    unsigned sum, cnt, mine, sp = 0u;
    for (;;) {
        sum = 0u; cnt = 0u; mine = 0u;
#pragma unroll
        for (unsigned j = 0; j < 16; ++j) { const unsigned c = xb_ld(&bar[XB_XCNT(j)]); sum += c; cnt += (c > 0u) ? 1u : 0u; mine = (j == x) ? c : mine; }
        if (sum == G) break;
        __builtin_amdgcn_s_sleep(1);
        if ((++sp & 255u) == 0u) { if (xb_ld(&bar[XB_TMO])) break; if (sp > XB_SPIN_CAP) { atomicAdd(&bar[XB_TMO], 1u); break; } }
    }
    nloc = mine > 0u ? mine : 1u; nx = cnt > 0u ? cnt : 1u;
}
__device__ __forceinline__ void xcd_barrier(const XcdBarrier& b) {
    asm volatile("s_waitcnt vmcnt(0)" ::: "memory");
    __syncthreads();
    if (threadIdx.x == 0) {
        unsigned* bar = b.bar;
        __builtin_amdgcn_s_waitcnt(0);
        unsigned nloc = b.st[0], nx = b.st[1];
        if (nloc == 0u) { xcd_barrier_complete(bar, b.x, nloc, nx); b.st[0] = nloc; b.st[1] = nx; }
        const unsigned old = xb_add(&bar[XB_XSUB(b.x)], 1u);
        const unsigned gen = old / nloc;
        if (old + 1u == (gen + 1u) * nloc) {
            __builtin_amdgcn_fence(__ATOMIC_RELEASE, "agent");
            asm volatile("s_waitcnt vmcnt(0)" ::: "memory");
            const unsigned og = xb_add(&bar[XB_TOP], 1u);
            const unsigned tg = og / nx;
            if (og + 1u == (tg + 1u) * nx) xb_add(&bar[XB_TOPGEN], 1u);
            else XB_SPIN(xb_ld(&bar[XB_TOPGEN]) == tg, bar);
            __builtin_amdgcn_fence(__ATOMIC_ACQUIRE, "agent");
            xb_add(&bar[XB_XGEN(b.x)], 1u);
            asm volatile("s_waitcnt vmcnt(0)" ::: "memory");
        } else {
            XB_SPIN(xb_ld(&bar[XB_XGEN(b.x)]) == gen, bar);
            __builtin_amdgcn_fence(__ATOMIC_ACQUIRE, "agent");
            asm volatile("s_waitcnt vmcnt(0)" ::: "memory");
        }
    }
    __syncthreads();
}

namespace pg8 {
constexpr int BM = 256, BK = 64, HALF = 128, HTB = HALF * BK * 2, STAGE_BYTES = 8 * HTB;
__device__ __forceinline__ int lds_byte(int r, int c) { const int st = (r >> 4) * 2 + (c >> 5), rr = r & 15, cc = c & 31, ob = rr * 64 + cc * 2; return st * 1024 + (ob ^ (((ob >> 9) & 1) << 5)); }
__device__ __forceinline__ void stage_rc(int b, int& R, int& C) { const int st = b / 1024, sb = b % 1024, swz = sb ^ (((sb >> 9) & 1) << 5); R = (st >> 1) * 16 + swz / 64; C = (st & 1) * 32 + (swz % 64) / 2; }
__device__ __forceinline__ int perm32(int rho) { const int n = rho >> 4, i = rho & 15; return 8 * (i >> 2) + 4 * n + (i & 3); }

struct Unit { int pn; int orow0; int mt; int e; };

template <class Epi, class Sched, int FP8 = 0>
__device__ __forceinline__ void gemm_phase(LAS unsigned char* lds, const char* Abase, const char* Bbase, const int K, const Sched& S, const Epi& E) {
    int tid_ = threadIdx.x; asm volatile("" : "+v"(tid_));
    const int tid = tid_, wid = __builtin_amdgcn_readfirstlane(tid >> 6), lane = tid & 63, wr = wid >> 2, wc = wid & 3, fr = lane & 15, fq = lane >> 4;
    const unsigned K2 = FP8 ? (unsigned)K : (unsigned)K * 2u;
    const int nt = (int)(K2 / 128u);
    int Rr[2], Cc[2]; unsigned voffB[2];
#pragma unroll
    for (int i = 0; i < 2; ++i) { stage_rc(tid * 16 + i * 8192, Rr[i], Cc[i]); const int Rb = (Rr[i] & ~31) + perm32(Rr[i] & 31); voffB[i] = (unsigned)Rb * K2 + (unsigned)Cc[i] * 2u; }
    const size_t kstep = (size_t)(BK * 2);
    const size_t hstep = (size_t)HALF * K2;
    const unsigned ldsw = (unsigned)wid * 1024u;
    const int aoff = FP8 ? lds_byte(wr * 64 + fr, 32 * (fq >> 1) + 16 * (fq & 1)) : lds_byte(wr * 64 + fr, fq * 8), boff = FP8 ? lds_byte(wc * 32 + fr, 32 * (fq >> 1) + 16 * (fq & 1)) : lds_byte(wc * 32 + fr, fq * 8);
#define PG8_SA(b, h) (((b) * 2 + (h)) * HTB)
#define PG8_SB(b, h) ((4 + (b) * 2 + (h)) * HTB)
#define PG8_STAGE(bufoff, gbase, voff) do { _Pragma("unroll") for (int _i = 0; _i < 2; ++_i) \
        __builtin_amdgcn_global_load_lds((const unsigned*)((const char*)(gbase) + (voff)[_i]), (LAS unsigned*)(lds + (bufoff) + ldsw + _i * 8192), 16, 0, 0); } while (0)
#define PG8_LD8(ptr) __builtin_shufflevector(*(const LAS i32x4_t*)(ptr), *(const LAS i32x4_t*)((ptr) + 16), 0, 1, 2, 3, 4, 5, 6, 7)
#define PG8_LDA(dst, b, h) do { if constexpr (FP8) { _Pragma("unroll") for (int m = 0; m < 4; ++m) dst##8[m] = PG8_LD8(lds + PG8_SA(b, h) + aoff + m * 2048); } \
        else { _Pragma("unroll") for (int m = 0; m < 4; ++m) _Pragma("unroll") for (int k = 0; k < 2; ++k) dst[m][k] = *(const LAS bf16x8*)(lds + PG8_SA(b, h) + aoff + m * 2048 + k * 1024); } } while (0)
#define PG8_LDB(dst, b, h) do { if constexpr (FP8) { _Pragma("unroll") for (int n = 0; n < 2; ++n) dst##8[n] = PG8_LD8(lds + PG8_SB(b, h) + boff + n * 2048); } \
        else { _Pragma("unroll") for (int n = 0; n < 2; ++n) _Pragma("unroll") for (int k = 0; k < 2; ++k) dst[n][k] = *(const LAS bf16x8*)(lds + PG8_SB(b, h) + boff + n * 2048 + k * 1024); } } while (0)
#define PG8_MMA(ai, bj, At, Bt) do { __builtin_amdgcn_s_setprio(1); _Pragma("unroll") for (int m = 0; m < 4; ++m) _Pragma("unroll") for (int n = 0; n < 2; ++n) { \
        if constexpr (FP8) asm volatile("v_mfma_f32_16x16x128_f8f6f4 %0, %1, %2, %0" : "+v"(acc[ai][bj][m][n]) : "v"(Bt##8[n]), "v"(At##8[m])); \
        else { _Pragma("unroll") for (int k = 0; k < 2; ++k) acc[ai][bj][m][n] = __builtin_amdgcn_mfma_f32_16x16x32_bf16(Bt[n][k], At[m][k], acc[ai][bj][m][n], 0, 0, 0); } } \
        __builtin_amdgcn_s_setprio(0); } while (0)
#define PG8_WAIT_V(n) asm volatile("s_waitcnt vmcnt(" #n ")" ::: "memory")
#define PG8_WAIT_L(n) asm volatile("s_waitcnt lgkmcnt(" #n ")" ::: "memory")
#define PG8_BAR __builtin_amdgcn_s_barrier()
#define PG8_SCHED __builtin_amdgcn_sched_barrier(0)
    Unit cur, nxt; int ui = 0;
    if (!S.next(0, cur)) return;
    f32x4 acc[2][2][4][2];
#pragma unroll
    for (int a = 0; a < 2; ++a)
#pragma unroll
        for (int b = 0; b < 2; ++b)
#pragma unroll
            for (int m = 0; m < 4; ++m)
#pragma unroll
                for (int n = 0; n < 2; ++n) acc[a][b][m][n] = (f32x4){0.f, 0.f, 0.f, 0.f};
    bf16x8 At[4][2], B0[2][2], B1[2][2];
    i32x8 At8[4], B08[2], B18[2];
    unsigned vAc0[2], vAc1[2], vAn0[2], vAn1[2];
#pragma unroll
    for (int i = 0; i < 2; ++i) { vAc0[i] = (unsigned)S.arow(cur, Rr[i]) * K2 + (unsigned)Cc[i] * 2u; vAc1[i] = (unsigned)S.arow(cur, HALF + Rr[i]) * K2 + (unsigned)Cc[i] * 2u; vAn0[i] = vAc0[i]; vAn1[i] = vAc1[i]; }
    const char* cB = Bbase + S.boff(cur);
    PG8_STAGE(PG8_SB(0, 0), cB, voffB); PG8_STAGE(PG8_SB(0, 1), cB + hstep, voffB); PG8_STAGE(PG8_SA(0, 0), Abase, vAc0); PG8_STAGE(PG8_SA(0, 1), Abase, vAc1);
    if (wr == 1) PG8_BAR;
    PG8_WAIT_V(2); PG8_BAR;
    PG8_STAGE(PG8_SB(1, 0), cB + kstep, voffB); PG8_STAGE(PG8_SA(1, 0), Abase + kstep, vAc0); PG8_STAGE(PG8_SB(1, 1), cB + hstep + kstep, voffB);
    PG8_WAIT_V(6); PG8_BAR;
    for (;;) {
        const bool has_next = S.next(ui + 1, nxt);
        const char* nB = has_next ? Bbase + S.boff(nxt) : cB;
        if (has_next) {
#pragma unroll
            for (int i = 0; i < 2; ++i) { vAn0[i] = (unsigned)S.arow(nxt, Rr[i]) * K2 + (unsigned)Cc[i] * 2u; vAn1[i] = (unsigned)S.arow(nxt, HALF + Rr[i]) * K2 + (unsigned)Cc[i] * 2u; }
        } else {
#pragma unroll
            for (int i = 0; i < 2; ++i) { vAn0[i] = vAc0[i]; vAn1[i] = vAc1[i]; }
        }
        for (int t = 0; t < nt; t += 2) {
            const bool last = (t == nt - 2);
            const char* a1 = Abase + (size_t)(t + 1) * kstep;
            const char* a2 = last ? Abase : Abase + (size_t)(t + 2) * kstep; const char* b2 = last ? nB : cB + (size_t)(t + 2) * kstep;
            const char* a3 = a2 + kstep; const char* b3 = b2 + kstep;
            unsigned v20[2], v21[2];
#pragma unroll
            for (int i = 0; i < 2; ++i) { v20[i] = last ? vAn0[i] : vAc0[i]; v21[i] = last ? vAn1[i] : vAc1[i]; }
            PG8_LDB(B0, 0, 0); PG8_LDB(B1, 0, 1); PG8_SCHED; PG8_LDA(At, 0, 0); PG8_STAGE(PG8_SA(1, 1), a1, vAc1);
            PG8_WAIT_V(8); PG8_WAIT_L(0); PG8_BAR; PG8_MMA(0, 0, At, B0); PG8_MMA(0, 1, At, B1); PG8_BAR; PG8_SCHED;
            PG8_LDA(At, 0, 1); PG8_STAGE(PG8_SB(0, 0), b2, voffB); PG8_STAGE(PG8_SB(0, 1), b2 + hstep, voffB); PG8_STAGE(PG8_SA(0, 0), a2, v20);
            PG8_WAIT_V(8); PG8_WAIT_L(0); PG8_BAR; PG8_MMA(1, 0, At, B0); PG8_MMA(1, 1, At, B1); PG8_BAR; PG8_SCHED;
            PG8_LDB(B0, 1, 0); PG8_LDB(B1, 1, 1); PG8_SCHED; PG8_LDA(At, 1, 0); PG8_STAGE(PG8_SA(0, 1), a2, v21);
            PG8_WAIT_V(8); PG8_WAIT_L(0); PG8_BAR; PG8_MMA(0, 0, At, B0); PG8_MMA(0, 1, At, B1); PG8_BAR; PG8_SCHED;
            PG8_LDA(At, 1, 1); PG8_STAGE(PG8_SB(1, 0), b3, voffB); PG8_STAGE(PG8_SB(1, 1), b3 + hstep, voffB); PG8_STAGE(PG8_SA(1, 0), a3, v20);
            PG8_WAIT_V(8); PG8_WAIT_L(0); PG8_BAR; PG8_MMA(1, 0, At, B0); PG8_MMA(1, 1, At, B1); PG8_BAR; PG8_SCHED;
        }
        if (wr == 0) PG8_BAR;
        if constexpr (FP8) asm volatile("s_nop 15\n\ts_nop 15" ::: "memory");
        E(acc, cur, wr, wc, fr, fq);
        if (!has_next) break;
#pragma unroll
        for (int a = 0; a < 2; ++a)
#pragma unroll
            for (int b = 0; b < 2; ++b)
#pragma unroll
                for (int m = 0; m < 4; ++m)
#pragma unroll
                    for (int n = 0; n < 2; ++n) acc[a][b][m][n] = (f32x4){0.f, 0.f, 0.f, 0.f};
        cur = nxt; cB = nB; ++ui;
#pragma unroll
        for (int i = 0; i < 2; ++i) { vAc0[i] = vAn0[i]; vAc1[i] = vAn1[i]; }
        if (wr == 1) PG8_BAR;
    }
    PG8_WAIT_V(0);
    PG8_BAR;
#undef PG8_SA
#undef PG8_SB
#undef PG8_STAGE
#undef PG8_LDA
#undef PG8_LDB
#undef PG8_MMA
#undef PG8_WAIT_V
#undef PG8_WAIT_L
#undef PG8_BAR
#undef PG8_SCHED
}
}
struct LinSched {
    int nM, nN, nwg, G, c; size_t bstride;
    __device__ __forceinline__ void init(int M, int N, int K, int G_, int c_) { nM = M / 256; nN = N / 256; nwg = nM * nN; G = G_; c = c_; bstride = (size_t)256 * K * 2; }
    __device__ __forceinline__ bool next(int i, pg8::Unit& u) const {
        const long L = (long)i * G + c; if (L >= nwg) return false;
        int wgid = (int)L; { const int q = nwg / 8, r = nwg % 8, xcd = wgid % 8, off = wgid / 8; wgid = (xcd < r ? xcd * (q + 1) : r * (q + 1) + (xcd - r) * q) + off; }
        const int nig = 8 * nN, gid = wgid / nig, fm = gid * 8, gsz = (nM - fm) < 8 ? (nM - fm) : 8;
        u.mt = fm + ((wgid % nig) % gsz); u.pn = (wgid % nig) / gsz; u.orow0 = u.mt * 256; u.e = 0; return true;
    }
    __device__ __forceinline__ int arow(const pg8::Unit& u, int lr) const { return u.orow0 + lr; }
    __device__ __forceinline__ size_t boff(const pg8::Unit& u) const { return (size_t)u.pn * bstride; }
};
struct MoeTab { LAS int* ts; LAS int* cnt; LAS unsigned char* tile_e; };
__device__ __forceinline__ MoeTab moe_tab(LAS unsigned char* lds) { MoeTab t; t.ts = (LAS int*)(lds + LDSX_OFF); t.cnt = (LAS int*)(lds + LDSX_OFF + 256); t.tile_e = (LAS unsigned char*)(lds + LDSX_OFF + 512); return t; }
__device__ __forceinline__ void moe_tables(LAS unsigned char* lds, const unsigned* gcnt) {
    MoeTab T = moe_tab(lds);
    __syncthreads();
    if (threadIdx.x == 0) { int s = 0; for (int e = 0; e < NEXP; ++e) { const int c = (int)gcnt[e]; T.cnt[e] = c; T.ts[e] = s; s += (c + 255) >> 8; } T.ts[NEXP] = s; }
    __syncthreads();
    const int nt = T.ts[NEXP];
    for (int mt = threadIdx.x; mt < nt; mt += blockDim.x) { int e = 0; for (int j = 1; j < NEXP; ++j) e += (mt >= T.ts[j]) ? 1 : 0; T.tile_e[mt] = (unsigned char)e; }
    __syncthreads();
}
template <int GATHER> struct MoeSched {
    MoeTab T; const int* rowtok; int G, c; size_t bstride; size_t estride;
    __device__ __forceinline__ bool next(int i, pg8::Unit& u) const {
        const int L = i * G + c; const int nt = T.ts[NEXP]; if (L >= nt * 4) return false;
        u.mt = L >> 2; u.pn = L & 3; u.orow0 = u.mt * 256; u.e = (int)T.tile_e[u.mt]; return true;
    }
    __device__ __forceinline__ int arow(const pg8::Unit& u, int lr) const {
        if (GATHER) { const int idx = (u.mt - T.ts[u.e]) * 256 + lr; return idx < T.cnt[u.e] ? rowtok[(size_t)u.e * NTOK + idx] : 0; }
        return u.orow0 + lr;
    }
    __device__ __forceinline__ size_t boff(const pg8::Unit& u) const { return (size_t)u.e * estride + (size_t)u.pn * bstride; }
};

__device__ __forceinline__ u32x4 pack8(const f32x4 a, const f32x4 b) { u32x4 w; w.x = pk2(a[0], a[1]); w.y = pk2(a[2], a[3]); w.z = pk2(b[0], b[1]); w.w = pk2(b[2], b[3]); return w; }
struct EpiPlain {
    bf16* O; int ldc;
    __device__ __forceinline__ void operator()(const f32x4 (&acc)[2][2][4][2], const pg8::Unit& u, int wr, int wc, int fr, int fq) const {
        const int row0 = u.orow0 + wr * 64 + fr, col0 = u.pn * 256 + wc * 32 + 8 * fq;
#pragma unroll
        for (int ai = 0; ai < 2; ++ai)
#pragma unroll
            for (int m = 0; m < 4; ++m) { bf16* rowp = O + (size_t)(row0 + ai * 128 + m * 16) * ldc + col0;
#pragma unroll
                for (int bj = 0; bj < 2; ++bj) *(u32x4*)(rowp + bj * 128) = pack8(acc[ai][bj][m][0], acc[ai][bj][m][1]); }
    }
};
struct EpiPlainS {
    bf16* O; int ldc; float sc;
    __device__ __forceinline__ void operator()(const f32x4 (&acc)[2][2][4][2], const pg8::Unit& u, int wr, int wc, int fr, int fq) const {
        const int row0 = u.orow0 + wr * 64 + fr, col0 = u.pn * 256 + wc * 32 + 8 * fq;
#pragma unroll
        for (int ai = 0; ai < 2; ++ai)
#pragma unroll
            for (int m = 0; m < 4; ++m) { bf16* rowp = O + (size_t)(row0 + ai * 128 + m * 16) * ldc + col0;
#pragma unroll
                for (int bj = 0; bj < 2; ++bj) *(u32x4*)(rowp + bj * 128) = pack8(acc[ai][bj][m][0] * sc, acc[ai][bj][m][1] * sc); }
    }
};
struct EpiEvenIn {
    bf16* O; const float* rope;
    __device__ __forceinline__ void operator()(const f32x4 (&acc)[2][2][4][2], const pg8::Unit& u, int wr, int wc, int fr, int fq) const {
        const int row0 = u.orow0 + wr * 64 + fr, col0 = u.pn * 256 + wc * 32 + 8 * fq;
        const bool lat = u.orow0 < NLAT;
#pragma unroll
        for (int ai = 0; ai < 2; ++ai)
#pragma unroll
            for (int m = 0; m < 4; ++m) { const int row = row0 + ai * 128 + m * 16; bf16* rowp = O + (size_t)row * EN + col0;
                const int s = row & (SEQ - 1); const int pos = (wc & 1) ? (s & 63) : (s >> 6);
#pragma unroll
                for (int bj = 0; bj < 2; ++bj) { f32x4 v0 = acc[ai][bj][m][0], v1 = acc[ai][bj][m][1];
                    const bool rp = lat && (u.pn < 2 || (u.pn == 2 && bj == 0));
                    if (rp) { const f32x4 c = *(const f32x4*)(rope + pos * 16 + 4 * fq), sn = *(const f32x4*)(rope + 1024 + pos * 16 + 4 * fq);
                        const f32x4 o1 = v0 * c - v1 * sn, o2 = v1 * c + v0 * sn; v0 = o1; v1 = o2; }
                    *(u32x4*)(rowp + bj * 128) = pack8(v0, v1); } }
    }
};
struct EpiOddIn {
    bf16* O;
    __device__ __forceinline__ void operator()(const f32x4 (&acc)[2][2][4][2], const pg8::Unit& u, int wr, int wc, int fr, int fq) const {
        const int row0 = u.orow0 + wr * 64 + fr;
#pragma unroll
        for (int ai = 0; ai < 2; ++ai)
#pragma unroll
            for (int m = 0; m < 4; ++m) { bf16* rowp = O + (size_t)(row0 + ai * 128 + m * 16) * 2048;
                if (u.pn < 4) {
#pragma unroll
                    for (int bj = 0; bj < 2; ++bj) *(u32x4*)(rowp + u.pn * 256 + bj * 128 + wc * 32 + 8 * fq) = pack8(acc[ai][bj][m][0], acc[ai][bj][m][1]);
                } else {
                    *(u32x4*)(rowp + 1024 + (u.pn - 4) * 128 + wc * 32 + 8 * fq) = pack8(acc[ai][0][m][0] * acc[ai][1][m][0], acc[ai][0][m][1] * acc[ai][1][m][1]);
                } }
    }
};
struct EpiG1 {
    unsigned char* O; float sc;
    __device__ __forceinline__ void operator()(const f32x4 (&acc)[2][2][4][2], const pg8::Unit& u, int wr, int wc, int fr, int fq) const {
        const int row0 = u.orow0 + wr * 64 + fr, col0 = u.pn * 128 + wc * 32 + 8 * fq;
#pragma unroll
        for (int ai = 0; ai < 2; ++ai)
#pragma unroll
            for (int m = 0; m < 4; ++m) { unsigned char* rowp = O + (size_t)(row0 + ai * 128 + m * 16) * DEXP + col0;
                f32x4 a0 = acc[ai][0][m][0] * sc, a1 = acc[ai][0][m][1] * sc;
#pragma unroll
                for (int j = 0; j < 4; ++j) { a0[j] = fast_silu(a0[j]); a1[j] = fast_silu(a1[j]); }
                const f32x4 h0 = a0 * (acc[ai][1][m][0] * sc), h1v = a1 * (acc[ai][1][m][1] * sc);
                *(u32x2*)rowp = (u32x2){pk4_fp8(h0[0], h0[1], h0[2], h0[3]), pk4_fp8(h1v[0], h1v[1], h1v[2], h1v[3])}; }
    }
};
struct Frame {
    LAS unsigned char* lds;
    int tid, lane, wave, vcu, G;
    float* out; unsigned char* ws;
};
__device__ __forceinline__ const float* inptr(const Frame& F, int i) {
    const unsigned long long v = ((const LAS unsigned long long*)(F.lds + MISC_OFF + 256))[i];
    const unsigned lo = __builtin_amdgcn_readfirstlane((unsigned)v), hi = __builtin_amdgcn_readfirstlane((unsigned)(v >> 32));
    return (const float*)(((unsigned long long)hi << 32) | lo);
}
enum { I_X = 0, I_C, I_CTX, I_CCTX, I_WINE, I_WOUTE, I_SINK, I_WA2, I_BA, I_NORMW, I_WINO, I_CONVW, I_CONVB, I_WOUTO, I_ADAW, I_ADAB, I_LNW, I_LNB, I_WG, I_BG, I_WE, I_BE, I_W1, I_W3, I_W2 };
__device__ __forceinline__ int launder_v(int x) { asm volatile("" : "+v"(x)); return x; }
__device__ __forceinline__ int launder_s(int x) { asm volatile("" : "+s"(x)); return x; }
__device__ __forceinline__ Frame relaunder(const Frame& F0) { Frame F = F0; F.tid = launder_v(F0.tid); F.lane = F.tid & 63; F.wave = __builtin_amdgcn_readfirstlane(F.tid >> 6); F.vcu = launder_s(F0.vcu); return F; }
__device__ __forceinline__ const float* modp(const Frame& F, int l, int bi, int n) { return (const float*)(F.ws + WS_MOD) + ((size_t)(l * 17 + bi) * 6 + n) * D; }
__device__ __forceinline__ int row_bi(int row) { return row < NLAT ? (row >> 12) : 16; }

__device__ __forceinline__ void sincos_d(double a, float& c, float& s) {
    const double TWO_OVER_PI = 0.63661977236758134308, PIO2_HI = 1.57079632679489655800e+00, PIO2_LO = 6.12323399573676603587e-17;
    const double n = __builtin_rint(a * TWO_OVER_PI); double r = (a - n * PIO2_HI) - n * PIO2_LO; const double r2 = r * r;
    double sp = -1.0 / 1307674368000.0; sp = sp * r2 + 1.0 / 6227020800.0; sp = sp * r2 - 1.0 / 39916800.0; sp = sp * r2 + 1.0 / 362880.0; sp = sp * r2 - 1.0 / 5040.0; sp = sp * r2 + 1.0 / 120.0; sp = sp * r2 - 1.0 / 6.0; sp = sp * r2 + 1.0; sp *= r;
    double cp = 1.0 / 20922789888000.0; cp = cp * r2 - 1.0 / 87178291200.0; cp = cp * r2 + 1.0 / 479001600.0; cp = cp * r2 - 1.0 / 3628800.0; cp = cp * r2 + 1.0 / 40320.0; cp = cp * r2 - 1.0 / 720.0; cp = cp * r2 + 1.0 / 24.0; cp = cp * r2 - 0.5; cp = cp * r2 + 1.0;
    const int q = ((int)n) & 3;
    const double sv = (q == 0) ? sp : (q == 1) ? cp : (q == 2) ? -sp : -cp;
    const double cv = (q == 0) ? cp : (q == 1) ? -sp : (q == 2) ? -cp : sp;
    c = (float)cv; s = (float)sv;
}
__device__ __forceinline__ void ph_ada(const Frame& F0) {
    Frame F = relaunder(F0);
    LAS float* sl = (LAS float*)F.lds;
    LAS float* red = (LAS float*)(F.lds + 17 * 1024 * 4);
    for (int idx = F.tid; idx < 17 * 1024; idx += 512) { const int bi = idx >> 10, k = idx & 1023; const float c = bi < 16 ? inptr(F, I_C)[bi * 1024 + k] : inptr(F, I_CCTX)[k]; sl[idx] = c / (1.0f + expf(-c)); }
    __syncthreads();
    for (int it = F.vcu; it < 4 * 96; it += F.G) {
        const int l = it / 96, n0 = (it % 96) * 64;
        const float* W = inptr(F, I_ADAW) + (size_t)l * 1024 * 6144 + n0 + F.lane;
        float acc[17];
#pragma unroll
        for (int b = 0; b < 17; ++b) acc[b] = 0.f;
        const int kb = F.wave * 128;
        for (int k = kb; k < kb + 128; k += 4) {
            const float w0 = W[(size_t)k * 6144], w1 = W[(size_t)(k + 1) * 6144], w2 = W[(size_t)(k + 2) * 6144], w3 = W[(size_t)(k + 3) * 6144];
#pragma unroll
            for (int b = 0; b < 17; ++b) { const f32x4 s = *(const LAS f32x4*)(sl + b * 1024 + k); acc[b] += s[0] * w0 + s[1] * w1 + s[2] * w2 + s[3] * w3; }
        }
#pragma unroll
        for (int b = 0; b < 17; ++b) red[(F.wave * 17 + b) * 64 + F.lane] = acc[b];
        __syncthreads();
        for (int idx = F.tid; idx < 17 * 64; idx += 512) { const int b = idx >> 6, ln = idx & 63; float s = 0.f;
#pragma unroll
            for (int w = 0; w < 8; ++w) s += red[(w * 17 + b) * 64 + ln];
            ((float*)(F.ws + WS_MOD))[(size_t)(l * 17 + b) * 6144 + n0 + ln] = s + inptr(F, I_ADAB)[l * 6144 + n0 + ln]; }
        __syncthreads();
    }
    if (F.vcu == F.G - 1) {
        float* rope = (float*)(F.ws + WS_ROPE);
        for (int idx = F.tid; idx < 1024; idx += 512) { const int pos = idx >> 4, f = idx & 15;
            const double base4[4] = {1.0, 0.56234132519034908, 0.31622776601683794, 0.17782794100389228};
            double inv = (f & 3) == 0 ? base4[0] : (f & 3) == 1 ? base4[1] : (f & 3) == 2 ? base4[2] : base4[3];
            const int a = f >> 2; inv *= (a == 0) ? 1.0 : (a == 1) ? 0.1 : (a == 2) ? 0.01 : 0.001;
            float c, s; sincos_d((double)pos * inv, c, s); rope[idx] = c; rope[1024 + idx] = s; }
    }
}

__device__ __forceinline__ void tr_item(const float* W, int srcN, int K, bf16* WT, int drow0, int k0, int srccol, LAS float* scr, int lane) {
    float v[32];
    const float* p = W + (size_t)(k0 + (lane >> 5)) * srcN + (srccol >= 0 ? srccol : 0);
#pragma unroll
    for (int i = 0; i < 32; ++i) v[i] = p[(size_t)(2 * i) * srcN];
#pragma unroll
    for (int i = 0; i < 32; ++i) scr[(2 * i + (lane >> 5)) * 33 + (lane & 31)] = srccol >= 0 ? v[i] : 0.f;
    asm volatile("s_waitcnt lgkmcnt(0)" ::: "memory");
    const int c = lane & 7;
#pragma unroll
    for (int j = 0; j < 4; ++j) { const int n = (lane >> 3) + 8 * j; const LAS float* s = scr + (8 * c) * 33 + n;
        u32x4 o; o.x = pk2(s[0 * 33], s[1 * 33]); o.y = pk2(s[2 * 33], s[3 * 33]); o.z = pk2(s[4 * 33], s[5 * 33]); o.w = pk2(s[6 * 33], s[7 * 33]);
        *(u32x4*)(WT + (size_t)(drow0 + n) * K + k0 + 8 * c) = o; }
    asm volatile("s_waitcnt lgkmcnt(0)" ::: "memory");
}
__device__ __forceinline__ void tr_item8(const float* W, int srcN, int K, unsigned char* WT, int drow0, int k0, int srccol, float scale, LAS float* scr, int lane) {
    float v[32];
    const float* p = W + (size_t)(k0 + (lane >> 5)) * srcN + srccol;
#pragma unroll
    for (int i = 0; i < 32; ++i) v[i] = p[(size_t)(2 * i) * srcN];
#pragma unroll
    for (int i = 0; i < 32; ++i) scr[(2 * i + (lane >> 5)) * 33 + (lane & 31)] = v[i] * scale;
    asm volatile("s_waitcnt lgkmcnt(0)" ::: "memory");
    const int c = lane & 3;
#pragma unroll
    for (int j = 0; j < 2; ++j) { const int n = (lane >> 2) + 16 * j; const LAS float* s = scr + (16 * c) * 33 + n;
        u32x4 o; o.x = pk4_fp8(s[0 * 33], s[1 * 33], s[2 * 33], s[3 * 33]); o.y = pk4_fp8(s[4 * 33], s[5 * 33], s[6 * 33], s[7 * 33]);
        o.z = pk4_fp8(s[8 * 33], s[9 * 33], s[10 * 33], s[11 * 33]); o.w = pk4_fp8(s[12 * 33], s[13 * 33], s[14 * 33], s[15 * 33]);
        *(u32x4*)(WT + (size_t)(drow0 + n) * K + k0 + 16 * c) = o; }
    asm volatile("s_waitcnt lgkmcnt(0)" ::: "memory");
}
__device__ __forceinline__ int even_srccol(int j) {
    if (j < 640) { const int hb = j & ~63, p = j & 63, g = p >> 3, e = p & 7; return hb + (g >> 2) * 32 + (e >> 2) * 16 + (g & 3) * 4 + (e & 3); }
    return j < EVEN_IN ? j : -1;
}
__device__ __forceinline__ int odd_srccol(int j) { const int t = j >> 8, r = j & 255; if (t < 4) return j; return (r < 128 ? 1024 : 2048 - 128) + 128 * (t - 4) + r; }
__device__ __forceinline__ void conv_dense_weights(const Frame& F0) {
    Frame F = relaunder(F0);
    LAS float* scr = (LAS float*)(F.lds + F.wave * 16384);
    const int gw = F.vcu * 8 + F.wave, NGW = F.G * 8;
    constexpr int I_EI = 16 * 80, I_SQ = 16 * 32, I_OI = 16 * 96;
    constexpr int NIT = 2 * (I_EI + I_SQ + I_OI + I_SQ);
    for (int it = gw; it < NIT; it += NGW) {
        int r = it; const int i = r & 1; r >>= 1;
        if (r < I_EI) { const int kb = r / 80, nb = r % 80; tr_item(inptr(F, I_WINE) + (size_t)i * 1024 * EVEN_IN, EVEN_IN, 1024, (bf16*)(F.ws + WS_WINE) + (size_t)i * EN * 1024, nb * 32, kb * 64, even_srccol(nb * 32 + (F.lane & 31)), scr, F.lane); continue; } r -= I_EI;
        if (r < I_SQ) { const int kb = r / 32, nb = r % 32; tr_item(inptr(F, I_WOUTE) + (size_t)i * 1024 * 1024, 1024, 1024, (bf16*)(F.ws + WS_WOUTE) + (size_t)i * 1024 * 1024, nb * 32, kb * 64, nb * 32 + (F.lane & 31), scr, F.lane); continue; } r -= I_SQ;
        if (r < I_OI) { const int kb = r / 96, nb = r % 96; tr_item(inptr(F, I_WINO) + (size_t)i * 1024 * ON, ON, 1024, (bf16*)(F.ws + WS_WINO) + (size_t)i * ON * 1024, nb * 32, kb * 64, odd_srccol(nb * 32 + (F.lane & 31)), scr, F.lane); continue; } r -= I_OI;
        { const int kb = r / 32, nb = r % 32; tr_item(inptr(F, I_WOUTO) + (size_t)i * 1024 * 1024, 1024, 1024, (bf16*)(F.ws + WS_WOUTO) + (size_t)i * 1024 * 1024, nb * 32, kb * 64, nb * 32 + (F.lane & 31), scr, F.lane); }
    }
}
constexpr float W8_SCALE = 64.0f;
__device__ __forceinline__ void conv_moe_item(const Frame& F, int l, int it, LAS float* scr) {
    constexpr int I_13 = 16 * 32, I_2 = 8 * 32;
    const int e = it / (I_13 + I_2); int r = it % (I_13 + I_2);
    const size_t eoff = ((size_t)l * NEXP + e) * 1024 * 512;
    if (r < I_13) { const int kb = r / 32, nb = r % 32; const int j0 = nb * 32, t = j0 >> 8, rr = j0 & 255;
        const float* src = (rr < 128 ? inptr(F, I_W1) : inptr(F, I_W3)) + eoff;
        tr_item8(src, 512, 1024, (unsigned char*)(F.ws + WS_W13) + (size_t)e * 1024 * 1024, j0, kb * 64, 128 * t + (rr & 127) + (F.lane & 31), W8_SCALE, scr, F.lane);
    } else { r -= I_13; const int kb = r / 32, nb = r % 32;
        tr_item8(inptr(F, I_W2) + eoff, 1024, 512, (unsigned char*)(F.ws + WS_W2) + (size_t)e * 1024 * 512, nb * 32, kb * 64, nb * 32 + (F.lane & 31), W8_SCALE, scr, F.lane); }
}
__device__ __forceinline__ void conv_moe_weights(const Frame& F0, int l) {
    Frame F = relaunder(F0); const int gw = F.vcu * 8 + F.wave, NGW = F.G * 8;
    LAS float* scr = (LAS float*)(F.lds + F.wave * 16384);
    for (int it = gw; it < NEXP * (16 * 32 + 8 * 32); it += NGW) conv_moe_item(F, l, it, scr);
}
__device__ __forceinline__ void ph_u0(const Frame& F0) {
    Frame F = relaunder(F0);
    const int gw = F.vcu * 8 + F.wave, NGW = F.G * 8;
    for (int r0 = gw * 4; r0 < NTOK; r0 += NGW * 4) {
        const int bi = row_bi(r0); const float* sh = modp(F, 0, bi, 0); const float* sc = modp(F, 0, bi, 1);
        f32x4 x[4][4];
#pragma unroll
        for (int r = 0; r < 4; ++r) { const int row = r0 + r; const float* src = row < NLAT ? inptr(F, I_X) + (size_t)row * D : inptr(F, I_CTX) + (size_t)(row - NLAT) * D;
#pragma unroll
            for (int j = 0; j < 4; ++j) x[r][j] = *(const f32x4*)(src + 4 * F.lane + 256 * j); }
#pragma unroll
        for (int j = 0; j < 4; ++j) { const int c = 4 * F.lane + 256 * j; const f32x4 a = *(const f32x4*)(sh + c), s = *(const f32x4*)(sc + c);
#pragma unroll
            for (int r = 0; r < 4; ++r) { const f32x4 u = x[r][j] * (1.0f + s) + a; u32x2 w; w.x = pk2(u[0], u[1]); w.y = pk2(u[2], u[3]); *(u32x2*)((bf16*)(F.ws + WS_U) + (size_t)(r0 + r) * D + c) = w; } }
    }
}

struct RowLN { f32x4 v[4]; };
__device__ __forceinline__ void ln_stats(f32x4 (&z)[4], float& mean, float& rstd) {
    float s = 0.f;
#pragma unroll
    for (int j = 0; j < 4; ++j) s += (z[j][0] + z[j][1]) + (z[j][2] + z[j][3]);
    mean = wave_sum(s) * (1.0f / D); float q = 0.f;
#pragma unroll
    for (int j = 0; j < 4; ++j) { z[j] = z[j] - mean; q += (z[j][0] * z[j][0] + z[j][1] * z[j][1]) + (z[j][2] * z[j][2] + z[j][3] * z[j][3]); }
    rstd = 1.0f / sqrtf(wave_sum(q) * (1.0f / D) + LN_EPS);
}
__device__ __forceinline__ void ln_rows(f32x4 (&z)[4], const float* lw, const float* lb, int lane) {
    float s = 0.f;
#pragma unroll
    for (int j = 0; j < 4; ++j) s += (z[j][0] + z[j][1]) + (z[j][2] + z[j][3]);
    const float mean = wave_sum(s) * (1.0f / D); float q = 0.f;
#pragma unroll
    for (int j = 0; j < 4; ++j) { z[j] = z[j] - mean; q += (z[j][0] * z[j][0] + z[j][1] * z[j][1]) + (z[j][2] * z[j][2] + z[j][3] * z[j][3]); }
    const float rstd = 1.0f / sqrtf(wave_sum(q) * (1.0f / D) + LN_EPS);
#pragma unroll
    for (int j = 0; j < 4; ++j) { const int c = 4 * lane + 256 * j; z[j] = z[j] * rstd * *(const f32x4*)(lw + c) + *(const f32x4*)(lb + c); }
}
__device__ __forceinline__ void ph_ln1(const Frame& F0, int l, int nrows, bool dry = false) {
    Frame F = relaunder(F0);
    LAS unsigned char* Thi = F.lds; LAS unsigned char* Tlo = F.lds + 33024;
    LAS float* red = (LAS float*)(F.lds + 66048);
    LAS float* lgt = (LAS float*)(F.lds + 82432);
    LAS int* lcnt = (LAS int*)(F.lds + 87552); LAS int* lbase = lcnt + 32;
    LAS unsigned* list = (LAS unsigned*)(F.lds + 87808);
    LAS float* LW = (LAS float*)(F.lds + 97024); LAS float* LB = LW + 1024; LAS float* WG = LB + 1024;
    const int lane = F.lane, w = F.wave;
    if (F.tid < 64) lcnt[F.tid] = 0;
    { const float* lwg = inptr(F, I_LNW) + (size_t)(l * 2 + 0) * D; const float* lbg = inptr(F, I_LNB) + (size_t)(l * 2 + 0) * D; const float* wgg = inptr(F, I_WG) + (size_t)l * 1024 * 4;
      for (int i = F.tid; i < 256; i += 512) { *(LAS f32x4*)(LW + 4 * i) = *(const f32x4*)(lwg + 4 * i); *(LAS f32x4*)(LB + 4 * i) = *(const f32x4*)(lbg + 4 * i); }
      for (int i = F.tid; i < 1024; i += 512) *(LAS f32x4*)(WG + 4 * i) = *(const f32x4*)(wgg + 4 * i); }
    bf16x8 Whi[2][4], Wlo[2][4];
    {
        const int n = lane & 15, kg = lane >> 4;
        const float* we = inptr(F, I_WE) + (size_t)l * 1024 * 32 + (size_t)(w * 128 + kg * 8) * 32 + n;
#pragma unroll
        for (int nt = 0; nt < 2; ++nt)
#pragma unroll
            for (int ks = 0; ks < 4; ++ks) { u32x4 hi, lo; unsigned hh[8], ll[8];
                const float* p = we + ks * 32 * 32 + nt * 16;
                asm volatile("" : "+v"(p));
#pragma unroll
                for (int j = 0; j < 8; ++j) {
                    const float v = p[j * 32];
                    const unsigned h = pk2(v, 0.f) & 0xffffu; const float r = v - __uint_as_float(h << 16); hh[j] = h; ll[j] = pk2(r, 0.f) & 0xffffu; }
                hi.x = hh[0] | (hh[1] << 16); hi.y = hh[2] | (hh[3] << 16); hi.z = hh[4] | (hh[5] << 16); hi.w = hh[6] | (hh[7] << 16);
                lo.x = ll[0] | (ll[1] << 16); lo.y = ll[2] | (ll[3] << 16); lo.z = ll[4] | (ll[5] << 16); lo.w = ll[6] | (ll[7] << 16);
                Whi[nt][ks] = __builtin_bit_cast(bf16x8, hi); Wlo[nt][ks] = __builtin_bit_cast(bf16x8, lo); }
    }
    const bf16* Y = (const bf16*)(F.ws + WS_P);
    const float* hsl = (l == 0 ? inptr(F, I_X) : F.out); const float* hsc = (l == 0 ? inptr(F, I_CTX) : (const float*)(F.ws + WS_HCTX));
    const float* bgp = inptr(F, I_BG) + l * 4; const float* bep = inptr(F, I_BE) + l * 32;
    const bool usey = !((l & 1) ? (KO_MASK & 4) : ((KO_MASK & 3) == 3));
    const int nbatch = nrows / 16; int nlist = 0; int prev_rbase = -1;
#define LN1_ROUTE(buf_, rbase_, slot_) do { if (F.tid < 16) { const int tk = F.tid; const LAS float* lg = lgt + (buf_) * 640 + tk * 40; \
        float gl[4]; _Pragma("unroll") for (int j = 0; j < 4; ++j) gl[j] = lg[32 + j] + bgp[j]; \
        float gmax = gl[0]; int g = 0; _Pragma("unroll") for (int j = 1; j < 4; ++j) if (gl[j] > gmax) { gmax = gl[j]; g = j; } \
        float den = 0.f; _Pragma("unroll") for (int j = 0; j < 4; ++j) den += expf(gl[j] - gmax); \
        const float pg = 1.0f / den; float el[8]; _Pragma("unroll") for (int j = 0; j < 8; ++j) el[j] = lg[g * 8 + j] + bep[g * 8 + j]; \
        float m0 = el[0]; int i0 = 0; _Pragma("unroll") for (int j = 1; j < 8; ++j) if (el[j] > m0) { m0 = el[j]; i0 = j; } \
        float m1 = -3.0e38f; int i1 = 0; _Pragma("unroll") for (int j = 0; j < 8; ++j) if (j != i0 && el[j] > m1) { m1 = el[j]; i1 = j; } \
        const float ex = expf(m1 - m0); const float w0 = pg / (1.0f + ex), w1 = pg * ex / (1.0f + ex); \
        const int e0 = g * 8 + i0, e1 = g * 8 + i1; \
        const int p0 = atomicAdd((int*)&lcnt[e0], 1), p1 = atomicAdd((int*)&lcnt[e1], 1); \
        LAS unsigned* L = list + ((slot_) * 16 + tk) * 8; \
        L[0] = (unsigned)((rbase_) + tk); L[1] = (unsigned)e0; L[2] = (unsigned)p0; L[3] = __float_as_uint(w0); L[4] = (unsigned)e1; L[5] = (unsigned)p1; L[6] = __float_as_uint(w1); } } while (0)
    __syncthreads();
    for (int bt = F.vcu; bt < nbatch; bt += F.G) {
        const int rbase = bt * 16; const int bi = row_bi(rbase);
        const float* g2 = modp(F, l, bi, 2); const float* sh = modp(F, l, bi, 3); const float* sc = modp(F, l, bi, 4);
        {
            f32x4 hv[2][4], gv[4], scv[4], shv[4]; u32x2 yv[2][4];
#pragma unroll
            for (int rr = 0; rr < 2; ++rr) { const int row = rbase + 2 * w + rr; const float* hs = row < NLAT ? hsl + (size_t)row * D : hsc + (size_t)(row - NLAT) * D;
#pragma unroll
                for (int j = 0; j < 4; ++j) { const int c = 4 * lane + 256 * j; hv[rr][j] = *(const f32x4*)(hs + c); yv[rr][j] = usey ? *(const u32x2*)(Y + (size_t)row * D + c) : (u32x2){0u, 0u}; } }
#pragma unroll
            for (int j = 0; j < 4; ++j) { const int c = 4 * lane + 256 * j; gv[j] = *(const f32x4*)(g2 + c); scv[j] = *(const f32x4*)(sc + c); shv[j] = *(const f32x4*)(sh + c); }
            f32x4 z[2][4]; float mean[2], rstd[2];
#pragma unroll
            for (int rr = 0; rr < 2; ++rr)
#pragma unroll
                for (int j = 0; j < 4; ++j) z[rr][j] = DN_ALPHA * hv[rr][j] + gv[j] * (f32x4){bflo(yv[rr][j].x), bfhi(yv[rr][j].x), bflo(yv[rr][j].y), bfhi(yv[rr][j].y)};
#pragma unroll
            for (int rr = 0; rr < 2; ++rr) ln_stats(z[rr], mean[rr], rstd[rr]);
            f32x4 ga[2] = {(f32x4){0.f, 0.f, 0.f, 0.f}, (f32x4){0.f, 0.f, 0.f, 0.f}};
#pragma unroll
            for (int j = 0; j < 4; ++j) { const int c = 4 * lane + 256 * j;
                const f32x4 lwv = *(const LAS f32x4*)(LW + c), lbv = *(const LAS f32x4*)(LB + c);
                const f32x4 g0 = *(const LAS f32x4*)(WG + 4 * c), g1 = *(const LAS f32x4*)(WG + 4 * c + 4), g2v = *(const LAS f32x4*)(WG + 4 * c + 8), g3 = *(const LAS f32x4*)(WG + 4 * c + 12);
#pragma unroll
                for (int rr = 0; rr < 2; ++rr) { const int lr = 2 * w + rr, row = rbase + lr;
                    float* hd = dry ? (float*)(F.ws + WS_GATT) + (size_t)row * D : (row < NLAT ? F.out + (size_t)row * D : (float*)(F.ws + WS_HCTX) + (size_t)(row - NLAT) * D);
                    const f32x4 zn = z[rr][j] * rstd[rr] * lwv + lbv;
                    *(f32x4*)(hd + c) = zn;
                    const f32x4 t = zn * (1.0f + scv[j]) + shv[j];
                    ga[rr] += t[0] * g0 + t[1] * g1 + t[2] * g2v + t[3] * g3;
                    const unsigned h01 = pk2(t[0], t[1]), h23 = pk2(t[2], t[3]);
                    u32x2 hw; hw.x = h01; hw.y = h23;
                    *(unsigned*)((unsigned char*)(F.ws + (dry ? WS_Q : WS_U8)) + (size_t)row * D + c) = pk4_fp8(t[0], t[1], t[2], t[3]);
                    const float r0 = t[0] - bflo(h01), r1 = t[1] - bfhi(h01), r2 = t[2] - bflo(h23), r3 = t[3] - bfhi(h23);
                    u32x2 lw2; lw2.x = pk2(r0, r1); lw2.y = pk2(r2, r3);
                    *(LAS u32x2*)(Thi + lr * 2064 + c * 2) = hw; *(LAS u32x2*)(Tlo + lr * 2064 + c * 2) = lw2; } }
#pragma unroll
            for (int rr = 0; rr < 2; ++rr) { const float q0 = wave_sum(ga[rr][0]), q1 = wave_sum(ga[rr][1]), q2 = wave_sum(ga[rr][2]), q3 = wave_sum(ga[rr][3]);
                if (lane == 0) *(LAS f32x4*)(lgt + (nlist & 1) * 640 + (2 * w + rr) * 40 + 32) = (f32x4){q0, q1, q2, q3}; }
        }
        __syncthreads();
        if (prev_rbase >= 0) LN1_ROUTE((nlist - 1) & 1, prev_rbase, nlist - 1);
        {
            f32x4 acc[2];
#pragma unroll
            for (int nt = 0; nt < 2; ++nt) acc[nt] = (f32x4){0.f, 0.f, 0.f, 0.f};
            const int tk = lane & 15, kg = lane >> 4;
#pragma unroll
            for (int ks = 0; ks < 4; ++ks) {
                const bf16x8 ah = *(const LAS bf16x8*)(Thi + tk * 2064 + (w * 128 + ks * 32 + kg * 8) * 2), al = *(const LAS bf16x8*)(Tlo + tk * 2064 + (w * 128 + ks * 32 + kg * 8) * 2);
#pragma unroll
                for (int nt = 0; nt < 2; ++nt) { acc[nt] = __builtin_amdgcn_mfma_f32_16x16x32_bf16(Whi[nt][ks], ah, acc[nt], 0, 0, 0);
                    acc[nt] = __builtin_amdgcn_mfma_f32_16x16x32_bf16(Wlo[nt][ks], ah, acc[nt], 0, 0, 0); acc[nt] = __builtin_amdgcn_mfma_f32_16x16x32_bf16(Whi[nt][ks], al, acc[nt], 0, 0, 0); }
            }
#pragma unroll
            for (int nt = 0; nt < 2; ++nt) *(LAS f32x4*)(red + (w * 16 + tk) * 32 + nt * 16 + 4 * kg) = acc[nt];
        }
        __syncthreads();
        { const int tk = F.tid & 15, n = F.tid >> 4; float s = 0.f;
#pragma unroll
            for (int ww = 0; ww < 8; ++ww) s += red[(ww * 16 + tk) * 32 + n];
            lgt[(nlist & 1) * 640 + tk * 40 + n] = s; }
        prev_rbase = rbase; ++nlist;
    }
    __syncthreads();
    if (prev_rbase >= 0) LN1_ROUTE((nlist - 1) & 1, prev_rbase, nlist - 1);
#undef LN1_ROUTE
    __syncthreads();
    if (F.tid < 32) lbase[F.tid] = (int)atomicAdd((unsigned*)(F.ws + WS_CTL) + CW_CNT + l * 64 + (dry ? 32 : 0) + F.tid, (unsigned)lcnt[F.tid]);
    __syncthreads();
    if (!dry) for (int idx = F.tid; idx < nlist * 16; idx += 512) {
        const LAS unsigned* L = list + idx * 8; const unsigned row = L[0], e0 = L[1], e1 = L[4]; const unsigned p0 = L[2] + (unsigned)lbase[e0], p1 = L[5] + (unsigned)lbase[e1];
        u32x4 a; a.x = e0; a.y = p0; a.z = L[3]; a.w = e1; u32x4 b; b.x = p1; b.y = L[6]; b.z = 0u; b.w = 0u;
        unsigned* ti = (unsigned*)(F.ws + WS_TOKINFO) + (size_t)row * 8; *(u32x4*)ti = a; *(u32x4*)(ti + 4) = b;
        int* rt = (int*)(F.ws + WS_ROWTOK); rt[(size_t)e0 * NTOK + p0] = (int)row; rt[(size_t)e1 * NTOK + p1] = (int)row;
    }
}

__device__ __forceinline__ void ph_ln2(const Frame& F0, int l, int nrows, bool dry = false) {
    Frame F = relaunder(F0);
    MoeTab T = moe_tab(F.lds);
    const int gw = F.vcu * 8 + F.wave, NGW = F.G * 8, lane = F.lane;
    const float* lw = inptr(F, I_LNW) + (size_t)(l * 2 + 1) * D; const float* lb = inptr(F, I_LNB) + (size_t)(l * 2 + 1) * D;
    const bf16* O2 = (const bf16*)(F.ws + WS_P);
    for (int r0 = gw * 4; r0 < nrows; r0 += NGW * 4) {
        const int bi = row_bi(r0);
        const float* g5 = modp(F, l, bi, 5);
        f32x4 z[4][4]; u32x2 ya[4][4], yb[4][4]; float w0[4], w1[4];
#pragma unroll
        for (int r = 0; r < 4; ++r) { const int row = r0 + r;
            const unsigned* ti = (const unsigned*)(F.ws + WS_TOKINFO) + (size_t)row * 8;
            const u32x4 a = *(const u32x4*)ti; const u32x2 b = *(const u32x2*)(ti + 4);
            const size_t s0 = (size_t)T.ts[a.x] * 256 + a.y, s1 = (size_t)T.ts[a.w] * 256 + b.x; w0[r] = __uint_as_float(a.z); w1[r] = __uint_as_float(b.y);
            const float* hd = row < NLAT ? F.out + (size_t)row * D : (const float*)(F.ws + WS_HCTX) + (size_t)(row - NLAT) * D;
#pragma unroll
            for (int j = 0; j < 4; ++j) { const int c = 4 * lane + 256 * j; z[r][j] = *(const f32x4*)(hd + c);
                if (!(KO_MASK & 8)) { ya[r][j] = *(const u32x2*)(O2 + s0 * D + c); yb[r][j] = *(const u32x2*)(O2 + s1 * D + c); } } }
#pragma unroll
        for (int j = 0; j < 4; ++j) { const f32x4 g = *(const f32x4*)(g5 + 4 * lane + 256 * j);
#pragma unroll
            for (int r = 0; r < 4; ++r) { f32x4 y = (f32x4){0.f, 0.f, 0.f, 0.f};
                if (!(KO_MASK & 8)) y = w0[r] * (f32x4){bflo(ya[r][j].x), bfhi(ya[r][j].x), bflo(ya[r][j].y), bfhi(ya[r][j].y)} + w1[r] * (f32x4){bflo(yb[r][j].x), bfhi(yb[r][j].x), bflo(yb[r][j].y), bfhi(yb[r][j].y)};
                z[r][j] = DN_ALPHA * z[r][j] + g * y; } }
        float mean[4], rstd[4];
#pragma unroll
        for (int r = 0; r < 4; ++r) ln_stats(z[r], mean[r], rstd[r]);
        const bool lat = r0 < NLAT;
        const bool wu = (l < 3) && (lat || l < 2);
        const float* sh = modp(F, l < 3 ? l + 1 : l, bi, 0); const float* sc = modp(F, l < 3 ? l + 1 : l, bi, 1);
#pragma unroll
        for (int j = 0; j < 4; ++j) { const int c = 4 * lane + 256 * j;
            const f32x4 lwv = *(const f32x4*)(lw + c), lbv = *(const f32x4*)(lb + c), scv = *(const f32x4*)(sc + c), shv = *(const f32x4*)(sh + c);
#pragma unroll
            for (int r = 0; r < 4; ++r) { const int row = r0 + r;
                float* hd = dry ? (float*)(F.ws + WS_GATT) + (size_t)row * D : (lat ? F.out + (size_t)row * D : (float*)(F.ws + WS_HCTX) + (size_t)(row - NLAT) * D);
                const f32x4 zn = z[r][j] * rstd[r] * lwv + lbv; *(f32x4*)(hd + c) = zn;
                if (wu) { const f32x4 u = zn * (1.0f + scv) + shv; u32x2 hw; hw.x = pk2(u[0], u[1]); hw.y = pk2(u[2], u[3]); *(u32x2*)((bf16*)(F.ws + (dry ? WS_Q : WS_U)) + (size_t)row * D + c) = hw; } } }
    }
}

__device__ __forceinline__ f32x4 ubf_lo(const u32x4 v) { return (f32x4){bflo(v.x), bfhi(v.x), bflo(v.y), bfhi(v.y)}; }
__device__ __forceinline__ f32x4 ubf_hi(const u32x4 v) { return (f32x4){bflo(v.z), bfhi(v.z), bflo(v.w), bfhi(v.w)}; }
__device__ __forceinline__ void ph_conv(const Frame& F0, int i, int nrows) {
    Frame F = relaunder(F0);
    const int gw = F.vcu * 8 + F.wave, NGW = F.G * 8, lane = F.lane;
    const float* cw = inptr(F, I_CONVW) + (size_t)i * 3 * D; const float* cb = inptr(F, I_CONVB) + (size_t)i * D;
    const bf16* P = (const bf16*)(F.ws + WS_P); bf16* Q = (bf16*)(F.ws + WS_Q);
    for (int r0 = gw * 4; r0 < nrows; r0 += NGW * 4) {
        const int s0 = r0 < NLAT ? (r0 & (SEQ - 1)) : ((r0 - NLAT) & (CTXL - 1)); const int slen = r0 < NLAT ? SEQ : CTXL;
        const bool hp = s0 > 0, hn = s0 + 4 < slen;
#pragma unroll
        for (int j = 0; j < 2; ++j) { const int c = 8 * lane + 512 * j;
            u32x4 p[6], gb[4];
            p[0] = (u32x4){0u, 0u, 0u, 0u}; p[5] = (u32x4){0u, 0u, 0u, 0u};
            if (hp) p[0] = *(const u32x4*)(P + (size_t)(r0 - 1) * 2048 + 1024 + c);
            if (hn) p[5] = *(const u32x4*)(P + (size_t)(r0 + 4) * 2048 + 1024 + c);
#pragma unroll
            for (int r = 0; r < 4; ++r) { p[r + 1] = *(const u32x4*)(P + (size_t)(r0 + r) * 2048 + 1024 + c); gb[r] = *(const u32x4*)(P + (size_t)(r0 + r) * 2048 + c); }
            const f32x4 w0a = *(const f32x4*)(cw + c), w0b = *(const f32x4*)(cw + c + 4), w1a = *(const f32x4*)(cw + D + c), w1b = *(const f32x4*)(cw + D + c + 4), w2a = *(const f32x4*)(cw + 2 * D + c), w2b = *(const f32x4*)(cw + 2 * D + c + 4);
            const f32x4 ba = *(const f32x4*)(cb + c), bb = *(const f32x4*)(cb + c + 4);
#pragma unroll
            for (int r = 0; r < 4; ++r) {
                const f32x4 ya = ubf_lo(gb[r]) * (ubf_lo(p[r]) * w0a + ubf_lo(p[r + 1]) * w1a + ubf_lo(p[r + 2]) * w2a + ba);
                const f32x4 yb = ubf_hi(gb[r]) * (ubf_hi(p[r]) * w0b + ubf_hi(p[r + 1]) * w1b + ubf_hi(p[r + 2]) * w2b + bb);
                *(u32x4*)(Q + (size_t)(r0 + r) * D + c) = pack8(ya, yb); } }
    }
}
#define MFMA32(a, b, c) __builtin_amdgcn_mfma_f32_32x32x16_bf16((a), (b), (c), 0, 0, 0)
#define MFMA16(a, b, c) __builtin_amdgcn_mfma_f32_16x16x32_bf16((a), (b), (c), 0, 0, 0)
constexpr int AK_STR = 144, AV_STR = 136, AK_BUF = 64 * AK_STR, AV_BUF = 64 * AV_STR;
__device__ __forceinline__ int crow32(int reg, int hh) { return (reg & 3) + 8 * (reg >> 2) + 4 * hh; }
__device__ __forceinline__ void attn_unit(const Frame& F, int ie, int b, int g, int qb, bool ctxq) {
    const bf16* P = (const bf16*)(F.ws + WS_P); bf16* Q = (bf16*)(F.ws + WS_Q);
    LAS unsigned char* Ks = F.lds; LAS unsigned char* Vt = F.lds + 2 * AK_BUF;
    const int w = F.wave, lane = F.lane, r = w >> 1, qh = w & 1, h = 4 * g + r, n = lane & 31, hh = lane >> 5;
    const int qpos0 = qb * 128 + qh * 64;
    const int qrow0 = ctxq ? NLAT + b * CTXL + qpos0 : b * SEQ + qpos0;
    if (KO_MASK & 1) {
#pragma unroll
        for (int nt = 0; nt < 2; ++nt)
#pragma unroll
            for (int c = 0; c < 4; ++c) *(u32x4*)(Q + (size_t)(qrow0 + 32 * nt + n) * D + h * 64 + 16 * c + 8 * hh) = (u32x4){0u, 0u, 0u, 0u};
        return;
    }
    bf16x8 qf[2][4];
#pragma unroll
    for (int nt = 0; nt < 2; ++nt)
#pragma unroll
        for (int c = 0; c < 4; ++c) qf[nt][c] = *(const bf16x8*)(P + (size_t)(qrow0 + 32 * nt + n) * EN + PC_Q + h * 64 + 16 * c + 8 * hh);
    const float sk = inptr(F, I_SINK)[ie * 8 + h] * LOG2E;
    float mrun[2] = {sk, sk}, lsum[2] = {1.f, 1.f};
    f32x16 O[2][2];
#pragma unroll
    for (int a = 0; a < 2; ++a)
#pragma unroll
        for (int c = 0; c < 2; ++c)
#pragma unroll
            for (int e = 0; e < 16; ++e) O[a][c][e] = 0.f;
    const int tw0 = ctxq ? 4 : ((qb == 0) ? 6 : 4), tw1 = ctxq ? 4 : ((qb == 31) ? 8 : 10);
    const int ntile = 4 + (tw1 - tw0);
    const int skey = F.tid >> 3, sch = F.tid & 7;
    u32x4 kreg, vreg;
#define TILE_OF(i) ((i) < 4 ? (i) : tw0 + ((i) - 4))
#define KROW_OF(t) ((t) < 4 ? NLAT + b * CTXL + 64 * (t) : b * SEQ + (qb - 1) * 128 + 64 * ((t) - 4))
    { const int kr = KROW_OF(0) + skey; kreg = *(const u32x4*)(P + (size_t)kr * EN + PC_K + g * 64 + sch * 8); vreg = *(const u32x4*)(P + (size_t)kr * EN + PC_V + g * 64 + sch * 8); }
    __syncthreads();
    {
        *(LAS u32x4*)(Ks + skey * AK_STR + sch * 16) = kreg;
        LAS unsigned short* vt = (LAS unsigned short*)(Vt + (sch * 8) * AV_STR + skey * 2);
        const unsigned vv[4] = {vreg.x, vreg.y, vreg.z, vreg.w};
#pragma unroll
        for (int e = 0; e < 4; ++e) { vt[(2 * e) * (AV_STR / 2)] = (unsigned short)(vv[e] & 0xffffu); vt[(2 * e + 1) * (AV_STR / 2)] = (unsigned short)(vv[e] >> 16); }
    }
    __syncthreads();
    const float c2 = 0.125f * LOG2E;
    for (int i = 0; i < ntile; ++i) {
        const int buf = i & 1, t = TILE_OF(i);
        if (i + 1 < ntile) { const int t1 = TILE_OF(i + 1); const int kr = KROW_OF(t1) + skey; kreg = *(const u32x4*)(P + (size_t)kr * EN + PC_K + g * 64 + sch * 8); vreg = *(const u32x4*)(P + (size_t)kr * EN + PC_V + g * 64 + sch * 8); }
        const LAS unsigned char* kb = Ks + buf * AK_BUF; const LAS unsigned char* vb = Vt + buf * AV_BUF;
        const bool msk = (t >= 4) && (t != 6) && (t != 7);
        const int kp0 = (qb - 1) * 128 + 64 * (t - 4);
        const bool skip = (qh == 0 && t == 9) || (qh == 1 && t == 4);
#pragma unroll 1
        for (int kt = 0; kt < 2; ++kt) {
            if (skip) break;
            f32x16 S[2];
#pragma unroll
            for (int c = 0; c < 2; ++c)
#pragma unroll
                for (int e = 0; e < 16; ++e) S[c][e] = 0.f;
#pragma unroll
            for (int c = 0; c < 4; ++c) { const bf16x8 kf = *(const LAS bf16x8*)(kb + (32 * kt + n) * AK_STR + (16 * c + 8 * hh) * 2);
#pragma unroll
                for (int nt = 0; nt < 2; ++nt) S[nt] = MFMA32(kf, qf[nt][c], S[nt]); }
#pragma unroll
            for (int nt = 0; nt < 2; ++nt) {
                if (msk) { const int qp = qpos0 + 32 * nt + n;
#pragma unroll
                    for (int e = 0; e < 16; ++e) { const int dd = qp - (kp0 + 32 * kt + crow32(e, hh)); if (dd > 128 || dd < -128) S[nt][e] = -INFINITY; } }
                float mx = fmaxf(fmaxf(S[nt][0], S[nt][1]), fmaxf(S[nt][2], S[nt][3]));
#pragma unroll
                for (int e = 4; e < 16; e += 4) mx = fmaxf(mx, fmaxf(fmaxf(S[nt][e], S[nt][e + 1]), fmaxf(S[nt][e + 2], S[nt][e + 3])));
                mx = fmaxf(mx, __shfl_xor(mx, 32));
                const float mnew = fmaxf(mrun[nt], mx * c2);
                if (__builtin_amdgcn_ballot_w64(mnew != mrun[nt]) != 0ull) {
                    const float alpha = __builtin_amdgcn_exp2f(mrun[nt] - mnew); mrun[nt] = mnew; lsum[nt] *= alpha;
#pragma unroll
                    for (int dt = 0; dt < 2; ++dt)
#pragma unroll
                        for (int e = 0; e < 16; ++e) O[dt][nt][e] *= alpha;
                }
                float rs = 0.f;
#pragma unroll
                for (int e = 0; e < 16; ++e) { const float p = __builtin_amdgcn_exp2f(__builtin_fmaf(S[nt][e], c2, -mnew)); S[nt][e] = p; rs += p; }
                rs += __shfl_xor(rs, 32);
                lsum[nt] += rs;
            }
#pragma unroll
            for (int s = 0; s < 2; ++s) {
                bf16x8 pf[2];
#pragma unroll
                for (int nt = 0; nt < 2; ++nt) { u32x4 pw; pw.x = pk2(S[nt][8 * s + 0], S[nt][8 * s + 1]); pw.y = pk2(S[nt][8 * s + 2], S[nt][8 * s + 3]); pw.z = pk2(S[nt][8 * s + 4], S[nt][8 * s + 5]); pw.w = pk2(S[nt][8 * s + 6], S[nt][8 * s + 7]); pf[nt] = __builtin_bit_cast(bf16x8, pw); }
#pragma unroll
                for (int dt = 0; dt < 2; ++dt) {
                    const LAS unsigned char* va = vb + (32 * dt + n) * AV_STR + (32 * kt + 16 * s + 4 * hh) * 2;
                    const s16x4 lo = *(const LAS s16x4*)va, hi = *(const LAS s16x4*)(va + 16);
                    const bf16x8 vf = __builtin_shufflevector(lo, hi, 0, 1, 2, 3, 4, 5, 6, 7);
#pragma unroll
                    for (int nt = 0; nt < 2; ++nt) O[dt][nt] = MFMA32(vf, pf[nt], O[dt][nt]);
                }
            }
        }
        if (i + 1 < ntile) {
            LAS unsigned char* kb2 = Ks + (buf ^ 1) * AK_BUF; LAS unsigned char* vb2 = Vt + (buf ^ 1) * AV_BUF;
            *(LAS u32x4*)(kb2 + skey * AK_STR + sch * 16) = kreg;
            LAS unsigned short* vt = (LAS unsigned short*)(vb2 + (sch * 8) * AV_STR + skey * 2);
            const unsigned vv[4] = {vreg.x, vreg.y, vreg.z, vreg.w};
#pragma unroll
            for (int e = 0; e < 4; ++e) { vt[(2 * e) * (AV_STR / 2)] = (unsigned short)(vv[e] & 0xffffu); vt[(2 * e + 1) * (AV_STR / 2)] = (unsigned short)(vv[e] >> 16); }
        }
        __syncthreads();
    }
#pragma unroll
    for (int nt = 0; nt < 2; ++nt) { const float inv = 1.0f / lsum[nt]; bf16* orow = Q + (size_t)(qrow0 + 32 * nt + n) * D + h * 64;
#pragma unroll
        for (int dt = 0; dt < 2; ++dt)
#pragma unroll
            for (int rg = 0; rg < 4; ++rg) { u32x2 ow; ow.x = pk2(O[dt][nt][4 * rg] * inv, O[dt][nt][4 * rg + 1] * inv); ow.y = pk2(O[dt][nt][4 * rg + 2] * inv, O[dt][nt][4 * rg + 3] * inv);
                *(u32x2*)(orow + 32 * dt + 8 * rg + 4 * hh) = ow; } }
}

template <int d> __device__ __forceinline__ void glaA_unit(const Frame& F, int ie, int b, int c, int h) {
    const bf16* P = (const bf16*)(F.ws + WS_P);
    LAS unsigned char* QS = F.lds + F.wave * 16384; LAS unsigned char* KS = QS + 8192;
    const int lane = F.lane;
    const int row0 = c < 4 ? NLAT + b * CTXL + c * 64 : b * SEQ + (c - 4) * 64;
    const size_t U = (size_t)(b * NCHUNK + c) * 4 + h;
    bf16* gq = (bf16*)(F.ws + WS_GQIN); bf16* gk = (bf16*)(F.ws + WS_GKST); bf16* ga = (bf16*)(F.ws + WS_GATT);
    {
        const size_t UD = U * 2 + d;
        {
            u32x4 qr[8], kr[8];
#pragma unroll
            for (int it = 0; it < 8; ++it) { const int tok = it * 8 + (lane >> 3), ch = lane & 7; const size_t ro = (size_t)(row0 + tok) * EN + h * 64 + ch * 8; qr[it] = *(const u32x4*)(P + ro + PC_QG); kr[it] = *(const u32x4*)(P + ro + PC_KG); }
#pragma unroll
            for (int it = 0; it < 8; ++it) { const int tok = it * 8 + (lane >> 3), ch = lane & 7; const int so = tok * 128 + ((ch ^ (tok & 7)) << 4); *(LAS u32x4*)(QS + so) = qr[it]; *(LAS u32x4*)(KS + so) = kr[it]; }
        }
        const int ln = lane & 31, hh = lane >> 5;
        bf16x8 afr[2], bhi[2], blo[2]; float bav[2];
#pragma unroll
        for (int tt = 0; tt < 2; ++tt) afr[tt] = *(const bf16x8*)(P + (size_t)(row0 + 32 * tt + ln) * EN + PC_GG + 16 * d + 8 * hh);
#pragma unroll
        for (int dt = 0; dt < 2; ++dt) { const float* wp = inptr(F, I_WA2) + (size_t)((ie * 2 + d) * 16 + 8 * hh) * 256 + h * 64 + 32 * dt + ln;
            unsigned hh_[8], ll_[8];
#pragma unroll
            for (int j = 0; j < 8; ++j) { const float v = wp[(size_t)j * 256]; const unsigned hb = pk2(v, 0.f) & 0xffffu; hh_[j] = hb; ll_[j] = pk2(v - __uint_as_float(hb << 16), 0.f) & 0xffffu; }
            bhi[dt] = __builtin_bit_cast(bf16x8, (u32x4){hh_[0] | (hh_[1] << 16), hh_[2] | (hh_[3] << 16), hh_[4] | (hh_[5] << 16), hh_[6] | (hh_[7] << 16)});
            blo[dt] = __builtin_bit_cast(bf16x8, (u32x4){ll_[0] | (ll_[1] << 16), ll_[2] | (ll_[3] << 16), ll_[4] | (ll_[5] << 16), ll_[6] | (ll_[7] << 16)});
            bav[dt] = inptr(F, I_BA)[(ie * 2 + d) * 256 + h * 64 + 32 * dt + ln]; }
        f32x16 G[2][2];
#pragma unroll
        for (int tt = 0; tt < 2; ++tt)
#pragma unroll
            for (int dt = 0; dt < 2; ++dt) { f32x16 z16;
#pragma unroll
                for (int e = 0; e < 16; ++e) z16[e] = 0.f;
                z16 = MFMA32(afr[tt], bhi[dt], z16); G[tt][dt] = MFMA32(afr[tt], blo[dt], z16); }
        asm volatile("s_waitcnt lgkmcnt(0)" ::: "memory");
        float base[2] = {0.f, 0.f};
        int lofs[2][4];
#pragma unroll
        for (int dt = 0; dt < 2; ++dt)
#pragma unroll
            for (int e4 = 0; e4 < 4; ++e4) lofs[dt][e4] = (4 * hh + e4) * 128 + (((4 * dt + (ln >> 3)) ^ (4 * hh + e4)) << 4) + (ln & 7) * 2;
#pragma unroll
        for (int tq = 0; tq < 2; ++tq) { constexpr int dd = d; const int tt = dd ? 1 - tq : tq;
#pragma unroll
            for (int gq_ = 0; gq_ < 4; ++gq_) { const int g4 = dd ? 3 - gq_ : gq_;
                const int tokg = 32 * tt + 8 * g4;
#pragma unroll
                for (int dt = 0; dt < 2; ++dt) {
                    float la[4];
#pragma unroll
                    for (int e4 = 0; e4 < 4; ++e4) { const float g = G[tt][dt][4 * g4 + e4] + bav[dt];
                        la[e4] = (fminf(g, 0.f) * LOG2E - __builtin_amdgcn_logf(1.0f + __builtin_amdgcn_exp2f(-fabsf(g) * LOG2E))) * (1.0f / 16.0f); }
                    float cs[4];
                    if (dd == 0) { cs[0] = la[0]; cs[1] = cs[0] + la[1]; cs[2] = cs[1] + la[2]; cs[3] = cs[2] + la[3]; }
                    else { cs[3] = la[3]; cs[2] = cs[3] + la[2]; cs[1] = cs[2] + la[1]; cs[0] = cs[1] + la[0]; }
                    const float t4 = dd == 0 ? cs[3] : cs[0];
                    const float pt = __shfl_xor(t4, 32);
                    const float off = base[dt] + ((dd == 0 ? hh == 1 : hh == 0) ? pt : 0.f);
                    base[dt] += t4 + pt;
#pragma unroll
                    for (int e4 = 0; e4 < 4; ++e4) { const int so = tokg * 128 + lofs[dt][e4];
                        const float e1 = __builtin_amdgcn_exp2f(off + cs[e4]);
                        const float qi = bf2f(*(const LAS unsigned short*)(QS + so)) * 0.125f * e1, ki = bf2f(*(const LAS unsigned short*)(KS + so)) * __builtin_amdgcn_rcpf(e1);
                        const unsigned short q16 = (unsigned short)(pk2(qi, 0.f) & 0xffffu), k16 = (unsigned short)(pk2(ki, 0.f) & 0xffffu);
                        *(LAS unsigned short*)(QS + so) = q16; *(LAS unsigned short*)(KS + so) = k16; }
                }
            }
        }
        if (hh == 0) { ((float*)(F.ws + WS_GDEC))[UD * 64 + ln] = __builtin_amdgcn_exp2f(base[0]); ((float*)(F.ws + WS_GDEC))[UD * 64 + 32 + ln] = __builtin_amdgcn_exp2f(base[1]); }
        asm volatile("s_waitcnt lgkmcnt(0)" ::: "memory");
        {
            const int cc = lane & 7, dk0 = 32 * (cc >> 2) + 4 * (cc & 3);
#pragma unroll
            for (int it = 0; it < 8; ++it) { const int tok = it * 8 + (lane >> 3);
                const u32x2 lo = *(const LAS u32x2*)(QS + tok * 128 + ((((dk0 >> 3)) ^ (tok & 7)) << 4) + (dk0 & 7) * 2);
                const u32x2 hi = *(const LAS u32x2*)(QS + tok * 128 + ((((dk0 + 16) >> 3) ^ (tok & 7)) << 4) + (dk0 & 7) * 2);
                *(u32x4*)(gq + (UD * 64 + tok) * 64 + 8 * cc) = (u32x4){lo.x, lo.y, hi.x, hi.y};
                *(u32x4*)(gk + (UD * 64 + tok) * 64 + 8 * cc) = *(const LAS u32x4*)(KS + tok * 128 + ((cc ^ (tok & 7)) << 4)); }
        }
        {
            const int n = lane & 15, kg = lane >> 4;
#pragma unroll 1
            for (int I = 0; I < 4; ++I) {
                const int ti = 16 * I + n;
                bf16x8 qf[2];
#pragma unroll
                for (int ks2 = 0; ks2 < 2; ++ks2) qf[ks2] = *(const LAS bf16x8*)(QS + ti * 128 + (((4 * ks2 + kg) ^ (ti & 7)) << 4));
#pragma unroll
                for (int J = 0; J < 4; ++J) { f32x4 acc = (f32x4){0.f, 0.f, 0.f, 0.f};
                    const bool live = d == 0 ? (J <= I) : (J >= I);
                    if (live) {
                        const int tjr = 16 * J + n;
#pragma unroll
                        for (int ks2 = 0; ks2 < 2; ++ks2) { const bf16x8 kf = *(const LAS bf16x8*)(KS + tjr * 128 + (((4 * ks2 + kg) ^ (tjr & 7)) << 4)); acc = MFMA16(kf, qf[ks2], acc); }
#pragma unroll
                        for (int r = 0; r < 4; ++r) { const int tj = 16 * J + 4 * kg + r; const bool keep = d == 0 ? (tj <= ti) : (tj >= ti); if (!keep) acc[r] = 0.f; }
                    }
                    u32x2 ow; ow.x = pk2(acc[0], acc[1]); ow.y = pk2(acc[2], acc[3]);
                    *(u32x2*)(ga + (UD * 64 + ti) * 64 + 16 * J + 4 * kg) = ow; }
            }
        }
        asm volatile("s_waitcnt lgkmcnt(0)" ::: "memory");
    }
}

constexpr int GB_STG = 43008;
__device__ __forceinline__ int glaB_chunk(int d, int step) { return d == 0 ? step : (step < 4 ? 3 - step : 4 + (NCHUNK - 1 - step)); }
__device__ __forceinline__ int swz_k(int r) { return (r & 3) | (((r >> 3) & 1) << 2); }
__device__ __forceinline__ int swz_v(int r) { return ((r & 3) << 2) | ((r >> 2) & 3); }
template <int STAGE> __device__ __forceinline__ void glaB_issue(const Frame& F, int b, int h, int d, int step) {
    const int c = glaB_chunk(d, step);
    const size_t U = (size_t)(b * NCHUNK + c) * 4 + h, UD = U * 2 + d;
    const int row0 = c < 4 ? NLAT + b * CTXL + c * 64 : b * SEQ + (c - 4) * 64;
    const int tid = F.tid, row = tid >> 3, gch = (tid & 7) ^ (row & 7), gchk = (tid & 7) ^ swz_k(row);
    const int vr0 = tid >> 4, vr1 = vr0 + 32, vc0 = (tid & 15) ^ swz_v(vr0), vc1 = (tid & 15) ^ swz_v(vr1);
    LAS unsigned char* st = F.lds + STAGE * GB_STG + F.wave * 1024;
    const char* gq = (const char*)(F.ws + WS_GQIN) + UD * 8192 + row * 128 + gch * 16;
    const char* ga = (const char*)(F.ws + WS_GATT) + UD * 8192 + row * 128 + gch * 16;
    const char* gk = (const char*)(F.ws + WS_GKST) + UD * 8192 + row * 128 + gchk * 16;
    const char* gv = (const char*)(F.ws + WS_P) + (size_t)row0 * (EN * 2) + (PC_VG + h * 128) * 2;
    const char* gdc = (const char*)(F.ws + WS_GDEC) + UD * 256 + F.lane * 4;
    __builtin_amdgcn_global_load_lds((const unsigned*)gq, (LAS unsigned*)(st), 16, 0, 0);
    __builtin_amdgcn_global_load_lds((const unsigned*)ga, (LAS unsigned*)(st + 8192), 16, 0, 0);
    __builtin_amdgcn_global_load_lds((const unsigned*)gk, (LAS unsigned*)(st + 16384), 16, 0, 0);
    __builtin_amdgcn_global_load_lds((const unsigned*)(gv + (size_t)vr0 * (EN * 2) + vc0 * 16), (LAS unsigned*)(st + 24576), 16, 0, 0);
    __builtin_amdgcn_global_load_lds((const unsigned*)(gv + (size_t)vr1 * (EN * 2) + vc1 * 16), (LAS unsigned*)(st + 24576 + 8192), 16, 0, 0);
    __builtin_amdgcn_global_load_lds((const unsigned*)gdc, (LAS unsigned*)(F.lds + STAGE * GB_STG + 40960 + F.wave * 256), 4, 0, 0);
}
template <int ROWB, class SWZ> __device__ __forceinline__ bf16x8 gb_frag_tr(const LAS unsigned char* tile, int lane, int c, int ks, SWZ swz) {
    const int g = lane >> 4, q = (lane & 15) >> 2, p = lane & 3;
    const int r0 = 32 * ks + 8 * g + q, r1 = r0 + 4;
    const s16x4 lo = __builtin_amdgcn_ds_read_tr16_b64_v4i16((LAS s16x4*)(tile + ROWB * r0 + 16 * ((2 * c + (p >> 1)) ^ swz(r0)) + 8 * (p & 1)));
    const s16x4 hi = __builtin_amdgcn_ds_read_tr16_b64_v4i16((LAS s16x4*)(tile + ROWB * r1 + 16 * ((2 * c + (p >> 1)) ^ swz(r1)) + 8 * (p & 1)));
    return __builtin_shufflevector(lo, hi, 0, 1, 2, 3, 4, 5, 6, 7);
}
__device__ __forceinline__ bf16x8 gb_frag(const LAS unsigned char* tile, int row, int ch) { return *(const LAS bf16x8*)(tile + (row * 8 + (ch ^ (row & 7))) * 16); }
template <int STAGE> __device__ __forceinline__ void glaB_step(const Frame& F, int b, int h, int d, int step, f32x4 (&S)[4], bf16* od) {
    const int lane = F.lane, n = lane & 15, kg = lane >> 4, sl = F.wave;
    if (step == 0) asm volatile("s_waitcnt vmcnt(6)" ::: "memory"); else if (step == 1) asm volatile("s_waitcnt vmcnt(10)" ::: "memory"); else asm volatile("s_waitcnt vmcnt(14)" ::: "memory");
    __builtin_amdgcn_s_barrier();
    asm volatile("" ::: "memory");
    glaB_issue<(STAGE + 2) % 3>(F, b, h, d, step + 2 < NCHUNK ? step + 2 : NCHUNK - 1);
    asm volatile("" ::: "memory");
    const int c = glaB_chunk(d, step);
    const int row0 = c < 4 ? NLAT + b * CTXL + c * 64 : b * SEQ + (c - 4) * 64;
    const LAS unsigned char* st = F.lds + STAGE * GB_STG;
    bf16x8 vf[2], qf[4][2], af[4][2], kf[4][2]; f32x4 dc[4];
#pragma unroll
    for (int T = 0; T < 2; ++T) vf[T] = gb_frag_tr<256>(st + 24576, lane, sl, T, swz_v);
#pragma unroll
    for (int I = 0; I < 4; ++I)
#pragma unroll
        for (int T = 0; T < 2; ++T) { qf[I][T] = gb_frag(st, 16 * I + n, 4 * T + kg); af[I][T] = gb_frag(st + 8192, 16 * I + n, 4 * T + kg); }
#pragma unroll
    for (int I = 0; I < 4; ++I)
#pragma unroll
        for (int T = 0; T < 2; ++T) kf[I][T] = gb_frag_tr<128>(st + 16384, lane, I, T, swz_k);
#pragma unroll
    for (int q = 0; q < 4; ++q) dc[q] = *(const LAS f32x4*)(st + 40960 + sl * 256 + (16 * q + 4 * kg) * 4);
    bf16x8 sb[2];
#pragma unroll
    for (int G2 = 0; G2 < 2; ++G2) { u32x4 sw; sw.x = pk2(S[2 * G2][0], S[2 * G2][1]); sw.y = pk2(S[2 * G2][2], S[2 * G2][3]); sw.z = pk2(S[2 * G2 + 1][0], S[2 * G2 + 1][1]); sw.w = pk2(S[2 * G2 + 1][2], S[2 * G2 + 1][3]); sb[G2] = __builtin_bit_cast(bf16x8, sw); }
    asm volatile("s_waitcnt lgkmcnt(0)" ::: "memory");
    f32x4 o[4];
#pragma unroll
    for (int I = 0; I < 4; ++I) o[I] = (f32x4){0.f, 0.f, 0.f, 0.f};
#pragma unroll
    for (int I = 0; I < 4; ++I) o[I] = MFMA16(sb[0], qf[I][0], o[I]);
#pragma unroll
    for (int I = 0; I < 4; ++I) o[I] = MFMA16(sb[1], qf[I][1], o[I]);
#pragma unroll
    for (int q = 0; q < 4; ++q) S[q] = MFMA16(kf[q][0], vf[0], S[q]);
#pragma unroll
    for (int I = 0; I < 4; ++I) o[I] = MFMA16(vf[0], af[I][0], o[I]);
#pragma unroll
    for (int q = 0; q < 4; ++q) S[q] = MFMA16(kf[q][1], vf[1], S[q]);
#pragma unroll
    for (int I = 0; I < 4; ++I) o[I] = MFMA16(vf[1], af[I][1], o[I]);
#pragma unroll
    for (int q = 0; q < 4; ++q) S[q] = S[q] * dc[q];
    u32x2 ow[4];
#pragma unroll
    for (int I = 0; I < 4; ++I) { ow[I].x = pk2(o[I][0], o[I][1]); ow[I].y = pk2(o[I][2], o[I][3]); }
    asm volatile("s_waitcnt lgkmcnt(0)" ::: "memory");
#pragma unroll
    for (int I = 0; I < 4; ++I) *(u32x2*)(od + (size_t)(row0 + 16 * I + n) * 512 + h * 128 + 16 * sl + 4 * kg) = ow[I];
    asm volatile("" ::: "memory");
}
__device__ __forceinline__ void glaB_group(const Frame& F, int cg) {
    const int d = cg & 1, h = (cg >> 1) & 3, b = cg >> 3;
    bf16* od = (bf16*)(F.ws + WS_U) + (size_t)d * NTOK * 512;
    f32x4 S[4];
#pragma unroll
    for (int q = 0; q < 4; ++q) S[q] = (f32x4){0.f, 0.f, 0.f, 0.f};
    asm volatile("s_waitcnt vmcnt(0) lgkmcnt(0)" ::: "memory");
    __builtin_amdgcn_s_barrier();
    asm volatile("" ::: "memory");
    glaB_issue<0>(F, b, h, d, 0); glaB_issue<1>(F, b, h, d, 1);
    asm volatile("" ::: "memory");
    for (int s0 = 0; s0 + 2 < NCHUNK; s0 += 3) { glaB_step<0>(F, b, h, d, s0, S, od); glaB_step<1>(F, b, h, d, s0 + 1, S, od); glaB_step<2>(F, b, h, d, s0 + 2, S, od); }
    glaB_step<0>(F, b, h, d, 66, S, od); glaB_step<1>(F, b, h, d, 67, S, od);
    static_assert(NCHUNK == 68, "tail of the step loop");
    asm volatile("s_waitcnt vmcnt(0)" ::: "memory");
    __builtin_amdgcn_s_barrier();
}
__device__ __forceinline__ void conv_moe_dynamic(const Frame& F0, int l) {
    Frame F = relaunder(F0);
    LAS float* scr = (LAS float*)(F.lds + F.wave * 16384);
    unsigned* ctr = (unsigned*)(F.ws + WS_CTL) + CW_WQ + l * 64;
    constexpr int I_13 = 16 * 32, I_2 = 8 * 32, NIT = NEXP * (I_13 + I_2), CH = 8;
    for (;;) {
        unsigned t0 = 0; if (F.lane == 0) t0 = atomicAdd(ctr, (unsigned)CH);
        const int it0 = __builtin_amdgcn_readfirstlane((int)t0);
        if (it0 >= NIT) break;
        for (int it = it0; it < it0 + CH && it < NIT; ++it) conv_moe_item(F, l, it, scr);
    }
}

__device__ __forceinline__ void ph_combine(const Frame& F0, int ie, int nrows) {
    Frame F = relaunder(F0);
    const int gw = F.vcu * 8 + F.wave, NGW = F.G * 8, lane = F.lane;
    const bf16* P = (const bf16*)(F.ws + WS_P); bf16* Q = (bf16*)(F.ws + WS_Q);
    const bf16* o0 = (const bf16*)(F.ws + WS_U); const bf16* o1 = o0 + (size_t)NTOK * 512;
    const float* nw = inptr(F, I_NORMW) + (size_t)ie * 512;
    const int col = 8 * lane;
    const f32x4 nwa = *(const f32x4*)(nw + col), nwb = *(const f32x4*)(nw + col + 4);
    for (int r0 = gw * 4; r0 < nrows; r0 += NGW * 4) {
        if (KO_MASK & 2) {
#pragma unroll
            for (int r = 0; r < 4; ++r) *(u32x4*)(Q + (size_t)(r0 + r) * D + 512 + col) = (u32x4){0u, 0u, 0u, 0u};
            continue; }
        u32x4 a[4], bq[4], rr[4];
#pragma unroll
        for (int r = 0; r < 4; ++r) { const size_t row = r0 + r; a[r] = *(const u32x4*)(o0 + row * 512 + col); bq[r] = *(const u32x4*)(o1 + row * 512 + col); rr[r] = *(const u32x4*)(P + row * EN + PC_RG + col); }
#pragma unroll
        for (int r = 0; r < 4; ++r) {
            const f32x4 xa = ubf_lo(a[r]) + ubf_lo(bq[r]), xb = ubf_hi(a[r]) + ubf_hi(bq[r]);
            float ss = (xa[0] * xa[0] + xa[1] * xa[1]) + (xa[2] * xa[2] + xa[3] * xa[3]) + (xb[0] * xb[0] + xb[1] * xb[1]) + (xb[2] * xb[2] + xb[3] * xb[3]);
            ss = row16_sum(ss);
            const float rinv = 1.0f / sqrtf(ss * (1.0f / 128.0f) + RMS_EPS);
            f32x4 ra = ubf_lo(rr[r]), rb = ubf_hi(rr[r]);
#pragma unroll
            for (int j = 0; j < 4; ++j) { ra[j] = fast_silu(ra[j]); rb[j] = fast_silu(rb[j]); }
            *(u32x4*)(Q + (size_t)(r0 + r) * D + 512 + col) = pack8(xa * rinv * nwa * ra, xb * rinv * nwb * rb); }
    }
}

#if defined(FP8_PROBE)
typedef int i32x8 __attribute__((ext_vector_type(8)));
__device__ __forceinline__ unsigned fp8_of_int(int v) { const int a = v < 0 ? -v : v; const unsigned c = a == 0 ? 0x00u : a == 1 ? 0x38u : a == 2 ? 0x40u : 0x44u; return v < 0 ? (c | 0x80u) : c; }
__device__ __forceinline__ int fp8_kidx(int kg, int e) { return FP8_PROBE == 1 ? 32 * kg + e : (e < 16 ? 16 * kg + e : 64 + 16 * kg + (e - 16)); }
__device__ __forceinline__ bool fp8_layout_test(int lane) {
    const int r = lane & 15, kg = lane >> 4;
    i32x8 a, b;
#pragma unroll
    for (int w = 0; w < 8; ++w) { unsigned aw = 0, bw = 0;
#pragma unroll
        for (int by = 0; by < 4; ++by) { const int k = fp8_kidx(kg, 4 * w + by);
            const int av = (k == (7 * r + 3) % 128) ? 1 : 0; const int bv = ((k * 5 + r * 3) % 7) - 3;
            aw |= fp8_of_int(av) << (8 * by); bw |= fp8_of_int(bv) << (8 * by); }
        a[w] = (int)aw; b[w] = (int)bw; }
    f32x4 c = (f32x4){0.f, 0.f, 0.f, 0.f};
    c = __builtin_amdgcn_mfma_scale_f32_16x16x128_f8f6f4(a, b, c, 0, 0, 0, 0, 0, 0);
    bool bad = false;
#pragma unroll
    for (int q = 0; q < 4; ++q) { const int i = 4 * kg + q; const int kk = (7 * i + 3) % 128; const float ex = (float)(((kk * 5 + r * 3) % 7) - 3); if (c[q] != ex) bad = true; }
    return __builtin_amdgcn_ballot_w64(bad) != 0ull;
}
#endif
struct Args { const float* in[25]; float* out; unsigned char* ws; int ph_lo, ph_hi; };
constexpr int NPHASE = 2 + 9 * DEPTH;

__global__ void __launch_bounds__(512, 2) fwd(Args args) {
    extern __shared__ __attribute__((aligned(16))) unsigned char lds_raw[];
    Frame F;
    F.lds = (LAS unsigned char*)lds_raw;
    F.tid = threadIdx.x; F.lane = F.tid & 63; F.wave = __builtin_amdgcn_readfirstlane(F.tid >> 6);
    F.G = gridDim.x; { const int bx = blockIdx.x; F.vcu = (F.G % 8 == 0) ? (bx % 8) * (F.G / 8) + bx / 8 : bx; }
    F.out = args.out; F.ws = args.ws;
    volatile LAS unsigned* MISC = (volatile LAS unsigned*)(F.lds + MISC_OFF);
    if (F.tid < 64) MISC[F.tid] = 0u;
    if (F.tid < 25) ((LAS unsigned long long*)(F.lds + MISC_OFF + 256))[F.tid] = (unsigned long long)args.in[F.tid];
    __syncthreads();
    const int lo = args.ph_lo, hi = args.ph_hi;
    const bool multi = (hi - lo) > 1;
    XcdBarrier bar; bar.bar = (unsigned*)(F.ws + WS_CTL) + CW_BAR; bar.x = 0; bar.st = MISC + 8;
    if (multi) bar = xcd_barrier_post((unsigned*)(F.ws + WS_CTL) + CW_BAR, MISC + 8);
#ifndef PH_SEL
#define PH_SEL 0xffffffff
#endif
#define IN(k) (lo <= (k) && (k) < hi)
#define SEL(b) ((PH_SEL >> (b)) & 1)
#ifndef DUP_MASK
#define DUP_MASK 0
#endif
#define REP(bit) for (int rep_ = 0; rep_ < ((DUP_MASK & (bit)) ? 2 : 1); ++rep_)
#define SEAM(k) do { if ((k) + 1 < hi) xcd_barrier(bar); } while (0)

    if (SEL(0) && IN(0)) { REP(64) { ph_ada(F); __syncthreads(); conv_dense_weights(F); __syncthreads(); } SEAM(0); }
    if (SEL(1) && IN(1)) { REP(64) { ph_u0(F); __syncthreads(); } SEAM(1); }

    for (int l = 0; l < DEPTH; ++l) {
        const int pb = 2 + 9 * l; const bool even = (l & 1) == 0; const int ie = l >> 1;
        const int m_in = (l < 3) ? NTOK : NLAT;
        const int m_out = (l < 2) ? NTOK : NLAT;
        if (SEL(2) && IN(pb + 0)) {
            REP(32) { if (even) {
                LinSched S; S.init(m_in, EN, 1024, F.G, (int)blockIdx.x);
                EpiEvenIn E{(bf16*)(F.ws + WS_P), (const float*)(F.ws + WS_ROPE)};
                pg8::gemm_phase(F.lds, (const char*)(F.ws + WS_U), (const char*)(F.ws + WS_WINE) + (size_t)ie * EN * 1024 * 2, 1024, S, E);
            } else {
                LinSched S; S.init(m_in, ON, 1024, F.G, (int)blockIdx.x);
                EpiOddIn E{(bf16*)(F.ws + WS_P)};
                pg8::gemm_phase(F.lds, (const char*)(F.ws + WS_U), (const char*)(F.ws + WS_WINO) + (size_t)ie * ON * 1024 * 2, 1024, S, E);
            } }
            SEAM(pb + 0);
        }
        if (SEL(3) && IN(pb + 1)) {
            if (even) {
                const Frame Fm = relaunder(F);
                const int nun = NB * 2 * 32 + (l == 0 ? NB * 2 * 2 : 0);
                REP(1) for (int u = Fm.vcu; u < nun; u += Fm.G) {
                    if (u < NB * 2 * 32) attn_unit(Fm, ie, u >> 6, (u >> 5) & 1, u & 31, false);
                    else { const int v = u - NB * 2 * 32; attn_unit(Fm, ie, v >> 2, (v >> 1) & 1, v & 1, true); }
                }
                __syncthreads();
                if (!(KO_MASK & 2)) REP(2) for (int u = Fm.vcu * 8 + Fm.wave; u < NB * NCHUNK * 8; u += Fm.G * 8) { if (u & 1) glaA_unit<1>(Fm, ie, u / (NCHUNK * 8), (u / 8) % NCHUNK, (u >> 1) & 3); else glaA_unit<0>(Fm, ie, u / (NCHUNK * 8), (u / 8) % NCHUNK, (u >> 1) & 3); }
                __syncthreads();
            } else {
                REP(16) { ph_conv(F, ie, m_out); __syncthreads(); }
            }
            if (!even) REP(8) { conv_moe_weights(F, l); __syncthreads(); }
            SEAM(pb + 1);
        }
        if (even) {
            if (SEL(4) && IN(pb + 2)) {
                { const Frame Fm = relaunder(F);
                  if (!(KO_MASK & 2)) REP(4) for (int cg = Fm.vcu; cg < 128; cg += Fm.G) glaB_group(Fm, cg);
                  __syncthreads();
                  conv_moe_dynamic(Fm, l); }
                SEAM(pb + 2);
            }
            if (SEL(5) && IN(pb + 3)) { REP(16) { ph_combine(F, ie, m_out); __syncthreads(); } SEAM(pb + 3); }
        }
        if (SEL(6) && IN(pb + 4)) {
            REP(32) { LinSched S; S.init(m_out, 1024, 1024, F.G, (int)blockIdx.x);
            EpiPlain E{(bf16*)(F.ws + WS_P), 1024};
            pg8::gemm_phase(F.lds, (const char*)(F.ws + WS_Q), (const char*)(F.ws + (even ? WS_WOUTE : WS_WOUTO)) + (size_t)ie * 1024 * 1024 * 2, 1024, S, E); }
            SEAM(pb + 4);
        }
        if (SEL(7) && IN(pb + 5)) { if (DUP_MASK & 128) { ph_ln1(F, l, m_out, true); __syncthreads(); } ph_ln1(F, l, m_out); SEAM(pb + 5); }
        if (SEL(8) && IN(pb + 6)) {
            if (!(KO_MASK & 8)) REP(32) {
                moe_tables(F.lds, (const unsigned*)(F.ws + WS_CTL) + CW_CNT + l * 64);
                MoeSched<1> S; S.T = moe_tab(F.lds); S.rowtok = (const int*)(F.ws + WS_ROWTOK); S.G = F.G; S.c = F.vcu; S.bstride = (size_t)256 * 1024; S.estride = (size_t)1024 * 1024;
                EpiG1 E{(unsigned char*)(F.ws + WS_Q), 1.0f / W8_SCALE};
                pg8::gemm_phase<EpiG1, MoeSched<1>, 1>(F.lds, (const char*)(F.ws + WS_U8), (const char*)(F.ws + WS_W13), 1024, S, E);
            }
            SEAM(pb + 6);
        }
        if (SEL(9) && IN(pb + 7)) {
            if (!(KO_MASK & 8)) REP(32) {
                moe_tables(F.lds, (const unsigned*)(F.ws + WS_CTL) + CW_CNT + l * 64);
                MoeSched<0> S; S.T = moe_tab(F.lds); S.rowtok = nullptr; S.G = F.G; S.c = F.vcu; S.bstride = (size_t)256 * 512; S.estride = (size_t)1024 * 512;
                EpiPlainS E{(bf16*)(F.ws + WS_P), 1024, 1.0f / W8_SCALE};
                pg8::gemm_phase<EpiPlainS, MoeSched<0>, 1>(F.lds, (const char*)(F.ws + WS_Q), (const char*)(F.ws + WS_W2), 512, S, E);
            }
            SEAM(pb + 7);
        }
        if (SEL(10) && IN(pb + 8)) {
            moe_tables(F.lds, (const unsigned*)(F.ws + WS_CTL) + CW_CNT + l * 64);
            if (DUP_MASK & 256) { ph_ln2(F, l, m_out, true); __syncthreads(); }
            ph_ln2(F, l, m_out);
            SEAM(pb + 8);
        }
    }
#if defined(FP8_PROBE)
    if (blockIdx.x == 0) { __syncthreads(); if (F.tid < 64) { const bool bad = fp8_layout_test(F.tid); if (bad && F.tid == 0) F.out[0] = __builtin_nanf(""); } }
#endif
#undef IN
#undef SEAM
}

extern "C" void kernel_launch(void* const* d_in, const int* in_sizes, int n_in, void* d_out, int out_size, void* d_ws, size_t ws_size, hipStream_t stream) {
    static int grid = 0;
    if (grid == 0) {
        if (n_in != 25 || in_sizes[0] != NLAT * D || out_size != NLAT * D || ws_size < WS_END) { fprintf(stderr, "kernel_launch: unexpected shapes (n_in %d in0 %d out %d ws %zu)\n", n_in, n_in > 0 ? in_sizes[0] : -1, out_size, ws_size); grid = -1; return; }
        int dev = 0, cus = 0, per_cu = 0;
        if (hipGetDevice(&dev) != hipSuccess || hipDeviceGetAttribute(&cus, hipDeviceAttributeMultiprocessorCount, dev) != hipSuccess) { grid = -1; return; }
        if (hipFuncSetAttribute((const void*)fwd, hipFuncAttributeMaxDynamicSharedMemorySize, LDS_BYTES) != hipSuccess) { fprintf(stderr, "kernel_launch: hipFuncSetAttribute failed\n"); grid = -1; return; }
        if (hipOccupancyMaxActiveBlocksPerMultiprocessor(&per_cu, (const void*)fwd, 512, LDS_BYTES) != hipSuccess || per_cu < 1) fprintf(stderr, "kernel_launch: occupancy query says %d\n", per_cu);
        (void)hipGetLastError();
        grid = cus;
        if (grid < 242 || grid > 1024) { fprintf(stderr, "kernel_launch: built for a 256-CU device (got %d CUs)\n", cus); grid = -1; return; }
    }
    if (grid < 0) return;
    if (hipMemsetAsync((char*)d_ws + WS_CTL, 0, CTL_BYTES, stream) != hipSuccess) return;
    Args a{};
    for (int i = 0; i < 25; ++i) a.in[i] = (const float*)d_in[i];
    a.out = (float*)d_out; a.ws = (unsigned char*)d_ws;
#if N_LAUNCH_MODE == 1
    a.ph_lo = 0; a.ph_hi = NPHASE;
    hipLaunchKernelGGL(fwd, dim3(grid), dim3(512), LDS_BYTES, stream, a);
#else
    for (int k = 0; k < NPHASE; ++k) {
        if (k >= 2) { const int l = (k - 2) / 9, s = (k - 2) % 9; if ((l & 1) && (s == 2 || s == 3)) continue; }
        a.ph_lo = k; a.ph_hi = k + 1;
        hipLaunchKernelGGL(fwd, dim3(grid), dim3(512), LDS_BYTES, stream, a);
    }
#endif
}
```

```cpp
#include <hip/hip_runtime.h>
#define N_LAUNCH_MODE 1
#define KO_MASK 0
#define DUP_MASK 0
#include <cstdio>
#include <cstdint>

#ifndef KO_MASK
#define KO_MASK 0
#endif
#ifndef N_LAUNCH_MODE
#define N_LAUNCH_MODE 1
#endif

#define GAS __attribute__((address_space(1)))
#define LAS __attribute__((address_space(3)))
typedef unsigned short bf16;
typedef short bf16x8 __attribute__((ext_vector_type(8)));
typedef short s16x4 __attribute__((ext_vector_type(4)));
typedef float f32x2 __attribute__((ext_vector_type(2)));
typedef float f32x4 __attribute__((ext_vector_type(4)));
typedef float f32x16 __attribute__((ext_vector_type(16)));
typedef unsigned u32x2 __attribute__((ext_vector_type(2)));
typedef unsigned u32x4 __attribute__((ext_vector_type(4)));
typedef __bf16 bf16x2_t __attribute__((ext_vector_type(2)));
typedef int i32x8 __attribute__((ext_vector_type(8)));
typedef int i32x4_t __attribute__((ext_vector_type(4)));

constexpr int D = 1024, NB = 16, SEQ = 4096, CTXL = 256, DEPTH = 4;
constexpr int NLAT = NB * SEQ, NCTX = NB * CTXL, NTOK = NLAT + NCTX;
constexpr int EVEN_IN = 2336, EN = 2560, ON = 3072;
constexpr int NEXP = 32, DEXP = 512;
constexpr int SLOT_ROWS = 2 * NTOK + NEXP * 256;
constexpr float DN_ALPHA = 1.6817928305074290f;
constexpr float LN_EPS = 1e-5f, RMS_EPS = 1e-6f;
constexpr float LOG2E = 1.4426950408889634f;
constexpr int PC_Q = 0, PC_K = 512, PC_V = 640, PC_QG = 768, PC_KG = 1024, PC_VG = 1280, PC_RG = 1792, PC_GG = 2304;
constexpr int NCHUNK = 68;

constexpr size_t MiB = 1u << 20;
constexpr size_t WS_CTL = 0, CTL_BYTES = 1 * MiB;
constexpr size_t WS_MOD = 1 * MiB;
constexpr size_t WS_ROPE = 3 * MiB;
constexpr size_t WS_TOKINFO = 4 * MiB;
constexpr size_t WS_ROWTOK = 7 * MiB;
constexpr size_t WS_WINE = 16 * MiB, WS_WOUTE = 26 * MiB, WS_WINO = 30 * MiB, WS_WOUTO = 42 * MiB;
constexpr size_t WS_W13 = 46 * MiB, WS_W2 = 110 * MiB;
constexpr size_t WS_HCTX = 142 * MiB;
constexpr size_t WS_U = 158 * MiB;
constexpr size_t WS_P = 294 * MiB;
constexpr size_t WS_Q = 634 * MiB;
constexpr size_t WS_GATT = 778 * MiB, WS_GQIN = 846 * MiB, WS_GKST = 914 * MiB, WS_GVT = 982 * MiB, WS_GDEC = 1050 * MiB;
constexpr size_t WS_U8 = 1053 * MiB;
constexpr size_t WS_END = 1121 * MiB;
constexpr int CW_BAR = 4096;
constexpr int CW_CNT = 16384;
constexpr int CW_WQ = 20480;

constexpr int RING_BYTES = 131072;
constexpr int LDSX_OFF = RING_BYTES;
constexpr int MISC_OFF = LDSX_OFF + 8192;
constexpr int LDS_BYTES = 147456;

__device__ __forceinline__ unsigned pk2(float a, float b) { bf16x2_t r = __builtin_convertvector((f32x2){a, b}, bf16x2_t); return __builtin_bit_cast(unsigned, r); }
__device__ __forceinline__ unsigned pk4_fp8(float a, float b, float c, float d) { int r = __builtin_amdgcn_cvt_pk_fp8_f32(a, b, 0, false); r = __builtin_amdgcn_cvt_pk_fp8_f32(c, d, r, true); return (unsigned)r; }
__device__ __forceinline__ float bf2f(unsigned short h) { return __uint_as_float(((unsigned)h) << 16); }
__device__ __forceinline__ float bflo(unsigned w) { return __uint_as_float(w << 16); }
__device__ __forceinline__ float bfhi(unsigned w) { return __uint_as_float(w & 0xffff0000u); }
template <int CTRL> __device__ __forceinline__ float dppf(float v) { return __builtin_bit_cast(float, __builtin_amdgcn_update_dpp(0, __builtin_bit_cast(int, v), CTRL, 0xf, 0xf, false)); }
__device__ __forceinline__ float row16_sum(float v) { v += dppf<0xB1>(v); v += dppf<0x4E>(v); v += dppf<0x141>(v); v += dppf<0x140>(v); return v; }
__device__ __forceinline__ float wave_sum(float v) {
    v = row16_sum(v);
    const float s0 = __builtin_bit_cast(float, __builtin_amdgcn_readlane(__builtin_bit_cast(int, v), 0)), s1 = __builtin_bit_cast(float, __builtin_amdgcn_readlane(__builtin_bit_cast(int, v), 16));
    const float s2 = __builtin_bit_cast(float, __builtin_amdgcn_readlane(__builtin_bit_cast(int, v), 32)), s3 = __builtin_bit_cast(float, __builtin_amdgcn_readlane(__builtin_bit_cast(int, v), 48));
    return (s0 + s1) + (s2 + s3);
}
__device__ __forceinline__ float fast_silu(float x) { return x * __builtin_amdgcn_rcpf(1.0f + __builtin_amdgcn_exp2f(-x * LOG2E)); }

#define XB_TMO      128
#define XB_XCNT(j)  (256  + 64 * (j))
#define XB_XSUB(j)  (1280 + 64 * (j))
#define XB_XGEN(j)  (2304 + 64 * (j))
#define XB_TOP      3328
#define XB_TOPGEN   3392
#define XCD_BAR_WORDS 3456
#define XB_SPIN_CAP (1u << 22)
__device__ __forceinline__ unsigned xb_ld(unsigned* p)              { return __hip_atomic_load(p, __ATOMIC_RELAXED, __HIP_MEMORY_SCOPE_AGENT); }
__device__ __forceinline__ unsigned xb_add(unsigned* p, unsigned v) { return __hip_atomic_fetch_add(p, v, __ATOMIC_RELAXED, __HIP_MEMORY_SCOPE_AGENT); }
__device__ __forceinline__ unsigned xb_xcc_id() { return (unsigned)__builtin_amdgcn_s_getreg((3 << 11) | 20) & 0xFu; }
#define XB_SPIN(cond, bar) do { unsigned _sp = 0; while (cond) { __builtin_amdgcn_s_sleep(1); \
    if ((++_sp & 255u) == 0u) { if (xb_ld(&(bar)[XB_TMO])) break; if (_sp > XB_SPIN_CAP) { atomicAdd(&(bar)[XB_TMO], 1u); break; } } } } while (0)
struct XcdBarrier { unsigned* bar; unsigned x; volatile LAS unsigned* st; };
__device__ __forceinline__ XcdBarrier xcd_barrier_post(unsigned* bar, volatile LAS unsigned* st) {
    XcdBarrier b; b.bar = bar; b.x = xb_xcc_id(); b.st = st;
    if (threadIdx.x == 0) (void)xb_add(&bar[XB_XCNT(b.x)], 1u);
    return b;
}
__device__ __forceinline__ void xcd_barrier_complete(unsigned* bar, unsigned x, unsigned& nloc, unsigned& nx) {
    const unsigned G = gridDim.x * gridDim.y * gridDim.z;
    unsigned sum, cnt, mine, sp = 0u;
    for (;;) {
        sum = 0u; cnt = 0u; mine = 0u;
#pragma unroll
        for (unsigned j = 0; j < 16; ++j) { const unsigned c = xb_ld(&bar[XB_XCNT(j)]); sum += c; cnt += (c > 0u) ? 1u : 0u; mine = (j == x) ? c : mine; }
        if (sum == G) break;
        __builtin_amdgcn_s_sleep(1);
        if ((++sp & 255u) == 0u) { if (xb_ld(&bar[XB_TMO])) break; if (sp > XB_SPIN_CAP) { atomicAdd(&bar[XB_TMO], 1u); break; } }
    }
    nloc = mine > 0u ? mine : 1u; nx = cnt > 0u ? cnt : 1u;
}
__device__ __forceinline__ void xcd_barrier(const XcdBarrier& b) {
    asm volatile("s_waitcnt vmcnt(0)" ::: "memory");
    __syncthreads();
    if (threadIdx.x == 0) {
        unsigned* bar = b.bar;
        __builtin_amdgcn_s_waitcnt(0);
        unsigned nloc = b.st[0], nx = b.st[1];
        if (nloc == 0u) { xcd_barrier_complete(bar, b.x, nloc, nx); b.st[0] = nloc; b.st[1] = nx; }
        const unsigned old = xb_add(&bar[XB_XSUB(b.x)], 1u);
        const unsigned gen = old / nloc;
        if (old + 1u == (gen + 1u) * nloc) {
            __builtin_amdgcn_fence(__ATOMIC_RELEASE, "agent");
            asm volatile("s_waitcnt vmcnt(0)" ::: "memory");
            const unsigned og = xb_add(&bar[XB_TOP], 1u);
            const unsigned tg = og / nx;
            if (og + 1u == (tg + 1u) * nx) xb_add(&bar[XB_TOPGEN], 1u);
            else XB_SPIN(xb_ld(&bar[XB_TOPGEN]) == tg, bar);
            __builtin_amdgcn_fence(__ATOMIC_ACQUIRE, "agent");
            xb_add(&bar[XB_XGEN(b.x)], 1u);
            asm volatile("s_waitcnt vmcnt(0)" ::: "memory");
        } else {
            XB_SPIN(xb_ld(&bar[XB_XGEN(b.x)]) == gen, bar);
            __builtin_amdgcn_fence(__ATOMIC_ACQUIRE, "agent");
            asm volatile("s_waitcnt vmcnt(0)" ::: "memory");
        }
    }
    __syncthreads();
}

namespace pg8 {
constexpr int BM = 256, BK = 64, HALF = 128, HTB = HALF * BK * 2, STAGE_BYTES = 8 * HTB;
__device__ __forceinline__ int lds_byte(int r, int c) { const int st = (r >> 4) * 2 + (c >> 5), rr = r & 15, cc = c & 31, ob = rr * 64 + cc * 2; return st * 1024 + (ob ^ (((ob >> 9) & 1) << 5)); }
__device__ __forceinline__ void stage_rc(int b, int& R, int& C) { const int st = b / 1024, sb = b % 1024, swz = sb ^ (((sb >> 9) & 1) << 5); R = (st >> 1) * 16 + swz / 64; C = (st & 1) * 32 + (swz % 64) / 2; }
__device__ __forceinline__ int perm32(int rho) { const int n = rho >> 4, i = rho & 15; return 8 * (i >> 2) + 4 * n + (i & 3); }

struct Unit { int pn; int orow0; int mt; int e; };

template <class Epi, class Sched, int FP8 = 0>
__device__ __forceinline__ void gemm_phase(LAS unsigned char* lds, const char* Abase, const char* Bbase, const int K, const Sched& S, const Epi& E) {
    int tid_ = threadIdx.x; asm volatile("" : "+v"(tid_));
    const int tid = tid_, wid = __builtin_amdgcn_readfirstlane(tid >> 6), lane = tid & 63, wr = wid >> 2, wc = wid & 3, fr = lane & 15, fq = lane >> 4;
    const unsigned K2 = FP8 ? (unsigned)K : (unsigned)K * 2u;
    const int nt = (int)(K2 / 128u);
    int Rr[2], Cc[2]; unsigned voffB[2];
#pragma unroll
    for (int i = 0; i < 2; ++i) { stage_rc(tid * 16 + i * 8192, Rr[i], Cc[i]); const int Rb = (Rr[i] & ~31) + perm32(Rr[i] & 31); voffB[i] = (unsigned)Rb * K2 + (unsigned)Cc[i] * 2u; }
    const size_t kstep = (size_t)(BK * 2);
    const size_t hstep = (size_t)HALF * K2;
    const unsigned ldsw = (unsigned)wid * 1024u;
    const int aoff = FP8 ? lds_byte(wr * 64 + fr, 32 * (fq >> 1) + 16 * (fq & 1)) : lds_byte(wr * 64 + fr, fq * 8), boff = FP8 ? lds_byte(wc * 32 + fr, 32 * (fq >> 1) + 16 * (fq & 1)) : lds_byte(wc * 32 + fr, fq * 8);
#define PG8_SA(b, h) (((b) * 2 + (h)) * HTB)
#define PG8_SB(b, h) ((4 + (b) * 2 + (h)) * HTB)
#define PG8_STAGE(bufoff, gbase, voff) do { _Pragma("unroll") for (int _i = 0; _i < 2; ++_i) \
        __builtin_amdgcn_global_load_lds((const unsigned*)((const char*)(gbase) + (voff)[_i]), (LAS unsigned*)(lds + (bufoff) + ldsw + _i * 8192), 16, 0, 0); } while (0)
#define PG8_LD8(ptr) __builtin_shufflevector(*(const LAS i32x4_t*)(ptr), *(const LAS i32x4_t*)((ptr) + 16), 0, 1, 2, 3, 4, 5, 6, 7)
#define PG8_LDA(dst, b, h) do { if constexpr (FP8) { _Pragma("unroll") for (int m = 0; m < 4; ++m) dst##8[m] = PG8_LD8(lds + PG8_SA(b, h) + aoff + m * 2048); } \
        else { _Pragma("unroll") for (int m = 0; m < 4; ++m) _Pragma("unroll") for (int k = 0; k < 2; ++k) dst[m][k] = *(const LAS bf16x8*)(lds + PG8_SA(b, h) + aoff + m * 2048 + k * 1024); } } while (0)
#define PG8_LDB(dst, b, h) do { if constexpr (FP8) { _Pragma("unroll") for (int n = 0; n < 2; ++n) dst##8[n] = PG8_LD8(lds + PG8_SB(b, h) + boff + n * 2048); } \
        else { _Pragma("unroll") for (int n = 0; n < 2; ++n) _Pragma("unroll") for (int k = 0; k < 2; ++k) dst[n][k] = *(const LAS bf16x8*)(lds + PG8_SB(b, h) + boff + n * 2048 + k * 1024); } } while (0)
#define PG8_MMA(ai, bj, At, Bt) do { __builtin_amdgcn_s_setprio(1); _Pragma("unroll") for (int m = 0; m < 4; ++m) _Pragma("unroll") for (int n = 0; n < 2; ++n) { \
        if constexpr (FP8) asm volatile("v_mfma_f32_16x16x128_f8f6f4 %0, %1, %2, %0" : "+v"(acc[ai][bj][m][n]) : "v"(Bt##8[n]), "v"(At##8[m])); \
        else { _Pragma("unroll") for (int k = 0; k < 2; ++k) acc[ai][bj][m][n] = __builtin_amdgcn_mfma_f32_16x16x32_bf16(Bt[n][k], At[m][k], acc[ai][bj][m][n], 0, 0, 0); } } \
        __builtin_amdgcn_s_setprio(0); } while (0)
#define PG8_WAIT_V(n) asm volatile("s_waitcnt vmcnt(" #n ")" ::: "memory")
#define PG8_WAIT_L(n) asm volatile("s_waitcnt lgkmcnt(" #n ")" ::: "memory")
#define PG8_BAR __builtin_amdgcn_s_barrier()
#define PG8_SCHED __builtin_amdgcn_sched_barrier(0)
    Unit cur, nxt; int ui = 0;
    if (!S.next(0, cur)) return;
    f32x4 acc[2][2][4][2];
#pragma unroll
    for (int a = 0; a < 2; ++a)
#pragma unroll
        for (int b = 0; b < 2; ++b)
#pragma unroll
            for (int m = 0; m < 4; ++m)
#pragma unroll
                for (int n = 0; n < 2; ++n) { if constexpr (FP8) asm volatile("v_mov_b32 %0, 0\n\tv_mov_b32 %1, 0\n\tv_mov_b32 %2, 0\n\tv_mov_b32 %3, 0" : "=v"(acc[a][b][m][n][0]), "=v"(acc[a][b][m][n][1]), "=v"(acc[a][b][m][n][2]), "=v"(acc[a][b][m][n][3])); else acc[a][b][m][n] = (f32x4){0.f, 0.f, 0.f, 0.f}; }
    if constexpr (FP8) asm volatile("s_nop 7" ::: "memory");
    bf16x8 At[4][2], B0[2][2], B1[2][2];
    i32x8 At8[4], B08[2], B18[2];
    unsigned vAc0[2], vAc1[2], vAn0[2], vAn1[2];
#pragma unroll
    for (int i = 0; i < 2; ++i) { vAc0[i] = (unsigned)S.arow(cur, Rr[i]) * K2 + (unsigned)Cc[i] * 2u; vAc1[i] = (unsigned)S.arow(cur, HALF + Rr[i]) * K2 + (unsigned)Cc[i] * 2u; vAn0[i] = vAc0[i]; vAn1[i] = vAc1[i]; }
    const char* cB = Bbase + S.boff(cur);
    PG8_STAGE(PG8_SB(0, 0), cB, voffB); PG8_STAGE(PG8_SB(0, 1), cB + hstep, voffB); PG8_STAGE(PG8_SA(0, 0), Abase, vAc0); PG8_STAGE(PG8_SA(0, 1), Abase, vAc1);
    if (wr == 1) PG8_BAR;
    PG8_WAIT_V(2); PG8_BAR;
    PG8_STAGE(PG8_SB(1, 0), cB + kstep, voffB); PG8_STAGE(PG8_SA(1, 0), Abase + kstep, vAc0); PG8_STAGE(PG8_SB(1, 1), cB + hstep + kstep, voffB);
    PG8_WAIT_V(6); PG8_BAR;
    for (;;) {
        const bool has_next = S.next(ui + 1, nxt);
        const char* nB = has_next ? Bbase + S.boff(nxt) : cB;
        if (has_next) {
#pragma unroll
            for (int i = 0; i < 2; ++i) { vAn0[i] = (unsigned)S.arow(nxt, Rr[i]) * K2 + (unsigned)Cc[i] * 2u; vAn1[i] = (unsigned)S.arow(nxt, HALF + Rr[i]) * K2 + (unsigned)Cc[i] * 2u; }
        } else {
#pragma unroll
            for (int i = 0; i < 2; ++i) { vAn0[i] = vAc0[i]; vAn1[i] = vAc1[i]; }
        }
        for (int t = 0; t < nt; t += 2) {
            const bool last = (t == nt - 2);
            const char* a1 = Abase + (size_t)(t + 1) * kstep;
            const char* a2 = last ? Abase : Abase + (size_t)(t + 2) * kstep; const char* b2 = last ? nB : cB + (size_t)(t + 2) * kstep;
            const char* a3 = a2 + kstep; const char* b3 = b2 + kstep;
            unsigned v20[2], v21[2];
#pragma unroll
            for (int i = 0; i < 2; ++i) { v20[i] = last ? vAn0[i] : vAc0[i]; v21[i] = last ? vAn1[i] : vAc1[i]; }
            PG8_LDB(B0, 0, 0); PG8_LDB(B1, 0, 1); PG8_SCHED; PG8_LDA(At, 0, 0); PG8_STAGE(PG8_SA(1, 1), a1, vAc1);
            PG8_WAIT_V(8); PG8_WAIT_L(0); PG8_BAR; PG8_MMA(0, 0, At, B0); PG8_MMA(0, 1, At, B1); PG8_BAR; PG8_SCHED;
            PG8_LDA(At, 0, 1); PG8_STAGE(PG8_SB(0, 0), b2, voffB); PG8_STAGE(PG8_SB(0, 1), b2 + hstep, voffB); PG8_STAGE(PG8_SA(0, 0), a2, v20);
            PG8_WAIT_V(8); PG8_WAIT_L(0); PG8_BAR; PG8_MMA(1, 0, At, B0); PG8_MMA(1, 1, At, B1); PG8_BAR; PG8_SCHED;
            PG8_LDB(B0, 1, 0); PG8_LDB(B1, 1, 1); PG8_SCHED; PG8_LDA(At, 1, 0); PG8_STAGE(PG8_SA(0, 1), a2, v21);
            PG8_WAIT_V(8); PG8_WAIT_L(0); PG8_BAR; PG8_MMA(0, 0, At, B0); PG8_MMA(0, 1, At, B1); PG8_BAR; PG8_SCHED;
            PG8_LDA(At, 1, 1); PG8_STAGE(PG8_SB(1, 0), b3, voffB); PG8_STAGE(PG8_SB(1, 1), b3 + hstep, voffB); PG8_STAGE(PG8_SA(1, 0), a3, v20);
            PG8_WAIT_V(8); PG8_WAIT_L(0); PG8_BAR; PG8_MMA(1, 0, At, B0); PG8_MMA(1, 1, At, B1); PG8_BAR; PG8_SCHED;
        }
        if (wr == 0) PG8_BAR;
        if constexpr (FP8) asm volatile("s_nop 15\n\ts_nop 15" ::: "memory");
        E(acc, cur, wr, wc, fr, fq);
        if (!has_next) break;
#pragma unroll
        for (int a = 0; a < 2; ++a)
#pragma unroll
            for (int b = 0; b < 2; ++b)
#pragma unroll
                for (int m = 0; m < 4; ++m)
#pragma unroll
                    for (int n = 0; n < 2; ++n) { if constexpr (FP8) asm volatile("v_mov_b32 %0, 0\n\tv_mov_b32 %1, 0\n\tv_mov_b32 %2, 0\n\tv_mov_b32 %3, 0" : "=v"(acc[a][b][m][n][0]), "=v"(acc[a][b][m][n][1]), "=v"(acc[a][b][m][n][2]), "=v"(acc[a][b][m][n][3])); else acc[a][b][m][n] = (f32x4){0.f, 0.f, 0.f, 0.f}; }
        if constexpr (FP8) asm volatile("s_nop 7" ::: "memory");
        cur = nxt; cB = nB; ++ui;
#pragma unroll
        for (int i = 0; i < 2; ++i) { vAc0[i] = vAn0[i]; vAc1[i] = vAn1[i]; }
        if (wr == 1) PG8_BAR;
    }
    PG8_WAIT_V(0);
    PG8_BAR;
#undef PG8_SA
#undef PG8_SB
#undef PG8_STAGE
#undef PG8_LDA
#undef PG8_LDB
#undef PG8_MMA
#undef PG8_WAIT_V
#undef PG8_WAIT_L
#undef PG8_BAR
#undef PG8_SCHED
}
}
struct LinSched {
    int nM, nN, nwg, G, c; size_t bstride;
    __device__ __forceinline__ void init(int M, int N, int K, int G_, int c_) { nM = M / 256; nN = N / 256; nwg = nM * nN; G = G_; c = c_; bstride = (size_t)256 * K * 2; }
    __device__ __forceinline__ bool next(int i, pg8::Unit& u) const {
        const long L = (long)i * G + c; if (L >= nwg) return false;
        int wgid = (int)L; { const int q = nwg / 8, r = nwg % 8, xcd = wgid % 8, off = wgid / 8; wgid = (xcd < r ? xcd * (q + 1) : r * (q + 1) + (xcd - r) * q) + off; }
        const int nig = 8 * nN, gid = wgid / nig, fm = gid * 8, gsz = (nM - fm) < 8 ? (nM - fm) : 8;
        u.mt = fm + ((wgid % nig) % gsz); u.pn = (wgid % nig) / gsz; u.orow0 = u.mt * 256; u.e = 0; return true;
    }
    __device__ __forceinline__ int arow(const pg8::Unit& u, int lr) const { return u.orow0 + lr; }
    __device__ __forceinline__ size_t boff(const pg8::Unit& u) const { return (size_t)u.pn * bstride; }
};
struct MoeTab { LAS int* ts; LAS int* cnt; LAS unsigned char* tile_e; };
__device__ __forceinline__ MoeTab moe_tab(LAS unsigned char* lds) { MoeTab t; t.ts = (LAS int*)(lds + LDSX_OFF); t.cnt = (LAS int*)(lds + LDSX_OFF + 256); t.tile_e = (LAS unsigned char*)(lds + LDSX_OFF + 512); return t; }
__device__ __forceinline__ void moe_tables(LAS unsigned char* lds, const unsigned* gcnt) {
    MoeTab T = moe_tab(lds);
    __syncthreads();
    if (threadIdx.x == 0) { int s = 0; for (int e = 0; e < NEXP; ++e) { const int c = (int)gcnt[e]; T.cnt[e] = c; T.ts[e] = s; s += (c + 255) >> 8; } T.ts[NEXP] = s; }
    __syncthreads();
    const int nt = T.ts[NEXP];
    for (int mt = threadIdx.x; mt < nt; mt += blockDim.x) { int e = 0; for (int j = 1; j < NEXP; ++j) e += (mt >= T.ts[j]) ? 1 : 0; T.tile_e[mt] = (unsigned char)e; }
    __syncthreads();
}
template <int GATHER> struct MoeSched {
    MoeTab T; const int* rowtok; int G, c; size_t bstride; size_t estride;
    __device__ __forceinline__ bool next(int i, pg8::Unit& u) const {
        const int L = i * G + c; const int nt = T.ts[NEXP]; if (L >= nt * 4) return false;
        u.mt = L >> 2; u.pn = L & 3; u.orow0 = u.mt * 256; u.e = (int)T.tile_e[u.mt]; return true;
    }
    __device__ __forceinline__ int arow(const pg8::Unit& u, int lr) const {
        if (GATHER) { const int idx = (u.mt - T.ts[u.e]) * 256 + lr; return idx < T.cnt[u.e] ? rowtok[(size_t)u.e * NTOK + idx] : 0; }
        return u.orow0 + lr;
    }
    __device__ __forceinline__ size_t boff(const pg8::Unit& u) const { return (size_t)u.e * estride + (size_t)u.pn * bstride; }
};

__device__ __forceinline__ u32x4 pack8(const f32x4 a, const f32x4 b) { u32x4 w; w.x = pk2(a[0], a[1]); w.y = pk2(a[2], a[3]); w.z = pk2(b[0], b[1]); w.w = pk2(b[2], b[3]); return w; }
struct EpiPlain {
    bf16* O; int ldc;
    __device__ __forceinline__ void operator()(const f32x4 (&acc)[2][2][4][2], const pg8::Unit& u, int wr, int wc, int fr, int fq) const {
        const int row0 = u.orow0 + wr * 64 + fr, col0 = u.pn * 256 + wc * 32 + 8 * fq;
#pragma unroll
        for (int ai = 0; ai < 2; ++ai)
#pragma unroll
            for (int m = 0; m < 4; ++m) { bf16* rowp = O + (size_t)(row0 + ai * 128 + m * 16) * ldc + col0;
#pragma unroll
                for (int bj = 0; bj < 2; ++bj) *(u32x4*)(rowp + bj * 128) = pack8(acc[ai][bj][m][0], acc[ai][bj][m][1]); }
    }
};
struct EpiPlainS {
    bf16* O; int ldc; float sc;
    __device__ __forceinline__ void operator()(const f32x4 (&acc)[2][2][4][2], const pg8::Unit& u, int wr, int wc, int fr, int fq) const {
        const int row0 = u.orow0 + wr * 64 + fr, col0 = u.pn * 256 + wc * 32 + 8 * fq;
#pragma unroll
        for (int ai = 0; ai < 2; ++ai)
#pragma unroll
            for (int m = 0; m < 4; ++m) { bf16* rowp = O + (size_t)(row0 + ai * 128 + m * 16) * ldc + col0;
#pragma unroll
                for (int bj = 0; bj < 2; ++bj) *(u32x4*)(rowp + bj * 128) = pack8(acc[ai][bj][m][0] * sc, acc[ai][bj][m][1] * sc); }
    }
};
struct EpiEvenIn {
    bf16* O; const float* rope;
    __device__ __forceinline__ void operator()(const f32x4 (&acc)[2][2][4][2], const pg8::Unit& u, int wr, int wc, int fr, int fq) const {
        const int row0 = u.orow0 + wr * 64 + fr, col0 = u.pn * 256 + wc * 32 + 8 * fq;
        const bool lat = u.orow0 < NLAT;
#pragma unroll
        for (int ai = 0; ai < 2; ++ai)
#pragma unroll
            for (int m = 0; m < 4; ++m) { const int row = row0 + ai * 128 + m * 16; bf16* rowp = O + (size_t)row * EN + col0;
                const int s = row & (SEQ - 1); const int pos = (wc & 1) ? (s & 63) : (s >> 6);
#pragma unroll
                for (int bj = 0; bj < 2; ++bj) { f32x4 v0 = acc[ai][bj][m][0], v1 = acc[ai][bj][m][1];
                    const bool rp = lat && (u.pn < 2 || (u.pn == 2 && bj == 0));
                    if (rp) { const f32x4 c = *(const f32x4*)(rope + pos * 16 + 4 * fq), sn = *(const f32x4*)(rope + 1024 + pos * 16 + 4 * fq);
                        const f32x4 o1 = v0 * c - v1 * sn, o2 = v1 * c + v0 * sn; v0 = o1; v1 = o2; }
                    *(u32x4*)(rowp + bj * 128) = pack8(v0, v1); } }
    }
};
struct EpiOddIn {
    bf16* O;
    __device__ __forceinline__ void operator()(const f32x4 (&acc)[2][2][4][2], const pg8::Unit& u, int wr, int wc, int fr, int fq) const {
        const int row0 = u.orow0 + wr * 64 + fr;
#pragma unroll
        for (int ai = 0; ai < 2; ++ai)
#pragma unroll
            for (int m = 0; m < 4; ++m) { bf16* rowp = O + (size_t)(row0 + ai * 128 + m * 16) * 2048;
                if (u.pn < 4) {
#pragma unroll
                    for (int bj = 0; bj < 2; ++bj) *(u32x4*)(rowp + u.pn * 256 + bj * 128 + wc * 32 + 8 * fq) = pack8(acc[ai][bj][m][0], acc[ai][bj][m][1]);
                } else {
                    *(u32x4*)(rowp + 1024 + (u.pn - 4) * 128 + wc * 32 + 8 * fq) = pack8(acc[ai][0][m][0] * acc[ai][1][m][0], acc[ai][0][m][1] * acc[ai][1][m][1]);
                } }
    }
};
struct EpiG1 {
    unsigned char* O; float sc;
    __device__ __forceinline__ void operator()(const f32x4 (&acc)[2][2][4][2], const pg8::Unit& u, int wr, int wc, int fr, int fq) const {
        const int row0 = u.orow0 + wr * 64 + fr, col0 = u.pn * 128 + wc * 32 + 8 * fq;
#pragma unroll
        for (int ai = 0; ai < 2; ++ai)
#pragma unroll
            for (int m = 0; m < 4; ++m) { unsigned char* rowp = O + (size_t)(row0 + ai * 128 + m * 16) * DEXP + col0;
                f32x4 a0 = acc[ai][0][m][0] * sc, a1 = acc[ai][0][m][1] * sc;
#pragma unroll
                for (int j = 0; j < 4; ++j) { a0[j] = fast_silu(a0[j]); a1[j] = fast_silu(a1[j]); }
                const f32x4 h0 = a0 * (acc[ai][1][m][0] * sc), h1v = a1 * (acc[ai][1][m][1] * sc);
                *(u32x2*)rowp = (u32x2){pk4_fp8(h0[0], h0[1], h0[2], h0[3]), pk4_fp8(h1v[0], h1v[1], h1v[2], h1v[3])}; }
    }
};
struct Frame {
    LAS unsigned char* lds;
    int tid, lane, wave, vcu, G;
    float* out; unsigned char* ws;
};
__device__ __forceinline__ const float* inptr(const Frame& F, int i) {
    const unsigned long long v = ((const LAS unsigned long long*)(F.lds + MISC_OFF + 256))[i];
    const unsigned lo = __builtin_amdgcn_readfirstlane((unsigned)v), hi = __builtin_amdgcn_readfirstlane((unsigned)(v >> 32));
    return (const float*)(((unsigned long long)hi << 32) | lo);
}
enum { I_X = 0, I_C, I_CTX, I_CCTX, I_WINE, I_WOUTE, I_SINK, I_WA2, I_BA, I_NORMW, I_WINO, I_CONVW, I_CONVB, I_WOUTO, I_ADAW, I_ADAB, I_LNW, I_LNB, I_WG, I_BG, I_WE, I_BE, I_W1, I_W3, I_W2 };
__device__ __forceinline__ int launder_v(int x) { asm volatile("" : "+v"(x)); return x; }
__device__ __forceinline__ int launder_s(int x) { asm volatile("" : "+s"(x)); return x; }
__device__ __forceinline__ Frame relaunder(const Frame& F0) { Frame F = F0; F.tid = launder_v(F0.tid); F.lane = F.tid & 63; F.wave = __builtin_amdgcn_readfirstlane(F.tid >> 6); F.vcu = launder_s(F0.vcu); return F; }
__device__ __forceinline__ const float* modp(const Frame& F, int l, int bi, int n) { return (const float*)(F.ws + WS_MOD) + ((size_t)(l * 17 + bi) * 6 + n) * D; }
__device__ __forceinline__ int row_bi(int row) { return row < NLAT ? (row >> 12) : 16; }

__device__ __forceinline__ void sincos_d(double a, float& c, float& s) {
    const double TWO_OVER_PI = 0.63661977236758134308, PIO2_HI = 1.57079632679489655800e+00, PIO2_LO = 6.12323399573676603587e-17;
    const double n = __builtin_rint(a * TWO_OVER_PI); double r = (a - n * PIO2_HI) - n * PIO2_LO; const double r2 = r * r;
    double sp = -1.0 / 1307674368000.0; sp = sp * r2 + 1.0 / 6227020800.0; sp = sp * r2 - 1.0 / 39916800.0; sp = sp * r2 + 1.0 / 362880.0; sp = sp * r2 - 1.0 / 5040.0; sp = sp * r2 + 1.0 / 120.0; sp = sp * r2 - 1.0 / 6.0; sp = sp * r2 + 1.0; sp *= r;
    double cp = 1.0 / 20922789888000.0; cp = cp * r2 - 1.0 / 87178291200.0; cp = cp * r2 + 1.0 / 479001600.0; cp = cp * r2 - 1.0 / 3628800.0; cp = cp * r2 + 1.0 / 40320.0; cp = cp * r2 - 1.0 / 720.0; cp = cp * r2 + 1.0 / 24.0; cp = cp * r2 - 0.5; cp = cp * r2 + 1.0;
    const int q = ((int)n) & 3;
    const double sv = (q == 0) ? sp : (q == 1) ? cp : (q == 2) ? -sp : -cp;
    const double cv = (q == 0) ? cp : (q == 1) ? -sp : (q == 2) ? -cp : sp;
    c = (float)cv; s = (float)sv;
}
__device__ __forceinline__ void ph_ada(const Frame& F0) {
    Frame F = relaunder(F0);
    LAS float* sl = (LAS float*)F.lds;
    LAS float* red = (LAS float*)(F.lds + 17 * 1024 * 4);
    for (int idx = F.tid; idx < 17 * 1024; idx += 512) { const int bi = idx >> 10, k = idx & 1023; const float c = bi < 16 ? inptr(F, I_C)[bi * 1024 + k] : inptr(F, I_CCTX)[k]; sl[idx] = c / (1.0f + expf(-c)); }
    __syncthreads();
    for (int it = F.vcu; it < 4 * 96; it += F.G) {
        const int l = it / 96, n0 = (it % 96) * 64;
        const float* W = inptr(F, I_ADAW) + (size_t)l * 1024 * 6144 + n0 + F.lane;
        float acc[17];
#pragma unroll
        for (int b = 0; b < 17; ++b) acc[b] = 0.f;
        const int kb = F.wave * 128;
        for (int k = kb; k < kb + 128; k += 4) {
            const float w0 = W[(size_t)k * 6144], w1 = W[(size_t)(k + 1) * 6144], w2 = W[(size_t)(k + 2) * 6144], w3 = W[(size_t)(k + 3) * 6144];
#pragma unroll
            for (int b = 0; b < 17; ++b) { const f32x4 s = *(const LAS f32x4*)(sl + b * 1024 + k); acc[b] += s[0] * w0 + s[1] * w1 + s[2] * w2 + s[3] * w3; }
        }
#pragma unroll
        for (int b = 0; b < 17; ++b) red[(F.wave * 17 + b) * 64 + F.lane] = acc[b];
        __syncthreads();
        for (int idx = F.tid; idx < 17 * 64; idx += 512) { const int b = idx >> 6, ln = idx & 63; float s = 0.f;
#pragma unroll
            for (int w = 0; w < 8; ++w) s += red[(w * 17 + b) * 64 + ln];
            ((float*)(F.ws + WS_MOD))[(size_t)(l * 17 + b) * 6144 + n0 + ln] = s + inptr(F, I_ADAB)[l * 6144 + n0 + ln]; }
        __syncthreads();
    }
    if (F.vcu == F.G - 1) {
        float* rope = (float*)(F.ws + WS_ROPE);
        for (int idx = F.tid; idx < 1024; idx += 512) { const int pos = idx >> 4, f = idx & 15;
            const double base4[4] = {1.0, 0.56234132519034908, 0.31622776601683794, 0.17782794100389228};
            double inv = (f & 3) == 0 ? base4[0] : (f & 3) == 1 ? base4[1] : (f & 3) == 2 ? base4[2] : base4[3];
            const int a = f >> 2; inv *= (a == 0) ? 1.0 : (a == 1) ? 0.1 : (a == 2) ? 0.01 : 0.001;
            float c, s; sincos_d((double)pos * inv, c, s); rope[idx] = c; rope[1024 + idx] = s; }
    }
}

__device__ __forceinline__ void tr_item(const float* W, int srcN, int K, bf16* WT, int drow0, int k0, int srccol, LAS float* scr, int lane) {
    float v[32];
    const float* p = W + (size_t)(k0 + (lane >> 5)) * srcN + (srccol >= 0 ? srccol : 0);
#pragma unroll
    for (int i = 0; i < 32; ++i) v[i] = p[(size_t)(2 * i) * srcN];
#pragma unroll
    for (int i = 0; i < 32; ++i) scr[(2 * i + (lane >> 5)) * 33 + (lane & 31)] = srccol >= 0 ? v[i] : 0.f;
    asm volatile("s_waitcnt lgkmcnt(0)" ::: "memory");
    const int c = lane & 7;
#pragma unroll
    for (int j = 0; j < 4; ++j) { const int n = (lane >> 3) + 8 * j; const LAS float* s = scr + (8 * c) * 33 + n;
        u32x4 o; o.x = pk2(s[0 * 33], s[1 * 33]); o.y = pk2(s[2 * 33], s[3 * 33]); o.z = pk2(s[4 * 33], s[5 * 33]); o.w = pk2(s[6 * 33], s[7 * 33]);
        *(u32x4*)(WT + (size_t)(drow0 + n) * K + k0 + 8 * c) = o; }
    asm volatile("s_waitcnt lgkmcnt(0)" ::: "memory");
}
__device__ __forceinline__ void tr_item8(const float* W, int srcN, int K, unsigned char* WT, int drow0, int k0, int srccol, float scale, LAS float* scr, int lane) {
    float v[32];
    const float* p = W + (size_t)(k0 + (lane >> 5)) * srcN + srccol;
#pragma unroll
    for (int i = 0; i < 32; ++i) v[i] = p[(size_t)(2 * i) * srcN];
#pragma unroll
    for (int i = 0; i < 32; ++i) scr[(2 * i + (lane >> 5)) * 33 + (lane & 31)] = v[i] * scale;
    asm volatile("s_waitcnt lgkmcnt(0)" ::: "memory");
    const int c = lane & 3;
#pragma unroll
    for (int j = 0; j < 2; ++j) { const int n = (lane >> 2) + 16 * j; const LAS float* s = scr + (16 * c) * 33 + n;
        u32x4 o; o.x = pk4_fp8(s[0 * 33], s[1 * 33], s[2 * 33], s[3 * 33]); o.y = pk4_fp8(s[4 * 33], s[5 * 33], s[6 * 33], s[7 * 33]);
        o.z = pk4_fp8(s[8 * 33], s[9 * 33], s[10 * 33], s[11 * 33]); o.w = pk4_fp8(s[12 * 33], s[13 * 33], s[14 * 33], s[15 * 33]);
        *(u32x4*)(WT + (size_t)(drow0 + n) * K + k0 + 16 * c) = o; }
    asm volatile("s_waitcnt lgkmcnt(0)" ::: "memory");
}
__device__ __forceinline__ int even_srccol(int j) {
    if (j < 640) { const int hb = j & ~63, p = j & 63, g = p >> 3, e = p & 7; return hb + (g >> 2) * 32 + (e >> 2) * 16 + (g & 3) * 4 + (e & 3); }
    return j < EVEN_IN ? j : -1;
}
__device__ __forceinline__ int odd_srccol(int j) { const int t = j >> 8, r = j & 255; if (t < 4) return j; return (r < 128 ? 1024 : 2048 - 128) + 128 * (t - 4) + r; }
__device__ __forceinline__ void conv_dense_weights(const Frame& F0) {
    Frame F = relaunder(F0);
    LAS float* scr = (LAS float*)(F.lds + F.wave * 16384);
    const int gw = F.vcu * 8 + F.wave, NGW = F.G * 8;
    constexpr int I_EI = 16 * 80, I_SQ = 16 * 32, I_OI = 16 * 96;
    constexpr int NIT = 2 * (I_EI + I_SQ + I_OI + I_SQ);
    for (int it = gw; it < NIT; it += NGW) {
        int r = it; const int i = r & 1; r >>= 1;
        if (r < I_EI) { const int kb = r / 80, nb = r % 80; tr_item(inptr(F, I_WINE) + (size_t)i * 1024 * EVEN_IN, EVEN_IN, 1024, (bf16*)(F.ws + WS_WINE) + (size_t)i * EN * 1024, nb * 32, kb * 64, even_srccol(nb * 32 + (F.lane & 31)), scr, F.lane); continue; } r -= I_EI;
        if (r < I_SQ) { const int kb = r / 32, nb = r % 32; tr_item(inptr(F, I_WOUTE) + (size_t)i * 1024 * 1024, 1024, 1024, (bf16*)(F.ws + WS_WOUTE) + (size_t)i * 1024 * 1024, nb * 32, kb * 64, nb * 32 + (F.lane & 31), scr, F.lane); continue; } r -= I_SQ;
        if (r < I_OI) { const int kb = r / 96, nb = r % 96; tr_item(inptr(F, I_WINO) + (size_t)i * 1024 * ON, ON, 1024, (bf16*)(F.ws + WS_WINO) + (size_t)i * ON * 1024, nb * 32, kb * 64, odd_srccol(nb * 32 + (F.lane & 31)), scr, F.lane); continue; } r -= I_OI;
        { const int kb = r / 32, nb = r % 32; tr_item(inptr(F, I_WOUTO) + (size_t)i * 1024 * 1024, 1024, 1024, (bf16*)(F.ws + WS_WOUTO) + (size_t)i * 1024 * 1024, nb * 32, kb * 64, nb * 32 + (F.lane & 31), scr, F.lane); }
    }
}
constexpr float W8_SCALE = 64.0f;
__device__ __forceinline__ void conv_moe_item(const Frame& F, int l, int it, LAS float* scr) {
    constexpr int I_13 = 16 * 32, I_2 = 8 * 32;
    const int e = it / (I_13 + I_2); int r = it % (I_13 + I_2);
    const size_t eoff = ((size_t)l * NEXP + e) * 1024 * 512;
    if (r < I_13) { const int kb = r / 32, nb = r % 32; const int j0 = nb * 32, t = j0 >> 8, rr = j0 & 255;
        const float* src = (rr < 128 ? inptr(F, I_W1) : inptr(F, I_W3)) + eoff;
        tr_item8(src, 512, 1024, (unsigned char*)(F.ws + WS_W13) + (size_t)e * 1024 * 1024, j0, kb * 64, 128 * t + (rr & 127) + (F.lane & 31), W8_SCALE, scr, F.lane);
    } else { r -= I_13; const int kb = r / 32, nb = r % 32;
        tr_item8(inptr(F, I_W2) + eoff, 1024, 512, (unsigned char*)(F.ws + WS_W2) + (size_t)e * 1024 * 512, nb * 32, kb * 64, nb * 32 + (F.lane & 31), W8_SCALE, scr, F.lane); }
}
__device__ __forceinline__ void conv_moe_weights(const Frame& F0, int l) {
    Frame F = relaunder(F0); const int gw = F.vcu * 8 + F.wave, NGW = F.G * 8;
    LAS float* scr = (LAS float*)(F.lds + F.wave * 16384);
    for (int it = gw; it < NEXP * (16 * 32 + 8 * 32); it += NGW) conv_moe_item(F, l, it, scr);
}
__device__ __forceinline__ void ph_u0(const Frame& F0) {
    Frame F = relaunder(F0);
    const int gw = F.vcu * 8 + F.wave, NGW = F.G * 8;
    for (int r0 = gw * 4; r0 < NTOK; r0 += NGW * 4) {
        const int bi = row_bi(r0); const float* sh = modp(F, 0, bi, 0); const float* sc = modp(F, 0, bi, 1);
        f32x4 x[4][4];
#pragma unroll
        for (int r = 0; r < 4; ++r) { const int row = r0 + r; const float* src = row < NLAT ? inptr(F, I_X) + (size_t)row * D : inptr(F, I_CTX) + (size_t)(row - NLAT) * D;
#pragma unroll
            for (int j = 0; j < 4; ++j) x[r][j] = *(const f32x4*)(src + 4 * F.lane + 256 * j); }
#pragma unroll
        for (int j = 0; j < 4; ++j) { const int c = 4 * F.lane + 256 * j; const f32x4 a = *(const f32x4*)(sh + c), s = *(const f32x4*)(sc + c);
#pragma unroll
            for (int r = 0; r < 4; ++r) { const f32x4 u = x[r][j] * (1.0f + s) + a; u32x2 w; w.x = pk2(u[0], u[1]); w.y = pk2(u[2], u[3]); *(u32x2*)((bf16*)(F.ws + WS_U) + (size_t)(r0 + r) * D + c) = w; } }
    }
}

struct RowLN { f32x4 v[4]; };
__device__ __forceinline__ void ln_stats(f32x4 (&z)[4], float& mean, float& rstd) {
    float s = 0.f;
#pragma unroll
    for (int j = 0; j < 4; ++j) s += (z[j][0] + z[j][1]) + (z[j][2] + z[j][3]);
    mean = wave_sum(s) * (1.0f / D); float q = 0.f;
#pragma unroll
    for (int j = 0; j < 4; ++j) { z[j] = z[j] - mean; q += (z[j][0] * z[j][0] + z[j][1] * z[j][1]) + (z[j][2] * z[j][2] + z[j][3] * z[j][3]); }
    rstd = 1.0f / sqrtf(wave_sum(q) * (1.0f / D) + LN_EPS);
}
__device__ __forceinline__ void ln_rows(f32x4 (&z)[4], const float* lw, const float* lb, int lane) {
    float s = 0.f;
#pragma unroll
    for (int j = 0; j < 4; ++j) s += (z[j][0] + z[j][1]) + (z[j][2] + z[j][3]);
    const float mean = wave_sum(s) * (1.0f / D); float q = 0.f;
#pragma unroll
    for (int j = 0; j < 4; ++j) { z[j] = z[j] - mean; q += (z[j][0] * z[j][0] + z[j][1] * z[j][1]) + (z[j][2] * z[j][2] + z[j][3] * z[j][3]); }
    const float rstd = 1.0f / sqrtf(wave_sum(q) * (1.0f / D) + LN_EPS);
#pragma unroll
    for (int j = 0; j < 4; ++j) { const int c = 4 * lane + 256 * j; z[j] = z[j] * rstd * *(const f32x4*)(lw + c) + *(const f32x4*)(lb + c); }
}
__device__ __forceinline__ void ph_ln1(const Frame& F0, int l, int nrows, bool dry = false) {
    Frame F = relaunder(F0);
    LAS unsigned char* Thi = F.lds; LAS unsigned char* Tlo = F.lds + 33024;
    LAS float* red = (LAS float*)(F.lds + 66048);
    LAS float* lgt = (LAS float*)(F.lds + 82432);
    LAS int* lcnt = (LAS int*)(F.lds + 87552); LAS int* lbase = lcnt + 32;
    LAS unsigned* list = (LAS unsigned*)(F.lds + 87808);
    LAS float* LW = (LAS float*)(F.lds + 97024); LAS float* LB = LW + 1024; LAS float* WG = LB + 1024;
    const int lane = F.lane, w = F.wave;
    if (F.tid < 64) lcnt[F.tid] = 0;
    { const float* lwg = inptr(F, I_LNW) + (size_t)(l * 2 + 0) * D; const float* lbg = inptr(F, I_LNB) + (size_t)(l * 2 + 0) * D; const float* wgg = inptr(F, I_WG) + (size_t)l * 1024 * 4;
      for (int i = F.tid; i < 256; i += 512) { *(LAS f32x4*)(LW + 4 * i) = *(const f32x4*)(lwg + 4 * i); *(LAS f32x4*)(LB + 4 * i) = *(const f32x4*)(lbg + 4 * i); }
      for (int i = F.tid; i < 1024; i += 512) *(LAS f32x4*)(WG + 4 * i) = *(const f32x4*)(wgg + 4 * i); }
    bf16x8 Whi[2][4], Wlo[2][4];
    {
        const int n = lane & 15, kg = lane >> 4;
        const float* we = inptr(F, I_WE) + (size_t)l * 1024 * 32 + (size_t)(w * 128 + kg * 8) * 32 + n;
#pragma unroll
        for (int nt = 0; nt < 2; ++nt)
#pragma unroll
            for (int ks = 0; ks < 4; ++ks) { u32x4 hi, lo; unsigned hh[8], ll[8];
                const float* p = we + ks * 32 * 32 + nt * 16;
                asm volatile("" : "+v"(p));
#pragma unroll
                for (int j = 0; j < 8; ++j) {
                    const float v = p[j * 32];
                    const unsigned h = pk2(v, 0.f) & 0xffffu; const float r = v - __uint_as_float(h << 16); hh[j] = h; ll[j] = pk2(r, 0.f) & 0xffffu; }
                hi.x = hh[0] | (hh[1] << 16); hi.y = hh[2] | (hh[3] << 16); hi.z = hh[4] | (hh[5] << 16); hi.w = hh[6] | (hh[7] << 16);
                lo.x = ll[0] | (ll[1] << 16); lo.y = ll[2] | (ll[3] << 16); lo.z = ll[4] | (ll[5] << 16); lo.w = ll[6] | (ll[7] << 16);
                Whi[nt][ks] = __builtin_bit_cast(bf16x8, hi); Wlo[nt][ks] = __builtin_bit_cast(bf16x8, lo); }
    }
    const bf16* Y = (const bf16*)(F.ws + WS_P);
    const float* hsl = (l == 0 ? inptr(F, I_X) : F.out); const float* hsc = (l == 0 ? inptr(F, I_CTX) : (const float*)(F.ws + WS_HCTX));
    const float* bgp = inptr(F, I_BG) + l * 4; const float* bep = inptr(F, I_BE) + l * 32;
    const bool usey = !((l & 1) ? (KO_MASK & 4) : ((KO_MASK & 3) == 3));
    const int nbatch = nrows / 16; int nlist = 0; int prev_rbase = -1;
#define LN1_ROUTE(buf_, rbase_, slot_) do { if (F.tid < 16) { const int tk = F.tid; const LAS float* lg = lgt + (buf_) * 640 + tk * 40; \
        float gl[4]; _Pragma("unroll") for (int j = 0; j < 4; ++j) gl[j] = lg[32 + j] + bgp[j]; \
        float gmax = gl[0]; int g = 0; _Pragma("unroll") for (int j = 1; j < 4; ++j) if (gl[j] > gmax) { gmax = gl[j]; g = j; } \
        float den = 0.f; _Pragma("unroll") for (int j = 0; j < 4; ++j) den += expf(gl[j] - gmax); \
        const float pg = 1.0f / den; float el[8]; _Pragma("unroll") for (int j = 0; j < 8; ++j) el[j] = lg[g * 8 + j] + bep[g * 8 + j]; \
        float m0 = el[0]; int i0 = 0; _Pragma("unroll") for (int j = 1; j < 8; ++j) if (el[j] > m0) { m0 = el[j]; i0 = j; } \
        float m1 = -3.0e38f; int i1 = 0; _Pragma("unroll") for (int j = 0; j < 8; ++j) if (j != i0 && el[j] > m1) { m1 = el[j]; i1 = j; } \
        const float ex = expf(m1 - m0); const float w0 = pg / (1.0f + ex), w1 = pg * ex / (1.0f + ex); \
        const int e0 = g * 8 + i0, e1 = g * 8 + i1; \
        const int p0 = atomicAdd((int*)&lcnt[e0], 1), p1 = atomicAdd((int*)&lcnt[e1], 1); \
        LAS unsigned* L = list + ((slot_) * 16 + tk) * 8; \
        L[0] = (unsigned)((rbase_) + tk); L[1] = (unsigned)e0; L[2] = (unsigned)p0; L[3] = __float_as_uint(w0); L[4] = (unsigned)e1; L[5] = (unsigned)p1; L[6] = __float_as_uint(w1); } } while (0)
    __syncthreads();
    for (int bt = F.vcu; bt < nbatch; bt += F.G) {
        const int rbase = bt * 16; const int bi = row_bi(rbase);
        const float* g2 = modp(F, l, bi, 2); const float* sh = modp(F, l, bi, 3); const float* sc = modp(F, l, bi, 4);
        {
            f32x4 hv[2][4], gv[4], scv[4], shv[4]; u32x2 yv[2][4];
#pragma unroll
            for (int rr = 0; rr < 2; ++rr) { const int row = rbase + 2 * w + rr; const float* hs = row < NLAT ? hsl + (size_t)row * D : hsc + (size_t)(row - NLAT) * D;
#pragma unroll
                for (int j = 0; j < 4; ++j) { const int c = 4 * lane + 256 * j; hv[rr][j] = *(const f32x4*)(hs + c); yv[rr][j] = usey ? *(const u32x2*)(Y + (size_t)row * D + c) : (u32x2){0u, 0u}; } }
#pragma unroll
            for (int j = 0; j < 4; ++j) { const int c = 4 * lane + 256 * j; gv[j] = *(const f32x4*)(g2 + c); scv[j] = *(const f32x4*)(sc + c); shv[j] = *(const f32x4*)(sh + c); }
            f32x4 z[2][4]; float mean[2], rstd[2];
#pragma unroll
            for (int rr = 0; rr < 2; ++rr)
#pragma unroll
                for (int j = 0; j < 4; ++j) z[rr][j] = DN_ALPHA * hv[rr][j] + gv[j] * (f32x4){bflo(yv[rr][j].x), bfhi(yv[rr][j].x), bflo(yv[rr][j].y), bfhi(yv[rr][j].y)};
#pragma unroll
            for (int rr = 0; rr < 2; ++rr) ln_stats(z[rr], mean[rr], rstd[rr]);
            f32x4 ga[2] = {(f32x4){0.f, 0.f, 0.f, 0.f}, (f32x4){0.f, 0.f, 0.f, 0.f}};
#pragma unroll
            for (int j = 0; j < 4; ++j) { const int c = 4 * lane + 256 * j;
                const f32x4 lwv = *(const LAS f32x4*)(LW + c), lbv = *(const LAS f32x4*)(LB + c);
                const f32x4 g0 = *(const LAS f32x4*)(WG + 4 * c), g1 = *(const LAS f32x4*)(WG + 4 * c + 4), g2v = *(const LAS f32x4*)(WG + 4 * c + 8), g3 = *(const LAS f32x4*)(WG + 4 * c + 12);
#pragma unroll
                for (int rr = 0; rr < 2; ++rr) { const int lr = 2 * w + rr, row = rbase + lr;
                    float* hd = dry ? (float*)(F.ws + WS_GATT) + (size_t)row * D : (row < NLAT ? F.out + (size_t)row * D : (float*)(F.ws + WS_HCTX) + (size_t)(row - NLAT) * D);
                    const f32x4 zn = z[rr][j] * rstd[rr] * lwv + lbv;
                    *(f32x4*)(hd + c) = zn;
                    const f32x4 t = zn * (1.0f + scv[j]) + shv[j];
                    ga[rr] += t[0] * g0 + t[1] * g1 + t[2] * g2v + t[3] * g3;
                    const unsigned h01 = pk2(t[0], t[1]), h23 = pk2(t[2], t[3]);
                    u32x2 hw; hw.x = h01; hw.y = h23;
                    *(unsigned*)((unsigned char*)(F.ws + (dry ? WS_Q : WS_U8)) + (size_t)row * D + c) = pk4_fp8(t[0], t[1], t[2], t[3]);
                    const float r0 = t[0] - bflo(h01), r1 = t[1] - bfhi(h01), r2 = t[2] - bflo(h23), r3 = t[3] - bfhi(h23);
                    u32x2 lw2; lw2.x = pk2(r0, r1); lw2.y = pk2(r2, r3);
                    *(LAS u32x2*)(Thi + lr * 2064 + c * 2) = hw; *(LAS u32x2*)(Tlo + lr * 2064 + c * 2) = lw2; } }
#pragma unroll
            for (int rr = 0; rr < 2; ++rr) { const float q0 = wave_sum(ga[rr][0]), q1 = wave_sum(ga[rr][1]), q2 = wave_sum(ga[rr][2]), q3 = wave_sum(ga[rr][3]);
                if (lane == 0) *(LAS f32x4*)(lgt + (nlist & 1) * 640 + (2 * w + rr) * 40 + 32) = (f32x4){q0, q1, q2, q3}; }
        }
        __syncthreads();
        if (prev_rbase >= 0) LN1_ROUTE((nlist - 1) & 1, prev_rbase, nlist - 1);
        {
            f32x4 acc[2];
#pragma unroll
            for (int nt = 0; nt < 2; ++nt) acc[nt] = (f32x4){0.f, 0.f, 0.f, 0.f};
            const int tk = lane & 15, kg = lane >> 4;
#pragma unroll
            for (int ks = 0; ks < 4; ++ks) {
                const bf16x8 ah = *(const LAS bf16x8*)(Thi + tk * 2064 + (w * 128 + ks * 32 + kg * 8) * 2), al = *(const LAS bf16x8*)(Tlo + tk * 2064 + (w * 128 + ks * 32 + kg * 8) * 2);
#pragma unroll
                for (int nt = 0; nt < 2; ++nt) { acc[nt] = __builtin_amdgcn_mfma_f32_16x16x32_bf16(Whi[nt][ks], ah, acc[nt], 0, 0, 0);
                    acc[nt] = __builtin_amdgcn_mfma_f32_16x16x32_bf16(Wlo[nt][ks], ah, acc[nt], 0, 0, 0); acc[nt] = __builtin_amdgcn_mfma_f32_16x16x32_bf16(Whi[nt][ks], al, acc[nt], 0, 0, 0); }
            }
#pragma unroll
            for (int nt = 0; nt < 2; ++nt) *(LAS f32x4*)(red + (w * 16 + tk) * 32 + nt * 16 + 4 * kg) = acc[nt];
        }
        __syncthreads();
        { const int tk = F.tid & 15, n = F.tid >> 4; float s = 0.f;
#pragma unroll
            for (int ww = 0; ww < 8; ++ww) s += red[(ww * 16 + tk) * 32 + n];
            lgt[(nlist & 1) * 640 + tk * 40 + n] = s; }
        prev_rbase = rbase; ++nlist;
    }
    __syncthreads();
    if (prev_rbase >= 0) LN1_ROUTE((nlist - 1) & 1, prev_rbase, nlist - 1);
#undef LN1_ROUTE
    __syncthreads();
    if (F.tid < 32) lbase[F.tid] = (int)atomicAdd((unsigned*)(F.ws + WS_CTL) + CW_CNT + l * 64 + (dry ? 32 : 0) + F.tid, (unsigned)lcnt[F.tid]);
    __syncthreads();
    if (!dry) for (int idx = F.tid; idx < nlist * 16; idx += 512) {
        const LAS unsigned* L = list + idx * 8; const unsigned row = L[0], e0 = L[1], e1 = L[4]; const unsigned p0 = L[2] + (unsigned)lbase[e0], p1 = L[5] + (unsigned)lbase[e1];
        u32x4 a; a.x = e0; a.y = p0; a.z = L[3]; a.w = e1; u32x4 b; b.x = p1; b.y = L[6]; b.z = 0u; b.w = 0u;
        unsigned* ti = (unsigned*)(F.ws + WS_TOKINFO) + (size_t)row * 8; *(u32x4*)ti = a; *(u32x4*)(ti + 4) = b;
        int* rt = (int*)(F.ws + WS_ROWTOK); rt[(size_t)e0 * NTOK + p0] = (int)row; rt[(size_t)e1 * NTOK + p1] = (int)row;
    }
}

__device__ __forceinline__ void ph_ln2(const Frame& F0, int l, int nrows, bool dry = false) {
    Frame F = relaunder(F0);
    MoeTab T = moe_tab(F.lds);
    const int gw = F.vcu * 8 + F.wave, NGW = F.G * 8, lane = F.lane;
    const float* lw = inptr(F, I_LNW) + (size_t)(l * 2 + 1) * D; const float* lb = inptr(F, I_LNB) + (size_t)(l * 2 + 1) * D;
    const bf16* O2 = (const bf16*)(F.ws + WS_P);
    for (int r0 = gw * 4; r0 < nrows; r0 += NGW * 4) {
        const int bi = row_bi(r0);
        const float* g5 = modp(F, l, bi, 5);
        f32x4 z[4][4]; u32x2 ya[4][4], yb[4][4]; float w0[4], w1[4];
#pragma unroll
        for (int r = 0; r < 4; ++r) { const int row = r0 + r;
            const unsigned* ti = (const unsigned*)(F.ws + WS_TOKINFO) + (size_t)row * 8;
            const u32x4 a = *(const u32x4*)ti; const u32x2 b = *(const u32x2*)(ti + 4);
            const size_t s0 = (size_t)T.ts[a.x] * 256 + a.y, s1 = (size_t)T.ts[a.w] * 256 + b.x; w0[r] = __uint_as_float(a.z); w1[r] = __uint_as_float(b.y);
            const float* hd = row < NLAT ? F.out + (size_t)row * D : (const float*)(F.ws + WS_HCTX) + (size_t)(row - NLAT) * D;
#pragma unroll
            for (int j = 0; j < 4; ++j) { const int c = 4 * lane + 256 * j; z[r][j] = *(const f32x4*)(hd + c);
                if (!(KO_MASK & 8)) { ya[r][j] = *(const u32x2*)(O2 + s0 * D + c); yb[r][j] = *(const u32x2*)(O2 + s1 * D + c); } } }
#pragma unroll
        for (int j = 0; j < 4; ++j) { const f32x4 g = *(const f32x4*)(g5 + 4 * lane + 256 * j);
#pragma unroll
            for (int r = 0; r < 4; ++r) { f32x4 y = (f32x4){0.f, 0.f, 0.f, 0.f};
                if (!(KO_MASK & 8)) y = w0[r] * (f32x4){bflo(ya[r][j].x), bfhi(ya[r][j].x), bflo(ya[r][j].y), bfhi(ya[r][j].y)} + w1[r] * (f32x4){bflo(yb[r][j].x), bfhi(yb[r][j].x), bflo(yb[r][j].y), bfhi(yb[r][j].y)};
                z[r][j] = DN_ALPHA * z[r][j] + g * y; } }
        float mean[4], rstd[4];
#pragma unroll
        for (int r = 0; r < 4; ++r) ln_stats(z[r], mean[r], rstd[r]);
        const bool lat = r0 < NLAT;
        const bool wu = (l < 3) && (lat || l < 2);
        const float* sh = modp(F, l < 3 ? l + 1 : l, bi, 0); const float* sc = modp(F, l < 3 ? l + 1 : l, bi, 1);
#pragma unroll
        for (int j = 0; j < 4; ++j) { const int c = 4 * lane + 256 * j;
            const f32x4 lwv = *(const f32x4*)(lw + c), lbv = *(const f32x4*)(lb + c), scv = *(const f32x4*)(sc + c), shv = *(const f32x4*)(sh + c);
#pragma unroll
            for (int r = 0; r < 4; ++r) { const int row = r0 + r;
                float* hd = dry ? (float*)(F.ws + WS_GATT) + (size_t)row * D : (lat ? F.out + (size_t)row * D : (float*)(F.ws + WS_HCTX) + (size_t)(row - NLAT) * D);
                const f32x4 zn = z[r][j] * rstd[r] * lwv + lbv; *(f32x4*)(hd + c) = zn;
                if (wu) { const f32x4 u = zn * (1.0f + scv) + shv; u32x2 hw; hw.x = pk2(u[0], u[1]); hw.y = pk2(u[2], u[3]); *(u32x2*)((bf16*)(F.ws + (dry ? WS_Q : WS_U)) + (size_t)row * D + c) = hw; } } }
    }
}

__device__ __forceinline__ f32x4 ubf_lo(const u32x4 v) { return (f32x4){bflo(v.x), bfhi(v.x), bflo(v.y), bfhi(v.y)}; }
__device__ __forceinline__ f32x4 ubf_hi(const u32x4 v) { return (f32x4){bflo(v.z), bfhi(v.z), bflo(v.w), bfhi(v.w)}; }
__device__ __forceinline__ void ph_conv(const Frame& F0, int i, int nrows) {
    Frame F = relaunder(F0);
    const int gw = F.vcu * 8 + F.wave, NGW = F.G * 8, lane = F.lane;
    const float* cw = inptr(F, I_CONVW) + (size_t)i * 3 * D; const float* cb = inptr(F, I_CONVB) + (size_t)i * D;
    const bf16* P = (const bf16*)(F.ws + WS_P); bf16* Q = (bf16*)(F.ws + WS_Q);
    for (int r0 = gw * 4; r0 < nrows; r0 += NGW * 4) {
        const int s0 = r0 < NLAT ? (r0 & (SEQ - 1)) : ((r0 - NLAT) & (CTXL - 1)); const int slen = r0 < NLAT ? SEQ : CTXL;
        const bool hp = s0 > 0, hn = s0 + 4 < slen;
#pragma unroll
        for (int j = 0; j < 2; ++j) { const int c = 8 * lane + 512 * j;
            u32x4 p[6], gb[4];
            p[0] = (u32x4){0u, 0u, 0u, 0u}; p[5] = (u32x4){0u, 0u, 0u, 0u};
            if (hp) p[0] = *(const u32x4*)(P + (size_t)(r0 - 1) * 2048 + 1024 + c);
            if (hn) p[5] = *(const u32x4*)(P + (size_t)(r0 + 4) * 2048 + 1024 + c);
#pragma unroll
            for (int r = 0; r < 4; ++r) { p[r + 1] = *(const u32x4*)(P + (size_t)(r0 + r) * 2048 + 1024 + c); gb[r] = *(const u32x4*)(P + (size_t)(r0 + r) * 2048 + c); }
            const f32x4 w0a = *(const f32x4*)(cw + c), w0b = *(const f32x4*)(cw + c + 4), w1a = *(const f32x4*)(cw + D + c), w1b = *(const f32x4*)(cw + D + c + 4), w2a = *(const f32x4*)(cw + 2 * D + c), w2b = *(const f32x4*)(cw + 2 * D + c + 4);
            const f32x4 ba = *(const f32x4*)(cb + c), bb = *(const f32x4*)(cb + c + 4);
#pragma unroll
            for (int r = 0; r < 4; ++r) {
                const f32x4 ya = ubf_lo(gb[r]) * (ubf_lo(p[r]) * w0a + ubf_lo(p[r + 1]) * w1a + ubf_lo(p[r + 2]) * w2a + ba);
                const f32x4 yb = ubf_hi(gb[r]) * (ubf_hi(p[r]) * w0b + ubf_hi(p[r + 1]) * w1b + ubf_hi(p[r + 2]) * w2b + bb);
                *(u32x4*)(Q + (size_t)(r0 + r) * D + c) = pack8(ya, yb); } }
    }
}
#define MFMA32(a, b, c) __builtin_amdgcn_mfma_f32_32x32x16_bf16((a), (b), (c), 0, 0, 0)
#define MFMA16(a, b, c) __builtin_amdgcn_mfma_f32_16x16x32_bf16((a), (b), (c), 0, 0, 0)
constexpr int AK_STR = 144, AV_STR = 136, AK_BUF = 64 * AK_STR, AV_BUF = 64 * AV_STR;
__device__ __forceinline__ int crow32(int reg, int hh) { return (reg & 3) + 8 * (reg >> 2) + 4 * hh; }
__device__ __forceinline__ void attn_unit(const Frame& F, int ie, int b, int g, int qb, bool ctxq) {
    const bf16* P = (const bf16*)(F.ws + WS_P); bf16* Q = (bf16*)(F.ws + WS_Q);
    LAS unsigned char* Ks = F.lds; LAS unsigned char* Vt = F.lds + 2 * AK_BUF;
    const int w = F.wave, lane = F.lane, r = w >> 1, qh = w & 1, h = 4 * g + r, n = lane & 31, hh = lane >> 5;
    const int qpos0 = qb * 128 + qh * 64;
    const int qrow0 = ctxq ? NLAT + b * CTXL + qpos0 : b * SEQ + qpos0;
    if (KO_MASK & 1) {
#pragma unroll
        for (int nt = 0; nt < 2; ++nt)
#pragma unroll
            for (int c = 0; c < 4; ++c) *(u32x4*)(Q + (size_t)(qrow0 + 32 * nt + n) * D + h * 64 + 16 * c + 8 * hh) = (u32x4){0u, 0u, 0u, 0u};
        return;
    }
    bf16x8 qf[2][4];
#pragma unroll
    for (int nt = 0; nt < 2; ++nt)
#pragma unroll
        for (int c = 0; c < 4; ++c) qf[nt][c] = *(const bf16x8*)(P + (size_t)(qrow0 + 32 * nt + n) * EN + PC_Q + h * 64 + 16 * c + 8 * hh);
    const float sk = inptr(F, I_SINK)[ie * 8 + h] * LOG2E;
    float mrun[2] = {sk, sk}, lsum[2] = {1.f, 1.f};
    f32x16 O[2][2];
#pragma unroll
    for (int a = 0; a < 2; ++a)
#pragma unroll
        for (int c = 0; c < 2; ++c)
#pragma unroll
            for (int e = 0; e < 16; ++e) O[a][c][e] = 0.f;
    const int tw0 = ctxq ? 4 : ((qb == 0) ? 6 : 4), tw1 = ctxq ? 4 : ((qb == 31) ? 8 : 10);
    const int ntile = 4 + (tw1 - tw0);
    const int skey = F.tid >> 3, sch = F.tid & 7;
    u32x4 kreg, vreg;
#define TILE_OF(i) ((i) < 4 ? (i) : tw0 + ((i) - 4))
#define KROW_OF(t) ((t) < 4 ? NLAT + b * CTXL + 64 * (t) : b * SEQ + (qb - 1) * 128 + 64 * ((t) - 4))
    { const int kr = KROW_OF(0) + skey; kreg = *(const u32x4*)(P + (size_t)kr * EN + PC_K + g * 64 + sch * 8); vreg = *(const u32x4*)(P + (size_t)kr * EN + PC_V + g * 64 + sch * 8); }
    __syncthreads();
    {
        *(LAS u32x4*)(Ks + skey * AK_STR + sch * 16) = kreg;
        LAS unsigned short* vt = (LAS unsigned short*)(Vt + (sch * 8) * AV_STR + skey * 2);
        const unsigned vv[4] = {vreg.x, vreg.y, vreg.z, vreg.w};
#pragma unroll
        for (int e = 0; e < 4; ++e) { vt[(2 * e) * (AV_STR / 2)] = (unsigned short)(vv[e] & 0xffffu); vt[(2 * e + 1) * (AV_STR / 2)] = (unsigned short)(vv[e] >> 16); }
    }
    __syncthreads();
    const float c2 = 0.125f * LOG2E;
    for (int i = 0; i < ntile; ++i) {
        const int buf = i & 1, t = TILE_OF(i);
        if (i + 1 < ntile) { const int t1 = TILE_OF(i + 1); const int kr = KROW_OF(t1) + skey; kreg = *(const u32x4*)(P + (size_t)kr * EN + PC_K + g * 64 + sch * 8); vreg = *(const u32x4*)(P + (size_t)kr * EN + PC_V + g * 64 + sch * 8); }
        const LAS unsigned char* kb = Ks + buf * AK_BUF; const LAS unsigned char* vb = Vt + buf * AV_BUF;
        const bool msk = (t >= 4) && (t != 6) && (t != 7);
        const int kp0 = (qb - 1) * 128 + 64 * (t - 4);
        const bool skip = (qh == 0 && t == 9) || (qh == 1 && t == 4);
#pragma unroll 1
        for (int kt = 0; kt < 2; ++kt) {
            if (skip) break;
            f32x16 S[2];
#pragma unroll
            for (int c = 0; c < 2; ++c)
#pragma unroll
                for (int e = 0; e < 16; ++e) S[c][e] = 0.f;
#pragma unroll
            for (int c = 0; c < 4; ++c) { const bf16x8 kf = *(const LAS bf16x8*)(kb + (32 * kt + n) * AK_STR + (16 * c + 8 * hh) * 2);
#pragma unroll
                for (int nt = 0; nt < 2; ++nt) S[nt] = MFMA32(kf, qf[nt][c], S[nt]); }
#pragma unroll
            for (int nt = 0; nt < 2; ++nt) {
                if (msk) { const int qp = qpos0 + 32 * nt + n;
#pragma unroll
                    for (int e = 0; e < 16; ++e) { const int dd = qp - (kp0 + 32 * kt + crow32(e, hh)); if (dd > 128 || dd < -128) S[nt][e] = -INFINITY; } }
                float mx = fmaxf(fmaxf(S[nt][0], S[nt][1]), fmaxf(S[nt][2], S[nt][3]));
#pragma unroll
                for (int e = 4; e < 16; e += 4) mx = fmaxf(mx, fmaxf(fmaxf(S[nt][e], S[nt][e + 1]), fmaxf(S[nt][e + 2], S[nt][e + 3])));
                mx = fmaxf(mx, __shfl_xor(mx, 32));
                const float mnew = fmaxf(mrun[nt], mx * c2);
                if (__builtin_amdgcn_ballot_w64(mnew != mrun[nt]) != 0ull) {
                    const float alpha = __builtin_amdgcn_exp2f(mrun[nt] - mnew); mrun[nt] = mnew; lsum[nt] *= alpha;
#pragma unroll
                    for (int dt = 0; dt < 2; ++dt)
#pragma unroll
                        for (int e = 0; e < 16; ++e) O[dt][nt][e] *= alpha;
                }
                float rs = 0.f;
#pragma unroll
                for (int e = 0; e < 16; ++e) { const float p = __builtin_amdgcn_exp2f(__builtin_fmaf(S[nt][e], c2, -mnew)); S[nt][e] = p; rs += p; }
                rs += __shfl_xor(rs, 32);
                lsum[nt] += rs;
            }
#pragma unroll
            for (int s = 0; s < 2; ++s) {
                bf16x8 pf[2];
#pragma unroll
                for (int nt = 0; nt < 2; ++nt) { u32x4 pw; pw.x = pk2(S[nt][8 * s + 0], S[nt][8 * s + 1]); pw.y = pk2(S[nt][8 * s + 2], S[nt][8 * s + 3]); pw.z = pk2(S[nt][8 * s + 4], S[nt][8 * s + 5]); pw.w = pk2(S[nt][8 * s + 6], S[nt][8 * s + 7]); pf[nt] = __builtin_bit_cast(bf16x8, pw); }
#pragma unroll
                for (int dt = 0; dt < 2; ++dt) {
                    const LAS unsigned char* va = vb + (32 * dt + n) * AV_STR + (32 * kt + 16 * s + 4 * hh) * 2;
                    const s16x4 lo = *(const LAS s16x4*)va, hi = *(const LAS s16x4*)(va + 16);
                    const bf16x8 vf = __builtin_shufflevector(lo, hi, 0, 1, 2, 3, 4, 5, 6, 7);
#pragma unroll
                    for (int nt = 0; nt < 2; ++nt) O[dt][nt] = MFMA32(vf, pf[nt], O[dt][nt]);
                }
            }
        }
        if (i + 1 < ntile) {
            LAS unsigned char* kb2 = Ks + (buf ^ 1) * AK_BUF; LAS unsigned char* vb2 = Vt + (buf ^ 1) * AV_BUF;
            *(LAS u32x4*)(kb2 + skey * AK_STR + sch * 16) = kreg;
            LAS unsigned short* vt = (LAS unsigned short*)(vb2 + (sch * 8) * AV_STR + skey * 2);
            const unsigned vv[4] = {vreg.x, vreg.y, vreg.z, vreg.w};
#pragma unroll
            for (int e = 0; e < 4; ++e) { vt[(2 * e) * (AV_STR / 2)] = (unsigned short)(vv[e] & 0xffffu); vt[(2 * e + 1) * (AV_STR / 2)] = (unsigned short)(vv[e] >> 16); }
        }
        __syncthreads();
    }
#pragma unroll
    for (int nt = 0; nt < 2; ++nt) { const float inv = 1.0f / lsum[nt]; bf16* orow = Q + (size_t)(qrow0 + 32 * nt + n) * D + h * 64;
#pragma unroll
        for (int dt = 0; dt < 2; ++dt)
#pragma unroll
            for (int rg = 0; rg < 4; ++rg) { u32x2 ow; ow.x = pk2(O[dt][nt][4 * rg] * inv, O[dt][nt][4 * rg + 1] * inv); ow.y = pk2(O[dt][nt][4 * rg + 2] * inv, O[dt][nt][4 * rg + 3] * inv);
                *(u32x2*)(orow + 32 * dt + 8 * rg + 4 * hh) = ow; } }
}

template <int d> __device__ __forceinline__ void glaA_unit(const Frame& F, int ie, int b, int c, int h) {
    const bf16* P = (const bf16*)(F.ws + WS_P);
    LAS unsigned char* QS = F.lds + F.wave * 16384; LAS unsigned char* KS = QS + 8192;
    const int lane = F.lane;
    const int row0 = c < 4 ? NLAT + b * CTXL + c * 64 : b * SEQ + (c - 4) * 64;
    const size_t U = (size_t)(b * NCHUNK + c) * 4 + h;
    bf16* gq = (bf16*)(F.ws + WS_GQIN); bf16* gk = (bf16*)(F.ws + WS_GKST); bf16* ga = (bf16*)(F.ws + WS_GATT);
    {
        const size_t UD = U * 2 + d;
        {
            u32x4 qr[8], kr[8];
#pragma unroll
            for (int it = 0; it < 8; ++it) { const int tok = it * 8 + (lane >> 3), ch = lane & 7; const size_t ro = (size_t)(row0 + tok) * EN + h * 64 + ch * 8; qr[it] = *(const u32x4*)(P + ro + PC_QG); kr[it] = *(const u32x4*)(P + ro + PC_KG); }
#pragma unroll
            for (int it = 0; it < 8; ++it) { const int tok = it * 8 + (lane >> 3), ch = lane & 7; const int so = tok * 128 + ((ch ^ (tok & 7)) << 4); *(LAS u32x4*)(QS + so) = qr[it]; *(LAS u32x4*)(KS + so) = kr[it]; }
        }
        const int ln = lane & 31, hh = lane >> 5;
        bf16x8 afr[2], bhi[2], blo[2]; float bav[2];
#pragma unroll
        for (int tt = 0; tt < 2; ++tt) afr[tt] = *(const bf16x8*)(P + (size_t)(row0 + 32 * tt + ln) * EN + PC_GG + 16 * d + 8 * hh);
#pragma unroll
        for (int dt = 0; dt < 2; ++dt) { const float* wp = inptr(F, I_WA2) + (size_t)((ie * 2 + d) * 16 + 8 * hh) * 256 + h * 64 + 32 * dt + ln;
            unsigned hh_[8], ll_[8];
#pragma unroll
            for (int j = 0; j < 8; ++j) { const float v = wp[(size_t)j * 256]; const unsigned hb = pk2(v, 0.f) & 0xffffu; hh_[j] = hb; ll_[j] = pk2(v - __uint_as_float(hb << 16), 0.f) & 0xffffu; }
            bhi[dt] = __builtin_bit_cast(bf16x8, (u32x4){hh_[0] | (hh_[1] << 16), hh_[2] | (hh_[3] << 16), hh_[4] | (hh_[5] << 16), hh_[6] | (hh_[7] << 16)});
            blo[dt] = __builtin_bit_cast(bf16x8, (u32x4){ll_[0] | (ll_[1] << 16), ll_[2] | (ll_[3] << 16), ll_[4] | (ll_[5] << 16), ll_[6] | (ll_[7] << 16)});
            bav[dt] = inptr(F, I_BA)[(ie * 2 + d) * 256 + h * 64 + 32 * dt + ln]; }
        f32x16 G[2][2];
#pragma unroll
        for (int tt = 0; tt < 2; ++tt)
#pragma unroll
            for (int dt = 0; dt < 2; ++dt) { f32x16 z16;
#pragma unroll
                for (int e = 0; e < 16; ++e) z16[e] = 0.f;
                z16 = MFMA32(afr[tt], bhi[dt], z16); G[tt][dt] = MFMA32(afr[tt], blo[dt], z16); }
        asm volatile("s_waitcnt lgkmcnt(0)" ::: "memory");
        float base[2] = {0.f, 0.f};
        int lofs[2][4];
#pragma unroll
        for (int dt = 0; dt < 2; ++dt)
#pragma unroll
            for (int e4 = 0; e4 < 4; ++e4) lofs[dt][e4] = (4 * hh + e4) * 128 + (((4 * dt + (ln >> 3)) ^ (4 * hh + e4)) << 4) + (ln & 7) * 2;
#pragma unroll
        for (int tq = 0; tq < 2; ++tq) { constexpr int dd = d; const int tt = dd ? 1 - tq : tq;
#pragma unroll
            for (int gq_ = 0; gq_ < 4; ++gq_) { const int g4 = dd ? 3 - gq_ : gq_;
                const int tokg = 32 * tt + 8 * g4;
#pragma unroll
                for (int dt = 0; dt < 2; ++dt) {
                    float la[4];
#pragma unroll
                    for (int e4 = 0; e4 < 4; ++e4) { const float g = G[tt][dt][4 * g4 + e4] + bav[dt];
                        la[e4] = (fminf(g, 0.f) * LOG2E - __builtin_amdgcn_logf(1.0f + __builtin_amdgcn_exp2f(-fabsf(g) * LOG2E))) * (1.0f / 16.0f); }
                    float cs[4];
                    if (dd == 0) { cs[0] = la[0]; cs[1] = cs[0] + la[1]; cs[2] = cs[1] + la[2]; cs[3] = cs[2] + la[3]; }
                    else { cs[3] = la[3]; cs[2] = cs[3] + la[2]; cs[1] = cs[2] + la[1]; cs[0] = cs[1] + la[0]; }
                    const float t4 = dd == 0 ? cs[3] : cs[0];
                    const float pt = __shfl_xor(t4, 32);
                    const float off = base[dt] + ((dd == 0 ? hh == 1 : hh == 0) ? pt : 0.f);
                    base[dt] += t4 + pt;
#pragma unroll
                    for (int e4 = 0; e4 < 4; ++e4) { const int so = tokg * 128 + lofs[dt][e4];
                        const float e1 = __builtin_amdgcn_exp2f(off + cs[e4]);
                        const float qi = bf2f(*(const LAS unsigned short*)(QS + so)) * 0.125f * e1, ki = bf2f(*(const LAS unsigned short*)(KS + so)) * __builtin_amdgcn_rcpf(e1);
                        const unsigned short q16 = (unsigned short)(pk2(qi, 0.f) & 0xffffu), k16 = (unsigned short)(pk2(ki, 0.f) & 0xffffu);
                        *(LAS unsigned short*)(QS + so) = q16; *(LAS unsigned short*)(KS + so) = k16; }
                }
            }
        }
        if (hh == 0) { ((float*)(F.ws + WS_GDEC))[UD * 64 + ln] = __builtin_amdgcn_exp2f(base[0]); ((float*)(F.ws + WS_GDEC))[UD * 64 + 32 + ln] = __builtin_amdgcn_exp2f(base[1]); }
        asm volatile("s_waitcnt lgkmcnt(0)" ::: "memory");
        {
            const int cc = lane & 7, dk0 = 32 * (cc >> 2) + 4 * (cc & 3);
#pragma unroll
            for (int it = 0; it < 8; ++it) { const int tok = it * 8 + (lane >> 3);
                const u32x2 lo = *(const LAS u32x2*)(QS + tok * 128 + ((((dk0 >> 3)) ^ (tok & 7)) << 4) + (dk0 & 7) * 2);
                const u32x2 hi = *(const LAS u32x2*)(QS + tok * 128 + ((((dk0 + 16) >> 3) ^ (tok & 7)) << 4) + (dk0 & 7) * 2);
                *(u32x4*)(gq + (UD * 64 + tok) * 64 + 8 * cc) = (u32x4){lo.x, lo.y, hi.x, hi.y};
                *(u32x4*)(gk + (UD * 64 + tok) * 64 + 8 * cc) = *(const LAS u32x4*)(KS + tok * 128 + ((cc ^ (tok & 7)) << 4)); }
        }
        {
            const int n = lane & 15, kg = lane >> 4;
#pragma unroll 1
            for (int I = 0; I < 4; ++I) {
                const int ti = 16 * I + n;
                bf16x8 qf[2];
#pragma unroll
                for (int ks2 = 0; ks2 < 2; ++ks2) qf[ks2] = *(const LAS bf16x8*)(QS + ti * 128 + (((4 * ks2 + kg) ^ (ti & 7)) << 4));
#pragma unroll
                for (int J = 0; J < 4; ++J) { f32x4 acc = (f32x4){0.f, 0.f, 0.f, 0.f};
                    const bool live = d == 0 ? (J <= I) : (J >= I);
                    if (live) {
                        const int tjr = 16 * J + n;
#pragma unroll
                        for (int ks2 = 0; ks2 < 2; ++ks2) { const bf16x8 kf = *(const LAS bf16x8*)(KS + tjr * 128 + (((4 * ks2 + kg) ^ (tjr & 7)) << 4)); acc = MFMA16(kf, qf[ks2], acc); }
#pragma unroll
                        for (int r = 0; r < 4; ++r) { const int tj = 16 * J + 4 * kg + r; const bool keep = d == 0 ? (tj <= ti) : (tj >= ti); if (!keep) acc[r] = 0.f; }
                    }
                    u32x2 ow; ow.x = pk2(acc[0], acc[1]); ow.y = pk2(acc[2], acc[3]);
                    *(u32x2*)(ga + (UD * 64 + ti) * 64 + 16 * J + 4 * kg) = ow; }
            }
        }
        asm volatile("s_waitcnt lgkmcnt(0)" ::: "memory");
    }
}

constexpr int GB_STG = 43008;
__device__ __forceinline__ int glaB_chunk(int d, int step) { return d == 0 ? step : (step < 4 ? 3 - step : 4 + (NCHUNK - 1 - step)); }
__device__ __forceinline__ int swz_k(int r) { return (r & 3) | (((r >> 3) & 1) << 2); }
__device__ __forceinline__ int swz_v(int r) { return ((r & 3) << 2) | ((r >> 2) & 3); }
template <int STAGE> __device__ __forceinline__ void glaB_issue(const Frame& F, int b, int h, int d, int step) {
    const int c = glaB_chunk(d, step);
    const size_t U = (size_t)(b * NCHUNK + c) * 4 + h, UD = U * 2 + d;
    const int row0 = c < 4 ? NLAT + b * CTXL + c * 64 : b * SEQ + (c - 4) * 64;
    const int tid = F.tid, row = tid >> 3, gch = (tid & 7) ^ (row & 7), gchk = (tid & 7) ^ swz_k(row);
    const int vr0 = tid >> 4, vr1 = vr0 + 32, vc0 = (tid & 15) ^ swz_v(vr0), vc1 = (tid & 15) ^ swz_v(vr1);
    LAS unsigned char* st = F.lds + STAGE * GB_STG + F.wave * 1024;
    const char* gq = (const char*)(F.ws + WS_GQIN) + UD * 8192 + row * 128 + gch * 16;
    const char* ga = (const char*)(F.ws + WS_GATT) + UD * 8192 + row * 128 + gch * 16;
    const char* gk = (const char*)(F.ws + WS_GKST) + UD * 8192 + row * 128 + gchk * 16;
    const char* gv = (const char*)(F.ws + WS_P) + (size_t)row0 * (EN * 2) + (PC_VG + h * 128) * 2;
    const char* gdc = (const char*)(F.ws + WS_GDEC) + UD * 256 + F.lane * 4;
    __builtin_amdgcn_global_load_lds((const unsigned*)gq, (LAS unsigned*)(st), 16, 0, 0);
    __builtin_amdgcn_global_load_lds((const unsigned*)ga, (LAS unsigned*)(st + 8192), 16, 0, 0);
    __builtin_amdgcn_global_load_lds((const unsigned*)gk, (LAS unsigned*)(st + 16384), 16, 0, 0);
    __builtin_amdgcn_global_load_lds((const unsigned*)(gv + (size_t)vr0 * (EN * 2) + vc0 * 16), (LAS unsigned*)(st + 24576), 16, 0, 0);
    __builtin_amdgcn_global_load_lds((const unsigned*)(gv + (size_t)vr1 * (EN * 2) + vc1 * 16), (LAS unsigned*)(st + 24576 + 8192), 16, 0, 0);
    __builtin_amdgcn_global_load_lds((const unsigned*)gdc, (LAS unsigned*)(F.lds + STAGE * GB_STG + 40960 + F.wave * 256), 4, 0, 0);
}
template <int ROWB, class SWZ> __device__ __forceinline__ bf16x8 gb_frag_tr(const LAS unsigned char* tile, int lane, int c, int ks, SWZ swz) {
    const int g = lane >> 4, q = (lane & 15) >> 2, p = lane & 3;
    const int r0 = 32 * ks + 8 * g + q, r1 = r0 + 4;
    const s16x4 lo = __builtin_amdgcn_ds_read_tr16_b64_v4i16((LAS s16x4*)(tile + ROWB * r0 + 16 * ((2 * c + (p >> 1)) ^ swz(r0)) + 8 * (p & 1)));
    const s16x4 hi = __builtin_amdgcn_ds_read_tr16_b64_v4i16((LAS s16x4*)(tile + ROWB * r1 + 16 * ((2 * c + (p >> 1)) ^ swz(r1)) + 8 * (p & 1)));
    return __builtin_shufflevector(lo, hi, 0, 1, 2, 3, 4, 5, 6, 7);
}
__device__ __forceinline__ bf16x8 gb_frag(const LAS unsigned char* tile, int row, int ch) { return *(const LAS bf16x8*)(tile + (row * 8 + (ch ^ (row & 7))) * 16); }
template <int STAGE> __device__ __forceinline__ void glaB_step(const Frame& F, int b, int h, int d, int step, f32x4 (&S)[4], bf16* od) {
    const int lane = F.lane, n = lane & 15, kg = lane >> 4, sl = F.wave;
    if (step == 0) asm volatile("s_waitcnt vmcnt(6)" ::: "memory"); else if (step == 1) asm volatile("s_waitcnt vmcnt(10)" ::: "memory"); else asm volatile("s_waitcnt vmcnt(14)" ::: "memory");
    __builtin_amdgcn_s_barrier();
    asm volatile("" ::: "memory");
    glaB_issue<(STAGE + 2) % 3>(F, b, h, d, step + 2 < NCHUNK ? step + 2 : NCHUNK - 1);
    asm volatile("" ::: "memory");
    const int c = glaB_chunk(d, step);
    const int row0 = c < 4 ? NLAT + b * CTXL + c * 64 : b * SEQ + (c - 4) * 64;
    const LAS unsigned char* st = F.lds + STAGE * GB_STG;
    bf16x8 vf[2], qf[4][2], af[4][2], kf[4][2]; f32x4 dc[4];
#pragma unroll
    for (int T = 0; T < 2; ++T) vf[T] = gb_frag_tr<256>(st + 24576, lane, sl, T, swz_v);
#pragma unroll
    for (int I = 0; I < 4; ++I)
#pragma unroll
        for (int T = 0; T < 2; ++T) { qf[I][T] = gb_frag(st, 16 * I + n, 4 * T + kg); af[I][T] = gb_frag(st + 8192, 16 * I + n, 4 * T + kg); }
#pragma unroll
    for (int I = 0; I < 4; ++I)
#pragma unroll
        for (int T = 0; T < 2; ++T) kf[I][T] = gb_frag_tr<128>(st + 16384, lane, I, T, swz_k);
#pragma unroll
    for (int q = 0; q < 4; ++q) dc[q] = *(const LAS f32x4*)(st + 40960 + sl * 256 + (16 * q + 4 * kg) * 4);
    bf16x8 sb[2];
#pragma unroll
    for (int G2 = 0; G2 < 2; ++G2) { u32x4 sw; sw.x = pk2(S[2 * G2][0], S[2 * G2][1]); sw.y = pk2(S[2 * G2][2], S[2 * G2][3]); sw.z = pk2(S[2 * G2 + 1][0], S[2 * G2 + 1][1]); sw.w = pk2(S[2 * G2 + 1][2], S[2 * G2 + 1][3]); sb[G2] = __builtin_bit_cast(bf16x8, sw); }
    asm volatile("s_waitcnt lgkmcnt(0)" ::: "memory");
    f32x4 o[4];
#pragma unroll
    for (int I = 0; I < 4; ++I) o[I] = (f32x4){0.f, 0.f, 0.f, 0.f};
#pragma unroll
    for (int I = 0; I < 4; ++I) o[I] = MFMA16(sb[0], qf[I][0], o[I]);
#pragma unroll
    for (int I = 0; I < 4; ++I) o[I] = MFMA16(sb[1], qf[I][1], o[I]);
#pragma unroll
    for (int q = 0; q < 4; ++q) S[q] = MFMA16(kf[q][0], vf[0], S[q]);
#pragma unroll
    for (int I = 0; I < 4; ++I) o[I] = MFMA16(vf[0], af[I][0], o[I]);
#pragma unroll
    for (int q = 0; q < 4; ++q) S[q] = MFMA16(kf[q][1], vf[1], S[q]);
#pragma unroll
    for (int I = 0; I < 4; ++I) o[I] = MFMA16(vf[1], af[I][1], o[I]);
#pragma unroll
    for (int q = 0; q < 4; ++q) S[q] = S[q] * dc[q];
    u32x2 ow[4];
#pragma unroll
    for (int I = 0; I < 4; ++I) { ow[I].x = pk2(o[I][0], o[I][1]); ow[I].y = pk2(o[I][2], o[I][3]); }
    asm volatile("s_waitcnt lgkmcnt(0)" ::: "memory");
#pragma unroll
    for (int I = 0; I < 4; ++I) *(u32x2*)(od + (size_t)(row0 + 16 * I + n) * 512 + h * 128 + 16 * sl + 4 * kg) = ow[I];
    asm volatile("" ::: "memory");
}
__device__ __forceinline__ void glaB_group(const Frame& F, int cg) {
    const int d = cg & 1, h = (cg >> 1) & 3, b = cg >> 3;
    bf16* od = (bf16*)(F.ws + WS_U) + (size_t)d * NTOK * 512;
    f32x4 S[4];
#pragma unroll
    for (int q = 0; q < 4; ++q) S[q] = (f32x4){0.f, 0.f, 0.f, 0.f};
    asm volatile("s_waitcnt vmcnt(0) lgkmcnt(0)" ::: "memory");
    __builtin_amdgcn_s_barrier();
    asm volatile("" ::: "memory");
    glaB_issue<0>(F, b, h, d, 0); glaB_issue<1>(F, b, h, d, 1);
    asm volatile("" ::: "memory");
    for (int s0 = 0; s0 + 2 < NCHUNK; s0 += 3) { glaB_step<0>(F, b, h, d, s0, S, od); glaB_step<1>(F, b, h, d, s0 + 1, S, od); glaB_step<2>(F, b, h, d, s0 + 2, S, od); }
    glaB_step<0>(F, b, h, d, 66, S, od); glaB_step<1>(F, b, h, d, 67, S, od);
    static_assert(NCHUNK == 68, "tail of the step loop");
    asm volatile("s_waitcnt vmcnt(0)" ::: "memory");
    __builtin_amdgcn_s_barrier();
}
__device__ __forceinline__ void conv_moe_dynamic(const Frame& F0, int l) {
    Frame F = relaunder(F0);
    LAS float* scr = (LAS float*)(F.lds + F.wave * 16384);
    unsigned* ctr = (unsigned*)(F.ws + WS_CTL) + CW_WQ + l * 64;
    constexpr int I_13 = 16 * 32, I_2 = 8 * 32, NIT = NEXP * (I_13 + I_2), CH = 8;
    for (;;) {
        unsigned t0 = 0; if (F.lane == 0) t0 = atomicAdd(ctr, (unsigned)CH);
        const int it0 = __builtin_amdgcn_readfirstlane((int)t0);
        if (it0 >= NIT) break;
        for (int it = it0; it < it0 + CH && it < NIT; ++it) conv_moe_item(F, l, it, scr);
    }
}

__device__ __forceinline__ void ph_combine(const Frame& F0, int ie, int nrows) {
    Frame F = relaunder(F0);
    const int gw = F.vcu * 8 + F.wave, NGW = F.G * 8, lane = F.lane;
    const bf16* P = (const bf16*)(F.ws + WS_P); bf16* Q = (bf16*)(F.ws + WS_Q);
    const bf16* o0 = (const bf16*)(F.ws + WS_U); const bf16* o1 = o0 + (size_t)NTOK * 512;
    const float* nw = inptr(F, I_NORMW) + (size_t)ie * 512;
    const int col = 8 * lane;
    const f32x4 nwa = *(const f32x4*)(nw + col), nwb = *(const f32x4*)(nw + col + 4);
    for (int r0 = gw * 4; r0 < nrows; r0 += NGW * 4) {
        if (KO_MASK & 2) {
#pragma unroll
            for (int r = 0; r < 4; ++r) *(u32x4*)(Q + (size_t)(r0 + r) * D + 512 + col) = (u32x4){0u, 0u, 0u, 0u};
            continue; }
        u32x4 a[4], bq[4], rr[4];
#pragma unroll
        for (int r = 0; r < 4; ++r) { const size_t row = r0 + r; a[r] = *(const u32x4*)(o0 + row * 512 + col); bq[r] = *(const u32x4*)(o1 + row * 512 + col); rr[r] = *(const u32x4*)(P + row * EN + PC_RG + col); }
#pragma unroll
        for (int r = 0; r < 4; ++r) {
            const f32x4 xa = ubf_lo(a[r]) + ubf_lo(bq[r]), xb = ubf_hi(a[r]) + ubf_hi(bq[r]);
            float ss = (xa[0] * xa[0] + xa[1] * xa[1]) + (xa[2] * xa[2] + xa[3] * xa[3]) + (xb[0] * xb[0] + xb[1] * xb[1]) + (xb[2] * xb[2] + xb[3] * xb[3]);
            ss = row16_sum(ss);
            const float rinv = 1.0f / sqrtf(ss * (1.0f / 128.0f) + RMS_EPS);
            f32x4 ra = ubf_lo(rr[r]), rb = ubf_hi(rr[r]);
#pragma unroll
            for (int j = 0; j < 4; ++j) { ra[j] = fast_silu(ra[j]); rb[j] = fast_silu(rb[j]); }
            *(u32x4*)(Q + (size_t)(r0 + r) * D + 512 + col) = pack8(xa * rinv * nwa * ra, xb * rinv * nwb * rb); }
    }
}

#if defined(FP8_PROBE)
typedef int i32x8 __attribute__((ext_vector_type(8)));
__device__ __forceinline__ unsigned fp8_of_int(int v) { const int a = v < 0 ? -v : v; const unsigned c = a == 0 ? 0x00u : a == 1 ? 0x38u : a == 2 ? 0x40u : 0x44u; return v < 0 ? (c | 0x80u) : c; }
__device__ __forceinline__ int fp8_kidx(int kg, int e) { return FP8_PROBE == 1 ? 32 * kg + e : (e < 16 ? 16 * kg + e : 64 + 16 * kg + (e - 16)); }
__device__ __forceinline__ bool fp8_layout_test(int lane) {
    const int r = lane & 15, kg = lane >> 4;
    i32x8 a, b;
#pragma unroll
    for (int w = 0; w < 8; ++w) { unsigned aw = 0, bw = 0;
#pragma unroll
        for (int by = 0; by < 4; ++by) { const int k = fp8_kidx(kg, 4 * w + by);
            const int av = (k == (7 * r + 3) % 128) ? 1 : 0; const int bv = ((k * 5 + r * 3) % 7) - 3;
            aw |= fp8_of_int(av) << (8 * by); bw |= fp8_of_int(bv) << (8 * by); }
        a[w] = (int)aw; b[w] = (int)bw; }
    f32x4 c = (f32x4){0.f, 0.f, 0.f, 0.f};
    c = __builtin_amdgcn_mfma_scale_f32_16x16x128_f8f6f4(a, b, c, 0, 0, 0, 0, 0, 0);
    bool bad = false;
#pragma unroll
    for (int q = 0; q < 4; ++q) { const int i = 4 * kg + q; const int kk = (7 * i + 3) % 128; const float ex = (float)(((kk * 5 + r * 3) % 7) - 3); if (c[q] != ex) bad = true; }
    return __builtin_amdgcn_ballot_w64(bad) != 0ull;
}
#endif
struct Args { const float* in[25]; float* out; unsigned char* ws; int ph_lo, ph_hi; };
constexpr int NPHASE = 2 + 9 * DEPTH;

__global__ void __launch_bounds__(512, 2) fwd(Args args) {
    extern __shared__ __attribute__((aligned(16))) unsigned char lds_raw[];
    Frame F;
    F.lds = (LAS unsigned char*)lds_raw;
    F.tid = threadIdx.x; F.lane = F.tid & 63; F.wave = __builtin_amdgcn_readfirstlane(F.tid >> 6);
    F.G = gridDim.x; { const int bx = blockIdx.x; F.vcu = (F.G % 8 == 0) ? (bx % 8) * (F.G / 8) + bx / 8 : bx; }
    F.out = args.out; F.ws = args.ws;
    volatile LAS unsigned* MISC = (volatile LAS unsigned*)(F.lds + MISC_OFF);
    if (F.tid < 64) MISC[F.tid] = 0u;
    if (F.tid < 25) ((LAS unsigned long long*)(F.lds + MISC_OFF + 256))[F.tid] = (unsigned long long)args.in[F.tid];
    __syncthreads();
    const int lo = args.ph_lo, hi = args.ph_hi;
    const bool multi = (hi - lo) > 1;
    XcdBarrier bar; bar.bar = (unsigned*)(F.ws + WS_CTL) + CW_BAR; bar.x = 0; bar.st = MISC + 8;
    if (multi) bar = xcd_barrier_post((unsigned*)(F.ws + WS_CTL) + CW_BAR, MISC + 8);
#ifndef PH_SEL
#define PH_SEL 0xffffffff
#endif
#define IN(k) (lo <= (k) && (k) < hi)
#define SEL(b) ((PH_SEL >> (b)) & 1)
#ifndef DUP_MASK
#define DUP_MASK 0
#endif
#define REP(bit) for (int rep_ = 0; rep_ < ((DUP_MASK & (bit)) ? 2 : 1); ++rep_)
#define SEAM(k) do { if ((k) + 1 < hi) xcd_barrier(bar); } while (0)

    if (SEL(0) && IN(0)) { REP(64) { ph_ada(F); __syncthreads(); conv_dense_weights(F); __syncthreads(); } SEAM(0); }
    if (SEL(1) && IN(1)) { REP(64) { ph_u0(F); __syncthreads(); } SEAM(1); }

    for (int l = 0; l < DEPTH; ++l) {
        const int pb = 2 + 9 * l; const bool even = (l & 1) == 0; const int ie = l >> 1;
        const int m_in = (l < 3) ? NTOK : NLAT;
        const int m_out = (l < 2) ? NTOK : NLAT;
        if (SEL(2) && IN(pb + 0)) {
            REP(32) { if (even) {
                LinSched S; S.init(m_in, EN, 1024, F.G, (int)blockIdx.x);
                EpiEvenIn E{(bf16*)(F.ws + WS_P), (const float*)(F.ws + WS_ROPE)};
                pg8::gemm_phase(F.lds, (const char*)(F.ws + WS_U), (const char*)(F.ws + WS_WINE) + (size_t)ie * EN * 1024 * 2, 1024, S, E);
            } else {
                LinSched S; S.init(m_in, ON, 1024, F.G, (int)blockIdx.x);
                EpiOddIn E{(bf16*)(F.ws + WS_P)};
                pg8::gemm_phase(F.lds, (const char*)(F.ws + WS_U), (const char*)(F.ws + WS_WINO) + (size_t)ie * ON * 1024 * 2, 1024, S, E);
            } }
            SEAM(pb + 0);
        }
        if (SEL(3) && IN(pb + 1)) {
            if (even) {
                const Frame Fm = relaunder(F);
                const int nun = NB * 2 * 32 + (l == 0 ? NB * 2 * 2 : 0);
                REP(1) for (int u = Fm.vcu; u < nun; u += Fm.G) {
                    if (u < NB * 2 * 32) attn_unit(Fm, ie, u >> 6, (u >> 5) & 1, u & 31, false);
                    else { const int v = u - NB * 2 * 32; attn_unit(Fm, ie, v >> 2, (v >> 1) & 1, v & 1, true); }
                }
                __syncthreads();
                if (!(KO_MASK & 2)) REP(2) for (int u = Fm.vcu * 8 + Fm.wave; u < NB * NCHUNK * 8; u += Fm.G * 8) { if (u & 1) glaA_unit<1>(Fm, ie, u / (NCHUNK * 8), (u / 8) % NCHUNK, (u >> 1) & 3); else glaA_unit<0>(Fm, ie, u / (NCHUNK * 8), (u / 8) % NCHUNK, (u >> 1) & 3); }
                __syncthreads();
            } else {
                REP(16) { ph_conv(F, ie, m_out); __syncthreads(); }
            }
            if (!even) REP(8) { conv_moe_weights(F, l); __syncthreads(); }
            SEAM(pb + 1);
        }
        if (even) {
            if (SEL(4) && IN(pb + 2)) {
                { const Frame Fm = relaunder(F);
                  if (!(KO_MASK & 2)) REP(4) for (int cg = Fm.vcu; cg < 128; cg += Fm.G) glaB_group(Fm, cg);
                  __syncthreads();
                  conv_moe_dynamic(Fm, l); }
                SEAM(pb + 2);
            }
            if (SEL(5) && IN(pb + 3)) { REP(16) { ph_combine(F, ie, m_out); __syncthreads(); } SEAM(pb + 3); }
        }
        if (SEL(6) && IN(pb + 4)) {
            REP(32) { LinSched S; S.init(m_out, 1024, 1024, F.G, (int)blockIdx.x);
            EpiPlain E{(bf16*)(F.ws + WS_P), 1024};
            pg8::gemm_phase(F.lds, (const char*)(F.ws + WS_Q), (const char*)(F.ws + (even ? WS_WOUTE : WS_WOUTO)) + (size_t)ie * 1024 * 1024 * 2, 1024, S, E); }
            SEAM(pb + 4);
        }
        if (SEL(7) && IN(pb + 5)) { if (DUP_MASK & 128) { ph_ln1(F, l, m_out, true); __syncthreads(); } ph_ln1(F, l, m_out); SEAM(pb + 5); }
        if (SEL(8) && IN(pb + 6)) {
            if (!(KO_MASK & 8)) REP(32) {
                moe_tables(F.lds, (const unsigned*)(F.ws + WS_CTL) + CW_CNT + l * 64);
                MoeSched<1> S; S.T = moe_tab(F.lds); S.rowtok = (const int*)(F.ws + WS_ROWTOK); S.G = F.G; S.c = F.vcu; S.bstride = (size_t)256 * 1024; S.estride = (size_t)1024 * 1024;
                EpiG1 E{(unsigned char*)(F.ws + WS_Q), 1.0f / W8_SCALE};
                pg8::gemm_phase<EpiG1, MoeSched<1>, 1>(F.lds, (const char*)(F.ws + WS_U8), (const char*)(F.ws + WS_W13), 1024, S, E);
            }
            SEAM(pb + 6);
        }
        if (SEL(9) && IN(pb + 7)) {
            if (!(KO_MASK & 8)) REP(32) {
                moe_tables(F.lds, (const unsigned*)(F.ws + WS_CTL) + CW_CNT + l * 64);
                MoeSched<0> S; S.T = moe_tab(F.lds); S.rowtok = nullptr; S.G = F.G; S.c = F.vcu; S.bstride = (size_t)256 * 512; S.estride = (size_t)1024 * 512;
                EpiPlainS E{(bf16*)(F.ws + WS_P), 1024, 1.0f / W8_SCALE};
                pg8::gemm_phase<EpiPlainS, MoeSched<0>, 1>(F.lds, (const char*)(F.ws + WS_Q), (const char*)(F.ws + WS_W2), 512, S, E);
            }
            SEAM(pb + 7);
        }
        if (SEL(10) && IN(pb + 8)) {
            moe_tables(F.lds, (const unsigned*)(F.ws + WS_CTL) + CW_CNT + l * 64);
            if (DUP_MASK & 256) { ph_ln2(F, l, m_out, true); __syncthreads(); }
            ph_ln2(F, l, m_out);
            SEAM(pb + 8);
        }
    }
#if defined(FP8_PROBE)
    if (blockIdx.x == 0) { __syncthreads(); if (F.tid < 64) { const bool bad = fp8_layout_test(F.tid); if (bad && F.tid == 0) F.out[0] = __builtin_nanf(""); } }
#endif
#undef IN
#undef SEAM
}

extern "C" void kernel_launch(void* const* d_in, const int* in_sizes, int n_in, void* d_out, int out_size, void* d_ws, size_t ws_size, hipStream_t stream) {
    static int grid = 0;
    if (grid == 0) {
        if (n_in != 25 || in_sizes[0] != NLAT * D || out_size != NLAT * D || ws_size < WS_END) { fprintf(stderr, "kernel_launch: unexpected shapes (n_in %d in0 %d out %d ws %zu)\n", n_in, n_in > 0 ? in_sizes[0] : -1, out_size, ws_size); grid = -1; return; }
        int dev = 0, cus = 0, per_cu = 0;
        if (hipGetDevice(&dev) != hipSuccess || hipDeviceGetAttribute(&cus, hipDeviceAttributeMultiprocessorCount, dev) != hipSuccess) { grid = -1; return; }
        if (hipFuncSetAttribute((const void*)fwd, hipFuncAttributeMaxDynamicSharedMemorySize, LDS_BYTES) != hipSuccess) { fprintf(stderr, "kernel_launch: hipFuncSetAttribute failed\n"); grid = -1; return; }
        if (hipOccupancyMaxActiveBlocksPerMultiprocessor(&per_cu, (const void*)fwd, 512, LDS_BYTES) != hipSuccess || per_cu < 1) fprintf(stderr, "kernel_launch: occupancy query says %d\n", per_cu);
        (void)hipGetLastError();
        grid = cus;
        if (grid < 242 || grid > 1024) { fprintf(stderr, "kernel_launch: built for a 256-CU device (got %d CUs)\n", cus); grid = -1; return; }
    }
    if (grid < 0) return;
    if (hipMemsetAsync((char*)d_ws + WS_CTL, 0, CTL_BYTES, stream) != hipSuccess) return;
    Args a{};
    for (int i = 0; i < 25; ++i) a.in[i] = (const float*)d_in[i];
    a.out = (float*)d_out; a.ws = (unsigned char*)d_ws;
#if N_LAUNCH_MODE == 1
    a.ph_lo = 0; a.ph_hi = NPHASE;
    hipLaunchKernelGGL(fwd, dim3(grid), dim3(512), LDS_BYTES, stream, a);
#else
    for (int k = 0; k < NPHASE; ++k) {
        if (k >= 2) { const int l = (k - 2) / 9, s = (k - 2) % 9; if ((l & 1) && (s == 2 || s == 3)) continue; }
        a.ph_lo = k; a.ph_hi = k + 1;
        hipLaunchKernelGGL(fwd, dim3(grid), dim3(512), LDS_BYTES, stream, a);
    }
#endif
}
```

```cpp
#include <hip/hip_runtime.h>
#define N_LAUNCH_MODE 1
#define KO_MASK 0
#define DUP_MASK 0
#include <cstdio>
#include <cstdint>

#ifndef KO_MASK
#define KO_MASK 0
#endif
#ifndef N_LAUNCH_MODE
#define N_LAUNCH_MODE 1
#endif

#define GAS __attribute__((address_space(1)))
#define LAS __attribute__((address_space(3)))
typedef unsigned short bf16;
typedef short bf16x8 __attribute__((ext_vector_type(8)));
typedef short s16x4 __attribute__((ext_vector_type(4)));
typedef float f32x2 __attribute__((ext_vector_type(2)));
typedef float f32x4 __attribute__((ext_vector_type(4)));
typedef float f32x16 __attribute__((ext_vector_type(16)));
typedef unsigned u32x2 __attribute__((ext_vector_type(2)));
typedef unsigned u32x4 __attribute__((ext_vector_type(4)));
typedef __bf16 bf16x2_t __attribute__((ext_vector_type(2)));
typedef int i32x8 __attribute__((ext_vector_type(8)));
typedef int i32x4_t __attribute__((ext_vector_type(4)));

constexpr int D = 1024, NB = 16, SEQ = 4096, CTXL = 256, DEPTH = 4;
constexpr int NLAT = NB * SEQ, NCTX = NB * CTXL, NTOK = NLAT + NCTX;
constexpr int EVEN_IN = 2336, EN = 2560, ON = 3072;
constexpr int NEXP = 32, DEXP = 512;
constexpr int SLOT_ROWS = 2 * NTOK + NEXP * 256;
constexpr float DN_ALPHA = 1.6817928305074290f;
constexpr float LN_EPS = 1e-5f, RMS_EPS = 1e-6f;
constexpr float LOG2E = 1.4426950408889634f;
constexpr int PC_Q = 0, PC_K = 512, PC_V = 640, PC_QG = 768, PC_KG = 1024, PC_VG = 1280, PC_RG = 1792, PC_GG = 2304;
constexpr int NCHUNK = 68;

constexpr size_t MiB = 1u << 20;
constexpr size_t WS_CTL = 0, CTL_BYTES = 1 * MiB;
constexpr size_t WS_MOD = 1 * MiB;
constexpr size_t WS_ROPE = 3 * MiB;
constexpr size_t WS_TOKINFO = 4 * MiB;
constexpr size_t WS_ROWTOK = 7 * MiB;
constexpr size_t WS_WINE = 16 * MiB, WS_WOUTE = 26 * MiB, WS_WINO = 30 * MiB, WS_WOUTO = 42 * MiB;
constexpr size_t WS_W13 = 46 * MiB, WS_W2 = 110 * MiB;
constexpr size_t WS_HCTX = 142 * MiB;
constexpr size_t WS_U = 158 * MiB;
constexpr size_t WS_P = 294 * MiB;
constexpr size_t WS_Q = 634 * MiB;
constexpr size_t WS_GATT = 778 * MiB, WS_GQIN = 846 * MiB, WS_GKST = 914 * MiB, WS_GVT = 982 * MiB, WS_GDEC = 1050 * MiB;
constexpr size_t WS_U8 = 1053 * MiB;
constexpr size_t WS_END = 1121 * MiB;
constexpr int CW_BAR = 4096;
constexpr int CW_CNT = 16384;
constexpr int CW_WQ = 20480;

constexpr int RING_BYTES = 131072;
constexpr int LDSX_OFF = RING_BYTES;
constexpr int MISC_OFF = LDSX_OFF + 8192;
constexpr int LDS_BYTES = 147456;

__device__ __forceinline__ unsigned pk2(float a, float b) { bf16x2_t r = __builtin_convertvector((f32x2){a, b}, bf16x2_t); return __builtin_bit_cast(unsigned, r); }
__device__ __forceinline__ unsigned pk4_fp8(float a, float b, float c, float d) { int r = __builtin_amdgcn_cvt_pk_fp8_f32(a, b, 0, false); r = __builtin_amdgcn_cvt_pk_fp8_f32(c, d, r, true); return (unsigned)r; }
__device__ __forceinline__ float bf2f(unsigned short h) { return __uint_as_float(((unsigned)h) << 16); }
__device__ __forceinline__ float bflo(unsigned w) { return __uint_as_float(w << 16); }
__device__ __forceinline__ float bfhi(unsigned w) { return __uint_as_float(w & 0xffff0000u); }
template <int CTRL> __device__ __forceinline__ float dppf(float v) { return __builtin_bit_cast(float, __builtin_amdgcn_update_dpp(0, __builtin_bit_cast(int, v), CTRL, 0xf, 0xf, false)); }
__device__ __forceinline__ float row16_sum(float v) { v += dppf<0xB1>(v); v += dppf<0x4E>(v); v += dppf<0x141>(v); v += dppf<0x140>(v); return v; }
__device__ __forceinline__ float wave_sum(float v) {
    v = row16_sum(v);
    const float s0 = __builtin_bit_cast(float, __builtin_amdgcn_readlane(__builtin_bit_cast(int, v), 0)), s1 = __builtin_bit_cast(float, __builtin_amdgcn_readlane(__builtin_bit_cast(int, v), 16));
    const float s2 = __builtin_bit_cast(float, __builtin_amdgcn_readlane(__builtin_bit_cast(int, v), 32)), s3 = __builtin_bit_cast(float, __builtin_amdgcn_readlane(__builtin_bit_cast(int, v), 48));
    return (s0 + s1) + (s2 + s3);
}
__device__ __forceinline__ float fast_silu(float x) { return x * __builtin_amdgcn_rcpf(1.0f + __builtin_amdgcn_exp2f(-x * LOG2E)); }

#define XB_TMO      128
#define XB_XCNT(j)  (256  + 64 * (j))
#define XB_XSUB(j)  (1280 + 64 * (j))
#define XB_XGEN(j)  (2304 + 64 * (j))
#define XB_TOP      3328
#define XB_TOPGEN   3392
#define XCD_BAR_WORDS 3456
#define XB_SPIN_CAP (1u << 22)
__device__ __forceinline__ unsigned xb_ld(unsigned* p)              { return __hip_atomic_load(p, __ATOMIC_RELAXED, __HIP_MEMORY_SCOPE_AGENT); }
__device__ __forceinline__ unsigned xb_add(unsigned* p, unsigned v) { return __hip_atomic_fetch_add(p, v, __ATOMIC_RELAXED, __HIP_MEMORY_SCOPE_AGENT); }
__device__ __forceinline__ unsigned xb_xcc_id() { return (unsigned)__builtin_amdgcn_s_getreg((3 << 11) | 20) & 0xFu; }
#define XB_SPIN(cond, bar) do { unsigned _sp = 0; while (cond) { __builtin_amdgcn_s_sleep(1); \
    if ((++_sp & 255u) == 0u) { if (xb_ld(&(bar)[XB_TMO])) break; if (_sp > XB_SPIN_CAP) { atomicAdd(&(bar)[XB_TMO], 1u); break; } } } } while (0)
struct XcdBarrier { unsigned* bar; unsigned x; volatile LAS unsigned* st; };
__device__ __forceinline__ XcdBarrier xcd_barrier_post(unsigned* bar, volatile LAS unsigned* st) {
    XcdBarrier b; b.bar = bar; b.x = xb_xcc_id(); b.st = st;
    if (threadIdx.x == 0) (void)xb_add(&bar[XB_XCNT(b.x)], 1u);
    return b;
}
__device__ __forceinline__ void xcd_barrier_complete(unsigned* bar, unsigned x, unsigned& nloc, unsigned& nx) {
    const unsigned G = gridDim.x * gridDim.y * gridDim.z;
    unsigned sum, cnt, mine, sp = 0u;
    for (;;) {
        sum = 0u; cnt = 0u; mine = 0u;
#pragma unroll
        for (unsigned j = 0; j < 16; ++j) { const unsigned c = xb_ld(&bar[XB_XCNT(j)]); sum += c; cnt += (c > 0u) ? 1u : 0u; mine = (j == x) ? c : mine; }
        if (sum == G) break;
        __builtin_amdgcn_s_sleep(1);
        if ((++sp & 255u) == 0u) { if (xb_ld(&bar[XB_TMO])) break; if (sp > XB_SPIN_CAP) { atomicAdd(&bar[XB_TMO], 1u); break; } }
    }
    nloc = mine > 0u ? mine : 1u; nx = cnt > 0u ? cnt : 1u;
}
__device__ __forceinline__ void xcd_barrier(const XcdBarrier& b) {
    asm volatile("s_waitcnt vmcnt(0)" ::: "memory");
    __syncthreads();
    if (threadIdx.x == 0) {
        unsigned* bar = b.bar;
        __builtin_amdgcn_s_waitcnt(0);
        unsigned nloc = b.st[0], nx = b.st[1];
        if (nloc == 0u) { xcd_barrier_complete(bar, b.x, nloc, nx); b.st[0] = nloc; b.st[1] = nx; }
        const unsigned old = xb_add(&bar[XB_XSUB(b.x)], 1u);
        const unsigned gen = old / nloc;
        if (old + 1u == (gen + 1u) * nloc) {
            __builtin_amdgcn_fence(__ATOMIC_RELEASE, "agent");
            asm volatile("s_waitcnt vmcnt(0)" ::: "memory");
            const unsigned og = xb_add(&bar[XB_TOP], 1u);
            const unsigned tg = og / nx;
            if (og + 1u == (tg + 1u) * nx) xb_add(&bar[XB_TOPGEN], 1u);
            else XB_SPIN(xb_ld(&bar[XB_TOPGEN]) == tg, bar);
            __builtin_amdgcn_fence(__ATOMIC_ACQUIRE, "agent");
            xb_add(&bar[XB_XGEN(b.x)], 1u);
            asm volatile("s_waitcnt vmcnt(0)" ::: "memory");
        } else {
            XB_SPIN(xb_ld(&bar[XB_XGEN(b.x)]) == gen, bar);
            __builtin_amdgcn_fence(__ATOMIC_ACQUIRE, "agent");
            asm volatile("s_waitcnt vmcnt(0)" ::: "memory");
        }
    }
    __syncthreads();
}

namespace pg8 {
constexpr int BM = 256, BK = 64, HALF = 128, HTB = HALF * BK * 2, STAGE_BYTES = 8 * HTB;
__device__ __forceinline__ int lds_byte(int r, int c) { const int st = (r >> 4) * 2 + (c >> 5), rr = r & 15, cc = c & 31, ob = rr * 64 + cc * 2; return st * 1024 + (ob ^ (((ob >> 9) & 1) << 5)); }
__device__ __forceinline__ void stage_rc(int b, int& R, int& C) { const int st = b / 1024, sb = b % 1024, swz = sb ^ (((sb >> 9) & 1) << 5); R = (st >> 1) * 16 + swz / 64; C = (st & 1) * 32 + (swz % 64) / 2; }
__device__ __forceinline__ int perm32(int rho) { const int n = rho >> 4, i = rho & 15; return 8 * (i >> 2) + 4 * n + (i & 3); }

struct Unit { int pn; int orow0; int mt; int e; };

template <class Epi, class Sched, int FP8 = 0>
__device__ __forceinline__ void gemm_phase(LAS unsigned char* lds, const char* Abase, const char* Bbase, const int K, const Sched& S, const Epi& E) {
    int tid_ = threadIdx.x; asm volatile("" : "+v"(tid_));
    const int tid = tid_, wid = __builtin_amdgcn_readfirstlane(tid >> 6), lane = tid & 63, wr = wid >> 2, wc = wid & 3, fr = lane & 15, fq = lane >> 4;
    const unsigned K2 = FP8 ? (unsigned)K : (unsigned)K * 2u;
    const int nt = (int)(K2 / 128u);
    int Rr[2], Cc[2]; unsigned voffB[2];
#pragma unroll
    for (int i = 0; i < 2; ++i) { stage_rc(tid * 16 + i * 8192, Rr[i], Cc[i]); const int Rb = (Rr[i] & ~31) + perm32(Rr[i] & 31); voffB[i] = (unsigned)Rb * K2 + (unsigned)Cc[i] * 2u; }
    const size_t kstep = (size_t)(BK * 2);
    const size_t hstep = (size_t)HALF * K2;
    const unsigned ldsw = (unsigned)wid * 1024u;
    const int aoff = FP8 ? lds_byte(wr * 64 + fr, 32 * (fq >> 1) + 16 * (fq & 1)) : lds_byte(wr * 64 + fr, fq * 8), boff = FP8 ? lds_byte(wc * 32 + fr, 32 * (fq >> 1) + 16 * (fq & 1)) : lds_byte(wc * 32 + fr, fq * 8);
#define PG8_SA(b, h) (((b) * 2 + (h)) * HTB)
#define PG8_SB(b, h) ((4 + (b) * 2 + (h)) * HTB)
#define PG8_STAGE(bufoff, gbase, voff) do { _Pragma("unroll") for (int _i = 0; _i < 2; ++_i) \
        __builtin_amdgcn_global_load_lds((const unsigned*)((const char*)(gbase) + (voff)[_i]), (LAS unsigned*)(lds + (bufoff) + ldsw + _i * 8192), 16, 0, 0); } while (0)
#define PG8_LD8(ptr) __builtin_shufflevector(*(const LAS i32x4_t*)(ptr), *(const LAS i32x4_t*)((ptr) + 16), 0, 1, 2, 3, 4, 5, 6, 7)
#define PG8_LDA(dst, b, h) do { if constexpr (FP8) { _Pragma("unroll") for (int m = 0; m < 4; ++m) dst##8[m] = PG8_LD8(lds + PG8_SA(b, h) + aoff + m * 2048); } \
        else { _Pragma("unroll") for (int m = 0; m < 4; ++m) _Pragma("unroll") for (int k = 0; k < 2; ++k) dst[m][k] = *(const LAS bf16x8*)(lds + PG8_SA(b, h) + aoff + m * 2048 + k * 1024); } } while (0)
#define PG8_LDB(dst, b, h) do { if constexpr (FP8) { _Pragma("unroll") for (int n = 0; n < 2; ++n) dst##8[n] = PG8_LD8(lds + PG8_SB(b, h) + boff + n * 2048); } \
        else { _Pragma("unroll") for (int n = 0; n < 2; ++n) _Pragma("unroll") for (int k = 0; k < 2; ++k) dst[n][k] = *(const LAS bf16x8*)(lds + PG8_SB(b, h) + boff + n * 2048 + k * 1024); } } while (0)
#define PG8_MMA(ai, bj, At, Bt) do { __builtin_amdgcn_s_setprio(1); _Pragma("unroll") for (int m = 0; m < 4; ++m) _Pragma("unroll") for (int n = 0; n < 2; ++n) { \
        if constexpr (FP8) asm volatile("v_mfma_f32_16x16x128_f8f6f4 %0, %1, %2, %0" : "+v"(acc[ai][bj][m][n]) : "v"(Bt##8[n]), "v"(At##8[m])); \
        else { _Pragma("unroll") for (int k = 0; k < 2; ++k) acc[ai][bj][m][n] = __builtin_amdgcn_mfma_f32_16x16x32_bf16(Bt[n][k], At[m][k], acc[ai][bj][m][n], 0, 0, 0); } } \
        __builtin_amdgcn_s_setprio(0); } while (0)
#define PG8_WAIT_V(n) asm volatile("s_waitcnt vmcnt(" #n ")" ::: "memory")
#define PG8_WAIT_L(n) asm volatile("s_waitcnt lgkmcnt(" #n ")" ::: "memory")
#define PG8_BAR __builtin_amdgcn_s_barrier()
#define PG8_SCHED __builtin_amdgcn_sched_barrier(0)
    Unit cur, nxt; int ui = 0;
    if (!S.next(0, cur)) return;
    f32x4 acc[2][2][4][2];
#pragma unroll
    for (int a = 0; a < 2; ++a)
#pragma unroll
        for (int b = 0; b < 2; ++b)
#pragma unroll
            for (int m = 0; m < 4; ++m)
#pragma unroll
                for (int n = 0; n < 2; ++n) { if constexpr (FP8) asm volatile("v_mov_b32 %0, 0\n\tv_mov_b32 %1, 0\n\tv_mov_b32 %2, 0\n\tv_mov_b32 %3, 0" : "=v"(acc[a][b][m][n][0]), "=v"(acc[a][b][m][n][1]), "=v"(acc[a][b][m][n][2]), "=v"(acc[a][b][m][n][3])); else acc[a][b][m][n] = (f32x4){0.f, 0.f, 0.f, 0.f}; }
    if constexpr (FP8) asm volatile("s_nop 7" ::: "memory");
    bf16x8 At[4][2], B0[2][2], B1[2][2];
    i32x8 At8[4], B08[2], B18[2];
    unsigned vAc0[2], vAc1[2], vAn0[2], vAn1[2];
#pragma unroll
    for (int i = 0; i < 2; ++i) { vAc0[i] = (unsigned)S.arow(cur, Rr[i]) * K2 + (unsigned)Cc[i] * 2u; vAc1[i] = (unsigned)S.arow(cur, HALF + Rr[i]) * K2 + (unsigned)Cc[i] * 2u; vAn0[i] = vAc0[i]; vAn1[i] = vAc1[i]; }
    const char* cB = Bbase + S.boff(cur);
    PG8_STAGE(PG8_SB(0, 0), cB, voffB); PG8_STAGE(PG8_SB(0, 1), cB + hstep, voffB); PG8_STAGE(PG8_SA(0, 0), Abase, vAc0); PG8_STAGE(PG8_SA(0, 1), Abase, vAc1);
    if (wr == 1) PG8_BAR;
    PG8_WAIT_V(2); PG8_BAR;
    PG8_STAGE(PG8_SB(1, 0), cB + kstep, voffB); PG8_STAGE(PG8_SA(1, 0), Abase + kstep, vAc0); PG8_STAGE(PG8_SB(1, 1), cB + hstep + kstep, voffB);
    PG8_WAIT_V(6); PG8_BAR;
    for (;;) {
        const bool has_next = S.next(ui + 1, nxt);
        const char* nB = has_next ? Bbase + S.boff(nxt) : cB;
        if (has_next) {
#pragma unroll
            for (int i = 0; i < 2; ++i) { vAn0[i] = (unsigned)S.arow(nxt, Rr[i]) * K2 + (unsigned)Cc[i] * 2u; vAn1[i] = (unsigned)S.arow(nxt, HALF + Rr[i]) * K2 + (unsigned)Cc[i] * 2u; }
        } else {
#pragma unroll
            for (int i = 0; i < 2; ++i) { vAn0[i] = vAc0[i]; vAn1[i] = vAc1[i]; }
        }
        for (int t = 0; t < nt; t += 2) {
            const bool last = (t == nt - 2);
            const char* a1 = Abase + (size_t)(t + 1) * kstep;
            const char* a2 = last ? Abase : Abase + (size_t)(t + 2) * kstep; const char* b2 = last ? nB : cB + (size_t)(t + 2) * kstep;
            const char* a3 = a2 + kstep; const char* b3 = b2 + kstep;
            unsigned v20[2], v21[2];
#pragma unroll
            for (int i = 0; i < 2; ++i) { v20[i] = last ? vAn0[i] : vAc0[i]; v21[i] = last ? vAn1[i] : vAc1[i]; }
            PG8_LDB(B0, 0, 0); PG8_LDB(B1, 0, 1); PG8_SCHED; PG8_LDA(At, 0, 0); PG8_STAGE(PG8_SA(1, 1), a1, vAc1);
            PG8_WAIT_V(8); PG8_WAIT_L(0); PG8_BAR; PG8_MMA(0, 0, At, B0); PG8_MMA(0, 1, At, B1); PG8_BAR; PG8_SCHED;
            PG8_LDA(At, 0, 1); PG8_STAGE(PG8_SB(0, 0), b2, voffB); PG8_STAGE(PG8_SB(0, 1), b2 + hstep, voffB); PG8_STAGE(PG8_SA(0, 0), a2, v20);
            PG8_WAIT_V(8); PG8_WAIT_L(0); PG8_BAR; PG8_MMA(1, 0, At, B0); PG8_MMA(1, 1, At, B1); PG8_BAR; PG8_SCHED;
            PG8_LDB(B0, 1, 0); PG8_LDB(B1, 1, 1); PG8_SCHED; PG8_LDA(At, 1, 0); PG8_STAGE(PG8_SA(0, 1), a2, v21);
            PG8_WAIT_V(8); PG8_WAIT_L(0); PG8_BAR; PG8_MMA(0, 0, At, B0); PG8_MMA(0, 1, At, B1); PG8_BAR; PG8_SCHED;
            PG8_LDA(At, 1, 1); PG8_STAGE(PG8_SB(1, 0), b3, voffB); PG8_STAGE(PG8_SB(1, 1), b3 + hstep, voffB); PG8_STAGE(PG8_SA(1, 0), a3, v20);
            PG8_WAIT_V(8); PG8_WAIT_L(0); PG8_BAR; PG8_MMA(1, 0, At, B0); PG8_MMA(1, 1, At, B1); PG8_BAR; PG8_SCHED;
        }
        if (wr == 0) PG8_BAR;
        if constexpr (FP8) asm volatile("s_nop 15\n\ts_nop 15" ::: "memory");
        E(acc, cur, wr, wc, fr, fq);
        if (!has_next) break;
#pragma unroll
        for (int a = 0; a < 2; ++a)
#pragma unroll
            for (int b = 0; b < 2; ++b)
#pragma unroll
                for (int m = 0; m < 4; ++m)
#pragma unroll
                    for (int n = 0; n < 2; ++n) { if constexpr (FP8) asm volatile("v_mov_b32 %0, 0\n\tv_mov_b32 %1, 0\n\tv_mov_b32 %2, 0\n\tv_mov_b32 %3, 0" : "=v"(acc[a][b][m][n][0]), "=v"(acc[a][b][m][n][1]), "=v"(acc[a][b][m][n][2]), "=v"(acc[a][b][m][n][3])); else acc[a][b][m][n] = (f32x4){0.f, 0.f, 0.f, 0.f}; }
        if constexpr (FP8) asm volatile("s_nop 7" ::: "memory");
        cur = nxt; cB = nB; ++ui;
#pragma unroll
        for (int i = 0; i < 2; ++i) { vAc0[i] = vAn0[i]; vAc1[i] = vAn1[i]; }
        if (wr == 1) PG8_BAR;
    }
    PG8_WAIT_V(0);
    PG8_BAR;
#undef PG8_SA
#undef PG8_SB
#undef PG8_STAGE
#undef PG8_LDA
#undef PG8_LDB
#undef PG8_MMA
#undef PG8_WAIT_V
#undef PG8_WAIT_L
#undef PG8_BAR
#undef PG8_SCHED
}
}
struct LinSched {
    int nM, nN, nwg, G, c; size_t bstride;
    __device__ __forceinline__ void init(int M, int N, int K, int G_, int c_) { nM = M / 256; nN = N / 256; nwg = nM * nN; G = G_; c = c_; bstride = (size_t)256 * K * 2; }
    __device__ __forceinline__ bool next(int i, pg8::Unit& u) const {
        const long L = (long)i * G + c; if (L >= nwg) return false;
        int wgid = (int)L; { const int q = nwg / 8, r = nwg % 8, xcd = wgid % 8, off = wgid / 8; wgid = (xcd < r ? xcd * (q + 1) : r * (q + 1) + (xcd - r) * q) + off; }
        const int nig = 8 * nN, gid = wgid / nig, fm = gid * 8, gsz = (nM - fm) < 8 ? (nM - fm) : 8;
        u.mt = fm + ((wgid % nig) % gsz); u.pn = (wgid % nig) / gsz; u.orow0 = u.mt * 256; u.e = 0; return true;
    }
    __device__ __forceinline__ int arow(const pg8::Unit& u, int lr) const { return u.orow0 + lr; }
    __device__ __forceinline__ size_t boff(const pg8::Unit& u) const { return (size_t)u.pn * bstride; }
};
struct MoeTab { LAS int* ts; LAS int* cnt; LAS unsigned char* tile_e; };
__device__ __forceinline__ MoeTab moe_tab(LAS unsigned char* lds) { MoeTab t; t.ts = (LAS int*)(lds + LDSX_OFF); t.cnt = (LAS int*)(lds + LDSX_OFF + 256); t.tile_e = (LAS unsigned char*)(lds + LDSX_OFF + 512); return t; }
__device__ __forceinline__ void moe_tables(LAS unsigned char* lds, const unsigned* gcnt) {
    MoeTab T = moe_tab(lds);
    __syncthreads();
    if (threadIdx.x == 0) { int s = 0; for (int e = 0; e < NEXP; ++e) { const int c = (int)gcnt[e]; T.cnt[e] = c; T.ts[e] = s; s += (c + 255) >> 8; } T.ts[NEXP] = s; }
    __syncthreads();
    const int nt = T.ts[NEXP];
    for (int mt = threadIdx.x; mt < nt; mt += blockDim.x) { int e = 0; for (int j = 1; j < NEXP; ++j) e += (mt >= T.ts[j]) ? 1 : 0; T.tile_e[mt] = (unsigned char)e; }
    __syncthreads();
}
template <int GATHER> struct MoeSched {
    MoeTab T; const int* rowtok; int G, c; size_t bstride; size_t estride;
    __device__ __forceinline__ bool next(int i, pg8::Unit& u) const {
        const int L = i * G + c; const int nt = T.ts[NEXP]; if (L >= nt * 4) return false;
        u.mt = L >> 2; u.pn = L & 3; u.orow0 = u.mt * 256; u.e = (int)T.tile_e[u.mt]; return true;
    }
    __device__ __forceinline__ int arow(const pg8::Unit& u, int lr) const {
        if (GATHER) { const int idx = (u.mt - T.ts[u.e]) * 256 + lr; return idx < T.cnt[u.e] ? rowtok[(size_t)u.e * NTOK + idx] : 0; }
        return u.orow0 + lr;
    }
    __device__ __forceinline__ size_t boff(const pg8::Unit& u) const { return (size_t)u.e * estride + (size_t)u.pn * bstride; }
};

__device__ __forceinline__ u32x4 pack8(const f32x4 a, const f32x4 b) { u32x4 w; w.x = pk2(a[0], a[1]); w.y = pk2(a[2], a[3]); w.z = pk2(b[0], b[1]); w.w = pk2(b[2], b[3]); return w; }
struct EpiPlain {
    bf16* O; int ldc;
    __device__ __forceinline__ void operator()(const f32x4 (&acc)[2][2][4][2], const pg8::Unit& u, int wr, int wc, int fr, int fq) const {
        const int row0 = u.orow0 + wr * 64 + fr, col0 = u.pn * 256 + wc * 32 + 8 * fq;
#pragma unroll
        for (int ai = 0; ai < 2; ++ai)
#pragma unroll
            for (int m = 0; m < 4; ++m) { bf16* rowp = O + (size_t)(row0 + ai * 128 + m * 16) * ldc + col0;
#pragma unroll
                for (int bj = 0; bj < 2; ++bj) *(u32x4*)(rowp + bj * 128) = pack8(acc[ai][bj][m][0], acc[ai][bj][m][1]); }
    }
};
struct EpiPlainS {
    bf16* O; int ldc; float sc;
    __device__ __forceinline__ void operator()(const f32x4 (&acc)[2][2][4][2], const pg8::Unit& u, int wr, int wc, int fr, int fq) const {
        const int row0 = u.orow0 + wr * 64 + fr, col0 = u.pn * 256 + wc * 32 + 8 * fq;
#pragma unroll
        for (int ai = 0; ai < 2; ++ai)
#pragma unroll
            for (int m = 0; m < 4; ++m) { bf16* rowp = O + (size_t)(row0 + ai * 128 + m * 16) * ldc + col0;
#pragma unroll
                for (int bj = 0; bj < 2; ++bj) *(u32x4*)(rowp + bj * 128) = pack8(acc[ai][bj][m][0] * sc, acc[ai][bj][m][1] * sc); }
    }
};
struct EpiEvenIn {
    bf16* O; const float* rope;
    __device__ __forceinline__ void operator()(const f32x4 (&acc)[2][2][4][2], const pg8::Unit& u, int wr, int wc, int fr, int fq) const {
        const int row0 = u.orow0 + wr * 64 + fr, col0 = u.pn * 256 + wc * 32 + 8 * fq;
        const bool lat = u.orow0 < NLAT;
#pragma unroll
        for (int ai = 0; ai < 2; ++ai)
#pragma unroll
            for (int m = 0; m < 4; ++m) { const int row = row0 + ai * 128 + m * 16; bf16* rowp = O + (size_t)row * EN + col0;
                const int s = row & (SEQ - 1); const int pos = (wc & 1) ? (s & 63) : (s >> 6);
#pragma unroll
                for (int bj = 0; bj < 2; ++bj) { f32x4 v0 = acc[ai][bj][m][0], v1 = acc[ai][bj][m][1];
                    const bool rp = lat && (u.pn < 2 || (u.pn == 2 && bj == 0));
                    if (rp) { const f32x4 c = *(const f32x4*)(rope + pos * 16 + 4 * fq), sn = *(const f32x4*)(rope + 1024 + pos * 16 + 4 * fq);
                        const f32x4 o1 = v0 * c - v1 * sn, o2 = v1 * c + v0 * sn; v0 = o1; v1 = o2; }
                    *(u32x4*)(rowp + bj * 128) = pack8(v0, v1); } }
    }
};
struct EpiOddIn {
    bf16* O;
    __device__ __forceinline__ void operator()(const f32x4 (&acc)[2][2][4][2], const pg8::Unit& u, int wr, int wc, int fr, int fq) const {
        const int row0 = u.orow0 + wr * 64 + fr;
#pragma unroll
        for (int ai = 0; ai < 2; ++ai)
#pragma unroll
            for (int m = 0; m < 4; ++m) { bf16* rowp = O + (size_t)(row0 + ai * 128 + m * 16) * 2048;
                if (u.pn < 4) {
#pragma unroll
                    for (int bj = 0; bj < 2; ++bj) *(u32x4*)(rowp + u.pn * 256 + bj * 128 + wc * 32 + 8 * fq) = pack8(acc[ai][bj][m][0], acc[ai][bj][m][1]);
                } else {
                    *(u32x4*)(rowp + 1024 + (u.pn - 4) * 128 + wc * 32 + 8 * fq) = pack8(acc[ai][0][m][0] * acc[ai][1][m][0], acc[ai][0][m][1] * acc[ai][1][m][1]);
                } }
    }
};
struct EpiG1 {
    unsigned char* O; float sc;
    __device__ __forceinline__ void operator()(const f32x4 (&acc)[2][2][4][2], const pg8::Unit& u, int wr, int wc, int fr, int fq) const {
        const int row0 = u.orow0 + wr * 64 + fr, col0 = u.pn * 128 + wc * 32 + 8 * fq;
#pragma unroll
        for (int ai = 0; ai < 2; ++ai)
#pragma unroll
            for (int m = 0; m < 4; ++m) { unsigned char* rowp = O + (size_t)(row0 + ai * 128 + m * 16) * DEXP + col0;
                f32x4 a0 = acc[ai][0][m][0] * sc, a1 = acc[ai][0][m][1] * sc;
#pragma unroll
                for (int j = 0; j < 4; ++j) { a0[j] = fast_silu(a0[j]); a1[j] = fast_silu(a1[j]); }
                const f32x4 h0 = a0 * (acc[ai][1][m][0] * sc), h1v = a1 * (acc[ai][1][m][1] * sc);
                *(u32x2*)rowp = (u32x2){pk4_fp8(h0[0], h0[1], h0[2], h0[3]), pk4_fp8(h1v[0], h1v[1], h1v[2], h1v[3])}; }
    }
};
struct Frame {
    LAS unsigned char* lds;
    int tid, lane, wave, vcu, G;
    float* out; unsigned char* ws;
};
__device__ __forceinline__ const float* inptr(const Frame& F, int i) {
    const unsigned long long v = ((const LAS unsigned long long*)(F.lds + MISC_OFF + 256))[i];
    const unsigned lo = __builtin_amdgcn_readfirstlane((unsigned)v), hi = __builtin_amdgcn_readfirstlane((unsigned)(v >> 32));
    return (const float*)(((unsigned long long)hi << 32) | lo);
}
enum { I_X = 0, I_C, I_CTX, I_CCTX, I_WINE, I_WOUTE, I_SINK, I_WA2, I_BA, I_NORMW, I_WINO, I_CONVW, I_CONVB, I_WOUTO, I_ADAW, I_ADAB, I_LNW, I_LNB, I_WG, I_BG, I_WE, I_BE, I_W1, I_W3, I_W2 };
__device__ __forceinline__ int launder_v(int x) { asm volatile("" : "+v"(x)); return x; }
__device__ __forceinline__ int launder_s(int x) { asm volatile("" : "+s"(x)); return x; }
__device__ __forceinline__ Frame relaunder(const Frame& F0) { Frame F = F0; F.tid = launder_v(F0.tid); F.lane = F.tid & 63; F.wave = __builtin_amdgcn_readfirstlane(F.tid >> 6); F.vcu = launder_s(F0.vcu); return F; }
__device__ __forceinline__ const float* modp(const Frame& F, int l, int bi, int n) { return (const float*)(F.ws + WS_MOD) + ((size_t)(l * 17 + bi) * 6 + n) * D; }
__device__ __forceinline__ int row_bi(int row) { return row < NLAT ? (row >> 12) : 16; }

__device__ __forceinline__ void sincos_d(double a, float& c, float& s) {
    const double TWO_OVER_PI = 0.63661977236758134308, PIO2_HI = 1.57079632679489655800e+00, PIO2_LO = 6.12323399573676603587e-17;
    const double n = __builtin_rint(a * TWO_OVER_PI); double r = (a - n * PIO2_HI) - n * PIO2_LO; const double r2 = r * r;
    double sp = -1.0 / 1307674368000.0; sp = sp * r2 + 1.0 / 6227020800.0; sp = sp * r2 - 1.0 / 39916800.0; sp = sp * r2 + 1.0 / 362880.0; sp = sp * r2 - 1.0 / 5040.0; sp = sp * r2 + 1.0 / 120.0; sp = sp * r2 - 1.0 / 6.0; sp = sp * r2 + 1.0; sp *= r;
    double cp = 1.0 / 20922789888000.0; cp = cp * r2 - 1.0 / 87178291200.0; cp = cp * r2 + 1.0 / 479001600.0; cp = cp * r2 - 1.0 / 3628800.0; cp = cp * r2 + 1.0 / 40320.0; cp = cp * r2 - 1.0 / 720.0; cp = cp * r2 + 1.0 / 24.0; cp = cp * r2 - 0.5; cp = cp * r2 + 1.0;
    const int q = ((int)n) & 3;
    const double sv = (q == 0) ? sp : (q == 1) ? cp : (q == 2) ? -sp : -cp;
    const double cv = (q == 0) ? cp : (q == 1) ? -sp : (q == 2) ? -cp : sp;
    c = (float)cv; s = (float)sv;
}
__device__ __forceinline__ void ph_ada(const Frame& F0) {
    Frame F = relaunder(F0);
    LAS float* sl = (LAS float*)F.lds;
    LAS float* red = (LAS float*)(F.lds + 17 * 1024 * 4);
    for (int idx = F.tid; idx < 17 * 1024; idx += 512) { const int bi = idx >> 10, k = idx & 1023; const float c = bi < 16 ? inptr(F, I_C)[bi * 1024 + k] : inptr(F, I_CCTX)[k]; sl[idx] = c / (1.0f + expf(-c)); }
    __syncthreads();
    for (int it = F.vcu; it < 4 * 96; it += F.G) {
        const int l = it / 96, n0 = (it % 96) * 64;
        const float* W = inptr(F, I_ADAW) + (size_t)l * 1024 * 6144 + n0 + F.lane;
        float acc[17];
#pragma unroll
        for (int b = 0; b < 17; ++b) acc[b] = 0.f;
        const int kb = F.wave * 128;
        for (int k = kb; k < kb + 128; k += 4) {
            const float w0 = W[(size_t)k * 6144], w1 = W[(size_t)(k + 1) * 6144], w2 = W[(size_t)(k + 2) * 6144], w3 = W[(size_t)(k + 3) * 6144];
#pragma unroll
            for (int b = 0; b < 17; ++b) { const f32x4 s = *(const LAS f32x4*)(sl + b * 1024 + k); acc[b] += s[0] * w0 + s[1] * w1 + s[2] * w2 + s[3] * w3; }
        }
#pragma unroll
        for (int b = 0; b < 17; ++b) red[(F.wave * 17 + b) * 64 + F.lane] = acc[b];
        __syncthreads();
        for (int idx = F.tid; idx < 17 * 64; idx += 512) { const int b = idx >> 6, ln = idx & 63; float s = 0.f;
#pragma unroll
            for (int w = 0; w < 8; ++w) s += red[(w * 17 + b) * 64 + ln];
            ((float*)(F.ws + WS_MOD))[(size_t)(l * 17 + b) * 6144 + n0 + ln] = s + inptr(F, I_ADAB)[l * 6144 + n0 + ln]; }
        __syncthreads();
    }
    if (F.vcu == F.G - 1) {
        float* rope = (float*)(F.ws + WS_ROPE);
        for (int idx = F.tid; idx < 1024; idx += 512) { const int pos = idx >> 4, f = idx & 15;
            const double base4[4] = {1.0, 0.56234132519034908, 0.31622776601683794, 0.17782794100389228};
            double inv = (f & 3) == 0 ? base4[0] : (f & 3) == 1 ? base4[1] : (f & 3) == 2 ? base4[2] : base4[3];
            const int a = f >> 2; inv *= (a == 0) ? 1.0 : (a == 1) ? 0.1 : (a == 2) ? 0.01 : 0.001;
            float c, s; sincos_d((double)pos * inv, c, s); rope[idx] = c; rope[1024 + idx] = s; }
    }
}

__device__ __forceinline__ void tr_item(const float* W, int srcN, int K, bf16* WT, int drow0, int k0, int srccol, LAS float* scr, int lane) {
    float v[32];
    const float* p = W + (size_t)(k0 + (lane >> 5)) * srcN + (srccol >= 0 ? srccol : 0);
#pragma unroll
    for (int i = 0; i < 32; ++i) v[i] = p[(size_t)(2 * i) * srcN];
#pragma unroll
    for (int i = 0; i < 32; ++i) scr[(2 * i + (lane >> 5)) * 33 + (lane & 31)] = srccol >= 0 ? v[i] : 0.f;
    asm volatile("s_waitcnt lgkmcnt(0)" ::: "memory");
    const int c = lane & 7;
#pragma unroll
    for (int j = 0; j < 4; ++j) { const int n = (lane >> 3) + 8 * j; const LAS float* s = scr + (8 * c) * 33 + n;
        u32x4 o; o.x = pk2(s[0 * 33], s[1 * 33]); o.y = pk2(s[2 * 33], s[3 * 33]); o.z = pk2(s[4 * 33], s[5 * 33]); o.w = pk2(s[6 * 33], s[7 * 33]);
        *(u32x4*)(WT + (size_t)(drow0 + n) * K + k0 + 8 * c) = o; }
    asm volatile("s_waitcnt lgkmcnt(0)" ::: "memory");
}
__device__ __forceinline__ void tr_item8(const float* W, int srcN, int K, unsigned char* WT, int drow0, int k0, int srccol, float scale, LAS float* scr, int lane) {
    float v[32];
    const float* p = W + (size_t)(k0 + (lane >> 5)) * srcN + srccol;
#pragma unroll
    for (int i = 0; i < 32; ++i) v[i] = p[(size_t)(2 * i) * srcN];
#pragma unroll
    for (int i = 0; i < 32; ++i) scr[(2 * i + (lane >> 5)) * 33 + (lane & 31)] = v[i] * scale;
    asm volatile("s_waitcnt lgkmcnt(0)" ::: "memory");
    const int c = lane & 3;
#pragma unroll
    for (int j = 0; j < 2; ++j) { const int n = (lane >> 2) + 16 * j; const LAS float* s = scr + (16 * c) * 33 + n;
        u32x4 o; o.x = pk4_fp8(s[0 * 33], s[1 * 33], s[2 * 33], s[3 * 33]); o.y = pk4_fp8(s[4 * 33], s[5 * 33], s[6 * 33], s[7 * 33]);
        o.z = pk4_fp8(s[8 * 33], s[9 * 33], s[10 * 33], s[11 * 33]); o.w = pk4_fp8(s[12 * 33], s[13 * 33], s[14 * 33], s[15 * 33]);
        *(u32x4*)(WT + (size_t)(drow0 + n) * K + k0 + 16 * c) = o; }
    asm volatile("s_waitcnt lgkmcnt(0)" ::: "memory");
}
__device__ __forceinline__ int even_srccol(int j) {
    if (j < 640) { const int hb = j & ~63, p = j & 63, g = p >> 3, e = p & 7; return hb + (g >> 2) * 32 + (e >> 2) * 16 + (g & 3) * 4 + (e & 3); }
    return j < EVEN_IN ? j : -1;
}
__device__ __forceinline__ int odd_srccol(int j) { const int t = j >> 8, r = j & 255; if (t < 4) return j; return (r < 128 ? 1024 : 2048 - 128) + 128 * (t - 4) + r; }
__device__ __forceinline__ void conv_dense_weights(const Frame& F0) {
    Frame F = relaunder(F0);
    LAS float* scr = (LAS float*)(F.lds + F.wave * 16384);
    const int gw = F.vcu * 8 + F.wave, NGW = F.G * 8;
    constexpr int I_EI = 16 * 80, I_SQ = 16 * 32, I_OI = 16 * 96;
    constexpr int NIT = 2 * (I_EI + I_SQ + I_OI + I_SQ);
    for (int it = gw; it < NIT; it += NGW) {
        int r = it; const int i = r & 1; r >>= 1;
        if (r < I_EI) { const int kb = r / 80, nb = r % 80; tr_item(inptr(F, I_WINE) + (size_t)i * 1024 * EVEN_IN, EVEN_IN, 1024, (bf16*)(F.ws + WS_WINE) + (size_t)i * EN * 1024, nb * 32, kb * 64, even_srccol(nb * 32 + (F.lane & 31)), scr, F.lane); continue; } r -= I_EI;
        if (r < I_SQ) { const int kb = r / 32, nb = r % 32; tr_item(inptr(F, I_WOUTE) + (size_t)i * 1024 * 1024, 1024, 1024, (bf16*)(F.ws + WS_WOUTE) + (size_t)i * 1024 * 1024, nb * 32, kb * 64, nb * 32 + (F.lane & 31), scr, F.lane); continue; } r -= I_SQ;
        if (r < I_OI) { const int kb = r / 96, nb = r % 96; tr_item(inptr(F, I_WINO) + (size_t)i * 1024 * ON, ON, 1024, (bf16*)(F.ws + WS_WINO) + (size_t)i * ON * 1024, nb * 32, kb * 64, odd_srccol(nb * 32 + (F.lane & 31)), scr, F.lane); continue; } r -= I_OI;
        { const int kb = r / 32, nb = r % 32; tr_item(inptr(F, I_WOUTO) + (size_t)i * 1024 * 1024, 1024, 1024, (bf16*)(F.ws + WS_WOUTO) + (size_t)i * 1024 * 1024, nb * 32, kb * 64, nb * 32 + (F.lane & 31), scr, F.lane); }
    }
}
constexpr float W8_SCALE = 64.0f;
__device__ __forceinline__ void conv_moe_item(const Frame& F, int l, int it, LAS float* scr) {
    constexpr int I_13 = 16 * 32, I_2 = 8 * 32;
    const int e = it / (I_13 + I_2); int r = it % (I_13 + I_2);
    const size_t eoff = ((size_t)l * NEXP + e) * 1024 * 512;
    if (r < I_13) { const int kb = r / 32, nb = r % 32; const int j0 = nb * 32, t = j0 >> 8, rr = j0 & 255;
        const float* src = (rr < 128 ? inptr(F, I_W1) : inptr(F, I_W3)) + eoff;
        tr_item8(src, 512, 1024, (unsigned char*)(F.ws + WS_W13) + (size_t)e * 1024 * 1024, j0, kb * 64, 128 * t + (rr & 127) + (F.lane & 31), W8_SCALE, scr, F.lane);
    } else { r -= I_13; const int kb = r / 32, nb = r % 32;
        tr_item8(inptr(F, I_W2) + eoff, 1024, 512, (unsigned char*)(F.ws + WS_W2) + (size_t)e * 1024 * 512, nb * 32, kb * 64, nb * 32 + (F.lane & 31), W8_SCALE, scr, F.lane); }
}
__device__ __forceinline__ void conv_moe_weights(const Frame& F0, int l) {
    Frame F = relaunder(F0); const int gw = F.vcu * 8 + F.wave, NGW = F.G * 8;
    LAS float* scr = (LAS float*)(F.lds + F.wave * 16384);
    for (int it = gw; it < NEXP * (16 * 32 + 8 * 32); it += NGW) conv_moe_item(F, l, it, scr);
}
__device__ __forceinline__ void ph_u0(const Frame& F0) {
    Frame F = relaunder(F0);
    const int gw = F.vcu * 8 + F.wave, NGW = F.G * 8;
    for (int r0 = gw * 4; r0 < NTOK; r0 += NGW * 4) {
        const int bi = row_bi(r0); const float* sh = modp(F, 0, bi, 0); const float* sc = modp(F, 0, bi, 1);
        f32x4 x[4][4];
#pragma unroll
        for (int r = 0; r < 4; ++r) { const int row = r0 + r; const float* src = row < NLAT ? inptr(F, I_X) + (size_t)row * D : inptr(F, I_CTX) + (size_t)(row - NLAT) * D;
#pragma unroll
            for (int j = 0; j < 4; ++j) x[r][j] = *(const f32x4*)(src + 4 * F.lane + 256 * j); }
#pragma unroll
        for (int j = 0; j < 4; ++j) { const int c = 4 * F.lane + 256 * j; const f32x4 a = *(const f32x4*)(sh + c), s = *(const f32x4*)(sc + c);
#pragma unroll
            for (int r = 0; r < 4; ++r) { const f32x4 u = x[r][j] * (1.0f + s) + a; u32x2 w; w.x = pk2(u[0], u[1]); w.y = pk2(u[2], u[3]); *(u32x2*)((bf16*)(F.ws + WS_U) + (size_t)(r0 + r) * D + c) = w; } }
    }
}

struct RowLN { f32x4 v[4]; };
__device__ __forceinline__ void ln_stats(f32x4 (&z)[4], float& mean, float& rstd) {
    float s = 0.f;
#pragma unroll
    for (int j = 0; j < 4; ++j) s += (z[j][0] + z[j][1]) + (z[j][2] + z[j][3]);
    mean = wave_sum(s) * (1.0f / D); float q = 0.f;
#pragma unroll
    for (int j = 0; j < 4; ++j) { z[j] = z[j] - mean; q += (z[j][0] * z[j][0] + z[j][1] * z[j][1]) + (z[j][2] * z[j][2] + z[j][3] * z[j][3]); }
    rstd = 1.0f / sqrtf(wave_sum(q) * (1.0f / D) + LN_EPS);
}
__device__ __forceinline__ void ln_rows(f32x4 (&z)[4], const float* lw, const float* lb, int lane) {
    float s = 0.f;
#pragma unroll
    for (int j = 0; j < 4; ++j) s += (z[j][0] + z[j][1]) + (z[j][2] + z[j][3]);
    const float mean = wave_sum(s) * (1.0f / D); float q = 0.f;
#pragma unroll
    for (int j = 0; j < 4; ++j) { z[j] = z[j] - mean; q += (z[j][0] * z[j][0] + z[j][1] * z[j][1]) + (z[j][2] * z[j][2] + z[j][3] * z[j][3]); }
    const float rstd = 1.0f / sqrtf(wave_sum(q) * (1.0f / D) + LN_EPS);
#pragma unroll
    for (int j = 0; j < 4; ++j) { const int c = 4 * lane + 256 * j; z[j] = z[j] * rstd * *(const f32x4*)(lw + c) + *(const f32x4*)(lb + c); }
}
__device__ __forceinline__ void ph_ln1(const Frame& F0, int l, int nrows, bool dry = false) {
    Frame F = relaunder(F0);
    LAS unsigned char* Thi = F.lds; LAS unsigned char* Tlo = F.lds + 33024;
    LAS float* red = (LAS float*)(F.lds + 66048);
    LAS float* lgt = (LAS float*)(F.lds + 82432);
    LAS int* lcnt = (LAS int*)(F.lds + 87552); LAS int* lbase = lcnt + 32;
    LAS unsigned* list = (LAS unsigned*)(F.lds + 87808);
    LAS float* LW = (LAS float*)(F.lds + 97024); LAS float* LB = LW + 1024; LAS float* WG = LB + 1024;
    const int lane = F.lane, w = F.wave;
    if (F.tid < 64) lcnt[F.tid] = 0;
    { const float* lwg = inptr(F, I_LNW) + (size_t)(l * 2 + 0) * D; const float* lbg = inptr(F, I_LNB) + (size_t)(l * 2 + 0) * D; const float* wgg = inptr(F, I_WG) + (size_t)l * 1024 * 4;
      for (int i = F.tid; i < 256; i += 512) { *(LAS f32x4*)(LW + 4 * i) = *(const f32x4*)(lwg + 4 * i); *(LAS f32x4*)(LB + 4 * i) = *(const f32x4*)(lbg + 4 * i); }
      for (int i = F.tid; i < 1024; i += 512) *(LAS f32x4*)(WG + 4 * i) = *(const f32x4*)(wgg + 4 * i); }
    bf16x8 Whi[2][4], Wlo[2][4];
    {
        const int n = lane & 15, kg = lane >> 4;
        const float* we = inptr(F, I_WE) + (size_t)l * 1024 * 32 + (size_t)(w * 128 + kg * 8) * 32 + n;
#pragma unroll
        for (int nt = 0; nt < 2; ++nt)
#pragma unroll
            for (int ks = 0; ks < 4; ++ks) { u32x4 hi, lo; unsigned hh[8], ll[8];
                const float* p = we + ks * 32 * 32 + nt * 16;
                asm volatile("" : "+v"(p));
#pragma unroll
                for (int j = 0; j < 8; ++j) {
                    const float v = p[j * 32];
                    const unsigned h = pk2(v, 0.f) & 0xffffu; const float r = v - __uint_as_float(h << 16); hh[j] = h; ll[j] = pk2(r, 0.f) & 0xffffu; }
                hi.x = hh[0] | (hh[1] << 16); hi.y = hh[2] | (hh[3] << 16); hi.z = hh[4] | (hh[5] << 16); hi.w = hh[6] | (hh[7] << 16);
                lo.x = ll[0] | (ll[1] << 16); lo.y = ll[2] | (ll[3] << 16); lo.z = ll[4] | (ll[5] << 16); lo.w = ll[6] | (ll[7] << 16);
                Whi[nt][ks] = __builtin_bit_cast(bf16x8, hi); Wlo[nt][ks] = __builtin_bit_cast(bf16x8, lo); }
    }
    const bf16* Y = (const bf16*)(F.ws + WS_P);
    const float* hsl = (l == 0 ? inptr(F, I_X) : F.out); const float* hsc = (l == 0 ? inptr(F, I_CTX) : (const float*)(F.ws + WS_HCTX));
    const float* bgp = inptr(F, I_BG) + l * 4; const float* bep = inptr(F, I_BE) + l * 32;
    const bool usey = !((l & 1) ? (KO_MASK & 4) : ((KO_MASK & 3) == 3));
    const int nbatch = nrows / 16; int nlist = 0; int prev_rbase = -1;
#define LN1_ROUTE(buf_, rbase_, slot_) do { if (F.tid < 16) { const int tk = F.tid; const LAS float* lg = lgt + (buf_) * 640 + tk * 40; \
        float gl[4]; _Pragma("unroll") for (int j = 0; j < 4; ++j) gl[j] = lg[32 + j] + bgp[j]; \
        float gmax = gl[0]; int g = 0; _Pragma("unroll") for (int j = 1; j < 4; ++j) if (gl[j] > gmax) { gmax = gl[j]; g = j; } \
        float den = 0.f; _Pragma("unroll") for (int j = 0; j < 4; ++j) den += expf(gl[j] - gmax); \
        const float pg = 1.0f / den; float el[8]; _Pragma("unroll") for (int j = 0; j < 8; ++j) el[j] = lg[g * 8 + j] + bep[g * 8 + j]; \
        float m0 = el[0]; int i0 = 0; _Pragma("unroll") for (int j = 1; j < 8; ++j) if (el[j] > m0) { m0 = el[j]; i0 = j; } \
        float m1 = -3.0e38f; int i1 = 0; _Pragma("unroll") for (int j = 0; j < 8; ++j) if (j != i0 && el[j] > m1) { m1 = el[j]; i1 = j; } \
        const float ex = expf(m1 - m0); const float w0 = pg / (1.0f + ex), w1 = pg * ex / (1.0f + ex); \
        const int e0 = g * 8 + i0, e1 = g * 8 + i1; \
        const int p0 = atomicAdd((int*)&lcnt[e0], 1), p1 = atomicAdd((int*)&lcnt[e1], 1); \
        LAS unsigned* L = list + ((slot_) * 16 + tk) * 8; \
        L[0] = (unsigned)((rbase_) + tk); L[1] = (unsigned)e0; L[2] = (unsigned)p0; L[3] = __float_as_uint(w0); L[4] = (unsigned)e1; L[5] = (unsigned)p1; L[6] = __float_as_uint(w1); } } while (0)
    __syncthreads();
    for (int bt = F.vcu; bt < nbatch; bt += F.G) {
        const int rbase = bt * 16; const int bi = row_bi(rbase);
        const float* g2 = modp(F, l, bi, 2); const float* sh = modp(F, l, bi, 3); const float* sc = modp(F, l, bi, 4);
        {
            f32x4 hv[2][4], gv[4], scv[4], shv[4]; u32x2 yv[2][4];
#pragma unroll
            for (int rr = 0; rr < 2; ++rr) { const int row = rbase + 2 * w + rr; const float* hs = row < NLAT ? hsl + (size_t)row * D : hsc + (size_t)(row - NLAT) * D;
#pragma unroll
                for (int j = 0; j < 4; ++j) { const int c = 4 * lane + 256 * j; hv[rr][j] = *(const f32x4*)(hs + c); yv[rr][j] = usey ? *(const u32x2*)(Y + (size_t)row * D + c) : (u32x2){0u, 0u}; } }
#pragma unroll
            for (int j = 0; j < 4; ++j) { const int c = 4 * lane + 256 * j; gv[j] = *(const f32x4*)(g2 + c); scv[j] = *(const f32x4*)(sc + c); shv[j] = *(const f32x4*)(sh + c); }
            f32x4 z[2][4]; float mean[2], rstd[2];
#pragma unroll
            for (int rr = 0; rr < 2; ++rr)
#pragma unroll
                for (int j = 0; j < 4; ++j) z[rr][j] = DN_ALPHA * hv[rr][j] + gv[j] * (f32x4){bflo(yv[rr][j].x), bfhi(yv[rr][j].x), bflo(yv[rr][j].y), bfhi(yv[rr][j].y)};
#pragma unroll
            for (int rr = 0; rr < 2; ++rr) ln_stats(z[rr], mean[rr], rstd[rr]);
            f32x4 ga[2] = {(f32x4){0.f, 0.f, 0.f, 0.f}, (f32x4){0.f, 0.f, 0.f, 0.f}};
#pragma unroll
            for (int j = 0; j < 4; ++j) { const int c = 4 * lane + 256 * j;
                const f32x4 lwv = *(const LAS f32x4*)(LW + c), lbv = *(const LAS f32x4*)(LB + c);
                const f32x4 g0 = *(const LAS f32x4*)(WG + 4 * c), g1 = *(const LAS f32x4*)(WG + 4 * c + 4), g2v = *(const LAS f32x4*)(WG + 4 * c + 8), g3 = *(const LAS f32x4*)(WG + 4 * c + 12);
#pragma unroll
                for (int rr = 0; rr < 2; ++rr) { const int lr = 2 * w + rr, row = rbase + lr;
                    float* hd = dry ? (float*)(F.ws + WS_GATT) + (size_t)row * D : (row < NLAT ? F.out + (size_t)row * D : (float*)(F.ws + WS_HCTX) + (size_t)(row - NLAT) * D);
                    const f32x4 zn = z[rr][j] * rstd[rr] * lwv + lbv;
                    *(f32x4*)(hd + c) = zn;
                    const f32x4 t = zn * (1.0f + scv[j]) + shv[j];
                    ga[rr] += t[0] * g0 + t[1] * g1 + t[2] * g2v + t[3] * g3;
                    const unsigned h01 = pk2(t[0], t[1]), h23 = pk2(t[2], t[3]);
                    u32x2 hw; hw.x = h01; hw.y = h23;
                    *(unsigned*)((unsigned char*)(F.ws + (dry ? WS_Q : WS_U8)) + (size_t)row * D + c) = pk4_fp8(t[0], t[1], t[2], t[3]);
                    const float r0 = t[0] - bflo(h01), r1 = t[1] - bfhi(h01), r2 = t[2] - bflo(h23), r3 = t[3] - bfhi(h23);
                    u32x2 lw2; lw2.x = pk2(r0, r1); lw2.y = pk2(r2, r3);
                    *(LAS u32x2*)(Thi + lr * 2064 + c * 2) = hw; *(LAS u32x2*)(Tlo + lr * 2064 + c * 2) = lw2; } }
#pragma unroll
            for (int rr = 0; rr < 2; ++rr) { const float q0 = wave_sum(ga[rr][0]), q1 = wave_sum(ga[rr][1]), q2 = wave_sum(ga[rr][2]), q3 = wave_sum(ga[rr][3]);
                if (lane == 0) *(LAS f32x4*)(lgt + (nlist & 1) * 640 + (2 * w + rr) * 40 + 32) = (f32x4){q0, q1, q2, q3}; }
        }
        __syncthreads();
        if (prev_rbase >= 0) LN1_ROUTE((nlist - 1) & 1, prev_rbase, nlist - 1);
        {
            f32x4 acc[2];
#pragma unroll
            for (int nt = 0; nt < 2; ++nt) acc[nt] = (f32x4){0.f, 0.f, 0.f, 0.f};
            const int tk = lane & 15, kg = lane >> 4;
#pragma unroll
            for (int ks = 0; ks < 4; ++ks) {
                const bf16x8 ah = *(const LAS bf16x8*)(Thi + tk * 2064 + (w * 128 + ks * 32 + kg * 8) * 2), al = *(const LAS bf16x8*)(Tlo + tk * 2064 + (w * 128 + ks * 32 + kg * 8) * 2);
#pragma unroll
                for (int nt = 0; nt < 2; ++nt) { acc[nt] = __builtin_amdgcn_mfma_f32_16x16x32_bf16(Whi[nt][ks], ah, acc[nt], 0, 0, 0);
                    acc[nt] = __builtin_amdgcn_mfma_f32_16x16x32_bf16(Wlo[nt][ks], ah, acc[nt], 0, 0, 0); acc[nt] = __builtin_amdgcn_mfma_f32_16x16x32_bf16(Whi[nt][ks], al, acc[nt], 0, 0, 0); }
            }
#pragma unroll
            for (int nt = 0; nt < 2; ++nt) *(LAS f32x4*)(red + (w * 16 + tk) * 32 + nt * 16 + 4 * kg) = acc[nt];
        }
        __syncthreads();
        { const int tk = F.tid & 15, n = F.tid >> 4; float s = 0.f;
#pragma unroll
            for (int ww = 0; ww < 8; ++ww) s += red[(ww * 16 + tk) * 32 + n];
            lgt[(nlist & 1) * 640 + tk * 40 + n] = s; }
        prev_rbase = rbase; ++nlist;
    }
    __syncthreads();
    if (prev_rbase >= 0) LN1_ROUTE((nlist - 1) & 1, prev_rbase, nlist - 1);
#undef LN1_ROUTE
    __syncthreads();
    if (F.tid < 32) lbase[F.tid] = (int)atomicAdd((unsigned*)(F.ws + WS_CTL) + CW_CNT + l * 64 + (dry ? 32 : 0) + F.tid, (unsigned)lcnt[F.tid]);
    __syncthreads();
    if (!dry) for (int idx = F.tid; idx < nlist * 16; idx += 512) {
        const LAS unsigned* L = list + idx * 8; const unsigned row = L[0], e0 = L[1], e1 = L[4]; const unsigned p0 = L[2] + (unsigned)lbase[e0], p1 = L[5] + (unsigned)lbase[e1];
        u32x4 a; a.x = e0; a.y = p0; a.z = L[3]; a.w = e1; u32x4 b; b.x = p1; b.y = L[6]; b.z = 0u; b.w = 0u;
        unsigned* ti = (unsigned*)(F.ws + WS_TOKINFO) + (size_t)row * 8; *(u32x4*)ti = a; *(u32x4*)(ti + 4) = b;
        int* rt = (int*)(F.ws + WS_ROWTOK); rt[(size_t)e0 * NTOK + p0] = (int)row; rt[(size_t)e1 * NTOK + p1] = (int)row;
    }
}

__device__ __forceinline__ void ph_ln2(const Frame& F0, int l, int nrows, bool dry = false) {
    Frame F = relaunder(F0);
    MoeTab T = moe_tab(F.lds);
    const int gw = F.vcu * 8 + F.wave, NGW = F.G * 8, lane = F.lane;
    const float* lw = inptr(F, I_LNW) + (size_t)(l * 2 + 1) * D; const float* lb = inptr(F, I_LNB) + (size_t)(l * 2 + 1) * D;
    const bf16* O2 = (const bf16*)(F.ws + WS_P);
    for (int r0 = gw * 4; r0 < nrows; r0 += NGW * 4) {
        const int bi = row_bi(r0);
        const float* g5 = modp(F, l, bi, 5);
        f32x4 z[4][4]; u32x2 ya[4][4], yb[4][4]; float w0[4], w1[4];
#pragma unroll
        for (int r = 0; r < 4; ++r) { const int row = r0 + r;
            const unsigned* ti = (const unsigned*)(F.ws + WS_TOKINFO) + (size_t)row * 8;
            const u32x4 a = *(const u32x4*)ti; const u32x2 b = *(const u32x2*)(ti + 4);
            const size_t s0 = (size_t)T.ts[a.x] * 256 + a.y, s1 = (size_t)T.ts[a.w] * 256 + b.x; w0[r] = __uint_as_float(a.z); w1[r] = __uint_as_float(b.y);
            const float* hd = row < NLAT ? F.out + (size_t)row * D : (const float*)(F.ws + WS_HCTX) + (size_t)(row - NLAT) * D;
#pragma unroll
            for (int j = 0; j < 4; ++j) { const int c = 4 * lane + 256 * j; z[r][j] = *(const f32x4*)(hd + c);
                if (!(KO_MASK & 8)) { ya[r][j] = *(const u32x2*)(O2 + s0 * D + c); yb[r][j] = *(const u32x2*)(O2 + s1 * D + c); } } }
#pragma unroll
        for (int j = 0; j < 4; ++j) { const f32x4 g = *(const f32x4*)(g5 + 4 * lane + 256 * j);
#pragma unroll
            for (int r = 0; r < 4; ++r) { f32x4 y = (f32x4){0.f, 0.f, 0.f, 0.f};
                if (!(KO_MASK & 8)) y = w0[r] * (f32x4){bflo(ya[r][j].x), bfhi(ya[r][j].x), bflo(ya[r][j].y), bfhi(ya[r][j].y)} + w1[r] * (f32x4){bflo(yb[r][j].x), bfhi(yb[r][j].x), bflo(yb[r][j].y), bfhi(yb[r][j].y)};
                z[r][j] = DN_ALPHA * z[r][j] + g * y; } }
        float mean[4], rstd[4];
#pragma unroll
        for (int r = 0; r < 4; ++r) ln_stats(z[r], mean[r], rstd[r]);
        const bool lat = r0 < NLAT;
        const bool wu = (l < 3) && (lat || l < 2);
        const float* sh = modp(F, l < 3 ? l + 1 : l, bi, 0); const float* sc = modp(F, l < 3 ? l + 1 : l, bi, 1);
#pragma unroll
        for (int j = 0; j < 4; ++j) { const int c = 4 * lane + 256 * j;
            const f32x4 lwv = *(const f32x4*)(lw + c), lbv = *(const f32x4*)(lb + c), scv = *(const f32x4*)(sc + c), shv = *(const f32x4*)(sh + c);
#pragma unroll
            for (int r = 0; r < 4; ++r) { const int row = r0 + r;
                float* hd = dry ? (float*)(F.ws + WS_GATT) + (size_t)row * D : (lat ? F.out + (size_t)row * D : (float*)(F.ws + WS_HCTX) + (size_t)(row - NLAT) * D);
                const f32x4 zn = z[r][j] * rstd[r] * lwv + lbv; *(f32x4*)(hd + c) = zn;
                if (wu) { const f32x4 u = zn * (1.0f + scv) + shv; u32x2 hw; hw.x = pk2(u[0], u[1]); hw.y = pk2(u[2], u[3]); *(u32x2*)((bf16*)(F.ws + (dry ? WS_Q : WS_U)) + (size_t)row * D + c) = hw; } } }
    }
}

__device__ __forceinline__ f32x4 ubf_lo(const u32x4 v) { return (f32x4){bflo(v.x), bfhi(v.x), bflo(v.y), bfhi(v.y)}; }
__device__ __forceinline__ f32x4 ubf_hi(const u32x4 v) { return (f32x4){bflo(v.z), bfhi(v.z), bflo(v.w), bfhi(v.w)}; }
__device__ __forceinline__ void ph_conv(const Frame& F0, int i, int nrows) {
    Frame F = relaunder(F0);
    const int gw = F.vcu * 8 + F.wave, NGW = F.G * 8, lane = F.lane;
    const float* cw = inptr(F, I_CONVW) + (size_t)i * 3 * D; const float* cb = inptr(F, I_CONVB) + (size_t)i * D;
    const bf16* P = (const bf16*)(F.ws + WS_P); bf16* Q = (bf16*)(F.ws + WS_Q);
    for (int r0 = gw * 4; r0 < nrows; r0 += NGW * 4) {
        const int s0 = r0 < NLAT ? (r0 & (SEQ - 1)) : ((r0 - NLAT) & (CTXL - 1)); const int slen = r0 < NLAT ? SEQ : CTXL;
        const bool hp = s0 > 0, hn = s0 + 4 < slen;
#pragma unroll
        for (int j = 0; j < 2; ++j) { const int c = 8 * lane + 512 * j;
            u32x4 p[6], gb[4];
            p[0] = (u32x4){0u, 0u, 0u, 0u}; p[5] = (u32x4){0u, 0u, 0u, 0u};
            if (hp) p[0] = *(const u32x4*)(P + (size_t)(r0 - 1) * 2048 + 1024 + c);
            if (hn) p[5] = *(const u32x4*)(P + (size_t)(r0 + 4) * 2048 + 1024 + c);
#pragma unroll
            for (int r = 0; r < 4; ++r) { p[r + 1] = *(const u32x4*)(P + (size_t)(r0 + r) * 2048 + 1024 + c); gb[r] = *(const u32x4*)(P + (size_t)(r0 + r) * 2048 + c); }
            const f32x4 w0a = *(const f32x4*)(cw + c), w0b = *(const f32x4*)(cw + c + 4), w1a = *(const f32x4*)(cw + D + c), w1b = *(const f32x4*)(cw + D + c + 4), w2a = *(const f32x4*)(cw + 2 * D + c), w2b = *(const f32x4*)(cw + 2 * D + c + 4);
            const f32x4 ba = *(const f32x4*)(cb + c), bb = *(const f32x4*)(cb + c + 4);
#pragma unroll
            for (int r = 0; r < 4; ++r) {
                const f32x4 ya = ubf_lo(gb[r]) * (ubf_lo(p[r]) * w0a + ubf_lo(p[r + 1]) * w1a + ubf_lo(p[r + 2]) * w2a + ba);
                const f32x4 yb = ubf_hi(gb[r]) * (ubf_hi(p[r]) * w0b + ubf_hi(p[r + 1]) * w1b + ubf_hi(p[r + 2]) * w2b + bb);
                *(u32x4*)(Q + (size_t)(r0 + r) * D + c) = pack8(ya, yb); } }
    }
}
#define MFMA32(a, b, c) __builtin_amdgcn_mfma_f32_32x32x16_bf16((a), (b), (c), 0, 0, 0)
#define MFMA16(a, b, c) __builtin_amdgcn_mfma_f32_16x16x32_bf16((a), (b), (c), 0, 0, 0)
constexpr int AK_STR = 144, AV_STR = 136, AK_BUF = 64 * AK_STR, AV_BUF = 64 * AV_STR;
__device__ __forceinline__ int crow32(int reg, int hh) { return (reg & 3) + 8 * (reg >> 2) + 4 * hh; }
__device__ __forceinline__ float xhalf_max(float v) { const unsigned u = __float_as_uint(v); const auto r = __builtin_amdgcn_permlane32_swap(u, u, false, false); return fmaxf(__uint_as_float(r[0]), __uint_as_float(r[1])); }
__device__ __forceinline__ float xhalf_sum(float v) { const unsigned u = __float_as_uint(v); const auto r = __builtin_amdgcn_permlane32_swap(u, u, false, false); return __uint_as_float(r[0]) + __uint_as_float(r[1]); }
constexpr float ATT_THR = 8.0f;
__device__ __forceinline__ void attn_unit(const Frame& F, int ie, int b, int g, int qb, bool ctxq) {
    const bf16* P = (const bf16*)(F.ws + WS_P); bf16* Q = (bf16*)(F.ws + WS_Q);
    LAS unsigned char* Ks = F.lds; LAS unsigned char* Vt = F.lds + 2 * AK_BUF;
    const int w = F.wave, lane = F.lane, r = w >> 1, qh = w & 1, h = 4 * g + r, n = lane & 31, hh = lane >> 5;
    const int qpos0 = qb * 128 + qh * 64;
    const int qrow0 = ctxq ? NLAT + b * CTXL + qpos0 : b * SEQ + qpos0;
    if (KO_MASK & 1) {
#pragma unroll
        for (int nt = 0; nt < 2; ++nt)
#pragma unroll
            for (int c = 0; c < 4; ++c) *(u32x4*)(Q + (size_t)(qrow0 + 32 * nt + n) * D + h * 64 + 16 * c + 8 * hh) = (u32x4){0u, 0u, 0u, 0u};
        return;
    }
    bf16x8 qf[2][4];
#pragma unroll
    for (int nt = 0; nt < 2; ++nt)
#pragma unroll
        for (int c = 0; c < 4; ++c) qf[nt][c] = *(const bf16x8*)(P + (size_t)(qrow0 + 32 * nt + n) * EN + PC_Q + h * 64 + 16 * c + 8 * hh);
    const float sk = inptr(F, I_SINK)[ie * 8 + h] * LOG2E;
    float mrun[2] = {sk, sk}, lsum[2] = {1.f, 1.f};
    f32x16 O[2][2];
#pragma unroll
    for (int a = 0; a < 2; ++a)
#pragma unroll
        for (int c = 0; c < 2; ++c)
#pragma unroll
            for (int e = 0; e < 16; ++e) O[a][c][e] = 0.f;
    const int tw0 = ctxq ? 4 : ((qb == 0) ? 6 : 4), tw1 = ctxq ? 4 : ((qb == 31) ? 8 : 10);
    const int ntile = 4 + (tw1 - tw0);
    const int skey = F.tid >> 3, sch = F.tid & 7;
    u32x4 kreg, vreg;
#define TILE_OF(i) ((i) < 4 ? (i) : tw0 + ((i) - 4))
#define KROW_OF(t) ((t) < 4 ? NLAT + b * CTXL + 64 * (t) : b * SEQ + (qb - 1) * 128 + 64 * ((t) - 4))
    { const int kr = KROW_OF(0) + skey; kreg = *(const u32x4*)(P + (size_t)kr * EN + PC_K + g * 64 + sch * 8); vreg = *(const u32x4*)(P + (size_t)kr * EN + PC_V + g * 64 + sch * 8); }
    __syncthreads();
    {
        *(LAS u32x4*)(Ks + skey * AK_STR + sch * 16) = kreg;
        LAS unsigned short* vt = (LAS unsigned short*)(Vt + (sch * 8) * AV_STR + skey * 2);
        const unsigned vv[4] = {vreg.x, vreg.y, vreg.z, vreg.w};
#pragma unroll
        for (int e = 0; e < 4; ++e) { vt[(2 * e) * (AV_STR / 2)] = (unsigned short)(vv[e] & 0xffffu); vt[(2 * e + 1) * (AV_STR / 2)] = (unsigned short)(vv[e] >> 16); }
    }
    __syncthreads();
    const float c2 = 0.125f * LOG2E;
    for (int i = 0; i < ntile; ++i) {
        const int buf = i & 1, t = TILE_OF(i);
        if (i + 1 < ntile) { const int t1 = TILE_OF(i + 1); const int kr = KROW_OF(t1) + skey; kreg = *(const u32x4*)(P + (size_t)kr * EN + PC_K + g * 64 + sch * 8); vreg = *(const u32x4*)(P + (size_t)kr * EN + PC_V + g * 64 + sch * 8); }
        const LAS unsigned char* kb = Ks + buf * AK_BUF; const LAS unsigned char* vb = Vt + buf * AV_BUF;
        const bool msk = (t >= 4) && (t != 6) && (t != 7);
        const int kp0 = (qb - 1) * 128 + 64 * (t - 4);
        const bool skip = (qh == 0 && t == 9) || (qh == 1 && t == 4);
#pragma unroll 1
        for (int kt = 0; kt < 2; ++kt) {
            if (skip) break;
            f32x16 S[2];
#pragma unroll
            for (int c = 0; c < 2; ++c)
#pragma unroll
                for (int e = 0; e < 16; ++e) S[c][e] = 0.f;
#pragma unroll
            for (int c = 0; c < 4; ++c) { const bf16x8 kf = *(const LAS bf16x8*)(kb + (32 * kt + n) * AK_STR + (16 * c + 8 * hh) * 2);
#pragma unroll
                for (int nt = 0; nt < 2; ++nt) S[nt] = MFMA32(kf, qf[nt][c], S[nt]); }
#pragma unroll
            for (int nt = 0; nt < 2; ++nt) {
                if (msk) { const int qp = qpos0 + 32 * nt + n;
#pragma unroll
                    for (int e = 0; e < 16; ++e) { const int dd = qp - (kp0 + 32 * kt + crow32(e, hh)); if (dd > 128 || dd < -128) S[nt][e] = -INFINITY; } }
                float mx = fmaxf(fmaxf(S[nt][0], S[nt][1]), fmaxf(S[nt][2], S[nt][3]));
#pragma unroll
                for (int e = 4; e < 16; e += 4) mx = fmaxf(mx, fmaxf(fmaxf(S[nt][e], S[nt][e + 1]), fmaxf(S[nt][e + 2], S[nt][e + 3])));
                mx = xhalf_max(mx) * c2;
                if (__builtin_amdgcn_ballot_w64(mx > mrun[nt] + ATT_THR) != 0ull) {
                    const float mnew_ = fmaxf(mrun[nt], mx); const float alpha = __builtin_amdgcn_exp2f(mrun[nt] - mnew_); mrun[nt] = mnew_; lsum[nt] *= alpha;
#pragma unroll
                    for (int dt = 0; dt < 2; ++dt)
#pragma unroll
                        for (int e = 0; e < 16; ++e) O[dt][nt][e] *= alpha;
                }
                const float mu = mrun[nt];
                float rs = 0.f;
#pragma unroll
                for (int e = 0; e < 16; ++e) { const float p = __builtin_amdgcn_exp2f(__builtin_fmaf(S[nt][e], c2, -mu)); S[nt][e] = p; rs += p; }
                lsum[nt] += xhalf_sum(rs);
            }
#pragma unroll
            for (int s = 0; s < 2; ++s) {
                bf16x8 pf[2];
#pragma unroll
                for (int nt = 0; nt < 2; ++nt) { u32x4 pw; pw.x = pk2(S[nt][8 * s + 0], S[nt][8 * s + 1]); pw.y = pk2(S[nt][8 * s + 2], S[nt][8 * s + 3]); pw.z = pk2(S[nt][8 * s + 4], S[nt][8 * s + 5]); pw.w = pk2(S[nt][8 * s + 6], S[nt][8 * s + 7]); pf[nt] = __builtin_bit_cast(bf16x8, pw); }
#pragma unroll
                for (int dt = 0; dt < 2; ++dt) {
                    const LAS unsigned char* va = vb + (32 * dt + n) * AV_STR + (32 * kt + 16 * s + 4 * hh) * 2;
                    const s16x4 lo = *(const LAS s16x4*)va, hi = *(const LAS s16x4*)(va + 16);
                    const bf16x8 vf = __builtin_shufflevector(lo, hi, 0, 1, 2, 3, 4, 5, 6, 7);
#pragma unroll
                    for (int nt = 0; nt < 2; ++nt) O[dt][nt] = MFMA32(vf, pf[nt], O[dt][nt]);
                }
            }
        }
        if (i + 1 < ntile) {
            LAS unsigned char* kb2 = Ks + (buf ^ 1) * AK_BUF; LAS unsigned char* vb2 = Vt + (buf ^ 1) * AV_BUF;
            *(LAS u32x4*)(kb2 + skey * AK_STR + sch * 16) = kreg;
            LAS unsigned short* vt = (LAS unsigned short*)(vb2 + (sch * 8) * AV_STR + skey * 2);
            const unsigned vv[4] = {vreg.x, vreg.y, vreg.z, vreg.w};
#pragma unroll
            for (int e = 0; e < 4; ++e) { vt[(2 * e) * (AV_STR / 2)] = (unsigned short)(vv[e] & 0xffffu); vt[(2 * e + 1) * (AV_STR / 2)] = (unsigned short)(vv[e] >> 16); }
        }
        __syncthreads();
    }
#pragma unroll
    for (int nt = 0; nt < 2; ++nt) { const float inv = 1.0f / lsum[nt]; bf16* orow = Q + (size_t)(qrow0 + 32 * nt + n) * D + h * 64 + (hh ? 8 : 0);
#pragma unroll
        for (int dt = 0; dt < 2; ++dt)
#pragma unroll
            for (int rg = 0; rg < 4; rg += 2) {
                u32x2 a, bq; a.x = pk2(O[dt][nt][4 * rg] * inv, O[dt][nt][4 * rg + 1] * inv); a.y = pk2(O[dt][nt][4 * rg + 2] * inv, O[dt][nt][4 * rg + 3] * inv);
                bq.x = pk2(O[dt][nt][4 * rg + 4] * inv, O[dt][nt][4 * rg + 5] * inv); bq.y = pk2(O[dt][nt][4 * rg + 6] * inv, O[dt][nt][4 * rg + 7] * inv);
                { const auto r0 = __builtin_amdgcn_permlane32_swap(a.x, bq.x, false, false); a.x = r0[0]; bq.x = r0[1]; }
                { const auto r1 = __builtin_amdgcn_permlane32_swap(a.y, bq.y, false, false); a.y = r1[0]; bq.y = r1[1]; }
                *(u32x4*)(orow + 32 * dt + 8 * rg) = (u32x4){a.x, a.y, bq.x, bq.y}; } }
}

template <int d> __device__ __forceinline__ void glaA_unit(const Frame& F, int ie, int b, int c, int h) {
    const bf16* P = (const bf16*)(F.ws + WS_P);
    LAS unsigned char* QS = F.lds + F.wave * 16384; LAS unsigned char* KS = QS + 8192;
    const int lane = F.lane;
    const int row0 = c < 4 ? NLAT + b * CTXL + c * 64 : b * SEQ + (c - 4) * 64;
    const size_t U = (size_t)(b * NCHUNK + c) * 4 + h;
    bf16* gq = (bf16*)(F.ws + WS_GQIN); bf16* gk = (bf16*)(F.ws + WS_GKST); bf16* ga = (bf16*)(F.ws + WS_GATT);
    {
        const size_t UD = U * 2 + d;
        {
            u32x4 qr[8], kr[8];
#pragma unroll
            for (int it = 0; it < 8; ++it) { const int tok = it * 8 + (lane >> 3), ch = lane & 7; const size_t ro = (size_t)(row0 + tok) * EN + h * 64 + ch * 8; qr[it] = *(const u32x4*)(P + ro + PC_QG); kr[it] = *(const u32x4*)(P + ro + PC_KG); }
#pragma unroll
            for (int it = 0; it < 8; ++it) { const int tok = it * 8 + (lane >> 3), ch = lane & 7; const int so = tok * 128 + ((ch ^ (tok & 7)) << 4); *(LAS u32x4*)(QS + so) = qr[it]; *(LAS u32x4*)(KS + so) = kr[it]; }
        }
        const int ln = lane & 31, hh = lane >> 5;
        bf16x8 afr[2], bhi[2], blo[2]; float bav[2];
#pragma unroll
        for (int tt = 0; tt < 2; ++tt) afr[tt] = *(const bf16x8*)(P + (size_t)(row0 + 32 * tt + ln) * EN + PC_GG + 16 * d + 8 * hh);
#pragma unroll
        for (int dt = 0; dt < 2; ++dt) { const float* wp = inptr(F, I_WA2) + (size_t)((ie * 2 + d) * 16 + 8 * hh) * 256 + h * 64 + 32 * dt + ln;
            unsigned hh_[8], ll_[8];
#pragma unroll
            for (int j = 0; j < 8; ++j) { const float v = wp[(size_t)j * 256]; const unsigned hb = pk2(v, 0.f) & 0xffffu; hh_[j] = hb; ll_[j] = pk2(v - __uint_as_float(hb << 16), 0.f) & 0xffffu; }
            bhi[dt] = __builtin_bit_cast(bf16x8, (u32x4){hh_[0] | (hh_[1] << 16), hh_[2] | (hh_[3] << 16), hh_[4] | (hh_[5] << 16), hh_[6] | (hh_[7] << 16)});
            blo[dt] = __builtin_bit_cast(bf16x8, (u32x4){ll_[0] | (ll_[1] << 16), ll_[2] | (ll_[3] << 16), ll_[4] | (ll_[5] << 16), ll_[6] | (ll_[7] << 16)});
            bav[dt] = inptr(F, I_BA)[(ie * 2 + d) * 256 + h * 64 + 32 * dt + ln]; }
        f32x16 G[2][2];
#pragma unroll
        for (int tt = 0; tt < 2; ++tt)
#pragma unroll
            for (int dt = 0; dt < 2; ++dt) { f32x16 z16;
#pragma unroll
                for (int e = 0; e < 16; ++e) z16[e] = 0.f;
                z16 = MFMA32(afr[tt], bhi[dt], z16); G[tt][dt] = MFMA32(afr[tt], blo[dt], z16); }
        asm volatile("s_waitcnt lgkmcnt(0)" ::: "memory");
        float base[2] = {0.f, 0.f};
        int lofs[2][4];
#pragma unroll
        for (int dt = 0; dt < 2; ++dt)
#pragma unroll
            for (int e4 = 0; e4 < 4; ++e4) lofs[dt][e4] = (4 * hh + e4) * 128 + (((4 * dt + (ln >> 3)) ^ (4 * hh + e4)) << 4) + (ln & 7) * 2;
#pragma unroll
        for (int tq = 0; tq < 2; ++tq) { constexpr int dd = d; const int tt = dd ? 1 - tq : tq;
#pragma unroll
            for (int gq_ = 0; gq_ < 4; ++gq_) { const int g4 = dd ? 3 - gq_ : gq_;
                const int tokg = 32 * tt + 8 * g4;
#pragma unroll
                for (int dt = 0; dt < 2; ++dt) {
                    float la[4];
#pragma unroll
                    for (int e4 = 0; e4 < 4; ++e4) { const float g = G[tt][dt][4 * g4 + e4] + bav[dt];
                        la[e4] = (fminf(g, 0.f) * LOG2E - __builtin_amdgcn_logf(1.0f + __builtin_amdgcn_exp2f(-fabsf(g) * LOG2E))) * (1.0f / 16.0f); }
                    float cs[4];
                    if (dd == 0) { cs[0] = la[0]; cs[1] = cs[0] + la[1]; cs[2] = cs[1] + la[2]; cs[3] = cs[2] + la[3]; }
                    else { cs[3] = la[3]; cs[2] = cs[3] + la[2]; cs[1] = cs[2] + la[1]; cs[0] = cs[1] + la[0]; }
                    const float t4 = dd == 0 ? cs[3] : cs[0];
                    const float pt = __shfl_xor(t4, 32);
                    const float off = base[dt] + ((dd == 0 ? hh == 1 : hh == 0) ? pt : 0.f);
                    base[dt] += t4 + pt;
#pragma unroll
                    for (int e4 = 0; e4 < 4; ++e4) { const int so = tokg * 128 + lofs[dt][e4];
                        const float e1 = __builtin_amdgcn_exp2f(off + cs[e4]);
                        const float qi = bf2f(*(const LAS unsigned short*)(QS + so)) * 0.125f * e1, ki = bf2f(*(const LAS unsigned short*)(KS + so)) * __builtin_amdgcn_rcpf(e1);
                        const unsigned short q16 = (unsigned short)(pk2(qi, 0.f) & 0xffffu), k16 = (unsigned short)(pk2(ki, 0.f) & 0xffffu);
                        *(LAS unsigned short*)(QS + so) = q16; *(LAS unsigned short*)(KS + so) = k16; }
                }
            }
        }
        if (hh == 0) { ((float*)(F.ws + WS_GDEC))[UD * 64 + ln] = __builtin_amdgcn_exp2f(base[0]); ((float*)(F.ws + WS_GDEC))[UD * 64 + 32 + ln] = __builtin_amdgcn_exp2f(base[1]); }
        asm volatile("s_waitcnt lgkmcnt(0)" ::: "memory");
        {
            const int cc = lane & 7, dk0 = 32 * (cc >> 2) + 4 * (cc & 3);
#pragma unroll
            for (int it = 0; it < 8; ++it) { const int tok = it * 8 + (lane >> 3);
                const u32x2 lo = *(const LAS u32x2*)(QS + tok * 128 + ((((dk0 >> 3)) ^ (tok & 7)) << 4) + (dk0 & 7) * 2);
                const u32x2 hi = *(const LAS u32x2*)(QS + tok * 128 + ((((dk0 + 16) >> 3) ^ (tok & 7)) << 4) + (dk0 & 7) * 2);
                *(u32x4*)(gq + (UD * 64 + tok) * 64 + 8 * cc) = (u32x4){lo.x, lo.y, hi.x, hi.y};
                *(u32x4*)(gk + (UD * 64 + tok) * 64 + 8 * cc) = *(const LAS u32x4*)(KS + tok * 128 + ((cc ^ (tok & 7)) << 4)); }
        }
        {
            const int n = lane & 15, kg = lane >> 4;
#pragma unroll 1
            for (int I = 0; I < 4; ++I) {
                const int ti = 16 * I + n;
                bf16x8 qf[2];
#pragma unroll
                for (int ks2 = 0; ks2 < 2; ++ks2) qf[ks2] = *(const LAS bf16x8*)(QS + ti * 128 + (((4 * ks2 + kg) ^ (ti & 7)) << 4));
#pragma unroll
                for (int J = 0; J < 4; ++J) { f32x4 acc = (f32x4){0.f, 0.f, 0.f, 0.f};
                    const bool live = d == 0 ? (J <= I) : (J >= I);
                    if (live) {
                        const int tjr = 16 * J + n;
#pragma unroll
                        for (int ks2 = 0; ks2 < 2; ++ks2) { const bf16x8 kf = *(const LAS bf16x8*)(KS + tjr * 128 + (((4 * ks2 + kg) ^ (tjr & 7)) << 4)); acc = MFMA16(kf, qf[ks2], acc); }
#pragma unroll
                        for (int r = 0; r < 4; ++r) { const int tj = 16 * J + 4 * kg + r; const bool keep = d == 0 ? (tj <= ti) : (tj >= ti); if (!keep) acc[r] = 0.f; }
                    }
                    u32x2 ow; ow.x = pk2(acc[0], acc[1]); ow.y = pk2(acc[2], acc[3]);
                    *(u32x2*)(ga + (UD * 64 + ti) * 64 + 16 * J + 4 * kg) = ow; }
            }
        }
        asm volatile("s_waitcnt lgkmcnt(0)" ::: "memory");
    }
}

constexpr int GB_STG = 43008;
__device__ __forceinline__ int glaB_chunk(int d, int step) { return d == 0 ? step : (step < 4 ? 3 - step : 4 + (NCHUNK - 1 - step)); }
__device__ __forceinline__ int swz_k(int r) { return (r & 3) | (((r >> 3) & 1) << 2); }
__device__ __forceinline__ int swz_v(int r) { return ((r & 3) << 2) | ((r >> 2) & 3); }
template <int STAGE> __device__ __forceinline__ void glaB_issue(const Frame& F, int b, int h, int d, int step) {
    const int c = glaB_chunk(d, step);
    const size_t U = (size_t)(b * NCHUNK + c) * 4 + h, UD = U * 2 + d;
    const int row0 = c < 4 ? NLAT + b * CTXL + c * 64 : b * SEQ + (c - 4) * 64;
    const int tid = F.tid, row = tid >> 3, gch = (tid & 7) ^ (row & 7), gchk = (tid & 7) ^ swz_k(row);
    const int vr0 = tid >> 4, vr1 = vr0 + 32, vc0 = (tid & 15) ^ swz_v(vr0), vc1 = (tid & 15) ^ swz_v(vr1);
    LAS unsigned char* st = F.lds + STAGE * GB_STG + F.wave * 1024;
    const char* gq = (const char*)(F.ws + WS_GQIN) + UD * 8192 + row * 128 + gch * 16;
    const char* ga = (const char*)(F.ws + WS_GATT) + UD * 8192 + row * 128 + gch * 16;
    const char* gk = (const char*)(F.ws + WS_GKST) + UD * 8192 + row * 128 + gchk * 16;
    const char* gv = (const char*)(F.ws + WS_P) + (size_t)row0 * (EN * 2) + (PC_VG + h * 128) * 2;
    const char* gdc = (const char*)(F.ws + WS_GDEC) + UD * 256 + F.lane * 4;
    __builtin_amdgcn_global_load_lds((const unsigned*)gq, (LAS unsigned*)(st), 16, 0, 0);
    __builtin_amdgcn_global_load_lds((const unsigned*)ga, (LAS unsigned*)(st + 8192), 16, 0, 0);
    __builtin_amdgcn_global_load_lds((const unsigned*)gk, (LAS unsigned*)(st + 16384), 16, 0, 0);
    __builtin_amdgcn_global_load_lds((const unsigned*)(gv + (size_t)vr0 * (EN * 2) + vc0 * 16), (LAS unsigned*)(st + 24576), 16, 0, 0);
    __builtin_amdgcn_global_load_lds((const unsigned*)(gv + (size_t)vr1 * (EN * 2) + vc1 * 16), (LAS unsigned*)(st + 24576 + 8192), 16, 0, 0);
    __builtin_amdgcn_global_load_lds((const unsigned*)gdc, (LAS unsigned*)(F.lds + STAGE * GB_STG + 40960 + F.wave * 256), 4, 0, 0);
}
template <int ROWB, class SWZ> __device__ __forceinline__ bf16x8 gb_frag_tr(const LAS unsigned char* tile, int lane, int c, int ks, SWZ swz) {
    const int g = lane >> 4, q = (lane & 15) >> 2, p = lane & 3;
    const int r0 = 32 * ks + 8 * g + q, r1 = r0 + 4;
    const s16x4 lo = __builtin_amdgcn_ds_read_tr16_b64_v4i16((LAS s16x4*)(tile + ROWB * r0 + 16 * ((2 * c + (p >> 1)) ^ swz(r0)) + 8 * (p & 1)));
    const s16x4 hi = __builtin_amdgcn_ds_read_tr16_b64_v4i16((LAS s16x4*)(tile + ROWB * r1 + 16 * ((2 * c + (p >> 1)) ^ swz(r1)) + 8 * (p & 1)));
    return __builtin_shufflevector(lo, hi, 0, 1, 2, 3, 4, 5, 6, 7);
}
__device__ __forceinline__ bf16x8 gb_frag(const LAS unsigned char* tile, int row, int ch) { return *(const LAS bf16x8*)(tile + (row * 8 + (ch ^ (row & 7))) * 16); }
template <int STAGE> __device__ __forceinline__ void glaB_step(const Frame& F, int b, int h, int d, int step, f32x4 (&S)[4], bf16* od) {
    const int lane = F.lane, n = lane & 15, kg = lane >> 4, sl = F.wave;
    if (step == 0) asm volatile("s_waitcnt vmcnt(6)" ::: "memory"); else if (step == 1) asm volatile("s_waitcnt vmcnt(10)" ::: "memory"); else asm volatile("s_waitcnt vmcnt(14)" ::: "memory");
    __builtin_amdgcn_s_barrier();
    asm volatile("" ::: "memory");
    glaB_issue<(STAGE + 2) % 3>(F, b, h, d, step + 2 < NCHUNK ? step + 2 : NCHUNK - 1);
    asm volatile("" ::: "memory");
    const int c = glaB_chunk(d, step);
    const int row0 = c < 4 ? NLAT + b * CTXL + c * 64 : b * SEQ + (c - 4) * 64;
    const LAS unsigned char* st = F.lds + STAGE * GB_STG;
    bf16x8 vf[2], qf[4][2], af[4][2], kf[4][2]; f32x4 dc[4];
#pragma unroll
    for (int T = 0; T < 2; ++T) vf[T] = gb_frag_tr<256>(st + 24576, lane, sl, T, swz_v);
#pragma unroll
    for (int I = 0; I < 4; ++I)
#pragma unroll
        for (int T = 0; T < 2; ++T) { qf[I][T] = gb_frag(st, 16 * I + n, 4 * T + kg); af[I][T] = gb_frag(st + 8192, 16 * I + n, 4 * T + kg); }
#pragma unroll
    for (int I = 0; I < 4; ++I)
#pragma unroll
        for (int T = 0; T < 2; ++T) kf[I][T] = gb_frag_tr<128>(st + 16384, lane, I, T, swz_k);
#pragma unroll
    for (int q = 0; q < 4; ++q) dc[q] = *(const LAS f32x4*)(st + 40960 + sl * 256 + (16 * q + 4 * kg) * 4);
    bf16x8 sb[2];
#pragma unroll
    for (int G2 = 0; G2 < 2; ++G2) { u32x4 sw; sw.x = pk2(S[2 * G2][0], S[2 * G2][1]); sw.y = pk2(S[2 * G2][2], S[2 * G2][3]); sw.z = pk2(S[2 * G2 + 1][0], S[2 * G2 + 1][1]); sw.w = pk2(S[2 * G2 + 1][2], S[2 * G2 + 1][3]); sb[G2] = __builtin_bit_cast(bf16x8, sw); }
    asm volatile("s_waitcnt lgkmcnt(0)" ::: "memory");
    f32x4 o[4];
#pragma unroll
    for (int I = 0; I < 4; ++I) o[I] = (f32x4){0.f, 0.f, 0.f, 0.f};
#pragma unroll
    for (int I = 0; I < 4; ++I) o[I] = MFMA16(sb[0], qf[I][0], o[I]);
#pragma unroll
    for (int I = 0; I < 4; ++I) o[I] = MFMA16(sb[1], qf[I][1], o[I]);
#pragma unroll
    for (int q = 0; q < 4; ++q) S[q] = MFMA16(kf[q][0], vf[0], S[q]);
#pragma unroll
    for (int I = 0; I < 4; ++I) o[I] = MFMA16(vf[0], af[I][0], o[I]);
#pragma unroll
    for (int q = 0; q < 4; ++q) S[q] = MFMA16(kf[q][1], vf[1], S[q]);
#pragma unroll
    for (int I = 0; I < 4; ++I) o[I] = MFMA16(vf[1], af[I][1], o[I]);
#pragma unroll
    for (int q = 0; q < 4; ++q) S[q] = S[q] * dc[q];
    u32x2 ow[4];
#pragma unroll
    for (int I = 0; I < 4; ++I) { ow[I].x = pk2(o[I][0], o[I][1]); ow[I].y = pk2(o[I][2], o[I][3]); }
    asm volatile("s_waitcnt lgkmcnt(0)" ::: "memory");
#pragma unroll
    for (int I = 0; I < 4; ++I) *(u32x2*)(od + (size_t)(row0 + 16 * I + n) * 512 + h * 128 + 16 * sl + 4 * kg) = ow[I];
    asm volatile("" ::: "memory");
}
__device__ __forceinline__ void glaB_group(const Frame& F, int cg) {
    const int d = cg & 1, h = (cg >> 1) & 3, b = cg >> 3;
    bf16* od = (bf16*)(F.ws + WS_U) + (size_t)d * NTOK * 512;
    f32x4 S[4];
#pragma unroll
    for (int q = 0; q < 4; ++q) S[q] = (f32x4){0.f, 0.f, 0.f, 0.f};
    asm volatile("s_waitcnt vmcnt(0) lgkmcnt(0)" ::: "memory");
    __builtin_amdgcn_s_barrier();
    asm volatile("" ::: "memory");
    glaB_issue<0>(F, b, h, d, 0); glaB_issue<1>(F, b, h, d, 1);
    asm volatile("" ::: "memory");
    for (int s0 = 0; s0 + 2 < NCHUNK; s0 += 3) { glaB_step<0>(F, b, h, d, s0, S, od); glaB_step<1>(F, b, h, d, s0 + 1, S, od); glaB_step<2>(F, b, h, d, s0 + 2, S, od); }
    glaB_step<0>(F, b, h, d, 66, S, od); glaB_step<1>(F, b, h, d, 67, S, od);
    static_assert(NCHUNK == 68, "tail of the step loop");
    asm volatile("s_waitcnt vmcnt(0)" ::: "memory");
    __builtin_amdgcn_s_barrier();
}
__device__ __forceinline__ void conv_moe_dynamic(const Frame& F0, int l) {
    Frame F = relaunder(F0);
    LAS float* scr = (LAS float*)(F.lds + F.wave * 16384);
    unsigned* ctr = (unsigned*)(F.ws + WS_CTL) + CW_WQ + l * 64;
    constexpr int I_13 = 16 * 32, I_2 = 8 * 32, NIT = NEXP * (I_13 + I_2), CH = 8;
    for (;;) {
        unsigned t0 = 0; if (F.lane == 0) t0 = atomicAdd(ctr, (unsigned)CH);
        const int it0 = __builtin_amdgcn_readfirstlane((int)t0);
        if (it0 >= NIT) break;
        for (int it = it0; it < it0 + CH && it < NIT; ++it) conv_moe_item(F, l, it, scr);
    }
}

__device__ __forceinline__ void ph_combine(const Frame& F0, int ie, int nrows) {
    Frame F = relaunder(F0);
    const int gw = F.vcu * 8 + F.wave, NGW = F.G * 8, lane = F.lane;
    const bf16* P = (const bf16*)(F.ws + WS_P); bf16* Q = (bf16*)(F.ws + WS_Q);
    const bf16* o0 = (const bf16*)(F.ws + WS_U); const bf16* o1 = o0 + (size_t)NTOK * 512;
    const float* nw = inptr(F, I_NORMW) + (size_t)ie * 512;
    const int col = 8 * lane;
    const f32x4 nwa = *(const f32x4*)(nw + col), nwb = *(const f32x4*)(nw + col + 4);
    for (int r0 = gw * 4; r0 < nrows; r0 += NGW * 4) {
        if (KO_MASK & 2) {
#pragma unroll
            for (int r = 0; r < 4; ++r) *(u32x4*)(Q + (size_t)(r0 + r) * D + 512 + col) = (u32x4){0u, 0u, 0u, 0u};
            continue; }
        u32x4 a[4], bq[4], rr[4];
#pragma unroll
        for (int r = 0; r < 4; ++r) { const size_t row = r0 + r; a[r] = *(const u32x4*)(o0 + row * 512 + col); bq[r] = *(const u32x4*)(o1 + row * 512 + col); rr[r] = *(const u32x4*)(P + row * EN + PC_RG + col); }
#pragma unroll
        for (int r = 0; r < 4; ++r) {
            const f32x4 xa = ubf_lo(a[r]) + ubf_lo(bq[r]), xb = ubf_hi(a[r]) + ubf_hi(bq[r]);
            float ss = (xa[0] * xa[0] + xa[1] * xa[1]) + (xa[2] * xa[2] + xa[3] * xa[3]) + (xb[0] * xb[0] + xb[1] * xb[1]) + (xb[2] * xb[2] + xb[3] * xb[3]);
            ss = row16_sum(ss);
            const float rinv = 1.0f / sqrtf(ss * (1.0f / 128.0f) + RMS_EPS);
            f32x4 ra = ubf_lo(rr[r]), rb = ubf_hi(rr[r]);
#pragma unroll
            for (int j = 0; j < 4; ++j) { ra[j] = fast_silu(ra[j]); rb[j] = fast_silu(rb[j]); }
            *(u32x4*)(Q + (size_t)(r0 + r) * D + 512 + col) = pack8(xa * rinv * nwa * ra, xb * rinv * nwb * rb); }
    }
}

#if defined(FP8_PROBE)
typedef int i32x8 __attribute__((ext_vector_type(8)));
__device__ __forceinline__ unsigned fp8_of_int(int v) { const int a = v < 0 ? -v : v; const unsigned c = a == 0 ? 0x00u : a == 1 ? 0x38u : a == 2 ? 0x40u : 0x44u; return v < 0 ? (c | 0x80u) : c; }
__device__ __forceinline__ int fp8_kidx(int kg, int e) { return FP8_PROBE == 1 ? 32 * kg + e : (e < 16 ? 16 * kg + e : 64 + 16 * kg + (e - 16)); }
__device__ __forceinline__ bool fp8_layout_test(int lane) {
    const int r = lane & 15, kg = lane >> 4;
    i32x8 a, b;
#pragma unroll
    for (int w = 0; w < 8; ++w) { unsigned aw = 0, bw = 0;
#pragma unroll
        for (int by = 0; by < 4; ++by) { const int k = fp8_kidx(kg, 4 * w + by);
            const int av = (k == (7 * r + 3) % 128) ? 1 : 0; const int bv = ((k * 5 + r * 3) % 7) - 3;
            aw |= fp8_of_int(av) << (8 * by); bw |= fp8_of_int(bv) << (8 * by); }
        a[w] = (int)aw; b[w] = (int)bw; }
    f32x4 c = (f32x4){0.f, 0.f, 0.f, 0.f};
    c = __builtin_amdgcn_mfma_scale_f32_16x16x128_f8f6f4(a, b, c, 0, 0, 0, 0, 0, 0);
    bool bad = false;
#pragma unroll
    for (int q = 0; q < 4; ++q) { const int i = 4 * kg + q; const int kk = (7 * i + 3) % 128; const float ex = (float)(((kk * 5 + r * 3) % 7) - 3); if (c[q] != ex) bad = true; }
    return __builtin_amdgcn_ballot_w64(bad) != 0ull;
}
#endif
struct Args { const float* in[25]; float* out; unsigned char* ws; int ph_lo, ph_hi; };
constexpr int NPHASE = 2 + 9 * DEPTH;

__global__ void __launch_bounds__(512, 2) fwd(Args args) {
    extern __shared__ __attribute__((aligned(16))) unsigned char lds_raw[];
    Frame F;
    F.lds = (LAS unsigned char*)lds_raw;
    F.tid = threadIdx.x; F.lane = F.tid & 63; F.wave = __builtin_amdgcn_readfirstlane(F.tid >> 6);
    F.G = gridDim.x; { const int bx = blockIdx.x; F.vcu = (F.G % 8 == 0) ? (bx % 8) * (F.G / 8) + bx / 8 : bx; }
    F.out = args.out; F.ws = args.ws;
    volatile LAS unsigned* MISC = (volatile LAS unsigned*)(F.lds + MISC_OFF);
    if (F.tid < 64) MISC[F.tid] = 0u;
    if (F.tid < 25) ((LAS unsigned long long*)(F.lds + MISC_OFF + 256))[F.tid] = (unsigned long long)args.in[F.tid];
    __syncthreads();
    const int lo = args.ph_lo, hi = args.ph_hi;
    const bool multi = (hi - lo) > 1;
    XcdBarrier bar; bar.bar = (unsigned*)(F.ws + WS_CTL) + CW_BAR; bar.x = 0; bar.st = MISC + 8;
    if (multi) bar = xcd_barrier_post((unsigned*)(F.ws + WS_CTL) + CW_BAR, MISC + 8);
#ifndef PH_SEL
#define PH_SEL 0xffffffff
#endif
#define IN(k) (lo <= (k) && (k) < hi)
#define SEL(b) ((PH_SEL >> (b)) & 1)
#ifndef DUP_MASK
#define DUP_MASK 0
#endif
#define REP(bit) for (int rep_ = 0; rep_ < ((DUP_MASK & (bit)) ? 2 : 1); ++rep_)
#define SEAM(k) do { if ((k) + 1 < hi) xcd_barrier(bar); } while (0)

    if (SEL(0) && IN(0)) { REP(64) { ph_ada(F); __syncthreads(); conv_dense_weights(F); __syncthreads(); } SEAM(0); }
    if (SEL(1) && IN(1)) { REP(64) { ph_u0(F); __syncthreads(); } SEAM(1); }

    for (int l = 0; l < DEPTH; ++l) {
        const int pb = 2 + 9 * l; const bool even = (l & 1) == 0; const int ie = l >> 1;
        const int m_in = (l < 3) ? NTOK : NLAT;
        const int m_out = (l < 2) ? NTOK : NLAT;
        if (SEL(2) && IN(pb + 0)) {
            REP(32) { if (even) {
                LinSched S; S.init(m_in, EN, 1024, F.G, (int)blockIdx.x);
                EpiEvenIn E{(bf16*)(F.ws + WS_P), (const float*)(F.ws + WS_ROPE)};
                pg8::gemm_phase(F.lds, (const char*)(F.ws + WS_U), (const char*)(F.ws + WS_WINE) + (size_t)ie * EN * 1024 * 2, 1024, S, E);
            } else {
                LinSched S; S.init(m_in, ON, 1024, F.G, (int)blockIdx.x);
                EpiOddIn E{(bf16*)(F.ws + WS_P)};
                pg8::gemm_phase(F.lds, (const char*)(F.ws + WS_U), (const char*)(F.ws + WS_WINO) + (size_t)ie * ON * 1024 * 2, 1024, S, E);
            } }
            SEAM(pb + 0);
        }
        if (SEL(3) && IN(pb + 1)) {
            if (even) {
                const Frame Fm = relaunder(F);
                const int nun = NB * 2 * 32 + (l == 0 ? NB * 2 * 2 : 0);
                REP(1) for (int u = Fm.vcu; u < nun; u += Fm.G) {
                    if (u < NB * 2 * 32) attn_unit(Fm, ie, u >> 6, (u >> 5) & 1, u & 31, false);
                    else { const int v = u - NB * 2 * 32; attn_unit(Fm, ie, v >> 2, (v >> 1) & 1, v & 1, true); }
                }
                __syncthreads();
                if (!(KO_MASK & 2)) REP(2) for (int u = Fm.vcu * 8 + Fm.wave; u < NB * NCHUNK * 8; u += Fm.G * 8) { if (u & 1) glaA_unit<1>(Fm, ie, u / (NCHUNK * 8), (u / 8) % NCHUNK, (u >> 1) & 3); else glaA_unit<0>(Fm, ie, u / (NCHUNK * 8), (u / 8) % NCHUNK, (u >> 1) & 3); }
                __syncthreads();
            } else {
                REP(16) { ph_conv(F, ie, m_out); __syncthreads(); }
            }
            if (!even) REP(8) { conv_moe_weights(F, l); __syncthreads(); }
            SEAM(pb + 1);
        }
        if (even) {
            if (SEL(4) && IN(pb + 2)) {
                { const Frame Fm = relaunder(F);
                  if (!(KO_MASK & 2)) REP(4) for (int cg = Fm.vcu; cg < 128; cg += Fm.G) glaB_group(Fm, cg);
                  __syncthreads();
                  conv_moe_dynamic(Fm, l); }
                SEAM(pb + 2);
            }
            if (SEL(5) && IN(pb + 3)) { REP(16) { ph_combine(F, ie, m_out); __syncthreads(); } SEAM(pb + 3); }
        }
        if (SEL(6) && IN(pb + 4)) {
            REP(32) { LinSched S; S.init(m_out, 1024, 1024, F.G, (int)blockIdx.x);
            EpiPlain E{(bf16*)(F.ws + WS_P), 1024};
            pg8::gemm_phase(F.lds, (const char*)(F.ws + WS_Q), (const char*)(F.ws + (even ? WS_WOUTE : WS_WOUTO)) + (size_t)ie * 1024 * 1024 * 2, 1024, S, E); }
            SEAM(pb + 4);
        }
        if (SEL(7) && IN(pb + 5)) { if (DUP_MASK & 128) { ph_ln1(F, l, m_out, true); __syncthreads(); } ph_ln1(F, l, m_out); SEAM(pb + 5); }
        if (SEL(8) && IN(pb + 6)) {
            if (!(KO_MASK & 8)) REP(32) {
                moe_tables(F.lds, (const unsigned*)(F.ws + WS_CTL) + CW_CNT + l * 64);
                MoeSched<1> S; S.T = moe_tab(F.lds); S.rowtok = (const int*)(F.ws + WS_ROWTOK); S.G = F.G; S.c = F.vcu; S.bstride = (size_t)256 * 1024; S.estride = (size_t)1024 * 1024;
                EpiG1 E{(unsigned char*)(F.ws + WS_Q), 1.0f / W8_SCALE};
                pg8::gemm_phase<EpiG1, MoeSched<1>, 1>(F.lds, (const char*)(F.ws + WS_U8), (const char*)(F.ws + WS_W13), 1024, S, E);
            }
            SEAM(pb + 6);
        }
        if (SEL(9) && IN(pb + 7)) {
            if (!(KO_MASK & 8)) REP(32) {
                moe_tables(F.lds, (const unsigned*)(F.ws + WS_CTL) + CW_CNT + l * 64);
                MoeSched<0> S; S.T = moe_tab(F.lds); S.rowtok = nullptr; S.G = F.G; S.c = F.vcu; S.bstride = (size_t)256 * 512; S.estride = (size_t)1024 * 512;
                EpiPlainS E{(bf16*)(F.ws + WS_P), 1024, 1.0f / W8_SCALE};
                pg8::gemm_phase<EpiPlainS, MoeSched<0>, 1>(F.lds, (const char*)(F.ws + WS_Q), (const char*)(F.ws + WS_W2), 512, S, E);
            }
            SEAM(pb + 7);
        }
        if (SEL(10) && IN(pb + 8)) {
            moe_tables(F.lds, (const unsigned*)(F.ws + WS_CTL) + CW_CNT + l * 64);
            if (DUP_MASK & 256) { ph_ln2(F, l, m_out, true); __syncthreads(); }
            ph_ln2(F, l, m_out);
            SEAM(pb + 8);
        }
    }
#if defined(FP8_PROBE)
    if (blockIdx.x == 0) { __syncthreads(); if (F.tid < 64) { const bool bad = fp8_layout_test(F.tid); if (bad && F.tid == 0) F.out[0] = __builtin_nanf(""); } }
#endif
#undef IN
#undef SEAM
}

extern "C" void kernel_launch(void* const* d_in, const int* in_sizes, int n_in, void* d_out, int out_size, void* d_ws, size_t ws_size, hipStream_t stream) {
    static int grid = 0;
    if (grid == 0) {
        if (n_in != 25 || in_sizes[0] != NLAT * D || out_size != NLAT * D || ws_size < WS_END) { fprintf(stderr, "kernel_launch: unexpected shapes (n_in %d in0 %d out %d ws %zu)\n", n_in, n_in > 0 ? in_sizes[0] : -1, out_size, ws_size); grid = -1; return; }
        int dev = 0, cus = 0, per_cu = 0;
        if (hipGetDevice(&dev) != hipSuccess || hipDeviceGetAttribute(&cus, hipDeviceAttributeMultiprocessorCount, dev) != hipSuccess) { grid = -1; return; }
        if (hipFuncSetAttribute((const void*)fwd, hipFuncAttributeMaxDynamicSharedMemorySize, LDS_BYTES) != hipSuccess) { fprintf(stderr, "kernel_launch: hipFuncSetAttribute failed\n"); grid = -1; return; }
        if (hipOccupancyMaxActiveBlocksPerMultiprocessor(&per_cu, (const void*)fwd, 512, LDS_BYTES) != hipSuccess || per_cu < 1) fprintf(stderr, "kernel_launch: occupancy query says %d\n", per_cu);
        (void)hipGetLastError();
        grid = cus;
        if (grid < 242 || grid > 1024) { fprintf(stderr, "kernel_launch: built for a 256-CU device (got %d CUs)\n", cus); grid = -1; return; }
    }
    if (grid < 0) return;
    if (hipMemsetAsync((char*)d_ws + WS_CTL, 0, CTL_BYTES, stream) != hipSuccess) return;
    Args a{};
    for (int i = 0; i < 25; ++i) a.in[i] = (const float*)d_in[i];
    a.out = (float*)d_out; a.ws = (unsigned char*)d_ws;
#if N_LAUNCH_MODE == 1
    a.ph_lo = 0; a.ph_hi = NPHASE;
    hipLaunchKernelGGL(fwd, dim3(grid), dim3(512), LDS_BYTES, stream, a);
#else
    for (int k = 0; k < NPHASE; ++k) {
        if (k >= 2) { const int l = (k - 2) / 9, s = (k - 2) % 9; if ((l & 1) && (s == 2 || s == 3)) continue; }
        a.ph_lo = k; a.ph_hi = k + 1;
        hipLaunchKernelGGL(fwd, dim3(grid), dim3(512), LDS_BYTES, stream, a);
    }
#endif
}
```

```cpp
#include <hip/hip_runtime.h>
#define N_LAUNCH_MODE 1
#define KO_MASK 0
#define DUP_MASK 0
#include <cstdio>
#include <cstdint>

#ifndef KO_MASK
#define KO_MASK 0
#endif
#ifndef N_LAUNCH_MODE
#define N_LAUNCH_MODE 1
#endif

#define GAS __attribute__((address_space(1)))
#define LAS __attribute__((address_space(3)))
typedef unsigned short bf16;
typedef short bf16x8 __attribute__((ext_vector_type(8)));
typedef short s16x4 __attribute__((ext_vector_type(4)));
typedef float f32x2 __attribute__((ext_vector_type(2)));
typedef float f32x4 __attribute__((ext_vector_type(4)));
typedef float f32x16 __attribute__((ext_vector_type(16)));
typedef unsigned u32x2 __attribute__((ext_vector_type(2)));
typedef unsigned u32x4 __attribute__((ext_vector_type(4)));
typedef __bf16 bf16x2_t __attribute__((ext_vector_type(2)));
typedef int i32x8 __attribute__((ext_vector_type(8)));
typedef int i32x4_t __attribute__((ext_vector_type(4)));

constexpr int D = 1024, NB = 16, SEQ = 4096, CTXL = 256, DEPTH = 4;
constexpr int NLAT = NB * SEQ, NCTX = NB * CTXL, NTOK = NLAT + NCTX;
constexpr int EVEN_IN = 2336, EN = 2560, ON = 3072;
constexpr int NEXP = 32, DEXP = 512;
constexpr int SLOT_ROWS = 2 * NTOK + NEXP * 256;
constexpr float DN_ALPHA = 1.6817928305074290f;
constexpr float LN_EPS = 1e-5f, RMS_EPS = 1e-6f;
constexpr float LOG2E = 1.4426950408889634f;
constexpr int PC_Q = 0, PC_K = 512, PC_V = 640, PC_QG = 768, PC_KG = 1024, PC_VG = 1280, PC_RG = 1792, PC_GG = 2304;
constexpr int NCHUNK = 68;

constexpr size_t MiB = 1u << 20;
constexpr size_t WS_CTL = 0, CTL_BYTES = 1 * MiB;
constexpr size_t WS_MOD = 1 * MiB;
constexpr size_t WS_ROPE = 3 * MiB;
constexpr size_t WS_TOKINFO = 4 * MiB;
constexpr size_t WS_ROWTOK = 7 * MiB;
constexpr size_t WS_WINE = 16 * MiB, WS_WOUTE = 26 * MiB, WS_WINO = 30 * MiB, WS_WOUTO = 42 * MiB;
constexpr size_t WS_W13 = 46 * MiB, WS_W2 = 110 * MiB;
constexpr size_t WS_HCTX = 142 * MiB;
constexpr size_t WS_U = 158 * MiB;
constexpr size_t WS_P = 294 * MiB;
constexpr size_t WS_Q = 634 * MiB;
constexpr size_t WS_GATT = 778 * MiB, WS_GQIN = 846 * MiB, WS_GKST = 914 * MiB, WS_GVT = 982 * MiB, WS_GDEC = 1050 * MiB;
constexpr size_t WS_U8 = 1053 * MiB;
constexpr size_t WS_END = 1121 * MiB;
constexpr int CW_BAR = 4096;
constexpr int CW_CNT = 16384;
constexpr int CW_WQ = 20480;

constexpr int RING_BYTES = 131072;
constexpr int LDSX_OFF = RING_BYTES;
constexpr int MISC_OFF = LDSX_OFF + 8192;
constexpr int LDS_BYTES = 147456;

__device__ __forceinline__ unsigned pk2(float a, float b) { bf16x2_t r = __builtin_convertvector((f32x2){a, b}, bf16x2_t); return __builtin_bit_cast(unsigned, r); }
__device__ __forceinline__ unsigned pk4_fp8(float a, float b, float c, float d) { int r = __builtin_amdgcn_cvt_pk_fp8_f32(a, b, 0, false); r = __builtin_amdgcn_cvt_pk_fp8_f32(c, d, r, true); return (unsigned)r; }
__device__ __forceinline__ float bf2f(unsigned short h) { return __uint_as_float(((unsigned)h) << 16); }
__device__ __forceinline__ float bflo(unsigned w) { return __uint_as_float(w << 16); }
__device__ __forceinline__ float bfhi(unsigned w) { return __uint_as_float(w & 0xffff0000u); }
template <int CTRL> __device__ __forceinline__ float dppf(float v) { return __builtin_bit_cast(float, __builtin_amdgcn_update_dpp(0, __builtin_bit_cast(int, v), CTRL, 0xf, 0xf, false)); }
__device__ __forceinline__ float row16_sum(float v) { v += dppf<0xB1>(v); v += dppf<0x4E>(v); v += dppf<0x141>(v); v += dppf<0x140>(v); return v; }
__device__ __forceinline__ float wave_sum(float v) {
    v = row16_sum(v);
    const float s0 = __builtin_bit_cast(float, __builtin_amdgcn_readlane(__builtin_bit_cast(int, v), 0)), s1 = __builtin_bit_cast(float, __builtin_amdgcn_readlane(__builtin_bit_cast(int, v), 16));
    const float s2 = __builtin_bit_cast(float, __builtin_amdgcn_readlane(__builtin_bit_cast(int, v), 32)), s3 = __builtin_bit_cast(float, __builtin_amdgcn_readlane(__builtin_bit_cast(int, v), 48));
    return (s0 + s1) + (s2 + s3);
}
__device__ __forceinline__ float fast_silu(float x) { return x * __builtin_amdgcn_rcpf(1.0f + __builtin_amdgcn_exp2f(-x * LOG2E)); }

#define XB_TMO      128
#define XB_XCNT(j)  (256  + 64 * (j))
#define XB_XSUB(j)  (1280 + 64 * (j))
#define XB_XGEN(j)  (2304 + 64 * (j))
#define XB_TOP      3328
#define XB_TOPGEN   3392
#define XCD_BAR_WORDS 3456
#define XB_SPIN_CAP (1u << 22)
__device__ __forceinline__ unsigned xb_ld(unsigned* p)              { return __hip_atomic_load(p, __ATOMIC_RELAXED, __HIP_MEMORY_SCOPE_AGENT); }
__device__ __forceinline__ unsigned xb_add(unsigned* p, unsigned v) { return __hip_atomic_fetch_add(p, v, __ATOMIC_RELAXED, __HIP_MEMORY_SCOPE_AGENT); }
__device__ __forceinline__ unsigned xb_xcc_id() { return (unsigned)__builtin_amdgcn_s_getreg((3 << 11) | 20) & 0xFu; }
#define XB_SPIN(cond, bar) do { unsigned _sp = 0; while (cond) { __builtin_amdgcn_s_sleep(1); \
    if ((++_sp & 255u) == 0u) { if (xb_ld(&(bar)[XB_TMO])) break; if (_sp > XB_SPIN_CAP) { atomicAdd(&(bar)[XB_TMO], 1u); break; } } } } while (0)
struct XcdBarrier { unsigned* bar; unsigned x; volatile LAS unsigned* st; };
__device__ __forceinline__ XcdBarrier xcd_barrier_post(unsigned* bar, volatile LAS unsigned* st) {
    XcdBarrier b; b.bar = bar; b.x = xb_xcc_id(); b.st = st;
    if (threadIdx.x == 0) (void)xb_add(&bar[XB_XCNT(b.x)], 1u);
    return b;
}
__device__ __forceinline__ void xcd_barrier_complete(unsigned* bar, unsigned x, unsigned& nloc, unsigned& nx) {
    const unsigned G = gridDim.x * gridDim.y * gridDim.z;
    unsigned sum, cnt, mine, sp = 0u;
    for (;;) {
        sum = 0u; cnt = 0u; mine = 0u;
#pragma unroll
        for (unsigned j = 0; j < 16; ++j) { const unsigned c = xb_ld(&bar[XB_XCNT(j)]); sum += c; cnt += (c > 0u) ? 1u : 0u; mine = (j == x) ? c : mine; }
        if (sum == G) break;
        __builtin_amdgcn_s_sleep(1);
        if ((++sp & 255u) == 0u) { if (xb_ld(&bar[XB_TMO])) break; if (sp > XB_SPIN_CAP) { atomicAdd(&bar[XB_TMO], 1u); break; } }
    }
    nloc = mine > 0u ? mine : 1u; nx = cnt > 0u ? cnt : 1u;
}
__device__ __forceinline__ void xcd_barrier(const XcdBarrier& b) {
    asm volatile("s_waitcnt vmcnt(0)" ::: "memory");
    __syncthreads();
    if (threadIdx.x == 0) {
        unsigned* bar = b.bar;
        __builtin_amdgcn_s_waitcnt(0);
        unsigned nloc = b.st[0], nx = b.st[1];
        if (nloc == 0u) { xcd_barrier_complete(bar, b.x, nloc, nx); b.st[0] = nloc; b.st[1] = nx; }
        const unsigned old = xb_add(&bar[XB_XSUB(b.x)], 1u);
        const unsigned gen = old / nloc;
        if (old + 1u == (gen + 1u) * nloc) {
            __builtin_amdgcn_fence(__ATOMIC_RELEASE, "agent");
            asm volatile("s_waitcnt vmcnt(0)" ::: "memory");
            const unsigned og = xb_add(&bar[XB_TOP], 1u);
            const unsigned tg = og / nx;
            if (og + 1u == (tg + 1u) * nx) xb_add(&bar[XB_TOPGEN], 1u);
            else XB_SPIN(xb_ld(&bar[XB_TOPGEN]) == tg, bar);
            __builtin_amdgcn_fence(__ATOMIC_ACQUIRE, "agent");
            xb_add(&bar[XB_XGEN(b.x)], 1u);
            asm volatile("s_waitcnt vmcnt(0)" ::: "memory");
        } else {
            XB_SPIN(xb_ld(&bar[XB_XGEN(b.x)]) == gen, bar);
            __builtin_amdgcn_fence(__ATOMIC_ACQUIRE, "agent");
            asm volatile("s_waitcnt vmcnt(0)" ::: "memory");
        }
    }
    __syncthreads();
}

namespace pg8 {
constexpr int BM = 256, BK = 64, HALF = 128, HTB = HALF * BK * 2, STAGE_BYTES = 8 * HTB;
__device__ __forceinline__ int lds_byte(int r, int c) { const int st = (r >> 4) * 2 + (c >> 5), rr = r & 15, cc = c & 31, ob = rr * 64 + cc * 2; return st * 1024 + (ob ^ (((ob >> 9) & 1) << 5)); }
__device__ __forceinline__ void stage_rc(int b, int& R, int& C) { const int st = b / 1024, sb = b % 1024, swz = sb ^ (((sb >> 9) & 1) << 5); R = (st >> 1) * 16 + swz / 64; C = (st & 1) * 32 + (swz % 64) / 2; }
__device__ __forceinline__ int perm32(int rho) { const int n = rho >> 4, i = rho & 15; return 8 * (i >> 2) + 4 * n + (i & 3); }

struct Unit { int pn; int orow0; int mt; int e; };

template <class Epi, class Sched, int FP8 = 0>
__device__ __forceinline__ void gemm_phase(LAS unsigned char* lds, const char* Abase, const char* Bbase, const int K, const Sched& S, const Epi& E) {
    int tid_ = threadIdx.x; asm volatile("" : "+v"(tid_));
    const int tid = tid_, wid = __builtin_amdgcn_readfirstlane(tid >> 6), lane = tid & 63, wr = wid >> 2, wc = wid & 3, fr = lane & 15, fq = lane >> 4;
    const unsigned K2 = FP8 ? (unsigned)K : (unsigned)K * 2u;
    const int nt = (int)(K2 / 128u);
    int Rr[2], Cc[2]; unsigned voffB[2];
#pragma unroll
    for (int i = 0; i < 2; ++i) { stage_rc(tid * 16 + i * 8192, Rr[i], Cc[i]); const int Rb = (Rr[i] & ~31) + perm32(Rr[i] & 31); voffB[i] = (unsigned)Rb * K2 + (unsigned)Cc[i] * 2u; }
    const size_t kstep = (size_t)(BK * 2);
    const size_t hstep = (size_t)HALF * K2;
    const unsigned ldsw = (unsigned)wid * 1024u;
    const int aoff = FP8 ? lds_byte(wr * 64 + fr, 32 * (fq >> 1) + 16 * (fq & 1)) : lds_byte(wr * 64 + fr, fq * 8), boff = FP8 ? lds_byte(wc * 32 + fr, 32 * (fq >> 1) + 16 * (fq & 1)) : lds_byte(wc * 32 + fr, fq * 8);
#define PG8_SA(b, h) (((b) * 2 + (h)) * HTB)
#define PG8_SB(b, h) ((4 + (b) * 2 + (h)) * HTB)
#define PG8_STAGE(bufoff, gbase, voff) do { _Pragma("unroll") for (int _i = 0; _i < 2; ++_i) \
        __builtin_amdgcn_global_load_lds((const unsigned*)((const char*)(gbase) + (voff)[_i]), (LAS unsigned*)(lds + (bufoff) + ldsw + _i * 8192), 16, 0, 0); } while (0)
#define PG8_LD8(ptr) __builtin_shufflevector(*(const LAS i32x4_t*)(ptr), *(const LAS i32x4_t*)((ptr) + 16), 0, 1, 2, 3, 4, 5, 6, 7)
#define PG8_LDA(dst, b, h) do { if constexpr (FP8) { _Pragma("unroll") for (int m = 0; m < 4; ++m) dst##8[m] = PG8_LD8(lds + PG8_SA(b, h) + aoff + m * 2048); } \
        else { _Pragma("unroll") for (int m = 0; m < 4; ++m) _Pragma("unroll") for (int k = 0; k < 2; ++k) dst[m][k] = *(const LAS bf16x8*)(lds + PG8_SA(b, h) + aoff + m * 2048 + k * 1024); } } while (0)
#define PG8_LDB(dst, b, h) do { if constexpr (FP8) { _Pragma("unroll") for (int n = 0; n < 2; ++n) dst##8[n] = PG8_LD8(lds + PG8_SB(b, h) + boff + n * 2048); } \
        else { _Pragma("unroll") for (int n = 0; n < 2; ++n) _Pragma("unroll") for (int k = 0; k < 2; ++k) dst[n][k] = *(const LAS bf16x8*)(lds + PG8_SB(b, h) + boff + n * 2048 + k * 1024); } } while (0)
#define PG8_MMA(ai, bj, At, Bt) do { __builtin_amdgcn_s_setprio(1); _Pragma("unroll") for (int m = 0; m < 4; ++m) _Pragma("unroll") for (int n = 0; n < 2; ++n) { \
        if constexpr (FP8) asm volatile("v_mfma_f32_16x16x128_f8f6f4 %0, %1, %2, %0" : "+v"(acc[ai][bj][m][n]) : "v"(Bt##8[n]), "v"(At##8[m])); \
        else { _Pragma("unroll") for (int k = 0; k < 2; ++k) acc[ai][bj][m][n] = __builtin_amdgcn_mfma_f32_16x16x32_bf16(Bt[n][k], At[m][k], acc[ai][bj][m][n], 0, 0, 0); } } \
        __builtin_amdgcn_s_setprio(0); } while (0)
#define PG8_WAIT_V(n) asm volatile("s_waitcnt vmcnt(" #n ")" ::: "memory")
#define PG8_WAIT_L(n) asm volatile("s_waitcnt lgkmcnt(" #n ")" ::: "memory")
#define PG8_BAR __builtin_amdgcn_s_barrier()
#define PG8_SCHED __builtin_amdgcn_sched_barrier(0)
    Unit cur, nxt; int ui = 0;
    if (!S.next(0, cur)) return;
    f32x4 acc[2][2][4][2];
#pragma unroll
    for (int a = 0; a < 2; ++a)
#pragma unroll
        for (int b = 0; b < 2; ++b)
#pragma unroll
            for (int m = 0; m < 4; ++m)
#pragma unroll
                for (int n = 0; n < 2; ++n) { if constexpr (FP8) asm volatile("v_mov_b32 %0, 0\n\tv_mov_b32 %1, 0\n\tv_mov_b32 %2, 0\n\tv_mov_b32 %3, 0" : "=v"(acc[a][b][m][n][0]), "=v"(acc[a][b][m][n][1]), "=v"(acc[a][b][m][n][2]), "=v"(acc[a][b][m][n][3])); else acc[a][b][m][n] = (f32x4){0.f, 0.f, 0.f, 0.f}; }
    if constexpr (FP8) asm volatile("s_nop 7" ::: "memory");
    bf16x8 At[4][2], B0[2][2], B1[2][2];
    i32x8 At8[4], B08[2], B18[2];
    unsigned vAc0[2], vAc1[2], vAn0[2], vAn1[2];
#pragma unroll
    for (int i = 0; i < 2; ++i) { vAc0[i] = (unsigned)S.arow(cur, Rr[i]) * K2 + (unsigned)Cc[i] * 2u; vAc1[i] = (unsigned)S.arow(cur, HALF + Rr[i]) * K2 + (unsigned)Cc[i] * 2u; vAn0[i] = vAc0[i]; vAn1[i] = vAc1[i]; }
    const char* cB = Bbase + S.boff(cur);
    PG8_STAGE(PG8_SB(0, 0), cB, voffB); PG8_STAGE(PG8_SB(0, 1), cB + hstep, voffB); PG8_STAGE(PG8_SA(0, 0), Abase, vAc0); PG8_STAGE(PG8_SA(0, 1), Abase, vAc1);
    if (wr == 1) PG8_BAR;
    PG8_WAIT_V(2); PG8_BAR;
    PG8_STAGE(PG8_SB(1, 0), cB + kstep, voffB); PG8_STAGE(PG8_SA(1, 0), Abase + kstep, vAc0); PG8_STAGE(PG8_SB(1, 1), cB + hstep + kstep, voffB);
    PG8_WAIT_V(6); PG8_BAR;
    for (;;) {
        const bool has_next = S.next(ui + 1, nxt);
        const char* nB = has_next ? Bbase + S.boff(nxt) : cB;
        if (has_next) {
#pragma unroll
            for (int i = 0; i < 2; ++i) { vAn0[i] = (unsigned)S.arow(nxt, Rr[i]) * K2 + (unsigned)Cc[i] * 2u; vAn1[i] = (unsigned)S.arow(nxt, HALF + Rr[i]) * K2 + (unsigned)Cc[i] * 2u; }
        } else {
#pragma unroll
            for (int i = 0; i < 2; ++i) { vAn0[i] = vAc0[i]; vAn1[i] = vAc1[i]; }
        }
        for (int t = 0; t < nt; t += 2) {
            const bool last = (t == nt - 2);
            const char* a1 = Abase + (size_t)(t + 1) * kstep;
            const char* a2 = last ? Abase : Abase + (size_t)(t + 2) * kstep; const char* b2 = last ? nB : cB + (size_t)(t + 2) * kstep;
            const char* a3 = a2 + kstep; const char* b3 = b2 + kstep;
            unsigned v20[2], v21[2];
#pragma unroll
            for (int i = 0; i < 2; ++i) { v20[i] = last ? vAn0[i] : vAc0[i]; v21[i] = last ? vAn1[i] : vAc1[i]; }
            PG8_LDB(B0, 0, 0); PG8_LDB(B1, 0, 1); PG8_SCHED; PG8_LDA(At, 0, 0); PG8_STAGE(PG8_SA(1, 1), a1, vAc1);
            PG8_WAIT_V(8); PG8_WAIT_L(0); PG8_BAR; PG8_MMA(0, 0, At, B0); PG8_MMA(0, 1, At, B1); PG8_BAR; PG8_SCHED;
            PG8_LDA(At, 0, 1); PG8_STAGE(PG8_SB(0, 0), b2, voffB); PG8_STAGE(PG8_SB(0, 1), b2 + hstep, voffB); PG8_STAGE(PG8_SA(0, 0), a2, v20);
            PG8_WAIT_V(8); PG8_WAIT_L(0); PG8_BAR; PG8_MMA(1, 0, At, B0); PG8_MMA(1, 1, At, B1); PG8_BAR; PG8_SCHED;
            PG8_LDB(B0, 1, 0); PG8_LDB(B1, 1, 1); PG8_SCHED; PG8_LDA(At, 1, 0); PG8_STAGE(PG8_SA(0, 1), a2, v21);
            PG8_WAIT_V(8); PG8_WAIT_L(0); PG8_BAR; PG8_MMA(0, 0, At, B0); PG8_MMA(0, 1, At, B1); PG8_BAR; PG8_SCHED;
            PG8_LDA(At, 1, 1); PG8_STAGE(PG8_SB(1, 0), b3, voffB); PG8_STAGE(PG8_SB(1, 1), b3 + hstep, voffB); PG8_STAGE(PG8_SA(1, 0), a3, v20);
            PG8_WAIT_V(8); PG8_WAIT_L(0); PG8_BAR; PG8_MMA(1, 0, At, B0); PG8_MMA(1, 1, At, B1); PG8_BAR; PG8_SCHED;
        }
        if (wr == 0) PG8_BAR;
        if constexpr (FP8) asm volatile("s_nop 15\n\ts_nop 15" ::: "memory");
        E(acc, cur, wr, wc, fr, fq);
        if (!has_next) break;
#pragma unroll
        for (int a = 0; a < 2; ++a)
#pragma unroll
            for (int b = 0; b < 2; ++b)
#pragma unroll
                for (int m = 0; m < 4; ++m)
#pragma unroll
                    for (int n = 0; n < 2; ++n) { if constexpr (FP8) asm volatile("v_mov_b32 %0, 0\n\tv_mov_b32 %1, 0\n\tv_mov_b32 %2, 0\n\tv_mov_b32 %3, 0" : "=v"(acc[a][b][m][n][0]), "=v"(acc[a][b][m][n][1]), "=v"(acc[a][b][m][n][2]), "=v"(acc[a][b][m][n][3])); else acc[a][b][m][n] = (f32x4){0.f, 0.f, 0.f, 0.f}; }
        if constexpr (FP8) asm volatile("s_nop 7" ::: "memory");
        cur = nxt; cB = nB; ++ui;
#pragma unroll
        for (int i = 0; i < 2; ++i) { vAc0[i] = vAn0[i]; vAc1[i] = vAn1[i]; }
        if (wr == 1) PG8_BAR;
    }
    PG8_WAIT_V(0);
    PG8_BAR;
#undef PG8_SA
#undef PG8_SB
#undef PG8_STAGE
#undef PG8_LDA
#undef PG8_LDB
#undef PG8_MMA
#undef PG8_WAIT_V
#undef PG8_WAIT_L
#undef PG8_BAR
#undef PG8_SCHED
}
}
struct LinSched {
    int nM, nN, nwg, G, c; size_t bstride;
    __device__ __forceinline__ void init(int M, int N, int K, int G_, int c_) { nM = M / 256; nN = N / 256; nwg = nM * nN; G = G_; c = c_; bstride = (size_t)256 * K * 2; }
    __device__ __forceinline__ bool next(int i, pg8::Unit& u) const {
        const long L = (long)i * G + c; if (L >= nwg) return false;
        int wgid = (int)L; { const int q = nwg / 8, r = nwg % 8, xcd = wgid % 8, off = wgid / 8; wgid = (xcd < r ? xcd * (q + 1) : r * (q + 1) + (xcd - r) * q) + off; }
        const int nig = 8 * nN, gid = wgid / nig, fm = gid * 8, gsz = (nM - fm) < 8 ? (nM - fm) : 8;
        u.mt = fm + ((wgid % nig) % gsz); u.pn = (wgid % nig) / gsz; u.orow0 = u.mt * 256; u.e = 0; return true;
    }
    __device__ __forceinline__ int arow(const pg8::Unit& u, int lr) const { return u.orow0 + lr; }
    __device__ __forceinline__ size_t boff(const pg8::Unit& u) const { return (size_t)u.pn * bstride; }
};
struct MoeTab { LAS int* ts; LAS int* cnt; LAS unsigned char* tile_e; };
__device__ __forceinline__ MoeTab moe_tab(LAS unsigned char* lds) { MoeTab t; t.ts = (LAS int*)(lds + LDSX_OFF); t.cnt = (LAS int*)(lds + LDSX_OFF + 256); t.tile_e = (LAS unsigned char*)(lds + LDSX_OFF + 512); return t; }
__device__ __forceinline__ void moe_tables(LAS unsigned char* lds, const unsigned* gcnt) {
    MoeTab T = moe_tab(lds);
    __syncthreads();
    if (threadIdx.x == 0) { int s = 0; for (int e = 0; e < NEXP; ++e) { const int c = (int)gcnt[e]; T.cnt[e] = c; T.ts[e] = s; s += (c + 255) >> 8; } T.ts[NEXP] = s; }
    __syncthreads();
    const int nt = T.ts[NEXP];
    for (int mt = threadIdx.x; mt < nt; mt += blockDim.x) { int e = 0; for (int j = 1; j < NEXP; ++j) e += (mt >= T.ts[j]) ? 1 : 0; T.tile_e[mt] = (unsigned char)e; }
    __syncthreads();
}
template <int GATHER> struct MoeSched {
    MoeTab T; const int* rowtok; int G, c; size_t bstride; size_t estride;
    __device__ __forceinline__ bool next(int i, pg8::Unit& u) const {
        const int L = i * G + c; const int nt = T.ts[NEXP]; if (L >= nt * 4) return false;
        u.mt = L >> 2; u.pn = L & 3; u.orow0 = u.mt * 256; u.e = (int)T.tile_e[u.mt]; return true;
    }
    __device__ __forceinline__ int arow(const pg8::Unit& u, int lr) const {
        if (GATHER) { const int idx = (u.mt - T.ts[u.e]) * 256 + lr; return idx < T.cnt[u.e] ? rowtok[(size_t)u.e * NTOK + idx] : 0; }
        return u.orow0 + lr;
    }
    __device__ __forceinline__ size_t boff(const pg8::Unit& u) const { return (size_t)u.e * estride + (size_t)u.pn * bstride; }
};

__device__ __forceinline__ u32x4 pack8(const f32x4 a, const f32x4 b) { u32x4 w; w.x = pk2(a[0], a[1]); w.y = pk2(a[2], a[3]); w.z = pk2(b[0], b[1]); w.w = pk2(b[2], b[3]); return w; }
struct EpiPlain {
    bf16* O; int ldc;
    __device__ __forceinline__ void operator()(const f32x4 (&acc)[2][2][4][2], const pg8::Unit& u, int wr, int wc, int fr, int fq) const {
        const int row0 = u.orow0 + wr * 64 + fr, col0 = u.pn * 256 + wc * 32 + 8 * fq;
#pragma unroll
        for (int ai = 0; ai < 2; ++ai)
#pragma unroll
            for (int m = 0; m < 4; ++m) { bf16* rowp = O + (size_t)(row0 + ai * 128 + m * 16) * ldc + col0;
#pragma unroll
                for (int bj = 0; bj < 2; ++bj) *(u32x4*)(rowp + bj * 128) = pack8(acc[ai][bj][m][0], acc[ai][bj][m][1]); }
    }
};
struct EpiPlainS {
    bf16* O; int ldc; float sc;
    __device__ __forceinline__ void operator()(const f32x4 (&acc)[2][2][4][2], const pg8::Unit& u, int wr, int wc, int fr, int fq) const {
        const int row0 = u.orow0 + wr * 64 + fr, col0 = u.pn * 256 + wc * 32 + 8 * fq;
#pragma unroll
        for (int ai = 0; ai < 2; ++ai)
#pragma unroll
            for (int m = 0; m < 4; ++m) { bf16* rowp = O + (size_t)(row0 + ai * 128 + m * 16) * ldc + col0;
#pragma unroll
                for (int bj = 0; bj < 2; ++bj) *(u32x4*)(rowp + bj * 128) = pack8(acc[ai][bj][m][0] * sc, acc[ai][bj][m][1] * sc); }
    }
};
struct EpiEvenIn {
    bf16* O; const float* rope;
    __device__ __forceinline__ void operator()(const f32x4 (&acc)[2][2][4][2], const pg8::Unit& u, int wr, int wc, int fr, int fq) const {
        const int row0 = u.orow0 + wr * 64 + fr, col0 = u.pn * 256 + wc * 32 + 8 * fq;
        const bool lat = u.orow0 < NLAT;
#pragma unroll
        for (int ai = 0; ai < 2; ++ai)
#pragma unroll
            for (int m = 0; m < 4; ++m) { const int row = row0 + ai * 128 + m * 16; bf16* rowp = O + (size_t)row * EN + col0;
                const int s = row & (SEQ - 1); const int pos = (wc & 1) ? (s & 63) : (s >> 6);
#pragma unroll
                for (int bj = 0; bj < 2; ++bj) { f32x4 v0 = acc[ai][bj][m][0], v1 = acc[ai][bj][m][1];
                    const bool rp = lat && (u.pn < 2 || (u.pn == 2 && bj == 0));
                    if (rp) { const f32x4 c = *(const f32x4*)(rope + pos * 16 + 4 * fq), sn = *(const f32x4*)(rope + 1024 + pos * 16 + 4 * fq);
                        const f32x4 o1 = v0 * c - v1 * sn, o2 = v1 * c + v0 * sn; v0 = o1; v1 = o2; }
                    *(u32x4*)(rowp + bj * 128) = pack8(v0, v1); } }
    }
};
struct EpiOddIn {
    bf16* O;
    __device__ __forceinline__ void operator()(const f32x4 (&acc)[2][2][4][2], const pg8::Unit& u, int wr, int wc, int fr, int fq) const {
        const int row0 = u.orow0 + wr * 64 + fr;
#pragma unroll
        for (int ai = 0; ai < 2; ++ai)
#pragma unroll
            for (int m = 0; m < 4; ++m) { bf16* rowp = O + (size_t)(row0 + ai * 128 + m * 16) * 2048;
                if (u.pn < 4) {
#pragma unroll
                    for (int bj = 0; bj < 2; ++bj) *(u32x4*)(rowp + u.pn * 256 + bj * 128 + wc * 32 + 8 * fq) = pack8(acc[ai][bj][m][0], acc[ai][bj][m][1]);
                } else {
                    *(u32x4*)(rowp + 1024 + (u.pn - 4) * 128 + wc * 32 + 8 * fq) = pack8(acc[ai][0][m][0] * acc[ai][1][m][0], acc[ai][0][m][1] * acc[ai][1][m][1]);
                } }
    }
};
struct EpiG1 {
    unsigned char* O; float sc;
    __device__ __forceinline__ void operator()(const f32x4 (&acc)[2][2][4][2], const pg8::Unit& u, int wr, int wc, int fr, int fq) const {
        const int row0 = u.orow0 + wr * 64 + fr, col0 = u.pn * 128 + wc * 32 + 8 * fq;
#pragma unroll
        for (int ai = 0; ai < 2; ++ai)
#pragma unroll
            for (int m = 0; m < 4; ++m) { unsigned char* rowp = O + (size_t)(row0 + ai * 128 + m * 16) * DEXP + col0;
                f32x4 a0 = acc[ai][0][m][0] * sc, a1 = acc[ai][0][m][1] * sc;
#pragma unroll
                for (int j = 0; j < 4; ++j) { a0[j] = fast_silu(a0[j]); a1[j] = fast_silu(a1[j]); }
                const f32x4 h0 = a0 * (acc[ai][1][m][0] * sc), h1v = a1 * (acc[ai][1][m][1] * sc);
                *(u32x2*)rowp = (u32x2){pk4_fp8(h0[0], h0[1], h0[2], h0[3]), pk4_fp8(h1v[0], h1v[1], h1v[2], h1v[3])}; }
    }
};
struct Frame {
    LAS unsigned char* lds;
    int tid, lane, wave, vcu, G;
    float* out; unsigned char* ws;
};
__device__ __forceinline__ const float* inptr(const Frame& F, int i) {
    const unsigned long long v = ((const LAS unsigned long long*)(F.lds + MISC_OFF + 256))[i];
    const unsigned lo = __builtin_amdgcn_readfirstlane((unsigned)v), hi = __builtin_amdgcn_readfirstlane((unsigned)(v >> 32));
    return (const float*)(((unsigned long long)hi << 32) | lo);
}
enum { I_X = 0, I_C, I_CTX, I_CCTX, I_WINE, I_WOUTE, I_SINK, I_WA2, I_BA, I_NORMW, I_WINO, I_CONVW, I_CONVB, I_WOUTO, I_ADAW, I_ADAB, I_LNW, I_LNB, I_WG, I_BG, I_WE, I_BE, I_W1, I_W3, I_W2 };
__device__ __forceinline__ int launder_v(int x) { asm volatile("" : "+v"(x)); return x; }
__device__ __forceinline__ int launder_s(int x) { asm volatile("" : "+s"(x)); return x; }
__device__ __forceinline__ Frame relaunder(const Frame& F0) { Frame F = F0; F.tid = launder_v(F0.tid); F.lane = F.tid & 63; F.wave = __builtin_amdgcn_readfirstlane(F.tid >> 6); F.vcu = launder_s(F0.vcu); return F; }
__device__ __forceinline__ const float* modp(const Frame& F, int l, int bi, int n) { return (const float*)(F.ws + WS_MOD) + ((size_t)(l * 17 + bi) * 6 + n) * D; }
__device__ __forceinline__ int row_bi(int row) { return row < NLAT ? (row >> 12) : 16; }

__device__ __forceinline__ void sincos_d(double a, float& c, float& s) {
    const double TWO_OVER_PI = 0.63661977236758134308, PIO2_HI = 1.57079632679489655800e+00, PIO2_LO = 6.12323399573676603587e-17;
    const double n = __builtin_rint(a * TWO_OVER_PI); double r = (a - n * PIO2_HI) - n * PIO2_LO; const double r2 = r * r;
    double sp = -1.0 / 1307674368000.0; sp = sp * r2 + 1.0 / 6227020800.0; sp = sp * r2 - 1.0 / 39916800.0; sp = sp * r2 + 1.0 / 362880.0; sp = sp * r2 - 1.0 / 5040.0; sp = sp * r2 + 1.0 / 120.0; sp = sp * r2 - 1.0 / 6.0; sp = sp * r2 + 1.0; sp *= r;
    double cp = 1.0 / 20922789888000.0; cp = cp * r2 - 1.0 / 87178291200.0; cp = cp * r2 + 1.0 / 479001600.0; cp = cp * r2 - 1.0 / 3628800.0; cp = cp * r2 + 1.0 / 40320.0; cp = cp * r2 - 1.0 / 720.0; cp = cp * r2 + 1.0 / 24.0; cp = cp * r2 - 0.5; cp = cp * r2 + 1.0;
    const int q = ((int)n) & 3;
    const double sv = (q == 0) ? sp : (q == 1) ? cp : (q == 2) ? -sp : -cp;
    const double cv = (q == 0) ? cp : (q == 1) ? -sp : (q == 2) ? -cp : sp;
    c = (float)cv; s = (float)sv;
}
__device__ __forceinline__ void ph_ada(const Frame& F0) {
    Frame F = relaunder(F0);
    LAS float* sl = (LAS float*)F.lds;
    LAS float* red = (LAS float*)(F.lds + 17 * 1024 * 4);
    for (int idx = F.tid; idx < 17 * 1024; idx += 512) { const int bi = idx >> 10, k = idx & 1023; const float c = bi < 16 ? inptr(F, I_C)[bi * 1024 + k] : inptr(F, I_CCTX)[k]; sl[idx] = c / (1.0f + expf(-c)); }
    __syncthreads();
    for (int it = F.vcu; it < 4 * 96; it += F.G) {
        const int l = it / 96, n0 = (it % 96) * 64;
        const float* W = inptr(F, I_ADAW) + (size_t)l * 1024 * 6144 + n0 + F.lane;
        float acc[17];
#pragma unroll
        for (int b = 0; b < 17; ++b) acc[b] = 0.f;
        const int kb = F.wave * 128;
        for (int k = kb; k < kb + 128; k += 4) {
            const float w0 = W[(size_t)k * 6144], w1 = W[(size_t)(k + 1) * 6144], w2 = W[(size_t)(k + 2) * 6144], w3 = W[(size_t)(k + 3) * 6144];
#pragma unroll
            for (int b = 0; b < 17; ++b) { const f32x4 s = *(const LAS f32x4*)(sl + b * 1024 + k); acc[b] += s[0] * w0 + s[1] * w1 + s[2] * w2 + s[3] * w3; }
        }
#pragma unroll
        for (int b = 0; b < 17; ++b) red[(F.wave * 17 + b) * 64 + F.lane] = acc[b];
        __syncthreads();
        for (int idx = F.tid; idx < 17 * 64; idx += 512) { const int b = idx >> 6, ln = idx & 63; float s = 0.f;
#pragma unroll
            for (int w = 0; w < 8; ++w) s += red[(w * 17 + b) * 64 + ln];
            ((float*)(F.ws + WS_MOD))[(size_t)(l * 17 + b) * 6144 + n0 + ln] = s + inptr(F, I_ADAB)[l * 6144 + n0 + ln]; }
        __syncthreads();
    }
    if (F.vcu == F.G - 1) {
        float* rope = (float*)(F.ws + WS_ROPE);
        for (int idx = F.tid; idx < 1024; idx += 512) { const int pos = idx >> 4, f = idx & 15;
            const double base4[4] = {1.0, 0.56234132519034908, 0.31622776601683794, 0.17782794100389228};
            double inv = (f & 3) == 0 ? base4[0] : (f & 3) == 1 ? base4[1] : (f & 3) == 2 ? base4[2] : base4[3];
            const int a = f >> 2; inv *= (a == 0) ? 1.0 : (a == 1) ? 0.1 : (a == 2) ? 0.01 : 0.001;
            float c, s; sincos_d((double)pos * inv, c, s); rope[idx] = c; rope[1024 + idx] = s; }
    }
}

__device__ __forceinline__ void tr_item(const float* W, int srcN, int K, bf16* WT, int drow0, int k0, int srccol, LAS float* scr, int lane) {
    float v[32];
    const float* p = W + (size_t)(k0 + (lane >> 5)) * srcN + (srccol >= 0 ? srccol : 0);
#pragma unroll
    for (int i = 0; i < 32; ++i) v[i] = __builtin_nontemporal_load(p + (size_t)(2 * i) * srcN);
#pragma unroll
    for (int i = 0; i < 32; ++i) scr[(2 * i + (lane >> 5)) * 33 + (lane & 31)] = srccol >= 0 ? v[i] : 0.f;
    asm volatile("s_waitcnt lgkmcnt(0)" ::: "memory");
    const int c = lane & 7;
#pragma unroll
    for (int j = 0; j < 4; ++j) { const int n = (lane >> 3) + 8 * j; const LAS float* s = scr + (8 * c) * 33 + n;
        u32x4 o; o.x = pk2(s[0 * 33], s[1 * 33]); o.y = pk2(s[2 * 33], s[3 * 33]); o.z = pk2(s[4 * 33], s[5 * 33]); o.w = pk2(s[6 * 33], s[7 * 33]);
        *(u32x4*)(WT + (size_t)(drow0 + n) * K + k0 + 8 * c) = o; }
    asm volatile("s_waitcnt lgkmcnt(0)" ::: "memory");
}
__device__ __forceinline__ void tr_item8(const float* W, int srcN, int K, unsigned char* WT, int drow0, int k0, int srccol, float scale, LAS float* scr, int lane) {
    float v[32];
    const float* p = W + (size_t)(k0 + (lane >> 5)) * srcN + srccol;
#pragma unroll
    for (int i = 0; i < 32; ++i) v[i] = __builtin_nontemporal_load(p + (size_t)(2 * i) * srcN);
#pragma unroll
    for (int i = 0; i < 32; ++i) scr[(2 * i + (lane >> 5)) * 33 + (lane & 31)] = v[i] * scale;
    asm volatile("s_waitcnt lgkmcnt(0)" ::: "memory");
    const int c = lane & 3;
#pragma unroll
    for (int j = 0; j < 2; ++j) { const int n = (lane >> 2) + 16 * j; const LAS float* s = scr + (16 * c) * 33 + n;
        u32x4 o; o.x = pk4_fp8(s[0 * 33], s[1 * 33], s[2 * 33], s[3 * 33]); o.y = pk4_fp8(s[4 * 33], s[5 * 33], s[6 * 33], s[7 * 33]);
        o.z = pk4_fp8(s[8 * 33], s[9 * 33], s[10 * 33], s[11 * 33]); o.w = pk4_fp8(s[12 * 33], s[13 * 33], s[14 * 33], s[15 * 33]);
        *(u32x4*)(WT + (size_t)(drow0 + n) * K + k0 + 16 * c) = o; }
    asm volatile("s_waitcnt lgkmcnt(0)" ::: "memory");
}
__device__ __forceinline__ int even_srccol(int j) {
    if (j < 640) { const int hb = j & ~63, p = j & 63, g = p >> 3, e = p & 7; return hb + (g >> 2) * 32 + (e >> 2) * 16 + (g & 3) * 4 + (e & 3); }
    return j < EVEN_IN ? j : -1;
}
__device__ __forceinline__ int odd_srccol(int j) { const int t = j >> 8, r = j & 255; if (t < 4) return j; return (r < 128 ? 1024 : 2048 - 128) + 128 * (t - 4) + r; }
__device__ __forceinline__ void conv_dense_weights(const Frame& F0) {
    Frame F = relaunder(F0);
    LAS float* scr = (LAS float*)(F.lds + F.wave * 16384);
    const int gw = F.vcu * 8 + F.wave, NGW = F.G * 8;
    constexpr int I_EI = 16 * 80, I_SQ = 16 * 32, I_OI = 16 * 96;
    constexpr int NIT = 2 * (I_EI + I_SQ + I_OI + I_SQ);
    for (int it = gw; it < NIT; it += NGW) {
        int r = it; const int i = r & 1; r >>= 1;
        if (r < I_EI) { const int kb = r / 80, nb = r % 80; tr_item(inptr(F, I_WINE) + (size_t)i * 1024 * EVEN_IN, EVEN_IN, 1024, (bf16*)(F.ws + WS_WINE) + (size_t)i * EN * 1024, nb * 32, kb * 64, even_srccol(nb * 32 + (F.lane & 31)), scr, F.lane); continue; } r -= I_EI;
        if (r < I_SQ) { const int kb = r / 32, nb = r % 32; tr_item(inptr(F, I_WOUTE) + (size_t)i * 1024 * 1024, 1024, 1024, (bf16*)(F.ws + WS_WOUTE) + (size_t)i * 1024 * 1024, nb * 32, kb * 64, nb * 32 + (F.lane & 31), scr, F.lane); continue; } r -= I_SQ;
        if (r < I_OI) { const int kb = r / 96, nb = r % 96; tr_item(inptr(F, I_WINO) + (size_t)i * 1024 * ON, ON, 1024, (bf16*)(F.ws + WS_WINO) + (size_t)i * ON * 1024, nb * 32, kb * 64, odd_srccol(nb * 32 + (F.lane & 31)), scr, F.lane); continue; } r -= I_OI;
        { const int kb = r / 32, nb = r % 32; tr_item(inptr(F, I_WOUTO) + (size_t)i * 1024 * 1024, 1024, 1024, (bf16*)(F.ws + WS_WOUTO) + (size_t)i * 1024 * 1024, nb * 32, kb * 64, nb * 32 + (F.lane & 31), scr, F.lane); }
    }
}
constexpr float W8_SCALE = 64.0f;
__device__ __forceinline__ void conv_moe_item(const Frame& F, int l, int it, LAS float* scr) {
    constexpr int I_13 = 16 * 32, I_2 = 8 * 32;
    const int e = it / (I_13 + I_2); int r = it % (I_13 + I_2);
    const size_t eoff = ((size_t)l * NEXP + e) * 1024 * 512;
    if (r < I_13) { const int kb = r / 32, nb = r % 32; const int j0 = nb * 32, t = j0 >> 8, rr = j0 & 255;
        const float* src = (rr < 128 ? inptr(F, I_W1) : inptr(F, I_W3)) + eoff;
        tr_item8(src, 512, 1024, (unsigned char*)(F.ws + WS_W13) + (size_t)e * 1024 * 1024, j0, kb * 64, 128 * t + (rr & 127) + (F.lane & 31), W8_SCALE, scr, F.lane);
    } else { r -= I_13; const int kb = r / 32, nb = r % 32;
        tr_item8(inptr(F, I_W2) + eoff, 1024, 512, (unsigned char*)(F.ws + WS_W2) + (size_t)e * 1024 * 512, nb * 32, kb * 64, nb * 32 + (F.lane & 31), W8_SCALE, scr, F.lane); }
}
__device__ __forceinline__ void conv_moe_weights(const Frame& F0, int l) {
    Frame F = relaunder(F0); const int gw = F.vcu * 8 + F.wave, NGW = F.G * 8;
    LAS float* scr = (LAS float*)(F.lds + F.wave * 16384);
    for (int it = gw; it < NEXP * (16 * 32 + 8 * 32); it += NGW) conv_moe_item(F, l, it, scr);
}
__device__ __forceinline__ void ph_u0(const Frame& F0) {
    Frame F = relaunder(F0);
    const int gw = F.vcu * 8 + F.wave, NGW = F.G * 8;
    for (int r0 = gw * 4; r0 < NTOK; r0 += NGW * 4) {
        const int bi = row_bi(r0); const float* sh = modp(F, 0, bi, 0); const float* sc = modp(F, 0, bi, 1);
        f32x4 x[4][4];
#pragma unroll
        for (int r = 0; r < 4; ++r) { const int row = r0 + r; const float* src = row < NLAT ? inptr(F, I_X) + (size_t)row * D : inptr(F, I_CTX) + (size_t)(row - NLAT) * D;
#pragma unroll
            for (int j = 0; j < 4; ++j) x[r][j] = *(const f32x4*)(src + 4 * F.lane + 256 * j); }
#pragma unroll
        for (int j = 0; j < 4; ++j) { const int c = 4 * F.lane + 256 * j; const f32x4 a = *(const f32x4*)(sh + c), s = *(const f32x4*)(sc + c);
#pragma unroll
            for (int r = 0; r < 4; ++r) { const f32x4 u = x[r][j] * (1.0f + s) + a; u32x2 w; w.x = pk2(u[0], u[1]); w.y = pk2(u[2], u[3]); *(u32x2*)((bf16*)(F.ws + WS_U) + (size_t)(r0 + r) * D + c) = w; } }
    }
}

struct RowLN { f32x4 v[4]; };
__device__ __forceinline__ void ln_stats(f32x4 (&z)[4], float& mean, float& rstd) {
    float s = 0.f;
#pragma unroll
    for (int j = 0; j < 4; ++j) s += (z[j][0] + z[j][1]) + (z[j][2] + z[j][3]);
    mean = wave_sum(s) * (1.0f / D); float q = 0.f;
#pragma unroll
    for (int j = 0; j < 4; ++j) { z[j] = z[j] - mean; q += (z[j][0] * z[j][0] + z[j][1] * z[j][1]) + (z[j][2] * z[j][2] + z[j][3] * z[j][3]); }
    rstd = 1.0f / sqrtf(wave_sum(q) * (1.0f / D) + LN_EPS);
}
__device__ __forceinline__ void ln_rows(f32x4 (&z)[4], const float* lw, const float* lb, int lane) {
    float s = 0.f;
#pragma unroll
    for (int j = 0; j < 4; ++j) s += (z[j][0] + z[j][1]) + (z[j][2] + z[j][3]);
    const float mean = wave_sum(s) * (1.0f / D); float q = 0.f;
#pragma unroll
    for (int j = 0; j < 4; ++j) { z[j] = z[j] - mean; q += (z[j][0] * z[j][0] + z[j][1] * z[j][1]) + (z[j][2] * z[j][2] + z[j][3] * z[j][3]); }
    const float rstd = 1.0f / sqrtf(wave_sum(q) * (1.0f / D) + LN_EPS);
#pragma unroll
    for (int j = 0; j < 4; ++j) { const int c = 4 * lane + 256 * j; z[j] = z[j] * rstd * *(const f32x4*)(lw + c) + *(const f32x4*)(lb + c); }
}
__device__ __forceinline__ void ph_ln1(const Frame& F0, int l, int nrows, bool dry = false) {
    Frame F = relaunder(F0);
    LAS unsigned char* Thi = F.lds; LAS unsigned char* Tlo = F.lds + 33024;
    LAS float* red = (LAS float*)(F.lds + 66048);
    LAS float* lgt = (LAS float*)(F.lds + 82432);
    LAS int* lcnt = (LAS int*)(F.lds + 87552); LAS int* lbase = lcnt + 32;
    LAS unsigned* list = (LAS unsigned*)(F.lds + 87808);
    LAS float* LW = (LAS float*)(F.lds + 97024); LAS float* LB = LW + 1024; LAS float* WG = LB + 1024;
    const int lane = F.lane, w = F.wave;
    if (F.tid < 64) lcnt[F.tid] = 0;
    { const float* lwg = inptr(F, I_LNW) + (size_t)(l * 2 + 0) * D; const float* lbg = inptr(F, I_LNB) + (size_t)(l * 2 + 0) * D; const float* wgg = inptr(F, I_WG) + (size_t)l * 1024 * 4;
      for (int i = F.tid; i < 256; i += 512) { *(LAS f32x4*)(LW + 4 * i) = *(const f32x4*)(lwg + 4 * i); *(LAS f32x4*)(LB + 4 * i) = *(const f32x4*)(lbg + 4 * i); }
      for (int i = F.tid; i < 1024; i += 512) *(LAS f32x4*)(WG + 4 * i) = *(const f32x4*)(wgg + 4 * i); }
    bf16x8 Whi[2][4], Wlo[2][4];
    {
        const int n = lane & 15, kg = lane >> 4;
        const float* we = inptr(F, I_WE) + (size_t)l * 1024 * 32 + (size_t)(w * 128 + kg * 8) * 32 + n;
#pragma unroll
        for (int nt = 0; nt < 2; ++nt)
#pragma unroll
            for (int ks = 0; ks < 4; ++ks) { u32x4 hi, lo; unsigned hh[8], ll[8];
                const float* p = we + ks * 32 * 32 + nt * 16;
                asm volatile("" : "+v"(p));
#pragma unroll
                for (int j = 0; j < 8; ++j) {
                    const float v = p[j * 32];
                    const unsigned h = pk2(v, 0.f) & 0xffffu; const float r = v - __uint_as_float(h << 16); hh[j] = h; ll[j] = pk2(r, 0.f) & 0xffffu; }
                hi.x = hh[0] | (hh[1] << 16); hi.y = hh[2] | (hh[3] << 16); hi.z = hh[4] | (hh[5] << 16); hi.w = hh[6] | (hh[7] << 16);
                lo.x = ll[0] | (ll[1] << 16); lo.y = ll[2] | (ll[3] << 16); lo.z = ll[4] | (ll[5] << 16); lo.w = ll[6] | (ll[7] << 16);
                Whi[nt][ks] = __builtin_bit_cast(bf16x8, hi); Wlo[nt][ks] = __builtin_bit_cast(bf16x8, lo); }
    }
    const bf16* Y = (const bf16*)(F.ws + WS_P);
    const float* hsl = (l == 0 ? inptr(F, I_X) : F.out); const float* hsc = (l == 0 ? inptr(F, I_CTX) : (const float*)(F.ws + WS_HCTX));
    const float* bgp = inptr(F, I_BG) + l * 4; const float* bep = inptr(F, I_BE) + l * 32;
    const bool usey = !((l & 1) ? (KO_MASK & 4) : ((KO_MASK & 3) == 3));
    const int nbatch = nrows / 16; int nlist = 0; int prev_rbase = -1;
#define LN1_ROUTE(buf_, rbase_, slot_) do { if (F.tid < 16) { const int tk = F.tid; const LAS float* lg = lgt + (buf_) * 640 + tk * 40; \
        float gl[4]; _Pragma("unroll") for (int j = 0; j < 4; ++j) gl[j] = lg[32 + j] + bgp[j]; \
        float gmax = gl[0]; int g = 0; _Pragma("unroll") for (int j = 1; j < 4; ++j) if (gl[j] > gmax) { gmax = gl[j]; g = j; } \
        float den = 0.f; _Pragma("unroll") for (int j = 0; j < 4; ++j) den += expf(gl[j] - gmax); \
        const float pg = 1.0f / den; float el[8]; _Pragma("unroll") for (int j = 0; j < 8; ++j) el[j] = lg[g * 8 + j] + bep[g * 8 + j]; \
        float m0 = el[0]; int i0 = 0; _Pragma("unroll") for (int j = 1; j < 8; ++j) if (el[j] > m0) { m0 = el[j]; i0 = j; } \
        float m1 = -3.0e38f; int i1 = 0; _Pragma("unroll") for (int j = 0; j < 8; ++j) if (j != i0 && el[j] > m1) { m1 = el[j]; i1 = j; } \
        const float ex = expf(m1 - m0); const float w0 = pg / (1.0f + ex), w1 = pg * ex / (1.0f + ex); \
        const int e0 = g * 8 + i0, e1 = g * 8 + i1; \
        const int p0 = atomicAdd((int*)&lcnt[e0], 1), p1 = atomicAdd((int*)&lcnt[e1], 1); \
        LAS unsigned* L = list + ((slot_) * 16 + tk) * 8; \
        L[0] = (unsigned)((rbase_) + tk); L[1] = (unsigned)e0; L[2] = (unsigned)p0; L[3] = __float_as_uint(w0); L[4] = (unsigned)e1; L[5] = (unsigned)p1; L[6] = __float_as_uint(w1); } } while (0)
    __syncthreads();
    for (int bt = F.vcu; bt < nbatch; bt += F.G) {
        const int rbase = bt * 16; const int bi = row_bi(rbase);
        const float* g2 = modp(F, l, bi, 2); const float* sh = modp(F, l, bi, 3); const float* sc = modp(F, l, bi, 4);
        {
            f32x4 hv[2][4], gv[4], scv[4], shv[4]; u32x2 yv[2][4];
#pragma unroll
            for (int rr = 0; rr < 2; ++rr) { const int row = rbase + 2 * w + rr; const float* hs = row < NLAT ? hsl + (size_t)row * D : hsc + (size_t)(row - NLAT) * D;
#pragma unroll
                for (int j = 0; j < 4; ++j) { const int c = 4 * lane + 256 * j; hv[rr][j] = *(const f32x4*)(hs + c); yv[rr][j] = usey ? __builtin_nontemporal_load((const u32x2*)(Y + (size_t)row * D + c)) : (u32x2){0u, 0u}; } }
#pragma unroll
            for (int j = 0; j < 4; ++j) { const int c = 4 * lane + 256 * j; gv[j] = *(const f32x4*)(g2 + c); scv[j] = *(const f32x4*)(sc + c); shv[j] = *(const f32x4*)(sh + c); }
            f32x4 z[2][4]; float mean[2], rstd[2];
#pragma unroll
            for (int rr = 0; rr < 2; ++rr)
#pragma unroll
                for (int j = 0; j < 4; ++j) z[rr][j] = DN_ALPHA * hv[rr][j] + gv[j] * (f32x4){bflo(yv[rr][j].x), bfhi(yv[rr][j].x), bflo(yv[rr][j].y), bfhi(yv[rr][j].y)};
#pragma unroll
            for (int rr = 0; rr < 2; ++rr) ln_stats(z[rr], mean[rr], rstd[rr]);
            f32x4 ga[2] = {(f32x4){0.f, 0.f, 0.f, 0.f}, (f32x4){0.f, 0.f, 0.f, 0.f}};
#pragma unroll
            for (int j = 0; j < 4; ++j) { const int c = 4 * lane + 256 * j;
                const f32x4 lwv = *(const LAS f32x4*)(LW + c), lbv = *(const LAS f32x4*)(LB + c);
                const f32x4 g0 = *(const LAS f32x4*)(WG + 4 * c), g1 = *(const LAS f32x4*)(WG + 4 * c + 4), g2v = *(const LAS f32x4*)(WG + 4 * c + 8), g3 = *(const LAS f32x4*)(WG + 4 * c + 12);
#pragma unroll
                for (int rr = 0; rr < 2; ++rr) { const int lr = 2 * w + rr, row = rbase + lr;
                    float* hd = dry ? (float*)(F.ws + WS_GATT) + (size_t)row * D : (row < NLAT ? F.out + (size_t)row * D : (float*)(F.ws + WS_HCTX) + (size_t)(row - NLAT) * D);
                    const f32x4 zn = z[rr][j] * rstd[rr] * lwv + lbv;
                    *(f32x4*)(hd + c) = zn;
                    const f32x4 t = zn * (1.0f + scv[j]) + shv[j];
                    ga[rr] += t[0] * g0 + t[1] * g1 + t[2] * g2v + t[3] * g3;
                    const unsigned h01 = pk2(t[0], t[1]), h23 = pk2(t[2], t[3]);
                    u32x2 hw; hw.x = h01; hw.y = h23;
                    *(unsigned*)((unsigned char*)(F.ws + (dry ? WS_Q : WS_U8)) + (size_t)row * D + c) = pk4_fp8(t[0], t[1], t[2], t[3]);
                    const float r0 = t[0] - bflo(h01), r1 = t[1] - bfhi(h01), r2 = t[2] - bflo(h23), r3 = t[3] - bfhi(h23);
                    u32x2 lw2; lw2.x = pk2(r0, r1); lw2.y = pk2(r2, r3);
                    *(LAS u32x2*)(Thi + lr * 2064 + c * 2) = hw; *(LAS u32x2*)(Tlo + lr * 2064 + c * 2) = lw2; } }
#pragma unroll
            for (int rr = 0; rr < 2; ++rr) { const float q0 = wave_sum(ga[rr][0]), q1 = wave_sum(ga[rr][1]), q2 = wave_sum(ga[rr][2]), q3 = wave_sum(ga[rr][3]);
                if (lane == 0) *(LAS f32x4*)(lgt + (nlist & 1) * 640 + (2 * w + rr) * 40 + 32) = (f32x4){q0, q1, q2, q3}; }
        }
        __syncthreads();
        if (prev_rbase >= 0) LN1_ROUTE((nlist - 1) & 1, prev_rbase, nlist - 1);
        {
            f32x4 acc[2];
#pragma unroll
            for (int nt = 0; nt < 2; ++nt) acc[nt] = (f32x4){0.f, 0.f, 0.f, 0.f};
            const int tk = lane & 15, kg = lane >> 4;
#pragma unroll
            for (int ks = 0; ks < 4; ++ks) {
                const bf16x8 ah = *(const LAS bf16x8*)(Thi + tk * 2064 + (w * 128 + ks * 32 + kg * 8) * 2), al = *(const LAS bf16x8*)(Tlo + tk * 2064 + (w * 128 + ks * 32 + kg * 8) * 2);
#pragma unroll
                for (int nt = 0; nt < 2; ++nt) { acc[nt] = __builtin_amdgcn_mfma_f32_16x16x32_bf16(Whi[nt][ks], ah, acc[nt], 0, 0, 0);
                    acc[nt] = __builtin_amdgcn_mfma_f32_16x16x32_bf16(Wlo[nt][ks], ah, acc[nt], 0, 0, 0); acc[nt] = __builtin_amdgcn_mfma_f32_16x16x32_bf16(Whi[nt][ks], al, acc[nt], 0, 0, 0); }
            }
#pragma unroll
            for (int nt = 0; nt < 2; ++nt) *(LAS f32x4*)(red + (w * 16 + tk) * 32 + nt * 16 + 4 * kg) = acc[nt];
        }
        __syncthreads();
        { const int tk = F.tid & 15, n = F.tid >> 4; float s = 0.f;
#pragma unroll
            for (int ww = 0; ww < 8; ++ww) s += red[(ww * 16 + tk) * 32 + n];
            lgt[(nlist & 1) * 640 + tk * 40 + n] = s; }
        prev_rbase = rbase; ++nlist;
    }
    __syncthreads();
    if (prev_rbase >= 0) LN1_ROUTE((nlist - 1) & 1, prev_rbase, nlist - 1);
#undef LN1_ROUTE
    __syncthreads();
    if (F.tid < 32) lbase[F.tid] = (int)atomicAdd((unsigned*)(F.ws + WS_CTL) + CW_CNT + l * 64 + (dry ? 32 : 0) + F.tid, (unsigned)lcnt[F.tid]);
    __syncthreads();
    if (!dry) for (int idx = F.tid; idx < nlist * 16; idx += 512) {
        const LAS unsigned* L = list + idx * 8; const unsigned row = L[0], e0 = L[1], e1 = L[4]; const unsigned p0 = L[2] + (unsigned)lbase[e0], p1 = L[5] + (unsigned)lbase[e1];
        u32x4 a; a.x = e0; a.y = p0; a.z = L[3]; a.w = e1; u32x4 b; b.x = p1; b.y = L[6]; b.z = 0u; b.w = 0u;
        unsigned* ti = (unsigned*)(F.ws + WS_TOKINFO) + (size_t)row * 8; *(u32x4*)ti = a; *(u32x4*)(ti + 4) = b;
        int* rt = (int*)(F.ws + WS_ROWTOK); rt[(size_t)e0 * NTOK + p0] = (int)row; rt[(size_t)e1 * NTOK + p1] = (int)row;
    }
}

__device__ __forceinline__ void ph_ln2(const Frame& F0, int l, int nrows, bool dry = false) {
    Frame F = relaunder(F0);
    MoeTab T = moe_tab(F.lds);
    const int gw = F.vcu * 8 + F.wave, NGW = F.G * 8, lane = F.lane;
    const float* lw = inptr(F, I_LNW) + (size_t)(l * 2 + 1) * D; const float* lb = inptr(F, I_LNB) + (size_t)(l * 2 + 1) * D;
    const bf16* O2 = (const bf16*)(F.ws + WS_P);
    for (int r0 = gw * 4; r0 < nrows; r0 += NGW * 4) {
        const int bi = row_bi(r0);
        const float* g5 = modp(F, l, bi, 5);
        f32x4 z[4][4]; u32x2 ya[4][4], yb[4][4]; float w0[4], w1[4];
#pragma unroll
        for (int r = 0; r < 4; ++r) { const int row = r0 + r;
            const unsigned* ti = (const unsigned*)(F.ws + WS_TOKINFO) + (size_t)row * 8;
            const u32x4 a = *(const u32x4*)ti; const u32x2 b = *(const u32x2*)(ti + 4);
            const size_t s0 = (size_t)T.ts[a.x] * 256 + a.y, s1 = (size_t)T.ts[a.w] * 256 + b.x; w0[r] = __uint_as_float(a.z); w1[r] = __uint_as_float(b.y);
            const float* hd = row < NLAT ? F.out + (size_t)row * D : (const float*)(F.ws + WS_HCTX) + (size_t)(row - NLAT) * D;
#pragma unroll
            for (int j = 0; j < 4; ++j) { const int c = 4 * lane + 256 * j; z[r][j] = *(const f32x4*)(hd + c);
                if (!(KO_MASK & 8)) { ya[r][j] = __builtin_nontemporal_load((const u32x2*)(O2 + s0 * D + c)); yb[r][j] = __builtin_nontemporal_load((const u32x2*)(O2 + s1 * D + c)); } } }
#pragma unroll
        for (int j = 0; j < 4; ++j) { const f32x4 g = *(const f32x4*)(g5 + 4 * lane + 256 * j);
#pragma unroll
            for (int r = 0; r < 4; ++r) { f32x4 y = (f32x4){0.f, 0.f, 0.f, 0.f};
                if (!(KO_MASK & 8)) y = w0[r] * (f32x4){bflo(ya[r][j].x), bfhi(ya[r][j].x), bflo(ya[r][j].y), bfhi(ya[r][j].y)} + w1[r] * (f32x4){bflo(yb[r][j].x), bfhi(yb[r][j].x), bflo(yb[r][j].y), bfhi(yb[r][j].y)};
                z[r][j] = DN_ALPHA * z[r][j] + g * y; } }
        float mean[4], rstd[4];
#pragma unroll
        for (int r = 0; r < 4; ++r) ln_stats(z[r], mean[r], rstd[r]);
        const bool lat = r0 < NLAT;
        const bool wu = (l < 3) && (lat || l < 2);
        const float* sh = modp(F, l < 3 ? l + 1 : l, bi, 0); const float* sc = modp(F, l < 3 ? l + 1 : l, bi, 1);
#pragma unroll
        for (int j = 0; j < 4; ++j) { const int c = 4 * lane + 256 * j;
            const f32x4 lwv = *(const f32x4*)(lw + c), lbv = *(const f32x4*)(lb + c), scv = *(const f32x4*)(sc + c), shv = *(const f32x4*)(sh + c);
#pragma unroll
            for (int r = 0; r < 4; ++r) { const int row = r0 + r;
                float* hd = dry ? (float*)(F.ws + WS_GATT) + (size_t)row * D : (lat ? F.out + (size_t)row * D : (float*)(F.ws + WS_HCTX) + (size_t)(row - NLAT) * D);
                const f32x4 zn = z[r][j] * rstd[r] * lwv + lbv; *(f32x4*)(hd + c) = zn;
                if (wu) { const f32x4 u = zn * (1.0f + scv) + shv; u32x2 hw; hw.x = pk2(u[0], u[1]); hw.y = pk2(u[2], u[3]); *(u32x2*)((bf16*)(F.ws + (dry ? WS_Q : WS_U)) + (size_t)row * D + c) = hw; } } }
    }
}

__device__ __forceinline__ f32x4 ubf_lo(const u32x4 v) { return (f32x4){bflo(v.x), bfhi(v.x), bflo(v.y), bfhi(v.y)}; }
__device__ __forceinline__ f32x4 ubf_hi(const u32x4 v) { return (f32x4){bflo(v.z), bfhi(v.z), bflo(v.w), bfhi(v.w)}; }
__device__ __forceinline__ void ph_conv(const Frame& F0, int i, int nrows) {
    Frame F = relaunder(F0);
    const int gw = F.vcu * 8 + F.wave, NGW = F.G * 8, lane = F.lane;
    const float* cw = inptr(F, I_CONVW) + (size_t)i * 3 * D; const float* cb = inptr(F, I_CONVB) + (size_t)i * D;
    const bf16* P = (const bf16*)(F.ws + WS_P); bf16* Q = (bf16*)(F.ws + WS_Q);
    for (int r0 = gw * 4; r0 < nrows; r0 += NGW * 4) {
        const int s0 = r0 < NLAT ? (r0 & (SEQ - 1)) : ((r0 - NLAT) & (CTXL - 1)); const int slen = r0 < NLAT ? SEQ : CTXL;
        const bool hp = s0 > 0, hn = s0 + 4 < slen;
#pragma unroll
        for (int j = 0; j < 2; ++j) { const int c = 8 * lane + 512 * j;
            u32x4 p[6], gb[4];
            p[0] = (u32x4){0u, 0u, 0u, 0u}; p[5] = (u32x4){0u, 0u, 0u, 0u};
            if (hp) p[0] = *(const u32x4*)(P + (size_t)(r0 - 1) * 2048 + 1024 + c);
            if (hn) p[5] = *(const u32x4*)(P + (size_t)(r0 + 4) * 2048 + 1024 + c);
#pragma unroll
            for (int r = 0; r < 4; ++r) { p[r + 1] = *(const u32x4*)(P + (size_t)(r0 + r) * 2048 + 1024 + c); gb[r] = *(const u32x4*)(P + (size_t)(r0 + r) * 2048 + c); }
            const f32x4 w0a = *(const f32x4*)(cw + c), w0b = *(const f32x4*)(cw + c + 4), w1a = *(const f32x4*)(cw + D + c), w1b = *(const f32x4*)(cw + D + c + 4), w2a = *(const f32x4*)(cw + 2 * D + c), w2b = *(const f32x4*)(cw + 2 * D + c + 4);
            const f32x4 ba = *(const f32x4*)(cb + c), bb = *(const f32x4*)(cb + c + 4);
#pragma unroll
            for (int r = 0; r < 4; ++r) {
                const f32x4 ya = ubf_lo(gb[r]) * (ubf_lo(p[r]) * w0a + ubf_lo(p[r + 1]) * w1a + ubf_lo(p[r + 2]) * w2a + ba);
                const f32x4 yb = ubf_hi(gb[r]) * (ubf_hi(p[r]) * w0b + ubf_hi(p[r + 1]) * w1b + ubf_hi(p[r + 2]) * w2b + bb);
                *(u32x4*)(Q + (size_t)(r0 + r) * D + c) = pack8(ya, yb); } }
    }
}
#define MFMA32(a, b, c) __builtin_amdgcn_mfma_f32_32x32x16_bf16((a), (b), (c), 0, 0, 0)
#define MFMA16(a, b, c) __builtin_amdgcn_mfma_f32_16x16x32_bf16((a), (b), (c), 0, 0, 0)
constexpr int AK_STR = 144, AV_STR = 136, AK_BUF = 64 * AK_STR, AV_BUF = 64 * AV_STR;
__device__ __forceinline__ int crow32(int reg, int hh) { return (reg & 3) + 8 * (reg >> 2) + 4 * hh; }
__device__ __forceinline__ float xhalf_max(float v) { const unsigned u = __float_as_uint(v); const auto r = __builtin_amdgcn_permlane32_swap(u, u, false, false); return fmaxf(__uint_as_float(r[0]), __uint_as_float(r[1])); }
__device__ __forceinline__ float xhalf_sum(float v) { const unsigned u = __float_as_uint(v); const auto r = __builtin_amdgcn_permlane32_swap(u, u, false, false); return __uint_as_float(r[0]) + __uint_as_float(r[1]); }
constexpr float ATT_THR = 8.0f;
__device__ __forceinline__ void attn_unit(const Frame& F, int ie, int b, int g, int qb, bool ctxq) {
    const bf16* P = (const bf16*)(F.ws + WS_P); bf16* Q = (bf16*)(F.ws + WS_Q);
    LAS unsigned char* Ks = F.lds; LAS unsigned char* Vt = F.lds + 2 * AK_BUF;
    const int w = F.wave, lane = F.lane, r = w >> 1, qh = w & 1, h = 4 * g + r, n = lane & 31, hh = lane >> 5;
    const int qpos0 = qb * 128 + qh * 64;
    const int qrow0 = ctxq ? NLAT + b * CTXL + qpos0 : b * SEQ + qpos0;
    if (KO_MASK & 1) {
#pragma unroll
        for (int nt = 0; nt < 2; ++nt)
#pragma unroll
            for (int c = 0; c < 4; ++c) *(u32x4*)(Q + (size_t)(qrow0 + 32 * nt + n) * D + h * 64 + 16 * c + 8 * hh) = (u32x4){0u, 0u, 0u, 0u};
        return;
    }
    bf16x8 qf[2][4];
#pragma unroll
    for (int nt = 0; nt < 2; ++nt)
#pragma unroll
        for (int c = 0; c < 4; ++c) qf[nt][c] = *(const bf16x8*)(P + (size_t)(qrow0 + 32 * nt + n) * EN + PC_Q + h * 64 + 16 * c + 8 * hh);
    const float sk = inptr(F, I_SINK)[ie * 8 + h] * LOG2E;
    float mrun[2] = {sk, sk}, lsum[2] = {1.f, 1.f};
    f32x16 O[2][2];
#pragma unroll
    for (int a = 0; a < 2; ++a)
#pragma unroll
        for (int c = 0; c < 2; ++c)
#pragma unroll
            for (int e = 0; e < 16; ++e) O[a][c][e] = 0.f;
    const int tw0 = ctxq ? 4 : ((qb == 0) ? 6 : 4), tw1 = ctxq ? 4 : ((qb == 31) ? 8 : 10);
    const int ntile = 4 + (tw1 - tw0);
    const int skey = F.tid >> 3, sch = F.tid & 7;
    u32x4 kreg, vreg;
#define TILE_OF(i) ((i) < 4 ? (i) : tw0 + ((i) - 4))
#define KROW_OF(t) ((t) < 4 ? NLAT + b * CTXL + 64 * (t) : b * SEQ + (qb - 1) * 128 + 64 * ((t) - 4))
    { const int kr = KROW_OF(0) + skey; kreg = *(const u32x4*)(P + (size_t)kr * EN + PC_K + g * 64 + sch * 8); vreg = *(const u32x4*)(P + (size_t)kr * EN + PC_V + g * 64 + sch * 8); }
    __syncthreads();
    {
        *(LAS u32x4*)(Ks + skey * AK_STR + sch * 16) = kreg;
        LAS unsigned short* vt = (LAS unsigned short*)(Vt + (sch * 8) * AV_STR + skey * 2);
        const unsigned vv[4] = {vreg.x, vreg.y, vreg.z, vreg.w};
#pragma unroll
        for (int e = 0; e < 4; ++e) { vt[(2 * e) * (AV_STR / 2)] = (unsigned short)(vv[e] & 0xffffu); vt[(2 * e + 1) * (AV_STR / 2)] = (unsigned short)(vv[e] >> 16); }
    }
    __syncthreads();
    const float c2 = 0.125f * LOG2E;
    for (int i = 0; i < ntile; ++i) {
        const int buf = i & 1, t = TILE_OF(i);
        if (i + 1 < ntile) { const int t1 = TILE_OF(i + 1); const int kr = KROW_OF(t1) + skey; kreg = *(const u32x4*)(P + (size_t)kr * EN + PC_K + g * 64 + sch * 8); vreg = *(const u32x4*)(P + (size_t)kr * EN + PC_V + g * 64 + sch * 8); }
        const LAS unsigned char* kb = Ks + buf * AK_BUF; const LAS unsigned char* vb = Vt + buf * AV_BUF;
        const bool msk = (t >= 4) && (t != 6) && (t != 7);
        const int kp0 = (qb - 1) * 128 + 64 * (t - 4);
        const bool skip = (qh == 0 && t == 9) || (qh == 1 && t == 4);
#pragma unroll 1
        for (int kt = 0; kt < 2; ++kt) {
            if (skip) break;
            f32x16 S[2];
#pragma unroll
            for (int c = 0; c < 2; ++c)
#pragma unroll
                for (int e = 0; e < 16; ++e) S[c][e] = 0.f;
#pragma unroll
            for (int c = 0; c < 4; ++c) { const bf16x8 kf = *(const LAS bf16x8*)(kb + (32 * kt + n) * AK_STR + (16 * c + 8 * hh) * 2);
#pragma unroll
                for (int nt = 0; nt < 2; ++nt) S[nt] = MFMA32(kf, qf[nt][c], S[nt]); }
#pragma unroll
            for (int nt = 0; nt < 2; ++nt) {
                if (msk) { const int qp = qpos0 + 32 * nt + n;
#pragma unroll
                    for (int e = 0; e < 16; ++e) { const int dd = qp - (kp0 + 32 * kt + crow32(e, hh)); if (dd > 128 || dd < -128) S[nt][e] = -INFINITY; } }
                float mx = fmaxf(fmaxf(S[nt][0], S[nt][1]), fmaxf(S[nt][2], S[nt][3]));
#pragma unroll
                for (int e = 4; e < 16; e += 4) mx = fmaxf(mx, fmaxf(fmaxf(S[nt][e], S[nt][e + 1]), fmaxf(S[nt][e + 2], S[nt][e + 3])));
                mx = xhalf_max(mx) * c2;
                if (__builtin_amdgcn_ballot_w64(mx > mrun[nt] + ATT_THR) != 0ull) {
                    const float mnew_ = fmaxf(mrun[nt], mx); const float alpha = __builtin_amdgcn_exp2f(mrun[nt] - mnew_); mrun[nt] = mnew_; lsum[nt] *= alpha;
#pragma unroll
                    for (int dt = 0; dt < 2; ++dt)
#pragma unroll
                        for (int e = 0; e < 16; ++e) O[dt][nt][e] *= alpha;
                }
                const float mu = mrun[nt];
                float rs = 0.f;
#pragma unroll
                for (int e = 0; e < 16; ++e) { const float p = __builtin_amdgcn_exp2f(__builtin_fmaf(S[nt][e], c2, -mu)); S[nt][e] = p; rs += p; }
                lsum[nt] += xhalf_sum(rs);
            }
#pragma unroll
            for (int s = 0; s < 2; ++s) {
                bf16x8 pf[2];
#pragma unroll
                for (int nt = 0; nt < 2; ++nt) { u32x4 pw; pw.x = pk2(S[nt][8 * s + 0], S[nt][8 * s + 1]); pw.y = pk2(S[nt][8 * s + 2], S[nt][8 * s + 3]); pw.z = pk2(S[nt][8 * s + 4], S[nt][8 * s + 5]); pw.w = pk2(S[nt][8 * s + 6], S[nt][8 * s + 7]); pf[nt] = __builtin_bit_cast(bf16x8, pw); }
#pragma unroll
                for (int dt = 0; dt < 2; ++dt) {
                    const LAS unsigned char* va = vb + (32 * dt + n) * AV_STR + (32 * kt + 16 * s + 4 * hh) * 2;
                    const s16x4 lo = *(const LAS s16x4*)va, hi = *(const LAS s16x4*)(va + 16);
                    const bf16x8 vf = __builtin_shufflevector(lo, hi, 0, 1, 2, 3, 4, 5, 6, 7);
#pragma unroll
                    for (int nt = 0; nt < 2; ++nt) O[dt][nt] = MFMA32(vf, pf[nt], O[dt][nt]);
                }
            }
        }
        if (i + 1 < ntile) {
            LAS unsigned char* kb2 = Ks + (buf ^ 1) * AK_BUF; LAS unsigned char* vb2 = Vt + (buf ^ 1) * AV_BUF;
            *(LAS u32x4*)(kb2 + skey * AK_STR + sch * 16) = kreg;
            LAS unsigned short* vt = (LAS unsigned short*)(vb2 + (sch * 8) * AV_STR + skey * 2);
            const unsigned vv[4] = {vreg.x, vreg.y, vreg.z, vreg.w};
#pragma unroll
            for (int e = 0; e < 4; ++e) { vt[(2 * e) * (AV_STR / 2)] = (unsigned short)(vv[e] & 0xffffu); vt[(2 * e + 1) * (AV_STR / 2)] = (unsigned short)(vv[e] >> 16); }
        }
        __syncthreads();
    }
#pragma unroll
    for (int nt = 0; nt < 2; ++nt) { const float inv = 1.0f / lsum[nt]; bf16* orow = Q + (size_t)(qrow0 + 32 * nt + n) * D + h * 64 + (hh ? 8 : 0);
#pragma unroll
        for (int dt = 0; dt < 2; ++dt)
#pragma unroll
            for (int rg = 0; rg < 4; rg += 2) {
                u32x2 a, bq; a.x = pk2(O[dt][nt][4 * rg] * inv, O[dt][nt][4 * rg + 1] * inv); a.y = pk2(O[dt][nt][4 * rg + 2] * inv, O[dt][nt][4 * rg + 3] * inv);
                bq.x = pk2(O[dt][nt][4 * rg + 4] * inv, O[dt][nt][4 * rg + 5] * inv); bq.y = pk2(O[dt][nt][4 * rg + 6] * inv, O[dt][nt][4 * rg + 7] * inv);
                { const auto r0 = __builtin_amdgcn_permlane32_swap(a.x, bq.x, false, false); a.x = r0[0]; bq.x = r0[1]; }
                { const auto r1 = __builtin_amdgcn_permlane32_swap(a.y, bq.y, false, false); a.y = r1[0]; bq.y = r1[1]; }
                *(u32x4*)(orow + 32 * dt + 8 * rg) = (u32x4){a.x, a.y, bq.x, bq.y}; } }
}

template <int d> __device__ __forceinline__ void glaA_unit(const Frame& F, int ie, int b, int c, int h) {
    const bf16* P = (const bf16*)(F.ws + WS_P);
    LAS unsigned char* QS = F.lds + F.wave * 16384; LAS unsigned char* KS = QS + 8192;
    const int lane = F.lane;
    const int row0 = c < 4 ? NLAT + b * CTXL + c * 64 : b * SEQ + (c - 4) * 64;
    const size_t U = (size_t)(b * NCHUNK + c) * 4 + h;
    bf16* gq = (bf16*)(F.ws + WS_GQIN); bf16* gk = (bf16*)(F.ws + WS_GKST); bf16* ga = (bf16*)(F.ws + WS_GATT);
    {
        const size_t UD = U * 2 + d;
        {
            u32x4 qr[8], kr[8];
#pragma unroll
            for (int it = 0; it < 8; ++it) { const int tok = it * 8 + (lane >> 3), ch = lane & 7; const size_t ro = (size_t)(row0 + tok) * EN + h * 64 + ch * 8; qr[it] = *(const u32x4*)(P + ro + PC_QG); kr[it] = *(const u32x4*)(P + ro + PC_KG); }
#pragma unroll
            for (int it = 0; it < 8; ++it) { const int tok = it * 8 + (lane >> 3), ch = lane & 7; const int so = tok * 128 + ((ch ^ (tok & 7)) << 4); *(LAS u32x4*)(QS + so) = qr[it]; *(LAS u32x4*)(KS + so) = kr[it]; }
        }
        const int ln = lane & 31, hh = lane >> 5;
        bf16x8 afr[2], bhi[2], blo[2]; float bav[2];
#pragma unroll
        for (int tt = 0; tt < 2; ++tt) afr[tt] = *(const bf16x8*)(P + (size_t)(row0 + 32 * tt + ln) * EN + PC_GG + 16 * d + 8 * hh);
#pragma unroll
        for (int dt = 0; dt < 2; ++dt) { const float* wp = inptr(F, I_WA2) + (size_t)((ie * 2 + d) * 16 + 8 * hh) * 256 + h * 64 + 32 * dt + ln;
            unsigned hh_[8], ll_[8];
#pragma unroll
            for (int j = 0; j < 8; ++j) { const float v = wp[(size_t)j * 256]; const unsigned hb = pk2(v, 0.f) & 0xffffu; hh_[j] = hb; ll_[j] = pk2(v - __uint_as_float(hb << 16), 0.f) & 0xffffu; }
            bhi[dt] = __builtin_bit_cast(bf16x8, (u32x4){hh_[0] | (hh_[1] << 16), hh_[2] | (hh_[3] << 16), hh_[4] | (hh_[5] << 16), hh_[6] | (hh_[7] << 16)});
            blo[dt] = __builtin_bit_cast(bf16x8, (u32x4){ll_[0] | (ll_[1] << 16), ll_[2] | (ll_[3] << 16), ll_[4] | (ll_[5] << 16), ll_[6] | (ll_[7] << 16)});
            bav[dt] = inptr(F, I_BA)[(ie * 2 + d) * 256 + h * 64 + 32 * dt + ln]; }
        f32x16 G[2][2];
#pragma unroll
        for (int tt = 0; tt < 2; ++tt)
#pragma unroll
            for (int dt = 0; dt < 2; ++dt) { f32x16 z16;
#pragma unroll
                for (int e = 0; e < 16; ++e) z16[e] = 0.f;
                z16 = MFMA32(afr[tt], bhi[dt], z16); G[tt][dt] = MFMA32(afr[tt], blo[dt], z16); }
        asm volatile("s_waitcnt lgkmcnt(0)" ::: "memory");
        float base[2] = {0.f, 0.f};
        int lofs[2][4];
#pragma unroll
        for (int dt = 0; dt < 2; ++dt)
#pragma unroll
            for (int e4 = 0; e4 < 4; ++e4) lofs[dt][e4] = (4 * hh + e4) * 128 + (((4 * dt + (ln >> 3)) ^ (4 * hh + e4)) << 4) + (ln & 7) * 2;
#pragma unroll
        for (int tq = 0; tq < 2; ++tq) { constexpr int dd = d; const int tt = dd ? 1 - tq : tq;
#pragma unroll
            for (int gq_ = 0; gq_ < 4; ++gq_) { const int g4 = dd ? 3 - gq_ : gq_;
                const int tokg = 32 * tt + 8 * g4;
#pragma unroll
                for (int dt = 0; dt < 2; ++dt) {
                    float la[4];
#pragma unroll
                    for (int e4 = 0; e4 < 4; ++e4) { const float g = G[tt][dt][4 * g4 + e4] + bav[dt];
                        la[e4] = (fminf(g, 0.f) * LOG2E - __builtin_amdgcn_logf(1.0f + __builtin_amdgcn_exp2f(-fabsf(g) * LOG2E))) * (1.0f / 16.0f); }
                    float cs[4];
                    if (dd == 0) { cs[0] = la[0]; cs[1] = cs[0] + la[1]; cs[2] = cs[1] + la[2]; cs[3] = cs[2] + la[3]; }
                    else { cs[3] = la[3]; cs[2] = cs[3] + la[2]; cs[1] = cs[2] + la[1]; cs[0] = cs[1] + la[0]; }
                    const float t4 = dd == 0 ? cs[3] : cs[0];
                    const float pt = __shfl_xor(t4, 32);
                    const float off = base[dt] + ((dd == 0 ? hh == 1 : hh == 0) ? pt : 0.f);
                    base[dt] += t4 + pt;
#pragma unroll
                    for (int e4 = 0; e4 < 4; ++e4) { const int so = tokg * 128 + lofs[dt][e4];
                        const float e1 = __builtin_amdgcn_exp2f(off + cs[e4]);
                        const float qi = bf2f(*(const LAS unsigned short*)(QS + so)) * 0.125f * e1, ki = bf2f(*(const LAS unsigned short*)(KS + so)) * __builtin_amdgcn_rcpf(e1);
                        const unsigned short q16 = (unsigned short)(pk2(qi, 0.f) & 0xffffu), k16 = (unsigned short)(pk2(ki, 0.f) & 0xffffu);
                        *(LAS unsigned short*)(QS + so) = q16; *(LAS unsigned short*)(KS + so) = k16; }
                }
            }
        }
        if (hh == 0) { ((float*)(F.ws + WS_GDEC))[UD * 64 + ln] = __builtin_amdgcn_exp2f(base[0]); ((float*)(F.ws + WS_GDEC))[UD * 64 + 32 + ln] = __builtin_amdgcn_exp2f(base[1]); }
        asm volatile("s_waitcnt lgkmcnt(0)" ::: "memory");
        {
            const int cc = lane & 7, dk0 = 32 * (cc >> 2) + 4 * (cc & 3);
#pragma unroll
            for (int it = 0; it < 8; ++it) { const int tok = it * 8 + (lane >> 3);
                const u32x2 lo = *(const LAS u32x2*)(QS + tok * 128 + ((((dk0 >> 3)) ^ (tok & 7)) << 4) + (dk0 & 7) * 2);
                const u32x2 hi = *(const LAS u32x2*)(QS + tok * 128 + ((((dk0 + 16) >> 3) ^ (tok & 7)) << 4) + (dk0 & 7) * 2);
                *(u32x4*)(gq + (UD * 64 + tok) * 64 + 8 * cc) = (u32x4){lo.x, lo.y, hi.x, hi.y};
                *(u32x4*)(gk + (UD * 64 + tok) * 64 + 8 * cc) = *(const LAS u32x4*)(KS + tok * 128 + ((cc ^ (tok & 7)) << 4)); }
        }
        {
            const int n = lane & 15, kg = lane >> 4;
#pragma unroll 1
            for (int I = 0; I < 4; ++I) {
                const int ti = 16 * I + n;
                bf16x8 qf[2];
#pragma unroll
                for (int ks2 = 0; ks2 < 2; ++ks2) qf[ks2] = *(const LAS bf16x8*)(QS + ti * 128 + (((4 * ks2 + kg) ^ (ti & 7)) << 4));
#pragma unroll
                for (int J = 0; J < 4; ++J) { f32x4 acc = (f32x4){0.f, 0.f, 0.f, 0.f};
                    const bool live = d == 0 ? (J <= I) : (J >= I);
                    if (live) {
                        const int tjr = 16 * J + n;
#pragma unroll
                        for (int ks2 = 0; ks2 < 2; ++ks2) { const bf16x8 kf = *(const LAS bf16x8*)(KS + tjr * 128 + (((4 * ks2 + kg) ^ (tjr & 7)) << 4)); acc = MFMA16(kf, qf[ks2], acc); }
#pragma unroll
                        for (int r = 0; r < 4; ++r) { const int tj = 16 * J + 4 * kg + r; const bool keep = d == 0 ? (tj <= ti) : (tj >= ti); if (!keep) acc[r] = 0.f; }
                    }
                    u32x2 ow; ow.x = pk2(acc[0], acc[1]); ow.y = pk2(acc[2], acc[3]);
                    *(u32x2*)(ga + (UD * 64 + ti) * 64 + 16 * J + 4 * kg) = ow; }
            }
        }
        asm volatile("s_waitcnt lgkmcnt(0)" ::: "memory");
    }
}

constexpr int GB_STG = 43008;
__device__ __forceinline__ int glaB_chunk(int d, int step) { return d == 0 ? step : (step < 4 ? 3 - step : 4 + (NCHUNK - 1 - step)); }
__device__ __forceinline__ int swz_k(int r) { return (r & 3) | (((r >> 3) & 1) << 2); }
__device__ __forceinline__ int swz_v(int r) { return ((r & 3) << 2) | ((r >> 2) & 3); }
template <int STAGE> __device__ __forceinline__ void glaB_issue(const Frame& F, int b, int h, int d, int step) {
    const int c = glaB_chunk(d, step);
    const size_t U = (size_t)(b * NCHUNK + c) * 4 + h, UD = U * 2 + d;
    const int row0 = c < 4 ? NLAT + b * CTXL + c * 64 : b * SEQ + (c - 4) * 64;
    const int tid = F.tid, row = tid >> 3, gch = (tid & 7) ^ (row & 7), gchk = (tid & 7) ^ swz_k(row);
    const int vr0 = tid >> 4, vr1 = vr0 + 32, vc0 = (tid & 15) ^ swz_v(vr0), vc1 = (tid & 15) ^ swz_v(vr1);
    LAS unsigned char* st = F.lds + STAGE * GB_STG + F.wave * 1024;
    const char* gq = (const char*)(F.ws + WS_GQIN) + UD * 8192 + row * 128 + gch * 16;
    const char* ga = (const char*)(F.ws + WS_GATT) + UD * 8192 + row * 128 + gch * 16;
    const char* gk = (const char*)(F.ws + WS_GKST) + UD * 8192 + row * 128 + gchk * 16;
    const char* gv = (const char*)(F.ws + WS_P) + (size_t)row0 * (EN * 2) + (PC_VG + h * 128) * 2;
    const char* gdc = (const char*)(F.ws + WS_GDEC) + UD * 256 + F.lane * 4;
    __builtin_amdgcn_global_load_lds((const unsigned*)gq, (LAS unsigned*)(st), 16, 0, 0);
    __builtin_amdgcn_global_load_lds((const unsigned*)ga, (LAS unsigned*)(st + 8192), 16, 0, 0);
    __builtin_amdgcn_global_load_lds((const unsigned*)gk, (LAS unsigned*)(st + 16384), 16, 0, 0);
    __builtin_amdgcn_global_load_lds((const unsigned*)(gv + (size_t)vr0 * (EN * 2) + vc0 * 16), (LAS unsigned*)(st + 24576), 16, 0, 0);
    __builtin_amdgcn_global_load_lds((const unsigned*)(gv + (size_t)vr1 * (EN * 2) + vc1 * 16), (LAS unsigned*)(st + 24576 + 8192), 16, 0, 0);
    __builtin_amdgcn_global_load_lds((const unsigned*)gdc, (LAS unsigned*)(F.lds + STAGE * GB_STG + 40960 + F.wave * 256), 4, 0, 0);
}
template <int ROWB, class SWZ> __device__ __forceinline__ bf16x8 gb_frag_tr(const LAS unsigned char* tile, int lane, int c, int ks, SWZ swz) {
    const int g = lane >> 4, q = (lane & 15) >> 2, p = lane & 3;
    const int r0 = 32 * ks + 8 * g + q, r1 = r0 + 4;
    const s16x4 lo = __builtin_amdgcn_ds_read_tr16_b64_v4i16((LAS s16x4*)(tile + ROWB * r0 + 16 * ((2 * c + (p >> 1)) ^ swz(r0)) + 8 * (p & 1)));
    const s16x4 hi = __builtin_amdgcn_ds_read_tr16_b64_v4i16((LAS s16x4*)(tile + ROWB * r1 + 16 * ((2 * c + (p >> 1)) ^ swz(r1)) + 8 * (p & 1)));
    return __builtin_shufflevector(lo, hi, 0, 1, 2, 3, 4, 5, 6, 7);
}
__device__ __forceinline__ bf16x8 gb_frag(const LAS unsigned char* tile, int row, int ch) { return *(const LAS bf16x8*)(tile + (row * 8 + (ch ^ (row & 7))) * 16); }
template <int STAGE> __device__ __forceinline__ void glaB_step(const Frame& F, int b, int h, int d, int step, f32x4 (&S)[4], bf16* od) {
    const int lane = F.lane, n = lane & 15, kg = lane >> 4, sl = F.wave;
    if (step == 0) asm volatile("s_waitcnt vmcnt(6)" ::: "memory"); else if (step == 1) asm volatile("s_waitcnt vmcnt(10)" ::: "memory"); else asm volatile("s_waitcnt vmcnt(14)" ::: "memory");
    __builtin_amdgcn_s_barrier();
    asm volatile("" ::: "memory");
    glaB_issue<(STAGE + 2) % 3>(F, b, h, d, step + 2 < NCHUNK ? step + 2 : NCHUNK - 1);
    asm volatile("" ::: "memory");
    const int c = glaB_chunk(d, step);
    const int row0 = c < 4 ? NLAT + b * CTXL + c * 64 : b * SEQ + (c - 4) * 64;
    const LAS unsigned char* st = F.lds + STAGE * GB_STG;
    bf16x8 vf[2], qf[4][2], af[4][2], kf[4][2]; f32x4 dc[4];
#pragma unroll
    for (int T = 0; T < 2; ++T) vf[T] = gb_frag_tr<256>(st + 24576, lane, sl, T, swz_v);
#pragma unroll
    for (int I = 0; I < 4; ++I)
#pragma unroll
        for (int T = 0; T < 2; ++T) { qf[I][T] = gb_frag(st, 16 * I + n, 4 * T + kg); af[I][T] = gb_frag(st + 8192, 16 * I + n, 4 * T + kg); }
#pragma unroll
    for (int I = 0; I < 4; ++I)
#pragma unroll
        for (int T = 0; T < 2; ++T) kf[I][T] = gb_frag_tr<128>(st + 16384, lane, I, T, swz_k);
#pragma unroll
    for (int q = 0; q < 4; ++q) dc[q] = *(const LAS f32x4*)(st + 40960 + sl * 256 + (16 * q + 4 * kg) * 4);
    bf16x8 sb[2];
#pragma unroll
    for (int G2 = 0; G2 < 2; ++G2) { u32x4 sw; sw.x = pk2(S[2 * G2][0], S[2 * G2][1]); sw.y = pk2(S[2 * G2][2], S[2 * G2][3]); sw.z = pk2(S[2 * G2 + 1][0], S[2 * G2 + 1][1]); sw.w = pk2(S[2 * G2 + 1][2], S[2 * G2 + 1][3]); sb[G2] = __builtin_bit_cast(bf16x8, sw); }
    asm volatile("s_waitcnt lgkmcnt(0)" ::: "memory");
    f32x4 o[4];
#pragma unroll
    for (int I = 0; I < 4; ++I) o[I] = (f32x4){0.f, 0.f, 0.f, 0.f};
#pragma unroll
    for (int I = 0; I < 4; ++I) o[I] = MFMA16(sb[0], qf[I][0], o[I]);
#pragma unroll
    for (int I = 0; I < 4; ++I) o[I] = MFMA16(sb[1], qf[I][1], o[I]);
#pragma unroll
    for (int q = 0; q < 4; ++q) S[q] = MFMA16(kf[q][0], vf[0], S[q]);
#pragma unroll
    for (int I = 0; I < 4; ++I) o[I] = MFMA16(vf[0], af[I][0], o[I]);
#pragma unroll
    for (int q = 0; q < 4; ++q) S[q] = MFMA16(kf[q][1], vf[1], S[q]);
#pragma unroll
    for (int I = 0; I < 4; ++I) o[I] = MFMA16(vf[1], af[I][1], o[I]);
#pragma unroll
    for (int q = 0; q < 4; ++q) S[q] = S[q] * dc[q];
    u32x2 ow[4];
#pragma unroll
    for (int I = 0; I < 4; ++I) { ow[I].x = pk2(o[I][0], o[I][1]); ow[I].y = pk2(o[I][2], o[I][3]); }
    asm volatile("s_waitcnt lgkmcnt(0)" ::: "memory");
#pragma unroll
    for (int I = 0; I < 4; ++I) *(u32x2*)(od + (size_t)(row0 + 16 * I + n) * 512 + h * 128 + 16 * sl + 4 * kg) = ow[I];
    asm volatile("" ::: "memory");
}
__device__ __forceinline__ void glaB_group(const Frame& F, int cg) {
    const int d = cg & 1, h = (cg >> 1) & 3, b = cg >> 3;
    bf16* od = (bf16*)(F.ws + WS_U) + (size_t)d * NTOK * 512;
    f32x4 S[4];
#pragma unroll
    for (int q = 0; q < 4; ++q) S[q] = (f32x4){0.f, 0.f, 0.f, 0.f};
    asm volatile("s_waitcnt vmcnt(0) lgkmcnt(0)" ::: "memory");
    __builtin_amdgcn_s_barrier();
    asm volatile("" ::: "memory");
    glaB_issue<0>(F, b, h, d, 0); glaB_issue<1>(F, b, h, d, 1);
    asm volatile("" ::: "memory");
    for (int s0 = 0; s0 + 2 < NCHUNK; s0 += 3) { glaB_step<0>(F, b, h, d, s0, S, od); glaB_step<1>(F, b, h, d, s0 + 1, S, od); glaB_step<2>(F, b, h, d, s0 + 2, S, od); }
    glaB_step<0>(F, b, h, d, 66, S, od); glaB_step<1>(F, b, h, d, 67, S, od);
    static_assert(NCHUNK == 68, "tail of the step loop");
    asm volatile("s_waitcnt vmcnt(0)" ::: "memory");
    __builtin_amdgcn_s_barrier();
}
__device__ __forceinline__ void conv_moe_dynamic(const Frame& F0, int l) {
    Frame F = relaunder(F0);
    LAS float* scr = (LAS float*)(F.lds + F.wave * 16384);
    unsigned* ctr = (unsigned*)(F.ws + WS_CTL) + CW_WQ + l * 64;
    constexpr int I_13 = 16 * 32, I_2 = 8 * 32, NIT = NEXP * (I_13 + I_2), CH = 8;
    for (;;) {
        unsigned t0 = 0; if (F.lane == 0) t0 = atomicAdd(ctr, (unsigned)CH);
        const int it0 = __builtin_amdgcn_readfirstlane((int)t0);
        if (it0 >= NIT) break;
        for (int it = it0; it < it0 + CH && it < NIT; ++it) conv_moe_item(F, l, it, scr);
    }
}

__device__ __forceinline__ void ph_combine(const Frame& F0, int ie, int nrows) {
    Frame F = relaunder(F0);
    const int gw = F.vcu * 8 + F.wave, NGW = F.G * 8, lane = F.lane;
    const bf16* P = (const bf16*)(F.ws + WS_P); bf16* Q = (bf16*)(F.ws + WS_Q);
    const bf16* o0 = (const bf16*)(F.ws + WS_U); const bf16* o1 = o0 + (size_t)NTOK * 512;
    const float* nw = inptr(F, I_NORMW) + (size_t)ie * 512;
    const int col = 8 * lane;
    const f32x4 nwa = *(const f32x4*)(nw + col), nwb = *(const f32x4*)(nw + col + 4);
    for (int r0 = gw * 4; r0 < nrows; r0 += NGW * 4) {
        if (KO_MASK & 2) {
#pragma unroll
            for (int r = 0; r < 4; ++r) *(u32x4*)(Q + (size_t)(r0 + r) * D + 512 + col) = (u32x4){0u, 0u, 0u, 0u};
            continue; }
        u32x4 a[4], bq[4], rr[4];
#pragma unroll
        for (int r = 0; r < 4; ++r) { const size_t row = r0 + r; a[r] = *(const u32x4*)(o0 + row * 512 + col); bq[r] = *(const u32x4*)(o1 + row * 512 + col); rr[r] = *(const u32x4*)(P + row * EN + PC_RG + col); }
#pragma unroll
        for (int r = 0; r < 4; ++r) {
            const f32x4 xa = ubf_lo(a[r]) + ubf_lo(bq[r]), xb = ubf_hi(a[r]) + ubf_hi(bq[r]);
            float ss = (xa[0] * xa[0] + xa[1] * xa[1]) + (xa[2] * xa[2] + xa[3] * xa[3]) + (xb[0] * xb[0] + xb[1] * xb[1]) + (xb[2] * xb[2] + xb[3] * xb[3]);
            ss = row16_sum(ss);
            const float rinv = 1.0f / sqrtf(ss * (1.0f / 128.0f) + RMS_EPS);
            f32x4 ra = ubf_lo(rr[r]), rb = ubf_hi(rr[r]);
#pragma unroll
            for (int j = 0; j < 4; ++j) { ra[j] = fast_silu(ra[j]); rb[j] = fast_silu(rb[j]); }
            *(u32x4*)(Q + (size_t)(r0 + r) * D + 512 + col) = pack8(xa * rinv * nwa * ra, xb * rinv * nwb * rb); }
    }
}

#if defined(FP8_PROBE)
typedef int i32x8 __attribute__((ext_vector_type(8)));
__device__ __forceinline__ unsigned fp8_of_int(int v) { const int a = v < 0 ? -v : v; const unsigned c = a == 0 ? 0x00u : a == 1 ? 0x38u : a == 2 ? 0x40u : 0x44u; return v < 0 ? (c | 0x80u) : c; }
__device__ __forceinline__ int fp8_kidx(int kg, int e) { return FP8_PROBE == 1 ? 32 * kg + e : (e < 16 ? 16 * kg + e : 64 + 16 * kg + (e - 16)); }
__device__ __forceinline__ bool fp8_layout_test(int lane) {
    const int r = lane & 15, kg = lane >> 4;
    i32x8 a, b;
#pragma unroll
    for (int w = 0; w < 8; ++w) { unsigned aw = 0, bw = 0;
#pragma unroll
        for (int by = 0; by < 4; ++by) { const int k = fp8_kidx(kg, 4 * w + by);
            const int av = (k == (7 * r + 3) % 128) ? 1 : 0; const int bv = ((k * 5 + r * 3) % 7) - 3;
            aw |= fp8_of_int(av) << (8 * by); bw |= fp8_of_int(bv) << (8 * by); }
        a[w] = (int)aw; b[w] = (int)bw; }
    f32x4 c = (f32x4){0.f, 0.f, 0.f, 0.f};
    c = __builtin_amdgcn_mfma_scale_f32_16x16x128_f8f6f4(a, b, c, 0, 0, 0, 0, 0, 0);
    bool bad = false;
#pragma unroll
    for (int q = 0; q < 4; ++q) { const int i = 4 * kg + q; const int kk = (7 * i + 3) % 128; const float ex = (float)(((kk * 5 + r * 3) % 7) - 3); if (c[q] != ex) bad = true; }
    return __builtin_amdgcn_ballot_w64(bad) != 0ull;
}
#endif
struct Args { const float* in[25]; float* out; unsigned char* ws; int ph_lo, ph_hi; };
constexpr int NPHASE = 2 + 9 * DEPTH;

__global__ void __launch_bounds__(512, 2) fwd(Args args) {
    extern __shared__ __attribute__((aligned(16))) unsigned char lds_raw[];
    Frame F;
    F.lds = (LAS unsigned char*)lds_raw;
    F.tid = threadIdx.x; F.lane = F.tid & 63; F.wave = __builtin_amdgcn_readfirstlane(F.tid >> 6);
    F.G = gridDim.x; { const int bx = blockIdx.x; F.vcu = (F.G % 8 == 0) ? (bx % 8) * (F.G / 8) + bx / 8 : bx; }
    F.out = args.out; F.ws = args.ws;
    volatile LAS unsigned* MISC = (volatile LAS unsigned*)(F.lds + MISC_OFF);
    if (F.tid < 64) MISC[F.tid] = 0u;
    if (F.tid < 25) ((LAS unsigned long long*)(F.lds + MISC_OFF + 256))[F.tid] = (unsigned long long)args.in[F.tid];
    __syncthreads();
    const int lo = args.ph_lo, hi = args.ph_hi;
    const bool multi = (hi - lo) > 1;
    XcdBarrier bar; bar.bar = (unsigned*)(F.ws + WS_CTL) + CW_BAR; bar.x = 0; bar.st = MISC + 8;
    if (multi) bar = xcd_barrier_post((unsigned*)(F.ws + WS_CTL) + CW_BAR, MISC + 8);
#ifndef PH_SEL
#define PH_SEL 0xffffffff
#endif
#define IN(k) (lo <= (k) && (k) < hi)
#define SEL(b) ((PH_SEL >> (b)) & 1)
#ifndef DUP_MASK
#define DUP_MASK 0
#endif
#define REP(bit) for (int rep_ = 0; rep_ < ((DUP_MASK & (bit)) ? 2 : 1); ++rep_)
#define SEAM(k) do { if ((k) + 1 < hi) xcd_barrier(bar); } while (0)

    if (SEL(0) && IN(0)) { REP(64) { ph_ada(F); __syncthreads(); conv_dense_weights(F); __syncthreads(); } SEAM(0); }
    if (SEL(1) && IN(1)) { REP(64) { ph_u0(F); __syncthreads(); } SEAM(1); }

    for (int l = 0; l < DEPTH; ++l) {
        const int pb = 2 + 9 * l; const bool even = (l & 1) == 0; const int ie = l >> 1;
        const int m_in = (l < 3) ? NTOK : NLAT;
        const int m_out = (l < 2) ? NTOK : NLAT;
        if (SEL(2) && IN(pb + 0)) {
            REP(32) { if (even) {
                LinSched S; S.init(m_in, EN, 1024, F.G, (int)blockIdx.x);
                EpiEvenIn E{(bf16*)(F.ws + WS_P), (const float*)(F.ws + WS_ROPE)};
                pg8::gemm_phase(F.lds, (const char*)(F.ws + WS_U), (const char*)(F.ws + WS_WINE) + (size_t)ie * EN * 1024 * 2, 1024, S, E);
            } else {
                LinSched S; S.init(m_in, ON, 1024, F.G, (int)blockIdx.x);
                EpiOddIn E{(bf16*)(F.ws + WS_P)};
                pg8::gemm_phase(F.lds, (const char*)(F.ws + WS_U), (const char*)(F.ws + WS_WINO) + (size_t)ie * ON * 1024 * 2, 1024, S, E);
            } }
            SEAM(pb + 0);
        }
        if (SEL(3) && IN(pb + 1)) {
            if (even) {
                const Frame Fm = relaunder(F);
                const int nun = NB * 2 * 32 + (l == 0 ? NB * 2 * 2 : 0);
                REP(1) for (int u = Fm.vcu; u < nun; u += Fm.G) {
                    if (u < NB * 2 * 32) attn_unit(Fm, ie, u >> 6, (u >> 5) & 1, u & 31, false);
                    else { const int v = u - NB * 2 * 32; attn_unit(Fm, ie, v >> 2, (v >> 1) & 1, v & 1, true); }
                }
                __syncthreads();
                if (!(KO_MASK & 2)) REP(2) for (int u = Fm.vcu * 8 + Fm.wave; u < NB * NCHUNK * 8; u += Fm.G * 8) { if (u & 1) glaA_unit<1>(Fm, ie, u / (NCHUNK * 8), (u / 8) % NCHUNK, (u >> 1) & 3); else glaA_unit<0>(Fm, ie, u / (NCHUNK * 8), (u / 8) % NCHUNK, (u >> 1) & 3); }
                __syncthreads();
            } else {
                REP(16) { ph_conv(F, ie, m_out); __syncthreads(); }
            }
            if (!even) REP(8) { conv_moe_weights(F, l); __syncthreads(); }
            SEAM(pb + 1);
        }
        if (even) {
            if (SEL(4) && IN(pb + 2)) {
                { const Frame Fm = relaunder(F);
                  if (!(KO_MASK & 2)) REP(4) for (int cg = Fm.vcu; cg < 128; cg += Fm.G) glaB_group(Fm, cg);
                  __syncthreads();
                  conv_moe_dynamic(Fm, l); }
                SEAM(pb + 2);
            }
            if (SEL(5) && IN(pb + 3)) { REP(16) { ph_combine(F, ie, m_out); __syncthreads(); } SEAM(pb + 3); }
        }
        if (SEL(6) && IN(pb + 4)) {
            REP(32) { LinSched S; S.init(m_out, 1024, 1024, F.G, (int)blockIdx.x);
            EpiPlain E{(bf16*)(F.ws + WS_P), 1024};
            pg8::gemm_phase(F.lds, (const char*)(F.ws + WS_Q), (const char*)(F.ws + (even ? WS_WOUTE : WS_WOUTO)) + (size_t)ie * 1024 * 1024 * 2, 1024, S, E); }
            SEAM(pb + 4);
        }
        if (SEL(7) && IN(pb + 5)) { if (DUP_MASK & 128) { ph_ln1(F, l, m_out, true); __syncthreads(); } ph_ln1(F, l, m_out); SEAM(pb + 5); }
        if (SEL(8) && IN(pb + 6)) {
            if (!(KO_MASK & 8)) REP(32) {
                moe_tables(F.lds, (const unsigned*)(F.ws + WS_CTL) + CW_CNT + l * 64);
                MoeSched<1> S; S.T = moe_tab(F.lds); S.rowtok = (const int*)(F.ws + WS_ROWTOK); S.G = F.G; S.c = F.vcu; S.bstride = (size_t)256 * 1024; S.estride = (size_t)1024 * 1024;
                EpiG1 E{(unsigned char*)(F.ws + WS_Q), 1.0f / W8_SCALE};
                pg8::gemm_phase<EpiG1, MoeSched<1>, 1>(F.lds, (const char*)(F.ws + WS_U8), (const char*)(F.ws + WS_W13), 1024, S, E);
            }
            SEAM(pb + 6);
        }
        if (SEL(9) && IN(pb + 7)) {
            if (!(KO_MASK & 8)) REP(32) {
                moe_tables(F.lds, (const unsigned*)(F.ws + WS_CTL) + CW_CNT + l * 64);
                MoeSched<0> S; S.T = moe_tab(F.lds); S.rowtok = nullptr; S.G = F.G; S.c = F.vcu; S.bstride = (size_t)256 * 512; S.estride = (size_t)1024 * 512;
                EpiPlainS E{(bf16*)(F.ws + WS_P), 1024, 1.0f / W8_SCALE};
                pg8::gemm_phase<EpiPlainS, MoeSched<0>, 1>(F.lds, (const char*)(F.ws + WS_Q), (const char*)(F.ws + WS_W2), 512, S, E);
            }
            SEAM(pb + 7);
        }
        if (SEL(10) && IN(pb + 8)) {
            moe_tables(F.lds, (const unsigned*)(F.ws + WS_CTL) + CW_CNT + l * 64);
            if (DUP_MASK & 256) { ph_ln2(F, l, m_out, true); __syncthreads(); }
            ph_ln2(F, l, m_out);
            SEAM(pb + 8);
        }
    }
#if defined(FP8_PROBE)
    if (blockIdx.x == 0) { __syncthreads(); if (F.tid < 64) { const bool bad = fp8_layout_test(F.tid); if (bad && F.tid == 0) F.out[0] = __builtin_nanf(""); } }
#endif
#undef IN
#undef SEAM
}

extern "C" void kernel_launch(void* const* d_in, const int* in_sizes, int n_in, void* d_out, int out_size, void* d_ws, size_t ws_size, hipStream_t stream) {
    static int grid = 0;
    if (grid == 0) {
        if (n_in != 25 || in_sizes[0] != NLAT * D || out_size != NLAT * D || ws_size < WS_END) { fprintf(stderr, "kernel_launch: unexpected shapes (n_in %d in0 %d out %d ws %zu)\n", n_in, n_in > 0 ? in_sizes[0] : -1, out_size, ws_size); grid = -1; return; }
        int dev = 0, cus = 0, per_cu = 0;
        if (hipGetDevice(&dev) != hipSuccess || hipDeviceGetAttribute(&cus, hipDeviceAttributeMultiprocessorCount, dev) != hipSuccess) { grid = -1; return; }
        if (hipFuncSetAttribute((const void*)fwd, hipFuncAttributeMaxDynamicSharedMemorySize, LDS_BYTES) != hipSuccess) { fprintf(stderr, "kernel_launch: hipFuncSetAttribute failed\n"); grid = -1; return; }
        if (hipOccupancyMaxActiveBlocksPerMultiprocessor(&per_cu, (const void*)fwd, 512, LDS_BYTES) != hipSuccess || per_cu < 1) fprintf(stderr, "kernel_launch: occupancy query says %d\n", per_cu);
        (void)hipGetLastError();
        grid = cus;
        if (grid < 242 || grid > 1024) { fprintf(stderr, "kernel_launch: built for a 256-CU device (got %d CUs)\n", cus); grid = -1; return; }
    }
    if (grid < 0) return;
    if (hipMemsetAsync((char*)d_ws + WS_CTL, 0, CTL_BYTES, stream) != hipSuccess) return;
    Args a{};
    for (int i = 0; i < 25; ++i) a.in[i] = (const float*)d_in[i];
    a.out = (float*)d_out; a.ws = (unsigned char*)d_ws;
#if N_LAUNCH_MODE == 1
    a.ph_lo = 0; a.ph_hi = NPHASE;
    hipLaunchKernelGGL(fwd, dim3(grid), dim3(512), LDS_BYTES, stream, a);
#else
    for (int k = 0; k < NPHASE; ++k) {
        if (k >= 2) { const int l = (k - 2) / 9, s = (k - 2) % 9; if ((l & 1) && (s == 2 || s == 3)) continue; }
        a.ph_lo = k; a.ph_hi = k + 1;
        hipLaunchKernelGGL(fwd, dim3(grid), dim3(512), LDS_BYTES, stream, a);
    }
#endif
}
```

```cpp
#include <hip/hip_runtime.h>
#define N_LAUNCH_MODE 1
#define KO_MASK 0
#define DUP_MASK 0
#include <cstdio>
#include <cstdint>

#ifndef KO_MASK
#define KO_MASK 0
#endif
#ifndef N_LAUNCH_MODE
#define N_LAUNCH_MODE 1
#endif

#define GAS __attribute__((address_space(1)))
#define LAS __attribute__((address_space(3)))
typedef unsigned short bf16;
typedef short bf16x8 __attribute__((ext_vector_type(8)));
typedef short s16x4 __attribute__((ext_vector_type(4)));
typedef float f32x2 __attribute__((ext_vector_type(2)));
typedef float f32x4 __attribute__((ext_vector_type(4)));
typedef float f32x16 __attribute__((ext_vector_type(16)));
typedef unsigned u32x2 __attribute__((ext_vector_type(2)));
typedef unsigned u32x4 __attribute__((ext_vector_type(4)));
typedef __bf16 bf16x2_t __attribute__((ext_vector_type(2)));
typedef int i32x8 __attribute__((ext_vector_type(8)));
typedef int i32x4_t __attribute__((ext_vector_type(4)));

constexpr int D = 1024, NB = 16, SEQ = 4096, CTXL = 256, DEPTH = 4;
constexpr int NLAT = NB * SEQ, NCTX = NB * CTXL, NTOK = NLAT + NCTX;
constexpr int EVEN_IN = 2336, EN = 2560, ON = 3072;
constexpr int NEXP = 32, DEXP = 512;
constexpr int SLOT_ROWS = 2 * NTOK + NEXP * 256;
constexpr float DN_ALPHA = 1.6817928305074290f;
constexpr float LN_EPS = 1e-5f, RMS_EPS = 1e-6f;
constexpr float LOG2E = 1.4426950408889634f;
constexpr int PC_Q = 0, PC_K = 512, PC_V = 640, PC_QG = 768, PC_KG = 1024, PC_VG = 1280, PC_RG = 1792, PC_GG = 2304;
constexpr int NCHUNK = 68;

constexpr size_t MiB = 1u << 20;
constexpr size_t WS_CTL = 0, CTL_BYTES = 1 * MiB;
constexpr size_t WS_MOD = 1 * MiB;
constexpr size_t WS_ROPE = 3 * MiB;
constexpr size_t WS_TOKINFO = 4 * MiB;
constexpr size_t WS_ROWTOK = 7 * MiB;
constexpr size_t WS_WINE = 16 * MiB, WS_WOUTE = 26 * MiB, WS_WINO = 30 * MiB, WS_WOUTO = 42 * MiB;
constexpr size_t WS_W13 = 46 * MiB, WS_W2 = 110 * MiB;
constexpr size_t WS_HCTX = 142 * MiB;
constexpr size_t WS_U = 158 * MiB;
constexpr size_t WS_P = 294 * MiB;
constexpr size_t WS_Q = 634 * MiB;
constexpr size_t WS_GATT = 778 * MiB, WS_GQIN = 846 * MiB, WS_GKST = 914 * MiB, WS_GVT = 982 * MiB, WS_GDEC = 1050 * MiB;
constexpr size_t WS_U8 = 1053 * MiB;
constexpr size_t WS_END = 1121 * MiB;
constexpr int CW_BAR = 4096;
constexpr int CW_CNT = 16384;
constexpr int CW_WQ = 20480;

constexpr int RING_BYTES = 131072;
constexpr int LDSX_OFF = RING_BYTES;
constexpr int MISC_OFF = LDSX_OFF + 8192;
constexpr int LDS_BYTES = 147456;

__device__ __forceinline__ unsigned pk2(float a, float b) { bf16x2_t r = __builtin_convertvector((f32x2){a, b}, bf16x2_t); return __builtin_bit_cast(unsigned, r); }
__device__ __forceinline__ unsigned pk4_fp8(float a, float b, float c, float d) { int r = __builtin_amdgcn_cvt_pk_fp8_f32(a, b, 0, false); r = __builtin_amdgcn_cvt_pk_fp8_f32(c, d, r, true); return (unsigned)r; }
__device__ __forceinline__ float bf2f(unsigned short h) { return __uint_as_float(((unsigned)h) << 16); }
__device__ __forceinline__ float bflo(unsigned w) { return __uint_as_float(w << 16); }
__device__ __forceinline__ float bfhi(unsigned w) { return __uint_as_float(w & 0xffff0000u); }
template <int CTRL> __device__ __forceinline__ float dppf(float v) { return __builtin_bit_cast(float, __builtin_amdgcn_update_dpp(0, __builtin_bit_cast(int, v), CTRL, 0xf, 0xf, false)); }
__device__ __forceinline__ float row16_sum(float v) { v += dppf<0xB1>(v); v += dppf<0x4E>(v); v += dppf<0x141>(v); v += dppf<0x140>(v); return v; }
__device__ __forceinline__ float wave_sum(float v) {
    v = row16_sum(v);
    const float s0 = __builtin_bit_cast(float, __builtin_amdgcn_readlane(__builtin_bit_cast(int, v), 0)), s1 = __builtin_bit_cast(float, __builtin_amdgcn_readlane(__builtin_bit_cast(int, v), 16));
    const float s2 = __builtin_bit_cast(float, __builtin_amdgcn_readlane(__builtin_bit_cast(int, v), 32)), s3 = __builtin_bit_cast(float, __builtin_amdgcn_readlane(__builtin_bit_cast(int, v), 48));
    return (s0 + s1) + (s2 + s3);
}
__device__ __forceinline__ float fast_silu(float x) { return x * __builtin_amdgcn_rcpf(1.0f + __builtin_amdgcn_exp2f(-x * LOG2E)); }

#define XB_TMO      128
#define XB_XCNT(j)  (256  + 64 * (j))
#define XB_XSUB(j)  (1280 + 64 * (j))
#define XB_XGEN(j)  (2304 + 64 * (j))
#define XB_TOP      3328
#define XB_TOPGEN   3392
#define XCD_BAR_WORDS 3456
#define XB_SPIN_CAP (1u << 22)
__device__ __forceinline__ unsigned xb_ld(unsigned* p)              { return __hip_atomic_load(p, __ATOMIC_RELAXED, __HIP_MEMORY_SCOPE_AGENT); }
__device__ __forceinline__ unsigned xb_add(unsigned* p, unsigned v) { return __hip_atomic_fetch_add(p, v, __ATOMIC_RELAXED, __HIP_MEMORY_SCOPE_AGENT); }
__device__ __forceinline__ unsigned xb_xcc_id() { return (unsigned)__builtin_amdgcn_s_getreg((3 << 11) | 20) & 0xFu; }
#define XB_SPIN(cond, bar) do { unsigned _sp = 0; while (cond) { __builtin_amdgcn_s_sleep(1); \
    if ((++_sp & 255u) == 0u) { if (xb_ld(&(bar)[XB_TMO])) break; if (_sp > XB_SPIN_CAP) { atomicAdd(&(bar)[XB_TMO], 1u); break; } } } } while (0)
struct XcdBarrier { unsigned* bar; unsigned x; volatile LAS unsigned* st; };
__device__ __forceinline__ XcdBarrier xcd_barrier_post(unsigned* bar, volatile LAS unsigned* st) {
    XcdBarrier b; b.bar = bar; b.x = xb_xcc_id(); b.st = st;
    if (threadIdx.x == 0) (void)xb_add(&bar[XB_XCNT(b.x)], 1u);
    return b;
}
__device__ __forceinline__ void xcd_barrier_complete(unsigned* bar, unsigned x, unsigned& nloc, unsigned& nx) {
    const unsigned G = gridDim.x * gridDim.y * gridDim.z;
    unsigned sum, cnt, mine, sp = 0u;
    for (;;) {
        sum = 0u; cnt = 0u; mine = 0u;
#pragma unroll
        for (unsigned j = 0; j < 16; ++j) { const unsigned c = xb_ld(&bar[XB_XCNT(j)]); sum += c; cnt += (c > 0u) ? 1u : 0u; mine = (j == x) ? c : mine; }
        if (sum == G) break;
        __builtin_amdgcn_s_sleep(1);
        if ((++sp & 255u) == 0u) { if (xb_ld(&bar[XB_TMO])) break; if (sp > XB_SPIN_CAP) { atomicAdd(&bar[XB_TMO], 1u); break; } }
    }
    nloc = mine > 0u ? mine : 1u; nx = cnt > 0u ? cnt : 1u;
}
__device__ __forceinline__ void xcd_barrier(const XcdBarrier& b) {
    asm volatile("s_waitcnt vmcnt(0)" ::: "memory");
    __syncthreads();
    if (threadIdx.x == 0) {
        unsigned* bar = b.bar;
        __builtin_amdgcn_s_waitcnt(0);
        unsigned nloc = b.st[0], nx = b.st[1];
        if (nloc == 0u) { xcd_barrier_complete(bar, b.x, nloc, nx); b.st[0] = nloc; b.st[1] = nx; }
        const unsigned old = xb_add(&bar[XB_XSUB(b.x)], 1u);
        const unsigned gen = old / nloc;
        if (old + 1u == (gen + 1u) * nloc) {
            __builtin_amdgcn_fence(__ATOMIC_RELEASE, "agent");
            asm volatile("s_waitcnt vmcnt(0)" ::: "memory");
            const unsigned og = xb_add(&bar[XB_TOP], 1u);
            const unsigned tg = og / nx;
            if (og + 1u == (tg + 1u) * nx) xb_add(&bar[XB_TOPGEN], 1u);
            else XB_SPIN(xb_ld(&bar[XB_TOPGEN]) == tg, bar);
            __builtin_amdgcn_fence(__ATOMIC_ACQUIRE, "agent");
            xb_add(&bar[XB_XGEN(b.x)], 1u);
            asm volatile("s_waitcnt vmcnt(0)" ::: "memory");
        } else {
            XB_SPIN(xb_ld(&bar[XB_XGEN(b.x)]) == gen, bar);
            __builtin_amdgcn_fence(__ATOMIC_ACQUIRE, "agent");
            asm volatile("s_waitcnt vmcnt(0)" ::: "memory");
        }
    }
    __syncthreads();
}

namespace pg8 {
constexpr int BM = 256, BK = 64, HALF = 128, HTB = HALF * BK * 2, STAGE_BYTES = 8 * HTB;
__device__ __forceinline__ int lds_byte(int r, int c) { const int st = (r >> 4) * 2 + (c >> 5), rr = r & 15, cc = c & 31, ob = rr * 64 + cc * 2; return st * 1024 + (ob ^ (((ob >> 9) & 1) << 5)); }
__device__ __forceinline__ void stage_rc(int b, int& R, int& C) { const int st = b / 1024, sb = b % 1024, swz = sb ^ (((sb >> 9) & 1) << 5); R = (st >> 1) * 16 + swz / 64; C = (st & 1) * 32 + (swz % 64) / 2; }
__device__ __forceinline__ int perm32(int rho) { const int n = rho >> 4, i = rho & 15; return 8 * (i >> 2) + 4 * n + (i & 3); }

struct Unit { int pn; int orow0; int mt; int e; };

template <class Epi, class Sched, int FP8 = 0>
__device__ __forceinline__ void gemm_phase(LAS unsigned char* lds, const char* Abase, const char* Bbase, const int K, const Sched& S, const Epi& E) {
    int tid_ = threadIdx.x; asm volatile("" : "+v"(tid_));
    const int tid = tid_, wid = __builtin_amdgcn_readfirstlane(tid >> 6), lane = tid & 63, wr = wid >> 2, wc = wid & 3, fr = lane & 15, fq = lane >> 4;
    const unsigned K2 = FP8 ? (unsigned)K : (unsigned)K * 2u;
    const int nt = (int)(K2 / 128u);
    int Rr[2], Cc[2]; unsigned voffB[2];
#pragma unroll
    for (int i = 0; i < 2; ++i) { stage_rc(tid * 16 + i * 8192, Rr[i], Cc[i]); const int Rb = (Rr[i] & ~31) + perm32(Rr[i] & 31); voffB[i] = (unsigned)Rb * K2 + (unsigned)Cc[i] * 2u; }
    const size_t kstep = (size_t)(BK * 2);
    const size_t hstep = (size_t)HALF * K2;
    const unsigned ldsw = (unsigned)wid * 1024u;
    const int aoff = FP8 ? lds_byte(wr * 64 + fr, 32 * (fq >> 1) + 16 * (fq & 1)) : lds_byte(wr * 64 + fr, fq * 8), boff = FP8 ? lds_byte(wc * 32 + fr, 32 * (fq >> 1) + 16 * (fq & 1)) : lds_byte(wc * 32 + fr, fq * 8);
#define PG8_SA(b, h) (((b) * 2 + (h)) * HTB)
#define PG8_SB(b, h) ((4 + (b) * 2 + (h)) * HTB)
#define PG8_STAGE(bufoff, gbase, voff) do { _Pragma("unroll") for (int _i = 0; _i < 2; ++_i) \
        __builtin_amdgcn_global_load_lds((const unsigned*)((const char*)(gbase) + (voff)[_i]), (LAS unsigned*)(lds + (bufoff) + ldsw + _i * 8192), 16, 0, 0); } while (0)
#define PG8_LD8(ptr) __builtin_shufflevector(*(const LAS i32x4_t*)(ptr), *(const LAS i32x4_t*)((ptr) + 16), 0, 1, 2, 3, 4, 5, 6, 7)
#define PG8_LDA(dst, b, h) do { if constexpr (FP8) { _Pragma("unroll") for (int m = 0; m < 4; ++m) dst##8[m] = PG8_LD8(lds + PG8_SA(b, h) + aoff + m * 2048); } \
        else { _Pragma("unroll") for (int m = 0; m < 4; ++m) _Pragma("unroll") for (int k = 0; k < 2; ++k) dst[m][k] = *(const LAS bf16x8*)(lds + PG8_SA(b, h) + aoff + m * 2048 + k * 1024); } } while (0)
#define PG8_LDB(dst, b, h) do { if constexpr (FP8) { _Pragma("unroll") for (int n = 0; n < 2; ++n) dst##8[n] = PG8_LD8(lds + PG8_SB(b, h) + boff + n * 2048); } \
        else { _Pragma("unroll") for (int n = 0; n < 2; ++n) _Pragma("unroll") for (int k = 0; k < 2; ++k) dst[n][k] = *(const LAS bf16x8*)(lds + PG8_SB(b, h) + boff + n * 2048 + k * 1024); } } while (0)
#define PG8_MMA(ai, bj, At, Bt) do { __builtin_amdgcn_s_setprio(1); _Pragma("unroll") for (int m = 0; m < 4; ++m) _Pragma("unroll") for (int n = 0; n < 2; ++n) { \
        if constexpr (FP8) asm volatile("v_mfma_f32_16x16x128_f8f6f4 %0, %1, %2, %0" : "+v"(acc[ai][bj][m][n]) : "v"(Bt##8[n]), "v"(At##8[m])); \
        else { _Pragma("unroll") for (int k = 0; k < 2; ++k) acc[ai][bj][m][n] = __builtin_amdgcn_mfma_f32_16x16x32_bf16(Bt[n][k], At[m][k], acc[ai][bj][m][n], 0, 0, 0); } } \
        __builtin_amdgcn_s_setprio(0); } while (0)
#define PG8_WAIT_V(n) asm volatile("s_waitcnt vmcnt(" #n ")" ::: "memory")
#define PG8_WAIT_L(n) asm volatile("s_waitcnt lgkmcnt(" #n ")" ::: "memory")
#define PG8_BAR __builtin_amdgcn_s_barrier()
#define PG8_SCHED __builtin_amdgcn_sched_barrier(0)
    Unit cur, nxt; int ui = 0;
    if (!S.next(0, cur)) return;
    f32x4 acc[2][2][4][2];
#pragma unroll
    for (int a = 0; a < 2; ++a)
#pragma unroll
        for (int b = 0; b < 2; ++b)
#pragma unroll
            for (int m = 0; m < 4; ++m)
#pragma unroll
                for (int n = 0; n < 2; ++n) { if constexpr (FP8) asm volatile("v_mov_b32 %0, 0\n\tv_mov_b32 %1, 0\n\tv_mov_b32 %2, 0\n\tv_mov_b32 %3, 0" : "=v"(acc[a][b][m][n][0]), "=v"(acc[a][b][m][n][1]), "=v"(acc[a][b][m][n][2]), "=v"(acc[a][b][m][n][3])); else acc[a][b][m][n] = (f32x4){0.f, 0.f, 0.f, 0.f}; }
    if constexpr (FP8) asm volatile("s_nop 7" ::: "memory");
    bf16x8 At[4][2], B0[2][2], B1[2][2];
    i32x8 At8[4], B08[2], B18[2];
    unsigned vAc0[2], vAc1[2], vAn0[2], vAn1[2];
#pragma unroll
    for (int i = 0; i < 2; ++i) { vAc0[i] = (unsigned)S.arow(cur, Rr[i]) * K2 + (unsigned)Cc[i] * 2u; vAc1[i] = (unsigned)S.arow(cur, HALF + Rr[i]) * K2 + (unsigned)Cc[i] * 2u; vAn0[i] = vAc0[i]; vAn1[i] = vAc1[i]; }
    const char* cB = Bbase + S.boff(cur);
    PG8_STAGE(PG8_SB(0, 0), cB, voffB); PG8_STAGE(PG8_SB(0, 1), cB + hstep, voffB); PG8_STAGE(PG8_SA(0, 0), Abase, vAc0); PG8_STAGE(PG8_SA(0, 1), Abase, vAc1);
    if (wr == 1) PG8_BAR;
    PG8_WAIT_V(2); PG8_BAR;
    PG8_STAGE(PG8_SB(1, 0), cB + kstep, voffB); PG8_STAGE(PG8_SA(1, 0), Abase + kstep, vAc0); PG8_STAGE(PG8_SB(1, 1), cB + hstep + kstep, voffB);
    PG8_WAIT_V(6); PG8_BAR;
    for (;;) {
        const bool has_next = S.next(ui + 1, nxt);
        const char* nB = has_next ? Bbase + S.boff(nxt) : cB;
        if (has_next) {
#pragma unroll
            for (int i = 0; i < 2; ++i) { vAn0[i] = (unsigned)S.arow(nxt, Rr[i]) * K2 + (unsigned)Cc[i] * 2u; vAn1[i] = (unsigned)S.arow(nxt, HALF + Rr[i]) * K2 + (unsigned)Cc[i] * 2u; }
        } else {
#pragma unroll
            for (int i = 0; i < 2; ++i) { vAn0[i] = vAc0[i]; vAn1[i] = vAc1[i]; }
        }
        for (int t = 0; t < nt; t += 2) {
            const bool last = (t == nt - 2);
            const char* a1 = Abase + (size_t)(t + 1) * kstep;
            const char* a2 = last ? Abase : Abase + (size_t)(t + 2) * kstep; const char* b2 = last ? nB : cB + (size_t)(t + 2) * kstep;
            const char* a3 = a2 + kstep; const char* b3 = b2 + kstep;
            unsigned v20[2], v21[2];
#pragma unroll
            for (int i = 0; i < 2; ++i) { v20[i] = last ? vAn0[i] : vAc0[i]; v21[i] = last ? vAn1[i] : vAc1[i]; }
            PG8_LDB(B0, 0, 0); PG8_LDB(B1, 0, 1); PG8_SCHED; PG8_LDA(At, 0, 0); PG8_STAGE(PG8_SA(1, 1), a1, vAc1);
            PG8_WAIT_V(8); PG8_WAIT_L(0); PG8_BAR; PG8_MMA(0, 0, At, B0); PG8_MMA(0, 1, At, B1); PG8_BAR; PG8_SCHED;
            PG8_LDA(At, 0, 1); PG8_STAGE(PG8_SB(0, 0), b2, voffB); PG8_STAGE(PG8_SB(0, 1), b2 + hstep, voffB); PG8_STAGE(PG8_SA(0, 0), a2, v20);
            PG8_WAIT_V(8); PG8_WAIT_L(0); PG8_BAR; PG8_MMA(1, 0, At, B0); PG8_MMA(1, 1, At, B1); PG8_BAR; PG8_SCHED;
            PG8_LDB(B0, 1, 0); PG8_LDB(B1, 1, 1); PG8_SCHED; PG8_LDA(At, 1, 0); PG8_STAGE(PG8_SA(0, 1), a2, v21);
            PG8_WAIT_V(8); PG8_WAIT_L(0); PG8_BAR; PG8_MMA(0, 0, At, B0); PG8_MMA(0, 1, At, B1); PG8_BAR; PG8_SCHED;
            PG8_LDA(At, 1, 1); PG8_STAGE(PG8_SB(1, 0), b3, voffB); PG8_STAGE(PG8_SB(1, 1), b3 + hstep, voffB); PG8_STAGE(PG8_SA(1, 0), a3, v20);
            PG8_WAIT_V(8); PG8_WAIT_L(0); PG8_BAR; PG8_MMA(1, 0, At, B0); PG8_MMA(1, 1, At, B1); PG8_BAR; PG8_SCHED;
        }
        if (wr == 0) PG8_BAR;
        if constexpr (FP8) asm volatile("s_nop 15\n\ts_nop 15" ::: "memory");
        E(acc, cur, wr, wc, fr, fq);
        if (!has_next) break;
#pragma unroll
        for (int a = 0; a < 2; ++a)
#pragma unroll
            for (int b = 0; b < 2; ++b)
#pragma unroll
                for (int m = 0; m < 4; ++m)
#pragma unroll
                    for (int n = 0; n < 2; ++n) { if constexpr (FP8) asm volatile("v_mov_b32 %0, 0\n\tv_mov_b32 %1, 0\n\tv_mov_b32 %2, 0\n\tv_mov_b32 %3, 0" : "=v"(acc[a][b][m][n][0]), "=v"(acc[a][b][m][n][1]), "=v"(acc[a][b][m][n][2]), "=v"(acc[a][b][m][n][3])); else acc[a][b][m][n] = (f32x4){0.f, 0.f, 0.f, 0.f}; }
        if constexpr (FP8) asm volatile("s_nop 7" ::: "memory");
        cur = nxt; cB = nB; ++ui;
#pragma unroll
        for (int i = 0; i < 2; ++i) { vAc0[i] = vAn0[i]; vAc1[i] = vAn1[i]; }
        if (wr == 1) PG8_BAR;
    }
    PG8_WAIT_V(0);
    PG8_BAR;
#undef PG8_SA
#undef PG8_SB
#undef PG8_STAGE
#undef PG8_LDA
#undef PG8_LDB
#undef PG8_MMA
#undef PG8_WAIT_V
#undef PG8_WAIT_L
#undef PG8_BAR
#undef PG8_SCHED
}
}
struct LinSched {
    int nM, nN, nwg, G, c; size_t bstride;
    __device__ __forceinline__ void init(int M, int N, int K, int G_, int c_) { nM = M / 256; nN = N / 256; nwg = nM * nN; G = G_; c = c_; bstride = (size_t)256 * K * 2; }
    __device__ __forceinline__ bool next(int i, pg8::Unit& u) const {
        const long L = (long)i * G + c; if (L >= nwg) return false;
        int wgid = (int)L; { const int q = nwg / 8, r = nwg % 8, xcd = wgid % 8, off = wgid / 8; wgid = (xcd < r ? xcd * (q + 1) : r * (q + 1) + (xcd - r) * q) + off; }
        const int nig = 8 * nN, gid = wgid / nig, fm = gid * 8, gsz = (nM - fm) < 8 ? (nM - fm) : 8;
        u.mt = fm + ((wgid % nig) % gsz); u.pn = (wgid % nig) / gsz; u.orow0 = u.mt * 256; u.e = 0; return true;
    }
    __device__ __forceinline__ int arow(const pg8::Unit& u, int lr) const { return u.orow0 + lr; }
    __device__ __forceinline__ size_t boff(const pg8::Unit& u) const { return (size_t)u.pn * bstride; }
};
struct MoeTab { LAS int* ts; LAS int* cnt; LAS unsigned char* tile_e; };
__device__ __forceinline__ MoeTab moe_tab(LAS unsigned char* lds) { MoeTab t; t.ts = (LAS int*)(lds + LDSX_OFF); t.cnt = (LAS int*)(lds + LDSX_OFF + 256); t.tile_e = (LAS unsigned char*)(lds + LDSX_OFF + 512); return t; }
__device__ __forceinline__ void moe_tables(LAS unsigned char* lds, const unsigned* gcnt) {
    MoeTab T = moe_tab(lds);
    __syncthreads();
    if (threadIdx.x == 0) { int s = 0; for (int e = 0; e < NEXP; ++e) { const int c = (int)gcnt[e]; T.cnt[e] = c; T.ts[e] = s; s += (c + 255) >> 8; } T.ts[NEXP] = s; }
    __syncthreads();
    const int nt = T.ts[NEXP];
    for (int mt = threadIdx.x; mt < nt; mt += blockDim.x) { int e = 0; for (int j = 1; j < NEXP; ++j) e += (mt >= T.ts[j]) ? 1 : 0; T.tile_e[mt] = (unsigned char)e; }
    __syncthreads();
}
template <int GATHER> struct MoeSched {
    MoeTab T; const int* rowtok; int G, c; size_t bstride; size_t estride;
    __device__ __forceinline__ bool next(int i, pg8::Unit& u) const {
        const int L = i * G + c; const int nt = T.ts[NEXP]; if (L >= nt * 4) return false;
        u.mt = L >> 2; u.pn = L & 3; u.orow0 = u.mt * 256; u.e = (int)T.tile_e[u.mt]; return true;
    }
    __device__ __forceinline__ int arow(const pg8::Unit& u, int lr) const {
        if (GATHER) { const int idx = (u.mt - T.ts[u.e]) * 256 + lr; return idx < T.cnt[u.e] ? rowtok[(size_t)u.e * NTOK + idx] : 0; }
        return u.orow0 + lr;
    }
    __device__ __forceinline__ size_t boff(const pg8::Unit& u) const { return (size_t)u.e * estride + (size_t)u.pn * bstride; }
};

__device__ __forceinline__ u32x4 pack8(const f32x4 a, const f32x4 b) { u32x4 w; w.x = pk2(a[0], a[1]); w.y = pk2(a[2], a[3]); w.z = pk2(b[0], b[1]); w.w = pk2(b[2], b[3]); return w; }
struct EpiPlain {
    bf16* O; int ldc;
    __device__ __forceinline__ void operator()(const f32x4 (&acc)[2][2][4][2], const pg8::Unit& u, int wr, int wc, int fr, int fq) const {
        const int row0 = u.orow0 + wr * 64 + fr, col0 = u.pn * 256 + wc * 32 + 8 * fq;
#pragma unroll
        for (int ai = 0; ai < 2; ++ai)
#pragma unroll
            for (int m = 0; m < 4; ++m) { bf16* rowp = O + (size_t)(row0 + ai * 128 + m * 16) * ldc + col0;
#pragma unroll
                for (int bj = 0; bj < 2; ++bj) *(u32x4*)(rowp + bj * 128) = pack8(acc[ai][bj][m][0], acc[ai][bj][m][1]); }
    }
};
struct EpiPlainS {
    bf16* O; int ldc; float sc;
    __device__ __forceinline__ void operator()(const f32x4 (&acc)[2][2][4][2], const pg8::Unit& u, int wr, int wc, int fr, int fq) const {
        const int row0 = u.orow0 + wr * 64 + fr, col0 = u.pn * 256 + wc * 32 + 8 * fq;
#pragma unroll
        for (int ai = 0; ai < 2; ++ai)
#pragma unroll
            for (int m = 0; m < 4; ++m) { bf16* rowp = O + (size_t)(row0 + ai * 128 + m * 16) * ldc + col0;
#pragma unroll
                for (int bj = 0; bj < 2; ++bj) *(u32x4*)(rowp + bj * 128) = pack8(acc[ai][bj][m][0] * sc, acc[ai][bj][m][1] * sc); }
    }
};
struct EpiEvenIn {
    bf16* O; const float* rope;
    __device__ __forceinline__ void operator()(const f32x4 (&acc)[2][2][4][2], const pg8::Unit& u, int wr, int wc, int fr, int fq) const {
        const int row0 = u.orow0 + wr * 64 + fr, col0 = u.pn * 256 + wc * 32 + 8 * fq;
        const bool lat = u.orow0 < NLAT;
#pragma unroll
        for (int ai = 0; ai < 2; ++ai)
#pragma unroll
            for (int m = 0; m < 4; ++m) { const int row = row0 + ai * 128 + m * 16; bf16* rowp = O + (size_t)row * EN + col0;
                const int s = row & (SEQ - 1); const int pos = (wc & 1) ? (s & 63) : (s >> 6);
#pragma unroll
                for (int bj = 0; bj < 2; ++bj) { f32x4 v0 = acc[ai][bj][m][0], v1 = acc[ai][bj][m][1];
                    const bool rp = lat && (u.pn < 2 || (u.pn == 2 && bj == 0));
                    if (rp) { const f32x4 c = *(const f32x4*)(rope + pos * 16 + 4 * fq), sn = *(const f32x4*)(rope + 1024 + pos * 16 + 4 * fq);
                        const f32x4 o1 = v0 * c - v1 * sn, o2 = v1 * c + v0 * sn; v0 = o1; v1 = o2; }
                    *(u32x4*)(rowp + bj * 128) = pack8(v0, v1); } }
    }
};
struct EpiOddIn {
    bf16* O;
    __device__ __forceinline__ void operator()(const f32x4 (&acc)[2][2][4][2], const pg8::Unit& u, int wr, int wc, int fr, int fq) const {
        const int row0 = u.orow0 + wr * 64 + fr;
#pragma unroll
        for (int ai = 0; ai < 2; ++ai)
#pragma unroll
            for (int m = 0; m < 4; ++m) { bf16* rowp = O + (size_t)(row0 + ai * 128 + m * 16) * 2048;
                if (u.pn < 4) {
#pragma unroll
                    for (int bj = 0; bj < 2; ++bj) *(u32x4*)(rowp + u.pn * 256 + bj * 128 + wc * 32 + 8 * fq) = pack8(acc[ai][bj][m][0], acc[ai][bj][m][1]);
                } else {
                    *(u32x4*)(rowp + 1024 + (u.pn - 4) * 128 + wc * 32 + 8 * fq) = pack8(acc[ai][0][m][0] * acc[ai][1][m][0], acc[ai][0][m][1] * acc[ai][1][m][1]);
                } }
    }
};
struct EpiG1 {
    unsigned char* O; float sc;
    __device__ __forceinline__ void operator()(const f32x4 (&acc)[2][2][4][2], const pg8::Unit& u, int wr, int wc, int fr, int fq) const {
        const int row0 = u.orow0 + wr * 64 + fr, col0 = u.pn * 128 + wc * 32 + 8 * fq;
#pragma unroll
        for (int ai = 0; ai < 2; ++ai)
#pragma unroll
            for (int m = 0; m < 4; ++m) { unsigned char* rowp = O + (size_t)(row0 + ai * 128 + m * 16) * DEXP + col0;
                f32x4 a0 = acc[ai][0][m][0] * sc, a1 = acc[ai][0][m][1] * sc;
#pragma unroll
                for (int j = 0; j < 4; ++j) { a0[j] = fast_silu(a0[j]); a1[j] = fast_silu(a1[j]); }
                const f32x4 h0 = a0 * (acc[ai][1][m][0] * sc), h1v = a1 * (acc[ai][1][m][1] * sc);
                *(u32x2*)rowp = (u32x2){pk4_fp8(h0[0], h0[1], h0[2], h0[3]), pk4_fp8(h1v[0], h1v[1], h1v[2], h1v[3])}; }
    }
};
struct Frame {
    LAS unsigned char* lds;
    int tid, lane, wave, vcu, G;
    float* out; unsigned char* ws;
};
__device__ __forceinline__ const float* inptr(const Frame& F, int i) {
    const unsigned long long v = ((const LAS unsigned long long*)(F.lds + MISC_OFF + 256))[i];
    const unsigned lo = __builtin_amdgcn_readfirstlane((unsigned)v), hi = __builtin_amdgcn_readfirstlane((unsigned)(v >> 32));
    return (const float*)(((unsigned long long)hi << 32) | lo);
}
enum { I_X = 0, I_C, I_CTX, I_CCTX, I_WINE, I_WOUTE, I_SINK, I_WA2, I_BA, I_NORMW, I_WINO, I_CONVW, I_CONVB, I_WOUTO, I_ADAW, I_ADAB, I_LNW, I_LNB, I_WG, I_BG, I_WE, I_BE, I_W1, I_W3, I_W2 };
__device__ __forceinline__ int launder_v(int x) { asm volatile("" : "+v"(x)); return x; }
__device__ __forceinline__ int launder_s(int x) { asm volatile("" : "+s"(x)); return x; }
__device__ __forceinline__ Frame relaunder(const Frame& F0) { Frame F = F0; F.tid = launder_v(F0.tid); F.lane = F.tid & 63; F.wave = __builtin_amdgcn_readfirstlane(F.tid >> 6); F.vcu = launder_s(F0.vcu); return F; }
__device__ __forceinline__ const float* modp(const Frame& F, int l, int bi, int n) { return (const float*)(F.ws + WS_MOD) + ((size_t)(l * 17 + bi) * 6 + n) * D; }
__device__ __forceinline__ int row_bi(int row) { return row < NLAT ? (row >> 12) : 16; }

__device__ __forceinline__ void sincos_d(double a, float& c, float& s) {
    const double TWO_OVER_PI = 0.63661977236758134308, PIO2_HI = 1.57079632679489655800e+00, PIO2_LO = 6.12323399573676603587e-17;
    const double n = __builtin_rint(a * TWO_OVER_PI); double r = (a - n * PIO2_HI) - n * PIO2_LO; const double r2 = r * r;
    double sp = -1.0 / 1307674368000.0; sp = sp * r2 + 1.0 / 6227020800.0; sp = sp * r2 - 1.0 / 39916800.0; sp = sp * r2 + 1.0 / 362880.0; sp = sp * r2 - 1.0 / 5040.0; sp = sp * r2 + 1.0 / 120.0; sp = sp * r2 - 1.0 / 6.0; sp = sp * r2 + 1.0; sp *= r;
    double cp = 1.0 / 20922789888000.0; cp = cp * r2 - 1.0 / 87178291200.0; cp = cp * r2 + 1.0 / 479001600.0; cp = cp * r2 - 1.0 / 3628800.0; cp = cp * r2 + 1.0 / 40320.0; cp = cp * r2 - 1.0 / 720.0; cp = cp * r2 + 1.0 / 24.0; cp = cp * r2 - 0.5; cp = cp * r2 + 1.0;
    const int q = ((int)n) & 3;
    const double sv = (q == 0) ? sp : (q == 1) ? cp : (q == 2) ? -sp : -cp;
    const double cv = (q == 0) ? cp : (q == 1) ? -sp : (q == 2) ? -cp : sp;
    c = (float)cv; s = (float)sv;
}
__device__ __forceinline__ void ph_ada(const Frame& F0) {
    Frame F = relaunder(F0);
    LAS float* sl = (LAS float*)F.lds;
    LAS float* red = (LAS float*)(F.lds + 17 * 1024 * 4);
    for (int idx = F.tid; idx < 17 * 1024; idx += 512) { const int bi = idx >> 10, k = idx & 1023; const float c = bi < 16 ? inptr(F, I_C)[bi * 1024 + k] : inptr(F, I_CCTX)[k]; sl[idx] = c / (1.0f + expf(-c)); }
    __syncthreads();
    for (int it = F.vcu; it < 4 * 96; it += F.G) {
        const int l = it / 96, n0 = (it % 96) * 64;
        const float* W = inptr(F, I_ADAW) + (size_t)l * 1024 * 6144 + n0 + F.lane;
        float acc[17];
#pragma unroll
        for (int b = 0; b < 17; ++b) acc[b] = 0.f;
        const int kb = F.wave * 128;
        for (int k = kb; k < kb + 128; k += 4) {
            const float w0 = W[(size_t)k * 6144], w1 = W[(size_t)(k + 1) * 6144], w2 = W[(size_t)(k + 2) * 6144], w3 = W[(size_t)(k + 3) * 6144];
#pragma unroll
            for (int b = 0; b < 17; ++b) { const f32x4 s = *(const LAS f32x4*)(sl + b * 1024 + k); acc[b] += s[0] * w0 + s[1] * w1 + s[2] * w2 + s[3] * w3; }
        }
#pragma unroll
        for (int b = 0; b < 17; ++b) red[(F.wave * 17 + b) * 64 + F.lane] = acc[b];
        __syncthreads();
        for (int idx = F.tid; idx < 17 * 64; idx += 512) { const int b = idx >> 6, ln = idx & 63; float s = 0.f;
#pragma unroll
            for (int w = 0; w < 8; ++w) s += red[(w * 17 + b) * 64 + ln];
            ((float*)(F.ws + WS_MOD))[(size_t)(l * 17 + b) * 6144 + n0 + ln] = s + inptr(F, I_ADAB)[l * 6144 + n0 + ln]; }
        __syncthreads();
    }
    if (F.vcu == F.G - 1) {
        float* rope = (float*)(F.ws + WS_ROPE);
        for (int idx = F.tid; idx < 1024; idx += 512) { const int pos = idx >> 4, f = idx & 15;
            const double base4[4] = {1.0, 0.56234132519034908, 0.31622776601683794, 0.17782794100389228};
            double inv = (f & 3) == 0 ? base4[0] : (f & 3) == 1 ? base4[1] : (f & 3) == 2 ? base4[2] : base4[3];
            const int a = f >> 2; inv *= (a == 0) ? 1.0 : (a == 1) ? 0.1 : (a == 2) ? 0.01 : 0.001;
            float c, s; sincos_d((double)pos * inv, c, s); rope[idx] = c; rope[1024 + idx] = s; }
    }
}

__device__ __forceinline__ void tr_item(const float* W, int srcN, int K, bf16* WT, int drow0, int k0, int srccol, LAS float* scr, int lane) {
    float v[32];
    const float* p = W + (size_t)(k0 + (lane >> 5)) * srcN + (srccol >= 0 ? srccol : 0);
#pragma unroll
    for (int i = 0; i < 32; ++i) v[i] = __builtin_nontemporal_load(p + (size_t)(2 * i) * srcN);
#pragma unroll
    for (int i = 0; i < 32; ++i) scr[(2 * i + (lane >> 5)) * 33 + (lane & 31)] = srccol >= 0 ? v[i] : 0.f;
    asm volatile("s_waitcnt lgkmcnt(0)" ::: "memory");
    const int c = lane & 7;
#pragma unroll
    for (int j = 0; j < 4; ++j) { const int n = (lane >> 3) + 8 * j; const LAS float* s = scr + (8 * c) * 33 + n;
        u32x4 o; o.x = pk2(s[0 * 33], s[1 * 33]); o.y = pk2(s[2 * 33], s[3 * 33]); o.z = pk2(s[4 * 33], s[5 * 33]); o.w = pk2(s[6 * 33], s[7 * 33]);
        *(u32x4*)(WT + (size_t)(drow0 + n) * K + k0 + 8 * c) = o; }
    asm volatile("s_waitcnt lgkmcnt(0)" ::: "memory");
}
__device__ __forceinline__ void tr_item8(const float* W, int srcN, int K, unsigned char* WT, int drow0, int k0, int srccol, float scale, LAS float* scr, int lane) {
    float v[32];
    const float* p = W + (size_t)(k0 + (lane >> 5)) * srcN + srccol;
#pragma unroll
    for (int i = 0; i < 32; ++i) v[i] = __builtin_nontemporal_load(p + (size_t)(2 * i) * srcN);
#pragma unroll
    for (int i = 0; i < 32; ++i) scr[(2 * i + (lane >> 5)) * 33 + (lane & 31)] = v[i] * scale;
    asm volatile("s_waitcnt lgkmcnt(0)" ::: "memory");
    const int c = lane & 3;
#pragma unroll
    for (int j = 0; j < 2; ++j) { const int n = (lane >> 2) + 16 * j; const LAS float* s = scr + (16 * c) * 33 + n;
        u32x4 o; o.x = pk4_fp8(s[0 * 33], s[1 * 33], s[2 * 33], s[3 * 33]); o.y = pk4_fp8(s[4 * 33], s[5 * 33], s[6 * 33], s[7 * 33]);
        o.z = pk4_fp8(s[8 * 33], s[9 * 33], s[10 * 33], s[11 * 33]); o.w = pk4_fp8(s[12 * 33], s[13 * 33], s[14 * 33], s[15 * 33]);
        *(u32x4*)(WT + (size_t)(drow0 + n) * K + k0 + 16 * c) = o; }
    asm volatile("s_waitcnt lgkmcnt(0)" ::: "memory");
}
__device__ __forceinline__ int even_srccol(int j) {
    if (j < 640) { const int hb = j & ~63, p = j & 63, g = p >> 3, e = p & 7; return hb + (g >> 2) * 32 + (e >> 2) * 16 + (g & 3) * 4 + (e & 3); }
    return j < EVEN_IN ? j : -1;
}
__device__ __forceinline__ int odd_srccol(int j) { const int t = j >> 8, r = j & 255; if (t < 4) return j; return (r < 128 ? 1024 : 2048 - 128) + 128 * (t - 4) + r; }
__device__ __forceinline__ void conv_dense_weights(const Frame& F0) {
    Frame F = relaunder(F0);
    LAS float* scr = (LAS float*)(F.lds + F.wave * 16384);
    const int gw = F.vcu * 8 + F.wave, NGW = F.G * 8;
    constexpr int I_EI = 16 * 80, I_SQ = 16 * 32, I_OI = 16 * 96;
    constexpr int NIT = 2 * (I_EI + I_SQ + I_OI + I_SQ);
    for (int it = gw; it < NIT; it += NGW) {
        int r = it; const int i = r & 1; r >>= 1;
        if (r < I_EI) { const int kb = r / 80, nb = r % 80; tr_item(inptr(F, I_WINE) + (size_t)i * 1024 * EVEN_IN, EVEN_IN, 1024, (bf16*)(F.ws + WS_WINE) + (size_t)i * EN * 1024, nb * 32, kb * 64, even_srccol(nb * 32 + (F.lane & 31)), scr, F.lane); continue; } r -= I_EI;
        if (r < I_SQ) { const int kb = r / 32, nb = r % 32; tr_item(inptr(F, I_WOUTE) + (size_t)i * 1024 * 1024, 1024, 1024, (bf16*)(F.ws + WS_WOUTE) + (size_t)i * 1024 * 1024, nb * 32, kb * 64, nb * 32 + (F.lane & 31), scr, F.lane); continue; } r -= I_SQ;
        if (r < I_OI) { const int kb = r / 96, nb = r % 96; tr_item(inptr(F, I_WINO) + (size_t)i * 1024 * ON, ON, 1024, (bf16*)(F.ws + WS_WINO) + (size_t)i * ON * 1024, nb * 32, kb * 64, odd_srccol(nb * 32 + (F.lane & 31)), scr, F.lane); continue; } r -= I_OI;
        { const int kb = r / 32, nb = r % 32; tr_item(inptr(F, I_WOUTO) + (size_t)i * 1024 * 1024, 1024, 1024, (bf16*)(F.ws + WS_WOUTO) + (size_t)i * 1024 * 1024, nb * 32, kb * 64, nb * 32 + (F.lane & 31), scr, F.lane); }
    }
}
constexpr float W8_SCALE = 64.0f;
__device__ __forceinline__ void conv_moe_item(const Frame& F, int l, int it, LAS float* scr) {
    constexpr int I_13 = 16 * 32, I_2 = 8 * 32;
    const int e = it / (I_13 + I_2); int r = it % (I_13 + I_2);
    const size_t eoff = ((size_t)l * NEXP + e) * 1024 * 512;
    if (r < I_13) { const int kb = r / 32, nb = r % 32; const int j0 = nb * 32, t = j0 >> 8, rr = j0 & 255;
        const float* src = (rr < 128 ? inptr(F, I_W1) : inptr(F, I_W3)) + eoff;
        tr_item8(src, 512, 1024, (unsigned char*)(F.ws + WS_W13) + (size_t)e * 1024 * 1024, j0, kb * 64, 128 * t + (rr & 127) + (F.lane & 31), W8_SCALE, scr, F.lane);
    } else { r -= I_13; const int kb = r / 32, nb = r % 32;
        tr_item8(inptr(F, I_W2) + eoff, 1024, 512, (unsigned char*)(F.ws + WS_W2) + (size_t)e * 1024 * 512, nb * 32, kb * 64, nb * 32 + (F.lane & 31), W8_SCALE, scr, F.lane); }
}
__device__ __forceinline__ void conv_moe_weights(const Frame& F0, int l) {
    Frame F = relaunder(F0); const int gw = F.vcu * 8 + F.wave, NGW = F.G * 8;
    LAS float* scr = (LAS float*)(F.lds + F.wave * 16384);
    for (int it = gw; it < NEXP * (16 * 32 + 8 * 32); it += NGW) conv_moe_item(F, l, it, scr);
}
__device__ __forceinline__ void ph_u0(const Frame& F0) {
    Frame F = relaunder(F0);
    const int gw = F.vcu * 8 + F.wave, NGW = F.G * 8;
    for (int r0 = gw * 4; r0 < NTOK; r0 += NGW * 4) {
        const int bi = row_bi(r0); const float* sh = modp(F, 0, bi, 0); const float* sc = modp(F, 0, bi, 1);
        f32x4 x[4][4];
#pragma unroll
        for (int r = 0; r < 4; ++r) { const int row = r0 + r; const float* src = row < NLAT ? inptr(F, I_X) + (size_t)row * D : inptr(F, I_CTX) + (size_t)(row - NLAT) * D;
#pragma unroll
            for (int j = 0; j < 4; ++j) x[r][j] = *(const f32x4*)(src + 4 * F.lane + 256 * j); }
#pragma unroll
        for (int j = 0; j < 4; ++j) { const int c = 4 * F.lane + 256 * j; const f32x4 a = *(const f32x4*)(sh + c), s = *(const f32x4*)(sc + c);
#pragma unroll
            for (int r = 0; r < 4; ++r) { const f32x4 u = x[r][j] * (1.0f + s) + a; u32x2 w; w.x = pk2(u[0], u[1]); w.y = pk2(u[2], u[3]); *(u32x2*)((bf16*)(F.ws + WS_U) + (size_t)(r0 + r) * D + c) = w; } }
    }
}

struct RowLN { f32x4 v[4]; };
__device__ __forceinline__ void ln_stats(f32x4 (&z)[4], float& mean, float& rstd) {
    float s = 0.f;
#pragma unroll
    for (int j = 0; j < 4; ++j) s += (z[j][0] + z[j][1]) + (z[j][2] + z[j][3]);
    mean = wave_sum(s) * (1.0f / D); float q = 0.f;
#pragma unroll
    for (int j = 0; j < 4; ++j) { z[j] = z[j] - mean; q += (z[j][0] * z[j][0] + z[j][1] * z[j][1]) + (z[j][2] * z[j][2] + z[j][3] * z[j][3]); }
    rstd = 1.0f / sqrtf(wave_sum(q) * (1.0f / D) + LN_EPS);
}
__device__ __forceinline__ void ln_rows(f32x4 (&z)[4], const float* lw, const float* lb, int lane) {
    float s = 0.f;
#pragma unroll
    for (int j = 0; j < 4; ++j) s += (z[j][0] + z[j][1]) + (z[j][2] + z[j][3]);
    const float mean = wave_sum(s) * (1.0f / D); float q = 0.f;
#pragma unroll
    for (int j = 0; j < 4; ++j) { z[j] = z[j] - mean; q += (z[j][0] * z[j][0] + z[j][1] * z[j][1]) + (z[j][2] * z[j][2] + z[j][3] * z[j][3]); }
    const float rstd = 1.0f / sqrtf(wave_sum(q) * (1.0f / D) + LN_EPS);
#pragma unroll
    for (int j = 0; j < 4; ++j) { const int c = 4 * lane + 256 * j; z[j] = z[j] * rstd * *(const f32x4*)(lw + c) + *(const f32x4*)(lb + c); }
}
__device__ __forceinline__ void ph_ln1(const Frame& F0, int l, int nrows, bool dry = false) {
    Frame F = relaunder(F0);
    LAS unsigned char* Thi = F.lds; LAS unsigned char* Tlo = F.lds + 33024;
    LAS float* red = (LAS float*)(F.lds + 66048);
    LAS float* lgt = (LAS float*)(F.lds + 82432);
    LAS int* lcnt = (LAS int*)(F.lds + 87552); LAS int* lbase = lcnt + 32;
    LAS unsigned* list = (LAS unsigned*)(F.lds + 87808);
    LAS float* LW = (LAS float*)(F.lds + 97024); LAS float* LB = LW + 1024; LAS float* WG = LB + 1024;
    const int lane = F.lane, w = F.wave;
    if (F.tid < 64) lcnt[F.tid] = 0;
    { const float* lwg = inptr(F, I_LNW) + (size_t)(l * 2 + 0) * D; const float* lbg = inptr(F, I_LNB) + (size_t)(l * 2 + 0) * D; const float* wgg = inptr(F, I_WG) + (size_t)l * 1024 * 4;
      for (int i = F.tid; i < 256; i += 512) { *(LAS f32x4*)(LW + 4 * i) = *(const f32x4*)(lwg + 4 * i); *(LAS f32x4*)(LB + 4 * i) = *(const f32x4*)(lbg + 4 * i); }
      for (int i = F.tid; i < 1024; i += 512) *(LAS f32x4*)(WG + 4 * i) = *(const f32x4*)(wgg + 4 * i); }
    bf16x8 Whi[2][4], Wlo[2][4];
    {
        const int n = lane & 15, kg = lane >> 4;
        const float* we = inptr(F, I_WE) + (size_t)l * 1024 * 32 + (size_t)(w * 128 + kg * 8) * 32 + n;
#pragma unroll
        for (int nt = 0; nt < 2; ++nt)
#pragma unroll
            for (int ks = 0; ks < 4; ++ks) { u32x4 hi, lo; unsigned hh[8], ll[8];
                const float* p = we + ks * 32 * 32 + nt * 16;
                asm volatile("" : "+v"(p));
#pragma unroll
                for (int j = 0; j < 8; ++j) {
                    const float v = p[j * 32];
                    const unsigned h = pk2(v, 0.f) & 0xffffu; const float r = v - __uint_as_float(h << 16); hh[j] = h; ll[j] = pk2(r, 0.f) & 0xffffu; }
                hi.x = hh[0] | (hh[1] << 16); hi.y = hh[2] | (hh[3] << 16); hi.z = hh[4] | (hh[5] << 16); hi.w = hh[6] | (hh[7] << 16);
                lo.x = ll[0] | (ll[1] << 16); lo.y = ll[2] | (ll[3] << 16); lo.z = ll[4] | (ll[5] << 16); lo.w = ll[6] | (ll[7] << 16);
                Whi[nt][ks] = __builtin_bit_cast(bf16x8, hi); Wlo[nt][ks] = __builtin_bit_cast(bf16x8, lo); }
    }
    const bf16* Y = (const bf16*)(F.ws + WS_P);
    const float* hsl = (l == 0 ? inptr(F, I_X) : F.out); const float* hsc = (l == 0 ? inptr(F, I_CTX) : (const float*)(F.ws + WS_HCTX));
    const float* bgp = inptr(F, I_BG) + l * 4; const float* bep = inptr(F, I_BE) + l * 32;
    const bool usey = !((l & 1) ? (KO_MASK & 4) : ((KO_MASK & 3) == 3));
    const int nbatch = nrows / 16; int nlist = 0; int prev_rbase = -1;
#define LN1_ROUTE(buf_, rbase_, slot_) do { if (F.tid < 16) { const int tk = F.tid; const LAS float* lg = lgt + (buf_) * 640 + tk * 40; \
        float gl[4]; _Pragma("unroll") for (int j = 0; j < 4; ++j) gl[j] = lg[32 + j] + bgp[j]; \
        float gmax = gl[0]; int g = 0; _Pragma("unroll") for (int j = 1; j < 4; ++j) if (gl[j] > gmax) { gmax = gl[j]; g = j; } \
        float den = 0.f; _Pragma("unroll") for (int j = 0; j < 4; ++j) den += expf(gl[j] - gmax); \
        const float pg = 1.0f / den; float el[8]; _Pragma("unroll") for (int j = 0; j < 8; ++j) el[j] = lg[g * 8 + j] + bep[g * 8 + j]; \
        float m0 = el[0]; int i0 = 0; _Pragma("unroll") for (int j = 1; j < 8; ++j) if (el[j] > m0) { m0 = el[j]; i0 = j; } \
        float m1 = -3.0e38f; int i1 = 0; _Pragma("unroll") for (int j = 0; j < 8; ++j) if (j != i0 && el[j] > m1) { m1 = el[j]; i1 = j; } \
        const float ex = expf(m1 - m0); const float w0 = pg / (1.0f + ex), w1 = pg * ex / (1.0f + ex); \
        const int e0 = g * 8 + i0, e1 = g * 8 + i1; \
        const int p0 = atomicAdd((int*)&lcnt[e0], 1), p1 = atomicAdd((int*)&lcnt[e1], 1); \
        LAS unsigned* L = list + ((slot_) * 16 + tk) * 8; \
        L[0] = (unsigned)((rbase_) + tk); L[1] = (unsigned)e0; L[2] = (unsigned)p0; L[3] = __float_as_uint(w0); L[4] = (unsigned)e1; L[5] = (unsigned)p1; L[6] = __float_as_uint(w1); } } while (0)
    __syncthreads();
    for (int bt = F.vcu; bt < nbatch; bt += F.G) {
        const int rbase = bt * 16; const int bi = row_bi(rbase);
        const float* g2 = modp(F, l, bi, 2); const float* sh = modp(F, l, bi, 3); const float* sc = modp(F, l, bi, 4);
        {
            f32x4 hv[2][4], gv[4], scv[4], shv[4]; u32x2 yv[2][4];
#pragma unroll
            for (int rr = 0; rr < 2; ++rr) { const int row = rbase + 2 * w + rr; const float* hs = row < NLAT ? hsl + (size_t)row * D : hsc + (size_t)(row - NLAT) * D;
#pragma unroll
                for (int j = 0; j < 4; ++j) { const int c = 4 * lane + 256 * j; hv[rr][j] = __builtin_nontemporal_load((const f32x4*)(hs + c)); yv[rr][j] = usey ? __builtin_nontemporal_load((const u32x2*)(Y + (size_t)row * D + c)) : (u32x2){0u, 0u}; } }
#pragma unroll
            for (int j = 0; j < 4; ++j) { const int c = 4 * lane + 256 * j; gv[j] = *(const f32x4*)(g2 + c); scv[j] = *(const f32x4*)(sc + c); shv[j] = *(const f32x4*)(sh + c); }
            f32x4 z[2][4]; float mean[2], rstd[2];
#pragma unroll
            for (int rr = 0; rr < 2; ++rr)
#pragma unroll
                for (int j = 0; j < 4; ++j) z[rr][j] = DN_ALPHA * hv[rr][j] + gv[j] * (f32x4){bflo(yv[rr][j].x), bfhi(yv[rr][j].x), bflo(yv[rr][j].y), bfhi(yv[rr][j].y)};
#pragma unroll
            for (int rr = 0; rr < 2; ++rr) ln_stats(z[rr], mean[rr], rstd[rr]);
            f32x4 ga[2] = {(f32x4){0.f, 0.f, 0.f, 0.f}, (f32x4){0.f, 0.f, 0.f, 0.f}};
#pragma unroll
            for (int j = 0; j < 4; ++j) { const int c = 4 * lane + 256 * j;
                const f32x4 lwv = *(const LAS f32x4*)(LW + c), lbv = *(const LAS f32x4*)(LB + c);
                const f32x4 g0 = *(const LAS f32x4*)(WG + 4 * c), g1 = *(const LAS f32x4*)(WG + 4 * c + 4), g2v = *(const LAS f32x4*)(WG + 4 * c + 8), g3 = *(const LAS f32x4*)(WG + 4 * c + 12);
#pragma unroll
                for (int rr = 0; rr < 2; ++rr) { const int lr = 2 * w + rr, row = rbase + lr;
                    float* hd = dry ? (float*)(F.ws + WS_GATT) + (size_t)row * D : (row < NLAT ? F.out + (size_t)row * D : (float*)(F.ws + WS_HCTX) + (size_t)(row - NLAT) * D);
                    const f32x4 zn = z[rr][j] * rstd[rr] * lwv + lbv;
                    __builtin_nontemporal_store(zn, (f32x4*)(hd + c));
                    const f32x4 t = zn * (1.0f + scv[j]) + shv[j];
                    ga[rr] += t[0] * g0 + t[1] * g1 + t[2] * g2v + t[3] * g3;
                    const unsigned h01 = pk2(t[0], t[1]), h23 = pk2(t[2], t[3]);
                    u32x2 hw; hw.x = h01; hw.y = h23;
                    *(unsigned*)((unsigned char*)(F.ws + (dry ? WS_Q : WS_U8)) + (size_t)row * D + c) = pk4_fp8(t[0], t[1], t[2], t[3]);
                    const float r0 = t[0] - bflo(h01), r1 = t[1] - bfhi(h01), r2 = t[2] - bflo(h23), r3 = t[3] - bfhi(h23);
                    u32x2 lw2; lw2.x = pk2(r0, r1); lw2.y = pk2(r2, r3);
                    *(LAS u32x2*)(Thi + lr * 2064 + c * 2) = hw; *(LAS u32x2*)(Tlo + lr * 2064 + c * 2) = lw2; } }
#pragma unroll
            for (int rr = 0; rr < 2; ++rr) { const float q0 = wave_sum(ga[rr][0]), q1 = wave_sum(ga[rr][1]), q2 = wave_sum(ga[rr][2]), q3 = wave_sum(ga[rr][3]);
                if (lane == 0) *(LAS f32x4*)(lgt + (nlist & 1) * 640 + (2 * w + rr) * 40 + 32) = (f32x4){q0, q1, q2, q3}; }
        }
        __syncthreads();
        if (prev_rbase >= 0) LN1_ROUTE((nlist - 1) & 1, prev_rbase, nlist - 1);
        {
            f32x4 acc[2];
#pragma unroll
            for (int nt = 0; nt < 2; ++nt) acc[nt] = (f32x4){0.f, 0.f, 0.f, 0.f};
            const int tk = lane & 15, kg = lane >> 4;
#pragma unroll
            for (int ks = 0; ks < 4; ++ks) {
                const bf16x8 ah = *(const LAS bf16x8*)(Thi + tk * 2064 + (w * 128 + ks * 32 + kg * 8) * 2), al = *(const LAS bf16x8*)(Tlo + tk * 2064 + (w * 128 + ks * 32 + kg * 8) * 2);
#pragma unroll
                for (int nt = 0; nt < 2; ++nt) { acc[nt] = __builtin_amdgcn_mfma_f32_16x16x32_bf16(Whi[nt][ks], ah, acc[nt], 0, 0, 0);
                    acc[nt] = __builtin_amdgcn_mfma_f32_16x16x32_bf16(Wlo[nt][ks], ah, acc[nt], 0, 0, 0); acc[nt] = __builtin_amdgcn_mfma_f32_16x16x32_bf16(Whi[nt][ks], al, acc[nt], 0, 0, 0); }
            }
#pragma unroll
            for (int nt = 0; nt < 2; ++nt) *(LAS f32x4*)(red + (w * 16 + tk) * 32 + nt * 16 + 4 * kg) = acc[nt];
        }
        __syncthreads();
        { const int tk = F.tid & 15, n = F.tid >> 4; float s = 0.f;
#pragma unroll
            for (int ww = 0; ww < 8; ++ww) s += red[(ww * 16 + tk) * 32 + n];
            lgt[(nlist & 1) * 640 + tk * 40 + n] = s; }
        prev_rbase = rbase; ++nlist;
    }
    __syncthreads();
    if (prev_rbase >= 0) LN1_ROUTE((nlist - 1) & 1, prev_rbase, nlist - 1);
#undef LN1_ROUTE
    __syncthreads();
    if (F.tid < 32) lbase[F.tid] = (int)atomicAdd((unsigned*)(F.ws + WS_CTL) + CW_CNT + l * 64 + (dry ? 32 : 0) + F.tid, (unsigned)lcnt[F.tid]);
    __syncthreads();
    if (!dry) for (int idx = F.tid; idx < nlist * 16; idx += 512) {
        const LAS unsigned* L = list + idx * 8; const unsigned row = L[0], e0 = L[1], e1 = L[4]; const unsigned p0 = L[2] + (unsigned)lbase[e0], p1 = L[5] + (unsigned)lbase[e1];
        u32x4 a; a.x = e0; a.y = p0; a.z = L[3]; a.w = e1; u32x4 b; b.x = p1; b.y = L[6]; b.z = 0u; b.w = 0u;
        unsigned* ti = (unsigned*)(F.ws + WS_TOKINFO) + (size_t)row * 8; *(u32x4*)ti = a; *(u32x4*)(ti + 4) = b;
        int* rt = (int*)(F.ws + WS_ROWTOK); rt[(size_t)e0 * NTOK + p0] = (int)row; rt[(size_t)e1 * NTOK + p1] = (int)row;
    }
}

__device__ __forceinline__ void ph_ln2(const Frame& F0, int l, int nrows, bool dry = false) {
    Frame F = relaunder(F0);
    MoeTab T = moe_tab(F.lds);
    const int gw = F.vcu * 8 + F.wave, NGW = F.G * 8, lane = F.lane;
    const float* lw = inptr(F, I_LNW) + (size_t)(l * 2 + 1) * D; const float* lb = inptr(F, I_LNB) + (size_t)(l * 2 + 1) * D;
    const bf16* O2 = (const bf16*)(F.ws + WS_P);
    for (int r0 = gw * 4; r0 < nrows; r0 += NGW * 4) {
        const int bi = row_bi(r0);
        const float* g5 = modp(F, l, bi, 5);
        f32x4 z[4][4]; u32x2 ya[4][4], yb[4][4]; float w0[4], w1[4];
#pragma unroll
        for (int r = 0; r < 4; ++r) { const int row = r0 + r;
            const unsigned* ti = (const unsigned*)(F.ws + WS_TOKINFO) + (size_t)row * 8;
            const u32x4 a = __builtin_nontemporal_load((const u32x4*)ti); const u32x2 b = __builtin_nontemporal_load((const u32x2*)(ti + 4));
            const size_t s0 = (size_t)T.ts[a.x] * 256 + a.y, s1 = (size_t)T.ts[a.w] * 256 + b.x; w0[r] = __uint_as_float(a.z); w1[r] = __uint_as_float(b.y);
            const float* hd = row < NLAT ? F.out + (size_t)row * D : (const float*)(F.ws + WS_HCTX) + (size_t)(row - NLAT) * D;
#pragma unroll
            for (int j = 0; j < 4; ++j) { const int c = 4 * lane + 256 * j; z[r][j] = __builtin_nontemporal_load((const f32x4*)(hd + c));
                if (!(KO_MASK & 8)) { ya[r][j] = __builtin_nontemporal_load((const u32x2*)(O2 + s0 * D + c)); yb[r][j] = __builtin_nontemporal_load((const u32x2*)(O2 + s1 * D + c)); } } }
#pragma unroll
        for (int j = 0; j < 4; ++j) { const f32x4 g = *(const f32x4*)(g5 + 4 * lane + 256 * j);
#pragma unroll
            for (int r = 0; r < 4; ++r) { f32x4 y = (f32x4){0.f, 0.f, 0.f, 0.f};
                if (!(KO_MASK & 8)) y = w0[r] * (f32x4){bflo(ya[r][j].x), bfhi(ya[r][j].x), bflo(ya[r][j].y), bfhi(ya[r][j].y)} + w1[r] * (f32x4){bflo(yb[r][j].x), bfhi(yb[r][j].x), bflo(yb[r][j].y), bfhi(yb[r][j].y)};
                z[r][j] = DN_ALPHA * z[r][j] + g * y; } }
        float mean[4], rstd[4];
#pragma unroll
        for (int r = 0; r < 4; ++r) ln_stats(z[r], mean[r], rstd[r]);
        const bool lat = r0 < NLAT;
        const bool wu = (l < 3) && (lat || l < 2);
        const float* sh = modp(F, l < 3 ? l + 1 : l, bi, 0); const float* sc = modp(F, l < 3 ? l + 1 : l, bi, 1);
#pragma unroll
        for (int j = 0; j < 4; ++j) { const int c = 4 * lane + 256 * j;
            const f32x4 lwv = *(const f32x4*)(lw + c), lbv = *(const f32x4*)(lb + c), scv = *(const f32x4*)(sc + c), shv = *(const f32x4*)(sh + c);
#pragma unroll
            for (int r = 0; r < 4; ++r) { const int row = r0 + r;
                float* hd = dry ? (float*)(F.ws + WS_GATT) + (size_t)row * D : (lat ? F.out + (size_t)row * D : (float*)(F.ws + WS_HCTX) + (size_t)(row - NLAT) * D);
                const f32x4 zn = z[r][j] * rstd[r] * lwv + lbv; __builtin_nontemporal_store(zn, (f32x4*)(hd + c));
                if (wu) { const f32x4 u = zn * (1.0f + scv) + shv; u32x2 hw; hw.x = pk2(u[0], u[1]); hw.y = pk2(u[2], u[3]); *(u32x2*)((bf16*)(F.ws + (dry ? WS_Q : WS_U)) + (size_t)row * D + c) = hw; } } }
    }
}

__device__ __forceinline__ f32x4 ubf_lo(const u32x4 v) { return (f32x4){bflo(v.x), bfhi(v.x), bflo(v.y), bfhi(v.y)}; }
__device__ __forceinline__ f32x4 ubf_hi(const u32x4 v) { return (f32x4){bflo(v.z), bfhi(v.z), bflo(v.w), bfhi(v.w)}; }
__device__ __forceinline__ void ph_conv(const Frame& F0, int i, int nrows) {
    Frame F = relaunder(F0);
    const int gw = F.vcu * 8 + F.wave, NGW = F.G * 8, lane = F.lane;
    const float* cw = inptr(F, I_CONVW) + (size_t)i * 3 * D; const float* cb = inptr(F, I_CONVB) + (size_t)i * D;
    const bf16* P = (const bf16*)(F.ws + WS_P); bf16* Q = (bf16*)(F.ws + WS_Q);
    for (int r0 = gw * 4; r0 < nrows; r0 += NGW * 4) {
        const int s0 = r0 < NLAT ? (r0 & (SEQ - 1)) : ((r0 - NLAT) & (CTXL - 1)); const int slen = r0 < NLAT ? SEQ : CTXL;
        const bool hp = s0 > 0, hn = s0 + 4 < slen;
#pragma unroll
        for (int j = 0; j < 2; ++j) { const int c = 8 * lane + 512 * j;
            u32x4 p[6], gb[4];
            p[0] = (u32x4){0u, 0u, 0u, 0u}; p[5] = (u32x4){0u, 0u, 0u, 0u};
            if (hp) p[0] = __builtin_nontemporal_load((const u32x4*)(P + (size_t)(r0 - 1) * 2048 + 1024 + c));
            if (hn) p[5] = __builtin_nontemporal_load((const u32x4*)(P + (size_t)(r0 + 4) * 2048 + 1024 + c));
#pragma unroll
            for (int r = 0; r < 4; ++r) { p[r + 1] = __builtin_nontemporal_load((const u32x4*)(P + (size_t)(r0 + r) * 2048 + 1024 + c)); gb[r] = __builtin_nontemporal_load((const u32x4*)(P + (size_t)(r0 + r) * 2048 + c)); }
            const f32x4 w0a = *(const f32x4*)(cw + c), w0b = *(const f32x4*)(cw + c + 4), w1a = *(const f32x4*)(cw + D + c), w1b = *(const f32x4*)(cw + D + c + 4), w2a = *(const f32x4*)(cw + 2 * D + c), w2b = *(const f32x4*)(cw + 2 * D + c + 4);
            const f32x4 ba = *(const f32x4*)(cb + c), bb = *(const f32x4*)(cb + c + 4);
#pragma unroll
            for (int r = 0; r < 4; ++r) {
                const f32x4 ya = ubf_lo(gb[r]) * (ubf_lo(p[r]) * w0a + ubf_lo(p[r + 1]) * w1a + ubf_lo(p[r + 2]) * w2a + ba);
                const f32x4 yb = ubf_hi(gb[r]) * (ubf_hi(p[r]) * w0b + ubf_hi(p[r + 1]) * w1b + ubf_hi(p[r + 2]) * w2b + bb);
                *(u32x4*)(Q + (size_t)(r0 + r) * D + c) = pack8(ya, yb); } }
    }
}
#define MFMA32(a, b, c) __builtin_amdgcn_mfma_f32_32x32x16_bf16((a), (b), (c), 0, 0, 0)
#define MFMA16(a, b, c) __builtin_amdgcn_mfma_f32_16x16x32_bf16((a), (b), (c), 0, 0, 0)
constexpr int AK_STR = 144, AV_STR = 136, AK_BUF = 64 * AK_STR, AV_BUF = 64 * AV_STR;
__device__ __forceinline__ int crow32(int reg, int hh) { return (reg & 3) + 8 * (reg >> 2) + 4 * hh; }
__device__ __forceinline__ float xhalf_max(float v) { const unsigned u = __float_as_uint(v); const auto r = __builtin_amdgcn_permlane32_swap(u, u, false, false); return fmaxf(__uint_as_float(r[0]), __uint_as_float(r[1])); }
__device__ __forceinline__ float xhalf_sum(float v) { const unsigned u = __float_as_uint(v); const auto r = __builtin_amdgcn_permlane32_swap(u, u, false, false); return __uint_as_float(r[0]) + __uint_as_float(r[1]); }
constexpr float ATT_THR = 8.0f;
__device__ __forceinline__ void attn_unit(const Frame& F, int ie, int b, int g, int qb, bool ctxq) {
    const bf16* P = (const bf16*)(F.ws + WS_P); bf16* Q = (bf16*)(F.ws + WS_Q);
    LAS unsigned char* Ks = F.lds; LAS unsigned char* Vt = F.lds + 2 * AK_BUF;
    const int w = F.wave, lane = F.lane, r = w >> 1, qh = w & 1, h = 4 * g + r, n = lane & 31, hh = lane >> 5;
    const int qpos0 = qb * 128 + qh * 64;
    const int qrow0 = ctxq ? NLAT + b * CTXL + qpos0 : b * SEQ + qpos0;
    if (KO_MASK & 1) {
#pragma unroll
        for (int nt = 0; nt < 2; ++nt)
#pragma unroll
            for (int c = 0; c < 4; ++c) *(u32x4*)(Q + (size_t)(qrow0 + 32 * nt + n) * D + h * 64 + 16 * c + 8 * hh) = (u32x4){0u, 0u, 0u, 0u};
        return;
    }
    bf16x8 qf[2][4];
#pragma unroll
    for (int nt = 0; nt < 2; ++nt)
#pragma unroll
        for (int c = 0; c < 4; ++c) qf[nt][c] = *(const bf16x8*)(P + (size_t)(qrow0 + 32 * nt + n) * EN + PC_Q + h * 64 + 16 * c + 8 * hh);
    const float sk = inptr(F, I_SINK)[ie * 8 + h] * LOG2E;
    float mrun[2] = {sk, sk}, lsum[2] = {1.f, 1.f};
    f32x16 O[2][2];
#pragma unroll
    for (int a = 0; a < 2; ++a)
#pragma unroll
        for (int c = 0; c < 2; ++c)
#pragma unroll
            for (int e = 0; e < 16; ++e) O[a][c][e] = 0.f;
    const int tw0 = ctxq ? 4 : ((qb == 0) ? 6 : 4), tw1 = ctxq ? 4 : ((qb == 31) ? 8 : 10);
    const int ntile = 4 + (tw1 - tw0);
    const int skey = F.tid >> 3, sch = F.tid & 7;
    u32x4 kreg, vreg;
#define TILE_OF(i) ((i) < 4 ? (i) : tw0 + ((i) - 4))
#define KROW_OF(t) ((t) < 4 ? NLAT + b * CTXL + 64 * (t) : b * SEQ + (qb - 1) * 128 + 64 * ((t) - 4))
    { const int kr = KROW_OF(0) + skey; kreg = *(const u32x4*)(P + (size_t)kr * EN + PC_K + g * 64 + sch * 8); vreg = *(const u32x4*)(P + (size_t)kr * EN + PC_V + g * 64 + sch * 8); }
    __syncthreads();
    {
        *(LAS u32x4*)(Ks + skey * AK_STR + sch * 16) = kreg;
        LAS unsigned short* vt = (LAS unsigned short*)(Vt + (sch * 8) * AV_STR + skey * 2);
        const unsigned vv[4] = {vreg.x, vreg.y, vreg.z, vreg.w};
#pragma unroll
        for (int e = 0; e < 4; ++e) { vt[(2 * e) * (AV_STR / 2)] = (unsigned short)(vv[e] & 0xffffu); vt[(2 * e + 1) * (AV_STR / 2)] = (unsigned short)(vv[e] >> 16); }
    }
    __syncthreads();
    const float c2 = 0.125f * LOG2E;
    for (int i = 0; i < ntile; ++i) {
        const int buf = i & 1, t = TILE_OF(i);
        if (i + 1 < ntile) { const int t1 = TILE_OF(i + 1); const int kr = KROW_OF(t1) + skey; kreg = *(const u32x4*)(P + (size_t)kr * EN + PC_K + g * 64 + sch * 8); vreg = *(const u32x4*)(P + (size_t)kr * EN + PC_V + g * 64 + sch * 8); }
        const LAS unsigned char* kb = Ks + buf * AK_BUF; const LAS unsigned char* vb = Vt + buf * AV_BUF;
        const bool msk = (t >= 4) && (t != 6) && (t != 7);
        const int kp0 = (qb - 1) * 128 + 64 * (t - 4);
        const bool skip = (qh == 0 && t == 9) || (qh == 1 && t == 4);
#pragma unroll 1
        for (int kt = 0; kt < 2; ++kt) {
            if (skip) break;
            f32x16 S[2];
#pragma unroll
            for (int c = 0; c < 2; ++c)
#pragma unroll
                for (int e = 0; e < 16; ++e) S[c][e] = 0.f;
#pragma unroll
            for (int c = 0; c < 4; ++c) { const bf16x8 kf = *(const LAS bf16x8*)(kb + (32 * kt + n) * AK_STR + (16 * c + 8 * hh) * 2);
#pragma unroll
                for (int nt = 0; nt < 2; ++nt) S[nt] = MFMA32(kf, qf[nt][c], S[nt]); }
#pragma unroll
            for (int nt = 0; nt < 2; ++nt) {
                if (msk) { const int qp = qpos0 + 32 * nt + n;
#pragma unroll
                    for (int e = 0; e < 16; ++e) { const int dd = qp - (kp0 + 32 * kt + crow32(e, hh)); if (dd > 128 || dd < -128) S[nt][e] = -INFINITY; } }
                float mx = fmaxf(fmaxf(S[nt][0], S[nt][1]), fmaxf(S[nt][2], S[nt][3]));
#pragma unroll
                for (int e = 4; e < 16; e += 4) mx = fmaxf(mx, fmaxf(fmaxf(S[nt][e], S[nt][e + 1]), fmaxf(S[nt][e + 2], S[nt][e + 3])));
                mx = xhalf_max(mx) * c2;
                if (__builtin_amdgcn_ballot_w64(mx > mrun[nt] + ATT_THR) != 0ull) {
                    const float mnew_ = fmaxf(mrun[nt], mx); const float alpha = __builtin_amdgcn_exp2f(mrun[nt] - mnew_); mrun[nt] = mnew_; lsum[nt] *= alpha;
#pragma unroll
                    for (int dt = 0; dt < 2; ++dt)
#pragma unroll
                        for (int e = 0; e < 16; ++e) O[dt][nt][e] *= alpha;
                }
                const float mu = mrun[nt];
                float rs = 0.f;
#pragma unroll
                for (int e = 0; e < 16; ++e) { const float p = __builtin_amdgcn_exp2f(__builtin_fmaf(S[nt][e], c2, -mu)); S[nt][e] = p; rs += p; }
                lsum[nt] += xhalf_sum(rs);
            }
#pragma unroll
            for (int s = 0; s < 2; ++s) {
                bf16x8 pf[2];
#pragma unroll
                for (int nt = 0; nt < 2; ++nt) { u32x4 pw; pw.x = pk2(S[nt][8 * s + 0], S[nt][8 * s + 1]); pw.y = pk2(S[nt][8 * s + 2], S[nt][8 * s + 3]); pw.z = pk2(S[nt][8 * s + 4], S[nt][8 * s + 5]); pw.w = pk2(S[nt][8 * s + 6], S[nt][8 * s + 7]); pf[nt] = __builtin_bit_cast(bf16x8, pw); }
#pragma unroll
                for (int dt = 0; dt < 2; ++dt) {
                    const LAS unsigned char* va = vb + (32 * dt + n) * AV_STR + (32 * kt + 16 * s + 4 * hh) * 2;
                    const s16x4 lo = *(const LAS s16x4*)va, hi = *(const LAS s16x4*)(va + 16);
                    const bf16x8 vf = __builtin_shufflevector(lo, hi, 0, 1, 2, 3, 4, 5, 6, 7);
#pragma unroll
                    for (int nt = 0; nt < 2; ++nt) O[dt][nt] = MFMA32(vf, pf[nt], O[dt][nt]);
                }
            }
        }
        if (i + 1 < ntile) {
            LAS unsigned char* kb2 = Ks + (buf ^ 1) * AK_BUF; LAS unsigned char* vb2 = Vt + (buf ^ 1) * AV_BUF;
            *(LAS u32x4*)(kb2 + skey * AK_STR + sch * 16) = kreg;
            LAS unsigned short* vt = (LAS unsigned short*)(vb2 + (sch * 8) * AV_STR + skey * 2);
            const unsigned vv[4] = {vreg.x, vreg.y, vreg.z, vreg.w};
#pragma unroll
            for (int e = 0; e < 4; ++e) { vt[(2 * e) * (AV_STR / 2)] = (unsigned short)(vv[e] & 0xffffu); vt[(2 * e + 1) * (AV_STR / 2)] = (unsigned short)(vv[e] >> 16); }
        }
        __syncthreads();
    }
#pragma unroll
    for (int nt = 0; nt < 2; ++nt) { const float inv = 1.0f / lsum[nt]; bf16* orow = Q + (size_t)(qrow0 + 32 * nt + n) * D + h * 64 + (hh ? 8 : 0);
#pragma unroll
        for (int dt = 0; dt < 2; ++dt)
#pragma unroll
            for (int rg = 0; rg < 4; rg += 2) {
                u32x2 a, bq; a.x = pk2(O[dt][nt][4 * rg] * inv, O[dt][nt][4 * rg + 1] * inv); a.y = pk2(O[dt][nt][4 * rg + 2] * inv, O[dt][nt][4 * rg + 3] * inv);
                bq.x = pk2(O[dt][nt][4 * rg + 4] * inv, O[dt][nt][4 * rg + 5] * inv); bq.y = pk2(O[dt][nt][4 * rg + 6] * inv, O[dt][nt][4 * rg + 7] * inv);
                { const auto r0 = __builtin_amdgcn_permlane32_swap(a.x, bq.x, false, false); a.x = r0[0]; bq.x = r0[1]; }
                { const auto r1 = __builtin_amdgcn_permlane32_swap(a.y, bq.y, false, false); a.y = r1[0]; bq.y = r1[1]; }
                *(u32x4*)(orow + 32 * dt + 8 * rg) = (u32x4){a.x, a.y, bq.x, bq.y}; } }
}

template <int d> __device__ __forceinline__ void glaA_unit(const Frame& F, int ie, int b, int c, int h) {
    const bf16* P = (const bf16*)(F.ws + WS_P);
    LAS unsigned char* QS = F.lds + F.wave * 16384; LAS unsigned char* KS = QS + 8192;
    const int lane = F.lane;
    const int row0 = c < 4 ? NLAT + b * CTXL + c * 64 : b * SEQ + (c - 4) * 64;
    const size_t U = (size_t)(b * NCHUNK + c) * 4 + h;
    bf16* gq = (bf16*)(F.ws + WS_GQIN); bf16* gk = (bf16*)(F.ws + WS_GKST); bf16* ga = (bf16*)(F.ws + WS_GATT);
    {
        const size_t UD = U * 2 + d;
        {
            u32x4 qr[8], kr[8];
#pragma unroll
            for (int it = 0; it < 8; ++it) { const int tok = it * 8 + (lane >> 3), ch = lane & 7; const size_t ro = (size_t)(row0 + tok) * EN + h * 64 + ch * 8; qr[it] = *(const u32x4*)(P + ro + PC_QG); kr[it] = *(const u32x4*)(P + ro + PC_KG); }
#pragma unroll
            for (int it = 0; it < 8; ++it) { const int tok = it * 8 + (lane >> 3), ch = lane & 7; const int so = tok * 128 + ((ch ^ (tok & 7)) << 4); *(LAS u32x4*)(QS + so) = qr[it]; *(LAS u32x4*)(KS + so) = kr[it]; }
        }
        const int ln = lane & 31, hh = lane >> 5;
        bf16x8 afr[2], bhi[2], blo[2]; float bav[2];
#pragma unroll
        for (int tt = 0; tt < 2; ++tt) afr[tt] = *(const bf16x8*)(P + (size_t)(row0 + 32 * tt + ln) * EN + PC_GG + 16 * d + 8 * hh);
#pragma unroll
        for (int dt = 0; dt < 2; ++dt) { const float* wp = inptr(F, I_WA2) + (size_t)((ie * 2 + d) * 16 + 8 * hh) * 256 + h * 64 + 32 * dt + ln;
            unsigned hh_[8], ll_[8];
#pragma unroll
            for (int j = 0; j < 8; ++j) { const float v = wp[(size_t)j * 256]; const unsigned hb = pk2(v, 0.f) & 0xffffu; hh_[j] = hb; ll_[j] = pk2(v - __uint_as_float(hb << 16), 0.f) & 0xffffu; }
            bhi[dt] = __builtin_bit_cast(bf16x8, (u32x4){hh_[0] | (hh_[1] << 16), hh_[2] | (hh_[3] << 16), hh_[4] | (hh_[5] << 16), hh_[6] | (hh_[7] << 16)});
            blo[dt] = __builtin_bit_cast(bf16x8, (u32x4){ll_[0] | (ll_[1] << 16), ll_[2] | (ll_[3] << 16), ll_[4] | (ll_[5] << 16), ll_[6] | (ll_[7] << 16)});
            bav[dt] = inptr(F, I_BA)[(ie * 2 + d) * 256 + h * 64 + 32 * dt + ln]; }
        f32x16 G[2][2];
#pragma unroll
        for (int tt = 0; tt < 2; ++tt)
#pragma unroll
            for (int dt = 0; dt < 2; ++dt) { f32x16 z16;
#pragma unroll
                for (int e = 0; e < 16; ++e) z16[e] = 0.f;
                z16 = MFMA32(afr[tt], bhi[dt], z16); G[tt][dt] = MFMA32(afr[tt], blo[dt], z16); }
        asm volatile("s_waitcnt lgkmcnt(0)" ::: "memory");
        float base[2] = {0.f, 0.f};
        int lofs[2][4];
#pragma unroll
        for (int dt = 0; dt < 2; ++dt)
#pragma unroll
            for (int e4 = 0; e4 < 4; ++e4) lofs[dt][e4] = (4 * hh + e4) * 128 + (((4 * dt + (ln >> 3)) ^ (4 * hh + e4)) << 4) + (ln & 7) * 2;
#pragma unroll
        for (int tq = 0; tq < 2; ++tq) { constexpr int dd = d; const int tt = dd ? 1 - tq : tq;
#pragma unroll
            for (int gq_ = 0; gq_ < 4; ++gq_) { const int g4 = dd ? 3 - gq_ : gq_;
                const int tokg = 32 * tt + 8 * g4;
#pragma unroll
                for (int dt = 0; dt < 2; ++dt) {
                    float la[4];
#pragma unroll
                    for (int e4 = 0; e4 < 4; ++e4) { const float g = G[tt][dt][4 * g4 + e4] + bav[dt];
                        la[e4] = (fminf(g, 0.f) * LOG2E - __builtin_amdgcn_logf(1.0f + __builtin_amdgcn_exp2f(-fabsf(g) * LOG2E))) * (1.0f / 16.0f); }
                    float cs[4];
                    if (dd == 0) { cs[0] = la[0]; cs[1] = cs[0] + la[1]; cs[2] = cs[1] + la[2]; cs[3] = cs[2] + la[3]; }
                    else { cs[3] = la[3]; cs[2] = cs[3] + la[2]; cs[1] = cs[2] + la[1]; cs[0] = cs[1] + la[0]; }
                    const float t4 = dd == 0 ? cs[3] : cs[0];
                    const float pt = __shfl_xor(t4, 32);
                    const float off = base[dt] + ((dd == 0 ? hh == 1 : hh == 0) ? pt : 0.f);
                    base[dt] += t4 + pt;
#pragma unroll
                    for (int e4 = 0; e4 < 4; ++e4) { const int so = tokg * 128 + lofs[dt][e4];
                        const float e1 = __builtin_amdgcn_exp2f(off + cs[e4]);
                        const float qi = bf2f(*(const LAS unsigned short*)(QS + so)) * 0.125f * e1, ki = bf2f(*(const LAS unsigned short*)(KS + so)) * __builtin_amdgcn_rcpf(e1);
                        const unsigned short q16 = (unsigned short)(pk2(qi, 0.f) & 0xffffu), k16 = (unsigned short)(pk2(ki, 0.f) & 0xffffu);
                        *(LAS unsigned short*)(QS + so) = q16; *(LAS unsigned short*)(KS + so) = k16; }
                }
            }
        }
        if (hh == 0) { ((float*)(F.ws + WS_GDEC))[UD * 64 + ln] = __builtin_amdgcn_exp2f(base[0]); ((float*)(F.ws + WS_GDEC))[UD * 64 + 32 + ln] = __builtin_amdgcn_exp2f(base[1]); }
        asm volatile("s_waitcnt lgkmcnt(0)" ::: "memory");
        {
            const int cc = lane & 7, dk0 = 32 * (cc >> 2) + 4 * (cc & 3);
#pragma unroll
            for (int it = 0; it < 8; ++it) { const int tok = it * 8 + (lane >> 3);
                const u32x2 lo = *(const LAS u32x2*)(QS + tok * 128 + ((((dk0 >> 3)) ^ (tok & 7)) << 4) + (dk0 & 7) * 2);
                const u32x2 hi = *(const LAS u32x2*)(QS + tok * 128 + ((((dk0 + 16) >> 3) ^ (tok & 7)) << 4) + (dk0 & 7) * 2);
                *(u32x4*)(gq + (UD * 64 + tok) * 64 + 8 * cc) = (u32x4){lo.x, lo.y, hi.x, hi.y};
                *(u32x4*)(gk + (UD * 64 + tok) * 64 + 8 * cc) = *(const LAS u32x4*)(KS + tok * 128 + ((cc ^ (tok & 7)) << 4)); }
        }
        {
            const int n = lane & 15, kg = lane >> 4;
#pragma unroll 1
            for (int I = 0; I < 4; ++I) {
                const int ti = 16 * I + n;
                bf16x8 qf[2];
#pragma unroll
                for (int ks2 = 0; ks2 < 2; ++ks2) qf[ks2] = *(const LAS bf16x8*)(QS + ti * 128 + (((4 * ks2 + kg) ^ (ti & 7)) << 4));
#pragma unroll
                for (int J = 0; J < 4; ++J) { f32x4 acc = (f32x4){0.f, 0.f, 0.f, 0.f};
                    const bool live = d == 0 ? (J <= I) : (J >= I);
                    if (live) {
                        const int tjr = 16 * J + n;
#pragma unroll
                        for (int ks2 = 0; ks2 < 2; ++ks2) { const bf16x8 kf = *(const LAS bf16x8*)(KS + tjr * 128 + (((4 * ks2 + kg) ^ (tjr & 7)) << 4)); acc = MFMA16(kf, qf[ks2], acc); }
#pragma unroll
                        for (int r = 0; r < 4; ++r) { const int tj = 16 * J + 4 * kg + r; const bool keep = d == 0 ? (tj <= ti) : (tj >= ti); if (!keep) acc[r] = 0.f; }
                    }
                    u32x2 ow; ow.x = pk2(acc[0], acc[1]); ow.y = pk2(acc[2], acc[3]);
                    *(u32x2*)(ga + (UD * 64 + ti) * 64 + 16 * J + 4 * kg) = ow; }
            }
        }
        asm volatile("s_waitcnt lgkmcnt(0)" ::: "memory");
    }
}

constexpr int GB_STG = 43008;
__device__ __forceinline__ int glaB_chunk(int d, int step) { return d == 0 ? step : (step < 4 ? 3 - step : 4 + (NCHUNK - 1 - step)); }
__device__ __forceinline__ int swz_k(int r) { return (r & 3) | (((r >> 3) & 1) << 2); }
__device__ __forceinline__ int swz_v(int r) { return ((r & 3) << 2) | ((r >> 2) & 3); }
template <int STAGE> __device__ __forceinline__ void glaB_issue(const Frame& F, int b, int h, int d, int step) {
    const int c = glaB_chunk(d, step);
    const size_t U = (size_t)(b * NCHUNK + c) * 4 + h, UD = U * 2 + d;
    const int row0 = c < 4 ? NLAT + b * CTXL + c * 64 : b * SEQ + (c - 4) * 64;
    const int tid = F.tid, row = tid >> 3, gch = (tid & 7) ^ (row & 7), gchk = (tid & 7) ^ swz_k(row);
    const int vr0 = tid >> 4, vr1 = vr0 + 32, vc0 = (tid & 15) ^ swz_v(vr0), vc1 = (tid & 15) ^ swz_v(vr1);
    LAS unsigned char* st = F.lds + STAGE * GB_STG + F.wave * 1024;
    const char* gq = (const char*)(F.ws + WS_GQIN) + UD * 8192 + row * 128 + gch * 16;
    const char* ga = (const char*)(F.ws + WS_GATT) + UD * 8192 + row * 128 + gch * 16;
    const char* gk = (const char*)(F.ws + WS_GKST) + UD * 8192 + row * 128 + gchk * 16;
    const char* gv = (const char*)(F.ws + WS_P) + (size_t)row0 * (EN * 2) + (PC_VG + h * 128) * 2;
    const char* gdc = (const char*)(F.ws + WS_GDEC) + UD * 256 + F.lane * 4;
    __builtin_amdgcn_global_load_lds((const unsigned*)gq, (LAS unsigned*)(st), 16, 0, 0);
    __builtin_amdgcn_global_load_lds((const unsigned*)ga, (LAS unsigned*)(st + 8192), 16, 0, 0);
    __builtin_amdgcn_global_load_lds((const unsigned*)gk, (LAS unsigned*)(st + 16384), 16, 0, 0);
    __builtin_amdgcn_global_load_lds((const unsigned*)(gv + (size_t)vr0 * (EN * 2) + vc0 * 16), (LAS unsigned*)(st + 24576), 16, 0, 0);
    __builtin_amdgcn_global_load_lds((const unsigned*)(gv + (size_t)vr1 * (EN * 2) + vc1 * 16), (LAS unsigned*)(st + 24576 + 8192), 16, 0, 0);
    __builtin_amdgcn_global_load_lds((const unsigned*)gdc, (LAS unsigned*)(F.lds + STAGE * GB_STG + 40960 + F.wave * 256), 4, 0, 0);
}
template <int ROWB, class SWZ> __device__ __forceinline__ bf16x8 gb_frag_tr(const LAS unsigned char* tile, int lane, int c, int ks, SWZ swz) {
    const int g = lane >> 4, q = (lane & 15) >> 2, p = lane & 3;
    const int r0 = 32 * ks + 8 * g + q, r1 = r0 + 4;
    const s16x4 lo = __builtin_amdgcn_ds_read_tr16_b64_v4i16((LAS s16x4*)(tile + ROWB * r0 + 16 * ((2 * c + (p >> 1)) ^ swz(r0)) + 8 * (p & 1)));
    const s16x4 hi = __builtin_amdgcn_ds_read_tr16_b64_v4i16((LAS s16x4*)(tile + ROWB * r1 + 16 * ((2 * c + (p >> 1)) ^ swz(r1)) + 8 * (p & 1)));
    return __builtin_shufflevector(lo, hi, 0, 1, 2, 3, 4, 5, 6, 7);
}
__device__ __forceinline__ bf16x8 gb_frag(const LAS unsigned char* tile, int row, int ch) { return *(const LAS bf16x8*)(tile + (row * 8 + (ch ^ (row & 7))) * 16); }
template <int STAGE> __device__ __forceinline__ void glaB_step(const Frame& F, int b, int h, int d, int step, f32x4 (&S)[4], bf16* od) {
    const int lane = F.lane, n = lane & 15, kg = lane >> 4, sl = F.wave;
    if (step == 0) asm volatile("s_waitcnt vmcnt(6)" ::: "memory"); else if (step == 1) asm volatile("s_waitcnt vmcnt(10)" ::: "memory"); else asm volatile("s_waitcnt vmcnt(14)" ::: "memory");
    __builtin_amdgcn_s_barrier();
    asm volatile("" ::: "memory");
    glaB_issue<(STAGE + 2) % 3>(F, b, h, d, step + 2 < NCHUNK ? step + 2 : NCHUNK - 1);
    asm volatile("" ::: "memory");
    const int c = glaB_chunk(d, step);
    const int row0 = c < 4 ? NLAT + b * CTXL + c * 64 : b * SEQ + (c - 4) * 64;
    const LAS unsigned char* st = F.lds + STAGE * GB_STG;
    bf16x8 vf[2], qf[4][2], af[4][2], kf[4][2]; f32x4 dc[4];
#pragma unroll
    for (int T = 0; T < 2; ++T) vf[T] = gb_frag_tr<256>(st + 24576, lane, sl, T, swz_v);
#pragma unroll
    for (int I = 0; I < 4; ++I)
#pragma unroll
        for (int T = 0; T < 2; ++T) { qf[I][T] = gb_frag(st, 16 * I + n, 4 * T + kg); af[I][T] = gb_frag(st + 8192, 16 * I + n, 4 * T + kg); }
#pragma unroll
    for (int I = 0; I < 4; ++I)
#pragma unroll
        for (int T = 0; T < 2; ++T) kf[I][T] = gb_frag_tr<128>(st + 16384, lane, I, T, swz_k);
#pragma unroll
    for (int q = 0; q < 4; ++q) dc[q] = *(const LAS f32x4*)(st + 40960 + sl * 256 + (16 * q + 4 * kg) * 4);
    bf16x8 sb[2];
#pragma unroll
    for (int G2 = 0; G2 < 2; ++G2) { u32x4 sw; sw.x = pk2(S[2 * G2][0], S[2 * G2][1]); sw.y = pk2(S[2 * G2][2], S[2 * G2][3]); sw.z = pk2(S[2 * G2 + 1][0], S[2 * G2 + 1][1]); sw.w = pk2(S[2 * G2 + 1][2], S[2 * G2 + 1][3]); sb[G2] = __builtin_bit_cast(bf16x8, sw); }
    asm volatile("s_waitcnt lgkmcnt(0)" ::: "memory");
    f32x4 o[4];
#pragma unroll
    for (int I = 0; I < 4; ++I) o[I] = (f32x4){0.f, 0.f, 0.f, 0.f};
#pragma unroll
    for (int I = 0; I < 4; ++I) o[I] = MFMA16(sb[0], qf[I][0], o[I]);
#pragma unroll
    for (int I = 0; I < 4; ++I) o[I] = MFMA16(sb[1], qf[I][1], o[I]);
#pragma unroll
    for (int q = 0; q < 4; ++q) S[q] = MFMA16(kf[q][0], vf[0], S[q]);
#pragma unroll
    for (int I = 0; I < 4; ++I) o[I] = MFMA16(vf[0], af[I][0], o[I]);
#pragma unroll
    for (int q = 0; q < 4; ++q) S[q] = MFMA16(kf[q][1], vf[1], S[q]);
#pragma unroll
    for (int I = 0; I < 4; ++I) o[I] = MFMA16(vf[1], af[I][1], o[I]);
#pragma unroll
    for (int q = 0; q < 4; ++q) S[q] = S[q] * dc[q];
    u32x2 ow[4];
#pragma unroll
    for (int I = 0; I < 4; ++I) { ow[I].x = pk2(o[I][0], o[I][1]); ow[I].y = pk2(o[I][2], o[I][3]); }
    asm volatile("s_waitcnt lgkmcnt(0)" ::: "memory");
#pragma unroll
    for (int I = 0; I < 4; ++I) *(u32x2*)(od + (size_t)(row0 + 16 * I + n) * 512 + h * 128 + 16 * sl + 4 * kg) = ow[I];
    asm volatile("" ::: "memory");
}
__device__ __forceinline__ void glaB_group(const Frame& F, int cg) {
    const int d = cg & 1, h = (cg >> 1) & 3, b = cg >> 3;
    bf16* od = (bf16*)(F.ws + WS_U) + (size_t)d * NTOK * 512;
    f32x4 S[4];
#pragma unroll
    for (int q = 0; q < 4; ++q) S[q] = (f32x4){0.f, 0.f, 0.f, 0.f};
    asm volatile("s_waitcnt vmcnt(0) lgkmcnt(0)" ::: "memory");
    __builtin_amdgcn_s_barrier();
    asm volatile("" ::: "memory");
    glaB_issue<0>(F, b, h, d, 0); glaB_issue<1>(F, b, h, d, 1);
    asm volatile("" ::: "memory");
    for (int s0 = 0; s0 + 2 < NCHUNK; s0 += 3) { glaB_step<0>(F, b, h, d, s0, S, od); glaB_step<1>(F, b, h, d, s0 + 1, S, od); glaB_step<2>(F, b, h, d, s0 + 2, S, od); }
    glaB_step<0>(F, b, h, d, 66, S, od); glaB_step<1>(F, b, h, d, 67, S, od);
    static_assert(NCHUNK == 68, "tail of the step loop");
    asm volatile("s_waitcnt vmcnt(0)" ::: "memory");
    __builtin_amdgcn_s_barrier();
}
__device__ __forceinline__ void conv_moe_dynamic(const Frame& F0, int l) {
    Frame F = relaunder(F0);
    LAS float* scr = (LAS float*)(F.lds + F.wave * 16384);
    unsigned* ctr = (unsigned*)(F.ws + WS_CTL) + CW_WQ + l * 64;
    constexpr int I_13 = 16 * 32, I_2 = 8 * 32, NIT = NEXP * (I_13 + I_2), CH = 8;
    for (;;) {
        unsigned t0 = 0; if (F.lane == 0) t0 = atomicAdd(ctr, (unsigned)CH);
        const int it0 = __builtin_amdgcn_readfirstlane((int)t0);
        if (it0 >= NIT) break;
        for (int it = it0; it < it0 + CH && it < NIT; ++it) conv_moe_item(F, l, it, scr);
    }
}

__device__ __forceinline__ void ph_combine(const Frame& F0, int ie, int nrows) {
    Frame F = relaunder(F0);
    const int gw = F.vcu * 8 + F.wave, NGW = F.G * 8, lane = F.lane;
    const bf16* P = (const bf16*)(F.ws + WS_P); bf16* Q = (bf16*)(F.ws + WS_Q);
    const bf16* o0 = (const bf16*)(F.ws + WS_U); const bf16* o1 = o0 + (size_t)NTOK * 512;
    const float* nw = inptr(F, I_NORMW) + (size_t)ie * 512;
    const int col = 8 * lane;
    const f32x4 nwa = *(const f32x4*)(nw + col), nwb = *(const f32x4*)(nw + col + 4);
    for (int r0 = gw * 4; r0 < nrows; r0 += NGW * 4) {
        if (KO_MASK & 2) {
#pragma unroll
            for (int r = 0; r < 4; ++r) *(u32x4*)(Q + (size_t)(r0 + r) * D + 512 + col) = (u32x4){0u, 0u, 0u, 0u};
            continue; }
        u32x4 a[4], bq[4], rr[4];
#pragma unroll
        for (int r = 0; r < 4; ++r) { const size_t row = r0 + r; a[r] = __builtin_nontemporal_load((const u32x4*)(o0 + row * 512 + col)); bq[r] = __builtin_nontemporal_load((const u32x4*)(o1 + row * 512 + col)); rr[r] = __builtin_nontemporal_load((const u32x4*)(P + row * EN + PC_RG + col)); }
#pragma unroll
        for (int r = 0; r < 4; ++r) {
            const f32x4 xa = ubf_lo(a[r]) + ubf_lo(bq[r]), xb = ubf_hi(a[r]) + ubf_hi(bq[r]);
            float ss = (xa[0] * xa[0] + xa[1] * xa[1]) + (xa[2] * xa[2] + xa[3] * xa[3]) + (xb[0] * xb[0] + xb[1] * xb[1]) + (xb[2] * xb[2] + xb[3] * xb[3]);
            ss = row16_sum(ss);
            const float rinv = 1.0f / sqrtf(ss * (1.0f / 128.0f) + RMS_EPS);
            f32x4 ra = ubf_lo(rr[r]), rb = ubf_hi(rr[r]);
#pragma unroll
            for (int j = 0; j < 4; ++j) { ra[j] = fast_silu(ra[j]); rb[j] = fast_silu(rb[j]); }
            *(u32x4*)(Q + (size_t)(r0 + r) * D + 512 + col) = pack8(xa * rinv * nwa * ra, xb * rinv * nwb * rb); }
    }
}

#if defined(FP8_PROBE)
typedef int i32x8 __attribute__((ext_vector_type(8)));
__device__ __forceinline__ unsigned fp8_of_int(int v) { const int a = v < 0 ? -v : v; const unsigned c = a == 0 ? 0x00u : a == 1 ? 0x38u : a == 2 ? 0x40u : 0x44u; return v < 0 ? (c | 0x80u) : c; }
__device__ __forceinline__ int fp8_kidx(int kg, int e) { return FP8_PROBE == 1 ? 32 * kg + e : (e < 16 ? 16 * kg + e : 64 + 16 * kg + (e - 16)); }
__device__ __forceinline__ bool fp8_layout_test(int lane) {
    const int r = lane & 15, kg = lane >> 4;
    i32x8 a, b;
#pragma unroll
    for (int w = 0; w < 8; ++w) { unsigned aw = 0, bw = 0;
#pragma unroll
        for (int by = 0; by < 4; ++by) { const int k = fp8_kidx(kg, 4 * w + by);
            const int av = (k == (7 * r + 3) % 128) ? 1 : 0; const int bv = ((k * 5 + r * 3) % 7) - 3;
            aw |= fp8_of_int(av) << (8 * by); bw |= fp8_of_int(bv) << (8 * by); }
        a[w] = (int)aw; b[w] = (int)bw; }
    f32x4 c = (f32x4){0.f, 0.f, 0.f, 0.f};
    c = __builtin_amdgcn_mfma_scale_f32_16x16x128_f8f6f4(a, b, c, 0, 0, 0, 0, 0, 0);
    bool bad = false;
#pragma unroll
    for (int q = 0; q < 4; ++q) { const int i = 4 * kg + q; const int kk = (7 * i + 3) % 128; const float ex = (float)(((kk * 5 + r * 3) % 7) - 3); if (c[q] != ex) bad = true; }
    return __builtin_amdgcn_ballot_w64(bad) != 0ull;
}
#endif
struct Args { const float* in[25]; float* out; unsigned char* ws; int ph_lo, ph_hi; };
constexpr int NPHASE = 2 + 9 * DEPTH;

__global__ void __launch_bounds__(512, 2) fwd(Args args) {
    extern __shared__ __attribute__((aligned(16))) unsigned char lds_raw[];
    Frame F;
    F.lds = (LAS unsigned char*)lds_raw;
    F.tid = threadIdx.x; F.lane = F.tid & 63; F.wave = __builtin_amdgcn_readfirstlane(F.tid >> 6);
    F.G = gridDim.x; { const int bx = blockIdx.x; F.vcu = (F.G % 8 == 0) ? (bx % 8) * (F.G / 8) + bx / 8 : bx; }
    F.out = args.out; F.ws = args.ws;
    volatile LAS unsigned* MISC = (volatile LAS unsigned*)(F.lds + MISC_OFF);
    if (F.tid < 64) MISC[F.tid] = 0u;
    if (F.tid < 25) ((LAS unsigned long long*)(F.lds + MISC_OFF + 256))[F.tid] = (unsigned long long)args.in[F.tid];
    __syncthreads();
    const int lo = args.ph_lo, hi = args.ph_hi;
    const bool multi = (hi - lo) > 1;
    XcdBarrier bar; bar.bar = (unsigned*)(F.ws + WS_CTL) + CW_BAR; bar.x = 0; bar.st = MISC + 8;
    if (multi) bar = xcd_barrier_post((unsigned*)(F.ws + WS_CTL) + CW_BAR, MISC + 8);
#ifndef PH_SEL
#define PH_SEL 0xffffffff
#endif
#define IN(k) (lo <= (k) && (k) < hi)
#define SEL(b) ((PH_SEL >> (b)) & 1)
#ifndef DUP_MASK
#define DUP_MASK 0
#endif
#define REP(bit) for (int rep_ = 0; rep_ < ((DUP_MASK & (bit)) ? 2 : 1); ++rep_)
#define SEAM(k) do { if ((k) + 1 < hi) xcd_barrier(bar); } while (0)

    if (SEL(0) && IN(0)) { REP(64) { ph_ada(F); __syncthreads(); conv_dense_weights(F); __syncthreads(); } SEAM(0); }
    if (SEL(1) && IN(1)) { REP(64) { ph_u0(F); __syncthreads(); } SEAM(1); }

    for (int l = 0; l < DEPTH; ++l) {
        const int pb = 2 + 9 * l; const bool even = (l & 1) == 0; const int ie = l >> 1;
        const int m_in = (l < 3) ? NTOK : NLAT;
        const int m_out = (l < 2) ? NTOK : NLAT;
        if (SEL(2) && IN(pb + 0)) {
            REP(32) { if (even) {
                LinSched S; S.init(m_in, EN, 1024, F.G, (int)blockIdx.x);
                EpiEvenIn E{(bf16*)(F.ws + WS_P), (const float*)(F.ws + WS_ROPE)};
                pg8::gemm_phase(F.lds, (const char*)(F.ws + WS_U), (const char*)(F.ws + WS_WINE) + (size_t)ie * EN * 1024 * 2, 1024, S, E);
            } else {
                LinSched S; S.init(m_in, ON, 1024, F.G, (int)blockIdx.x);
                EpiOddIn E{(bf16*)(F.ws + WS_P)};
                pg8::gemm_phase(F.lds, (const char*)(F.ws + WS_U), (const char*)(F.ws + WS_WINO) + (size_t)ie * ON * 1024 * 2, 1024, S, E);
            } }
            SEAM(pb + 0);
        }
        if (SEL(3) && IN(pb + 1)) {
            if (even) {
                const Frame Fm = relaunder(F);
                const int nun = NB * 2 * 32 + (l == 0 ? NB * 2 * 2 : 0);
                REP(1) for (int u = Fm.vcu; u < nun; u += Fm.G) {
                    if (u < NB * 2 * 32) attn_unit(Fm, ie, u >> 6, (u >> 5) & 1, u & 31, false);
                    else { const int v = u - NB * 2 * 32; attn_unit(Fm, ie, v >> 2, (v >> 1) & 1, v & 1, true); }
                }
                __syncthreads();
                if (!(KO_MASK & 2)) REP(2) for (int u = Fm.vcu * 8 + Fm.wave; u < NB * NCHUNK * 8; u += Fm.G * 8) { if (u & 1) glaA_unit<1>(Fm, ie, u / (NCHUNK * 8), (u / 8) % NCHUNK, (u >> 1) & 3); else glaA_unit<0>(Fm, ie, u / (NCHUNK * 8), (u / 8) % NCHUNK, (u >> 1) & 3); }
                __syncthreads();
            } else {
                REP(16) { ph_conv(F, ie, m_out); __syncthreads(); }
            }
            if (!even) REP(8) { conv_moe_weights(F, l); __syncthreads(); }
            SEAM(pb + 1);
        }
        if (even) {
            if (SEL(4) && IN(pb + 2)) {
                { const Frame Fm = relaunder(F);
                  if (!(KO_MASK & 2)) REP(4) for (int cg = Fm.vcu; cg < 128; cg += Fm.G) glaB_group(Fm, cg);
                  __syncthreads();
                  conv_moe_dynamic(Fm, l); }
                SEAM(pb + 2);
            }
            if (SEL(5) && IN(pb + 3)) { REP(16) { ph_combine(F, ie, m_out); __syncthreads(); } SEAM(pb + 3); }
        }
        if (SEL(6) && IN(pb + 4)) {
            REP(32) { LinSched S; S.init(m_out, 1024, 1024, F.G, (int)blockIdx.x);
            EpiPlain E{(bf16*)(F.ws + WS_P), 1024};
            pg8::gemm_phase(F.lds, (const char*)(F.ws + WS_Q), (const char*)(F.ws + (even ? WS_WOUTE : WS_WOUTO)) + (size_t)ie * 1024 * 1024 * 2, 1024, S, E); }
            SEAM(pb + 4);
        }
        if (SEL(7) && IN(pb + 5)) { if (DUP_MASK & 128) { ph_ln1(F, l, m_out, true); __syncthreads(); } ph_ln1(F, l, m_out); SEAM(pb + 5); }
        if (SEL(8) && IN(pb + 6)) {
            if (!(KO_MASK & 8)) REP(32) {
                moe_tables(F.lds, (const unsigned*)(F.ws + WS_CTL) + CW_CNT + l * 64);
                MoeSched<1> S; S.T = moe_tab(F.lds); S.rowtok = (const int*)(F.ws + WS_ROWTOK); S.G = F.G; S.c = F.vcu; S.bstride = (size_t)256 * 1024; S.estride = (size_t)1024 * 1024;
                EpiG1 E{(unsigned char*)(F.ws + WS_Q), 1.0f / W8_SCALE};
                pg8::gemm_phase<EpiG1, MoeSched<1>, 1>(F.lds, (const char*)(F.ws + WS_U8), (const char*)(F.ws + WS_W13), 1024, S, E);
            }
            SEAM(pb + 6);
        }
        if (SEL(9) && IN(pb + 7)) {
            if (!(KO_MASK & 8)) REP(32) {
                moe_tables(F.lds, (const unsigned*)(F.ws + WS_CTL) + CW_CNT + l * 64);
                MoeSched<0> S; S.T = moe_tab(F.lds); S.rowtok = nullptr; S.G = F.G; S.c = F.vcu; S.bstride = (size_t)256 * 512; S.estride = (size_t)1024 * 512;
                EpiPlainS E{(bf16*)(F.ws + WS_P), 1024, 1.0f / W8_SCALE};
                pg8::gemm_phase<EpiPlainS, MoeSched<0>, 1>(F.lds, (const char*)(F.ws + WS_Q), (const char*)(F.ws + WS_W2), 512, S, E);
            }
            SEAM(pb + 7);
        }
        if (SEL(10) && IN(pb + 8)) {
            moe_tables(F.lds, (const unsigned*)(F.ws + WS_CTL) + CW_CNT + l * 64);
            if (DUP_MASK & 256) { ph_ln2(F, l, m_out, true); __syncthreads(); }
            ph_ln2(F, l, m_out);
            SEAM(pb + 8);
        }
    }
#if defined(FP8_PROBE)
    if (blockIdx.x == 0) { __syncthreads(); if (F.tid < 64) { const bool bad = fp8_layout_test(F.tid); if (bad && F.tid == 0) F.out[0] = __builtin_nanf(""); } }
#endif
#undef IN
#undef SEAM
}

extern "C" void kernel_launch(void* const* d_in, const int* in_sizes, int n_in, void* d_out, int out_size, void* d_ws, size_t ws_size, hipStream_t stream) {
    static int grid = 0;
    if (grid == 0) {
        if (n_in != 25 || in_sizes[0] != NLAT * D || out_size != NLAT * D || ws_size < WS_END) { fprintf(stderr, "kernel_launch: unexpected shapes (n_in %d in0 %d out %d ws %zu)\n", n_in, n_in > 0 ? in_sizes[0] : -1, out_size, ws_size); grid = -1; return; }
        int dev = 0, cus = 0, per_cu = 0;
        if (hipGetDevice(&dev) != hipSuccess || hipDeviceGetAttribute(&cus, hipDeviceAttributeMultiprocessorCount, dev) != hipSuccess) { grid = -1; return; }
        if (hipFuncSetAttribute((const void*)fwd, hipFuncAttributeMaxDynamicSharedMemorySize, LDS_BYTES) != hipSuccess) { fprintf(stderr, "kernel_launch: hipFuncSetAttribute failed\n"); grid = -1; return; }
        if (hipOccupancyMaxActiveBlocksPerMultiprocessor(&per_cu, (const void*)fwd, 512, LDS_BYTES) != hipSuccess || per_cu < 1) fprintf(stderr, "kernel_launch: occupancy query says %d\n", per_cu);
        (void)hipGetLastError();
        grid = cus;
        if (grid < 242 || grid > 1024) { fprintf(stderr, "kernel_launch: built for a 256-CU device (got %d CUs)\n", cus); grid = -1; return; }
    }
    if (grid < 0) return;
    if (hipMemsetAsync((char*)d_ws + WS_CTL, 0, CTL_BYTES, stream) != hipSuccess) return;
    Args a{};
    for (int i = 0; i < 25; ++i) a.in[i] = (const float*)d_in[i];
    a.out = (float*)d_out; a.ws = (unsigned char*)d_ws;
#if N_LAUNCH_MODE == 1
    a.ph_lo = 0; a.ph_hi = NPHASE;
    hipLaunchKernelGGL(fwd, dim3(grid), dim3(512), LDS_BYTES, stream, a);
#else
    for (int k = 0; k < NPHASE; ++k) {
        if (k >= 2) { const int l = (k - 2) / 9, s = (k - 2) % 9; if ((l & 1) && (s == 2 || s == 3)) continue; }
        a.ph_lo = k; a.ph_hi = k + 1;
        hipLaunchKernelGGL(fwd, dim3(grid), dim3(512), LDS_BYTES, stream, a);
    }
#endif
}
```

```cpp
#include <hip/hip_runtime.h>
#define N_LAUNCH_MODE 1
#define KO_MASK 0
#define DUP_MASK 0
#include <cstdio>
#include <cstdint>

#ifndef KO_MASK
#define KO_MASK 0
#endif
#ifndef N_LAUNCH_MODE
#define N_LAUNCH_MODE 1
#endif

#define GAS __attribute__((address_space(1)))
#define LAS __attribute__((address_space(3)))
typedef unsigned short bf16;
typedef short bf16x8 __attribute__((ext_vector_type(8)));
typedef short s16x4 __attribute__((ext_vector_type(4)));
typedef float f32x2 __attribute__((ext_vector_type(2)));
typedef float f32x4 __attribute__((ext_vector_type(4)));
typedef float f32x16 __attribute__((ext_vector_type(16)));
typedef unsigned u32x2 __attribute__((ext_vector_type(2)));
typedef unsigned u32x4 __attribute__((ext_vector_type(4)));
typedef __bf16 bf16x2_t __attribute__((ext_vector_type(2)));
typedef int i32x8 __attribute__((ext_vector_type(8)));
typedef int i32x4_t __attribute__((ext_vector_type(4)));

constexpr int D = 1024, NB = 16, SEQ = 4096, CTXL = 256, DEPTH = 4;
constexpr int NLAT = NB * SEQ, NCTX = NB * CTXL, NTOK = NLAT + NCTX;
constexpr int EVEN_IN = 2336, EN = 2560, ON = 3072;
constexpr int NEXP = 32, DEXP = 512;
constexpr int SLOT_ROWS = 2 * NTOK + NEXP * 256;
constexpr float DN_ALPHA = 1.6817928305074290f;
constexpr float LN_EPS = 1e-5f, RMS_EPS = 1e-6f;
constexpr float LOG2E = 1.4426950408889634f;
constexpr int PC_Q = 0, PC_K = 512, PC_V = 640, PC_QG = 768, PC_KG = 1024, PC_VG = 1280, PC_RG = 1792, PC_GG = 2304;
constexpr int NCHUNK = 68;

constexpr size_t MiB = 1u << 20;
constexpr size_t WS_CTL = 0, CTL_BYTES = 1 * MiB;
constexpr size_t WS_MOD = 1 * MiB;
constexpr size_t WS_ROPE = 3 * MiB;
constexpr size_t WS_TOKINFO = 4 * MiB;
constexpr size_t WS_ROWTOK = 7 * MiB;
constexpr size_t WS_WINE = 16 * MiB, WS_WOUTE = 26 * MiB, WS_WINO = 30 * MiB, WS_WOUTO = 42 * MiB;
constexpr size_t WS_W13 = 46 * MiB, WS_W2 = 110 * MiB;
constexpr size_t WS_HCTX = 142 * MiB;
constexpr size_t WS_U = 158 * MiB;
constexpr size_t WS_P = 294 * MiB;
constexpr size_t WS_Q = 634 * MiB;
constexpr size_t WS_GATT = 778 * MiB, WS_GQIN = 846 * MiB, WS_GKST = 914 * MiB, WS_GVT = 982 * MiB, WS_GDEC = 1050 * MiB;
constexpr size_t WS_U8 = 1053 * MiB;
constexpr size_t WS_END = 1121 * MiB;
constexpr int CW_BAR = 4096;
constexpr int CW_CNT = 16384;
constexpr int CW_WQ = 20480;

constexpr int RING_BYTES = 131072;
constexpr int LDSX_OFF = RING_BYTES;
constexpr int MISC_OFF = LDSX_OFF + 8192;
constexpr int LDS_BYTES = 147456;

__device__ __forceinline__ unsigned pk2(float a, float b) { bf16x2_t r = __builtin_convertvector((f32x2){a, b}, bf16x2_t); return __builtin_bit_cast(unsigned, r); }
__device__ __forceinline__ unsigned pk4_fp8(float a, float b, float c, float d) { int r = __builtin_amdgcn_cvt_pk_fp8_f32(a, b, 0, false); r = __builtin_amdgcn_cvt_pk_fp8_f32(c, d, r, true); return (unsigned)r; }
__device__ __forceinline__ float bf2f(unsigned short h) { return __uint_as_float(((unsigned)h) << 16); }
__device__ __forceinline__ float bflo(unsigned w) { return __uint_as_float(w << 16); }
__device__ __forceinline__ float bfhi(unsigned w) { return __uint_as_float(w & 0xffff0000u); }
template <int CTRL> __device__ __forceinline__ float dppf(float v) { return __builtin_bit_cast(float, __builtin_amdgcn_update_dpp(0, __builtin_bit_cast(int, v), CTRL, 0xf, 0xf, false)); }
__device__ __forceinline__ float row16_sum(float v) { v += dppf<0xB1>(v); v += dppf<0x4E>(v); v += dppf<0x141>(v); v += dppf<0x140>(v); return v; }
__device__ __forceinline__ float wave_sum(float v) {
    v = row16_sum(v);
    const float s0 = __builtin_bit_cast(float, __builtin_amdgcn_readlane(__builtin_bit_cast(int, v), 0)), s1 = __builtin_bit_cast(float, __builtin_amdgcn_readlane(__builtin_bit_cast(int, v), 16));
    const float s2 = __builtin_bit_cast(float, __builtin_amdgcn_readlane(__builtin_bit_cast(int, v), 32)), s3 = __builtin_bit_cast(float, __builtin_amdgcn_readlane(__builtin_bit_cast(int, v), 48));
    return (s0 + s1) + (s2 + s3);
}
__device__ __forceinline__ float fast_silu(float x) { return x * __builtin_amdgcn_rcpf(1.0f + __builtin_amdgcn_exp2f(-x * LOG2E)); }

#define XB_TMO      128
#define XB_XCNT(j)  (256  + 64 * (j))
#define XB_XSUB(j)  (1280 + 64 * (j))
#define XB_XGEN(j)  (2304 + 64 * (j))
#define XB_TOP      3328
#define XB_TOPGEN   3392
#define XCD_BAR_WORDS 3456
#define XB_SPIN_CAP (1u << 22)
__device__ __forceinline__ unsigned xb_ld(unsigned* p)              { return __hip_atomic_load(p, __ATOMIC_RELAXED, __HIP_MEMORY_SCOPE_AGENT); }
__device__ __forceinline__ unsigned xb_add(unsigned* p, unsigned v) { return __hip_atomic_fetch_add(p, v, __ATOMIC_RELAXED, __HIP_MEMORY_SCOPE_AGENT); }
__device__ __forceinline__ unsigned xb_xcc_id() { return (unsigned)__builtin_amdgcn_s_getreg((3 << 11) | 20) & 0xFu; }
#define XB_SPIN(cond, bar) do { unsigned _sp = 0; while (cond) { __builtin_amdgcn_s_sleep(1); \
    if ((++_sp & 255u) == 0u) { if (xb_ld(&(bar)[XB_TMO])) break; if (_sp > XB_SPIN_CAP) { atomicAdd(&(bar)[XB_TMO], 1u); break; } } } } while (0)
struct XcdBarrier { unsigned* bar; unsigned x; volatile LAS unsigned* st; };
__device__ __forceinline__ XcdBarrier xcd_barrier_post(unsigned* bar, volatile LAS unsigned* st) {
    XcdBarrier b; b.bar = bar; b.x = xb_xcc_id(); b.st = st;
    if (threadIdx.x == 0) (void)xb_add(&bar[XB_XCNT(b.x)], 1u);
    return b;
}
__device__ __forceinline__ void xcd_barrier_complete(unsigned* bar, unsigned x, unsigned& nloc, unsigned& nx) {
    const unsigned G = gridDim.x * gridDim.y * gridDim.z;
    unsigned sum, cnt, mine, sp = 0u;
    for (;;) {
        sum = 0u; cnt = 0u; mine = 0u;
#pragma unroll
        for (unsigned j = 0; j < 16; ++j) { const unsigned c = xb_ld(&bar[XB_XCNT(j)]); sum += c; cnt += (c > 0u) ? 1u : 0u; mine = (j == x) ? c : mine; }
        if (sum == G) break;
        __builtin_amdgcn_s_sleep(1);
        if ((++sp & 255u) == 0u) { if (xb_ld(&bar[XB_TMO])) break; if (sp > XB_SPIN_CAP) { atomicAdd(&bar[XB_TMO], 1u); break; } }
    }
    nloc = mine > 0u ? mine : 1u; nx = cnt > 0u ? cnt : 1u;
}
__device__ __forceinline__ void xcd_barrier(const XcdBarrier& b) {
    asm volatile("s_waitcnt vmcnt(0)" ::: "memory");
    __syncthreads();
    if (threadIdx.x == 0) {
        unsigned* bar = b.bar;
        __builtin_amdgcn_s_waitcnt(0);
        unsigned nloc = b.st[0], nx = b.st[1];
        if (nloc == 0u) { xcd_barrier_complete(bar, b.x, nloc, nx); b.st[0] = nloc; b.st[1] = nx; }
        const unsigned old = xb_add(&bar[XB_XSUB(b.x)], 1u);
        const unsigned gen = old / nloc;
        if (old + 1u == (gen + 1u) * nloc) {
            __builtin_amdgcn_fence(__ATOMIC_RELEASE, "agent");
            asm volatile("s_waitcnt vmcnt(0)" ::: "memory");
            const unsigned og = xb_add(&bar[XB_TOP], 1u);
            const unsigned tg = og / nx;
            if (og + 1u == (tg + 1u) * nx) xb_add(&bar[XB_TOPGEN], 1u);
            else XB_SPIN(xb_ld(&bar[XB_TOPGEN]) == tg, bar);
            __builtin_amdgcn_fence(__ATOMIC_ACQUIRE, "agent");
            xb_add(&bar[XB_XGEN(b.x)], 1u);
            asm volatile("s_waitcnt vmcnt(0)" ::: "memory");
        } else {
            XB_SPIN(xb_ld(&bar[XB_XGEN(b.x)]) == gen, bar);
            __builtin_amdgcn_fence(__ATOMIC_ACQUIRE, "agent");
            asm volatile("s_waitcnt vmcnt(0)" ::: "memory");
        }
    }
    __syncthreads();
}

namespace pg8 {
constexpr int BM = 256, BK = 64, HALF = 128, HTB = HALF * BK * 2, STAGE_BYTES = 8 * HTB;
__device__ __forceinline__ int lds_byte(int r, int c) { const int st = (r >> 4) * 2 + (c >> 5), rr = r & 15, cc = c & 31, ob = rr * 64 + cc * 2; return st * 1024 + (ob ^ (((ob >> 9) & 1) << 5)); }
__device__ __forceinline__ void stage_rc(int b, int& R, int& C) { const int st = b / 1024, sb = b % 1024, swz = sb ^ (((sb >> 9) & 1) << 5); R = (st >> 1) * 16 + swz / 64; C = (st & 1) * 32 + (swz % 64) / 2; }
__device__ __forceinline__ int perm32(int rho) { const int n = rho >> 4, i = rho & 15; return 8 * (i >> 2) + 4 * n + (i & 3); }

struct Unit { int pn; int orow0; int mt; int e; };

template <class Epi, class Sched, int FP8 = 0>
__device__ __forceinline__ void gemm_phase(LAS unsigned char* lds, const char* Abase, const char* Bbase, const int K, const Sched& S, const Epi& E) {
    int tid_ = threadIdx.x; asm volatile("" : "+v"(tid_));
    const int tid = tid_, wid = __builtin_amdgcn_readfirstlane(tid >> 6), lane = tid & 63, wr = wid >> 2, wc = wid & 3, fr = lane & 15, fq = lane >> 4;
    const unsigned K2 = FP8 ? (unsigned)K : (unsigned)K * 2u;
    const int nt = (int)(K2 / 128u);
    int Rr[2], Cc[2]; unsigned voffB[2];
#pragma unroll
    for (int i = 0; i < 2; ++i) { stage_rc(tid * 16 + i * 8192, Rr[i], Cc[i]); const int Rb = (Rr[i] & ~31) + perm32(Rr[i] & 31); voffB[i] = (unsigned)Rb * K2 + (unsigned)Cc[i] * 2u; }
    const size_t kstep = (size_t)(BK * 2);
    const size_t hstep = (size_t)HALF * K2;
    const unsigned ldsw = (unsigned)wid * 1024u;
    const int aoff = FP8 ? lds_byte(wr * 64 + fr, 32 * (fq >> 1) + 16 * (fq & 1)) : lds_byte(wr * 64 + fr, fq * 8), boff = FP8 ? lds_byte(wc * 32 + fr, 32 * (fq >> 1) + 16 * (fq & 1)) : lds_byte(wc * 32 + fr, fq * 8);
#define PG8_SA(b, h) (((b) * 2 + (h)) * HTB)
#define PG8_SB(b, h) ((4 + (b) * 2 + (h)) * HTB)
#define PG8_STAGE(bufoff, gbase, voff) do { _Pragma("unroll") for (int _i = 0; _i < 2; ++_i) \
        __builtin_amdgcn_global_load_lds((const unsigned*)((const char*)(gbase) + (voff)[_i]), (LAS unsigned*)(lds + (bufoff) + ldsw + _i * 8192), 16, 0, 0); } while (0)
#define PG8_LD8(ptr) __builtin_shufflevector(*(const LAS i32x4_t*)(ptr), *(const LAS i32x4_t*)((ptr) + 16), 0, 1, 2, 3, 4, 5, 6, 7)
#define PG8_LDA(dst, b, h) do { if constexpr (FP8) { _Pragma("unroll") for (int m = 0; m < 4; ++m) dst##8[m] = PG8_LD8(lds + PG8_SA(b, h) + aoff + m * 2048); } \
        else { _Pragma("unroll") for (int m = 0; m < 4; ++m) _Pragma("unroll") for (int k = 0; k < 2; ++k) dst[m][k] = *(const LAS bf16x8*)(lds + PG8_SA(b, h) + aoff + m * 2048 + k * 1024); } } while (0)
#define PG8_LDB(dst, b, h) do { if constexpr (FP8) { _Pragma("unroll") for (int n = 0; n < 2; ++n) dst##8[n] = PG8_LD8(lds + PG8_SB(b, h) + boff + n * 2048); } \
        else { _Pragma("unroll") for (int n = 0; n < 2; ++n) _Pragma("unroll") for (int k = 0; k < 2; ++k) dst[n][k] = *(const LAS bf16x8*)(lds + PG8_SB(b, h) + boff + n * 2048 + k * 1024); } } while (0)
#define PG8_MMA(ai, bj, At, Bt) do { __builtin_amdgcn_s_setprio(1); _Pragma("unroll") for (int m = 0; m < 4; ++m) _Pragma("unroll") for (int n = 0; n < 2; ++n) { \
        if constexpr (FP8) asm volatile("v_mfma_f32_16x16x128_f8f6f4 %0, %1, %2, %0" : "+v"(acc[ai][bj][m][n]) : "v"(Bt##8[n]), "v"(At##8[m])); \
        else { _Pragma("unroll") for (int k = 0; k < 2; ++k) acc[ai][bj][m][n] = __builtin_amdgcn_mfma_f32_16x16x32_bf16(Bt[n][k], At[m][k], acc[ai][bj][m][n], 0, 0, 0); } } \
        __builtin_amdgcn_s_setprio(0); } while (0)
#define PG8_WAIT_V(n) asm volatile("s_waitcnt vmcnt(" #n ")" ::: "memory")
#define PG8_WAIT_L(n) asm volatile("s_waitcnt lgkmcnt(" #n ")" ::: "memory")
#define PG8_BAR __builtin_amdgcn_s_barrier()
#define PG8_SCHED __builtin_amdgcn_sched_barrier(0)
    Unit cur, nxt; int ui = 0;
    if (!S.next(0, cur)) return;
    f32x4 acc[2][2][4][2];
#pragma unroll
    for (int a = 0; a < 2; ++a)
#pragma unroll
        for (int b = 0; b < 2; ++b)
#pragma unroll
            for (int m = 0; m < 4; ++m)
#pragma unroll
                for (int n = 0; n < 2; ++n) { if constexpr (FP8) asm volatile("v_mov_b32 %0, 0\n\tv_mov_b32 %1, 0\n\tv_mov_b32 %2, 0\n\tv_mov_b32 %3, 0" : "=v"(acc[a][b][m][n][0]), "=v"(acc[a][b][m][n][1]), "=v"(acc[a][b][m][n][2]), "=v"(acc[a][b][m][n][3])); else acc[a][b][m][n] = (f32x4){0.f, 0.f, 0.f, 0.f}; }
    if constexpr (FP8) asm volatile("s_nop 7" ::: "memory");
    bf16x8 At[4][2], B0[2][2], B1[2][2];
    i32x8 At8[4], B08[2], B18[2];
    unsigned vAc0[2], vAc1[2], vAn0[2], vAn1[2];
#pragma unroll
    for (int i = 0; i < 2; ++i) { vAc0[i] = (unsigned)S.arow(cur, Rr[i]) * K2 + (unsigned)Cc[i] * 2u; vAc1[i] = (unsigned)S.arow(cur, HALF + Rr[i]) * K2 + (unsigned)Cc[i] * 2u; vAn0[i] = vAc0[i]; vAn1[i] = vAc1[i]; }
    const char* cB = Bbase + S.boff(cur);
    PG8_STAGE(PG8_SB(0, 0), cB, voffB); PG8_STAGE(PG8_SB(0, 1), cB + hstep, voffB); PG8_STAGE(PG8_SA(0, 0), Abase, vAc0); PG8_STAGE(PG8_SA(0, 1), Abase, vAc1);
    if (wr == 1) PG8_BAR;
    PG8_WAIT_V(2); PG8_BAR;
    PG8_STAGE(PG8_SB(1, 0), cB + kstep, voffB); PG8_STAGE(PG8_SA(1, 0), Abase + kstep, vAc0); PG8_STAGE(PG8_SB(1, 1), cB + hstep + kstep, voffB);
    PG8_WAIT_V(6); PG8_BAR;
    for (;;) {
        const bool has_next = S.next(ui + 1, nxt);
        const char* nB = has_next ? Bbase + S.boff(nxt) : cB;
        if (has_next) {
#pragma unroll
            for (int i = 0; i < 2; ++i) { vAn0[i] = (unsigned)S.arow(nxt, Rr[i]) * K2 + (unsigned)Cc[i] * 2u; vAn1[i] = (unsigned)S.arow(nxt, HALF + Rr[i]) * K2 + (unsigned)Cc[i] * 2u; }
        } else {
#pragma unroll
            for (int i = 0; i < 2; ++i) { vAn0[i] = vAc0[i]; vAn1[i] = vAc1[i]; }
        }
        for (int t = 0; t < nt; t += 2) {
            const bool last = (t == nt - 2);
            const char* a1 = Abase + (size_t)(t + 1) * kstep;
            const char* a2 = last ? Abase : Abase + (size_t)(t + 2) * kstep; const char* b2 = last ? nB : cB + (size_t)(t + 2) * kstep;
            const char* a3 = a2 + kstep; const char* b3 = b2 + kstep;
            unsigned v20[2], v21[2];
#pragma unroll
            for (int i = 0; i < 2; ++i) { v20[i] = last ? vAn0[i] : vAc0[i]; v21[i] = last ? vAn1[i] : vAc1[i]; }
            PG8_LDB(B0, 0, 0); PG8_LDB(B1, 0, 1); PG8_SCHED; PG8_LDA(At, 0, 0); PG8_STAGE(PG8_SA(1, 1), a1, vAc1);
            PG8_WAIT_V(8); PG8_WAIT_L(0); PG8_BAR; PG8_MMA(0, 0, At, B0); PG8_MMA(0, 1, At, B1); PG8_BAR; PG8_SCHED;
            PG8_LDA(At, 0, 1); PG8_STAGE(PG8_SB(0, 0), b2, voffB); PG8_STAGE(PG8_SB(0, 1), b2 + hstep, voffB); PG8_STAGE(PG8_SA(0, 0), a2, v20);
            PG8_WAIT_V(8); PG8_WAIT_L(0); PG8_BAR; PG8_MMA(1, 0, At, B0); PG8_MMA(1, 1, At, B1); PG8_BAR; PG8_SCHED;
            PG8_LDB(B0, 1, 0); PG8_LDB(B1, 1, 1); PG8_SCHED; PG8_LDA(At, 1, 0); PG8_STAGE(PG8_SA(0, 1), a2, v21);
            PG8_WAIT_V(8); PG8_WAIT_L(0); PG8_BAR; PG8_MMA(0, 0, At, B0); PG8_MMA(0, 1, At, B1); PG8_BAR; PG8_SCHED;
            PG8_LDA(At, 1, 1); PG8_STAGE(PG8_SB(1, 0), b3, voffB); PG8_STAGE(PG8_SB(1, 1), b3 + hstep, voffB); PG8_STAGE(PG8_SA(1, 0), a3, v20);
            PG8_WAIT_V(8); PG8_WAIT_L(0); PG8_BAR; PG8_MMA(1, 0, At, B0); PG8_MMA(1, 1, At, B1); PG8_BAR; PG8_SCHED;
        }
        if (wr == 0) PG8_BAR;
        if constexpr (FP8) asm volatile("s_nop 15\n\ts_nop 15" ::: "memory");
        E(acc, cur, wr, wc, fr, fq);
        if (!has_next) break;
#pragma unroll
        for (int a = 0; a < 2; ++a)
#pragma unroll
            for (int b = 0; b < 2; ++b)
#pragma unroll
                for (int m = 0; m < 4; ++m)
#pragma unroll
                    for (int n = 0; n < 2; ++n) { if constexpr (FP8) asm volatile("v_mov_b32 %0, 0\n\tv_mov_b32 %1, 0\n\tv_mov_b32 %2, 0\n\tv_mov_b32 %3, 0" : "=v"(acc[a][b][m][n][0]), "=v"(acc[a][b][m][n][1]), "=v"(acc[a][b][m][n][2]), "=v"(acc[a][b][m][n][3])); else acc[a][b][m][n] = (f32x4){0.f, 0.f, 0.f, 0.f}; }
        if constexpr (FP8) asm volatile("s_nop 7" ::: "memory");
        cur = nxt; cB = nB; ++ui;
#pragma unroll
        for (int i = 0; i < 2; ++i) { vAc0[i] = vAn0[i]; vAc1[i] = vAn1[i]; }
        if (wr == 1) PG8_BAR;
    }
    PG8_WAIT_V(0);
    PG8_BAR;
#undef PG8_SA
#undef PG8_SB
#undef PG8_STAGE
#undef PG8_LDA
#undef PG8_LDB
#undef PG8_MMA
#undef PG8_WAIT_V
#undef PG8_WAIT_L
#undef PG8_BAR
#undef PG8_SCHED
}
}
struct LinSched {
    int nM, nN, nwg, G, c; size_t bstride;
    __device__ __forceinline__ void init(int M, int N, int K, int G_, int c_) { nM = M / 256; nN = N / 256; nwg = nM * nN; G = G_; c = c_; bstride = (size_t)256 * K * 2; }
    __device__ __forceinline__ bool next(int i, pg8::Unit& u) const {
        const long L = (long)i * G + c; if (L >= nwg) return false;
        int wgid = (int)L; { const int q = nwg / 8, r = nwg % 8, xcd = wgid % 8, off = wgid / 8; wgid = (xcd < r ? xcd * (q + 1) : r * (q + 1) + (xcd - r) * q) + off; }
        const int nig = 8 * nN, gid = wgid / nig, fm = gid * 8, gsz = (nM - fm) < 8 ? (nM - fm) : 8;
        u.mt = fm + ((wgid % nig) % gsz); u.pn = (wgid % nig) / gsz; u.orow0 = u.mt * 256; u.e = 0; return true;
    }
    __device__ __forceinline__ int arow(const pg8::Unit& u, int lr) const { return u.orow0 + lr; }
    __device__ __forceinline__ size_t boff(const pg8::Unit& u) const { return (size_t)u.pn * bstride; }
};
struct MoeTab { LAS int* ts; LAS int* cnt; LAS unsigned char* tile_e; };
__device__ __forceinline__ MoeTab moe_tab(LAS unsigned char* lds) { MoeTab t; t.ts = (LAS int*)(lds + LDSX_OFF); t.cnt = (LAS int*)(lds + LDSX_OFF + 256); t.tile_e = (LAS unsigned char*)(lds + LDSX_OFF + 512); return t; }
__device__ __forceinline__ void moe_tables(LAS unsigned char* lds, const unsigned* gcnt) {
    MoeTab T = moe_tab(lds);
    __syncthreads();
    if (threadIdx.x == 0) { int s = 0; for (int e = 0; e < NEXP; ++e) { const int c = (int)gcnt[e]; T.cnt[e] = c; T.ts[e] = s; s += (c + 255) >> 8; } T.ts[NEXP] = s; }
    __syncthreads();
    const int nt = T.ts[NEXP];
    for (int mt = threadIdx.x; mt < nt; mt += blockDim.x) { int e = 0; for (int j = 1; j < NEXP; ++j) e += (mt >= T.ts[j]) ? 1 : 0; T.tile_e[mt] = (unsigned char)e; }
    __syncthreads();
}
template <int GATHER> struct MoeSched {
    MoeTab T; const int* rowtok; int G, c; size_t bstride; size_t estride;
    __device__ __forceinline__ bool next(int i, pg8::Unit& u) const {
        const int L = i * G + c; const int nt = T.ts[NEXP]; if (L >= nt * 4) return false;
        u.mt = L >> 2; u.pn = L & 3; u.orow0 = u.mt * 256; u.e = (int)T.tile_e[u.mt]; return true;
    }
    __device__ __forceinline__ int arow(const pg8::Unit& u, int lr) const {
        if (GATHER) { const int idx = (u.mt - T.ts[u.e]) * 256 + lr; return idx < T.cnt[u.e] ? rowtok[(size_t)u.e * NTOK + idx] : 0; }
        return u.orow0 + lr;
    }
    __device__ __forceinline__ size_t boff(const pg8::Unit& u) const { return (size_t)u.e * estride + (size_t)u.pn * bstride; }
};

__device__ __forceinline__ u32x4 pack8(const f32x4 a, const f32x4 b) { u32x4 w; w.x = pk2(a[0], a[1]); w.y = pk2(a[2], a[3]); w.z = pk2(b[0], b[1]); w.w = pk2(b[2], b[3]); return w; }
struct EpiPlain {
    bf16* O; int ldc;
    __device__ __forceinline__ void operator()(const f32x4 (&acc)[2][2][4][2], const pg8::Unit& u, int wr, int wc, int fr, int fq) const {
        const int row0 = u.orow0 + wr * 64 + fr, col0 = u.pn * 256 + wc * 32 + 8 * fq;
#pragma unroll
        for (int ai = 0; ai < 2; ++ai)
#pragma unroll
            for (int m = 0; m < 4; ++m) { bf16* rowp = O + (size_t)(row0 + ai * 128 + m * 16) * ldc + col0;
#pragma unroll
                for (int bj = 0; bj < 2; ++bj) *(u32x4*)(rowp + bj * 128) = pack8(acc[ai][bj][m][0], acc[ai][bj][m][1]); }
    }
};
struct EpiPlainS {
    bf16* O; int ldc; float sc;
    __device__ __forceinline__ void operator()(const f32x4 (&acc)[2][2][4][2], const pg8::Unit& u, int wr, int wc, int fr, int fq) const {
        const int row0 = u.orow0 + wr * 64 + fr, col0 = u.pn * 256 + wc * 32 + 8 * fq;
#pragma unroll
        for (int ai = 0; ai < 2; ++ai)
#pragma unroll
            for (int m = 0; m < 4; ++m) { bf16* rowp = O + (size_t)(row0 + ai * 128 + m * 16) * ldc + col0;
#pragma unroll
                for (int bj = 0; bj < 2; ++bj) *(u32x4*)(rowp + bj * 128) = pack8(acc[ai][bj][m][0] * sc, acc[ai][bj][m][1] * sc); }
    }
};
struct EpiEvenIn {
    bf16* O; const float* rope;
    __device__ __forceinline__ void operator()(const f32x4 (&acc)[2][2][4][2], const pg8::Unit& u, int wr, int wc, int fr, int fq) const {
        const int row0 = u.orow0 + wr * 64 + fr, col0 = u.pn * 256 + wc * 32 + 8 * fq;
        const bool lat = u.orow0 < NLAT;
#pragma unroll
        for (int ai = 0; ai < 2; ++ai)
#pragma unroll
            for (int m = 0; m < 4; ++m) { const int row = row0 + ai * 128 + m * 16; bf16* rowp = O + (size_t)row * EN + col0;
                const int s = row & (SEQ - 1); const int pos = (wc & 1) ? (s & 63) : (s >> 6);
#pragma unroll
                for (int bj = 0; bj < 2; ++bj) { f32x4 v0 = acc[ai][bj][m][0], v1 = acc[ai][bj][m][1];
                    const bool rp = lat && (u.pn < 2 || (u.pn == 2 && bj == 0));
                    if (rp) { const f32x4 c = *(const f32x4*)(rope + pos * 16 + 4 * fq), sn = *(const f32x4*)(rope + 1024 + pos * 16 + 4 * fq);
                        const f32x4 o1 = v0 * c - v1 * sn, o2 = v1 * c + v0 * sn; v0 = o1; v1 = o2; }
                    *(u32x4*)(rowp + bj * 128) = pack8(v0, v1); } }
    }
};
struct EpiOddIn {
    bf16* O;
    __device__ __forceinline__ void operator()(const f32x4 (&acc)[2][2][4][2], const pg8::Unit& u, int wr, int wc, int fr, int fq) const {
        const int row0 = u.orow0 + wr * 64 + fr;
#pragma unroll
        for (int ai = 0; ai < 2; ++ai)
#pragma unroll
            for (int m = 0; m < 4; ++m) { bf16* rowp = O + (size_t)(row0 + ai * 128 + m * 16) * 2048;
                if (u.pn < 4) {
#pragma unroll
                    for (int bj = 0; bj < 2; ++bj) *(u32x4*)(rowp + u.pn * 256 + bj * 128 + wc * 32 + 8 * fq) = pack8(acc[ai][bj][m][0], acc[ai][bj][m][1]);
                } else {
                    *(u32x4*)(rowp + 1024 + (u.pn - 4) * 128 + wc * 32 + 8 * fq) = pack8(acc[ai][0][m][0] * acc[ai][1][m][0], acc[ai][0][m][1] * acc[ai][1][m][1]);
                } }
    }
};
struct EpiG1 {
    unsigned char* O; float sc;
    __device__ __forceinline__ void operator()(const f32x4 (&acc)[2][2][4][2], const pg8::Unit& u, int wr, int wc, int fr, int fq) const {
        const int row0 = u.orow0 + wr * 64 + fr, col0 = u.pn * 128 + wc * 32 + 8 * fq;
#pragma unroll
        for (int ai = 0; ai < 2; ++ai)
#pragma unroll
            for (int m = 0; m < 4; ++m) { unsigned char* rowp = O + (size_t)(row0 + ai * 128 + m * 16) * DEXP + col0;
                f32x4 a0 = acc[ai][0][m][0] * sc, a1 = acc[ai][0][m][1] * sc;
#pragma unroll
                for (int j = 0; j < 4; ++j) { a0[j] = fast_silu(a0[j]); a1[j] = fast_silu(a1[j]); }
                const f32x4 h0 = a0 * (acc[ai][1][m][0] * sc), h1v = a1 * (acc[ai][1][m][1] * sc);
                *(u32x2*)rowp = (u32x2){pk4_fp8(h0[0], h0[1], h0[2], h0[3]), pk4_fp8(h1v[0], h1v[1], h1v[2], h1v[3])}; }
    }
};
struct Frame {
    LAS unsigned char* lds;
    int tid, lane, wave, vcu, G;
    float* out; unsigned char* ws;
};
__device__ __forceinline__ const float* inptr(const Frame& F, int i) {
    const unsigned long long v = ((const LAS unsigned long long*)(F.lds + MISC_OFF + 256))[i];
    const unsigned lo = __builtin_amdgcn_readfirstlane((unsigned)v), hi = __builtin_amdgcn_readfirstlane((unsigned)(v >> 32));
    return (const float*)(((unsigned long long)hi << 32) | lo);
}
enum { I_X = 0, I_C, I_CTX, I_CCTX, I_WINE, I_WOUTE, I_SINK, I_WA2, I_BA, I_NORMW, I_WINO, I_CONVW, I_CONVB, I_WOUTO, I_ADAW, I_ADAB, I_LNW, I_LNB, I_WG, I_BG, I_WE, I_BE, I_W1, I_W3, I_W2 };
__device__ __forceinline__ int launder_v(int x) { asm volatile("" : "+v"(x)); return x; }
__device__ __forceinline__ int launder_s(int x) { asm volatile("" : "+s"(x)); return x; }
__device__ __forceinline__ Frame relaunder(const Frame& F0) { Frame F = F0; F.tid = launder_v(F0.tid); F.lane = F.tid & 63; F.wave = __builtin_amdgcn_readfirstlane(F.tid >> 6); F.vcu = launder_s(F0.vcu); return F; }
__device__ __forceinline__ const float* modp(const Frame& F, int l, int bi, int n) { return (const float*)(F.ws + WS_MOD) + ((size_t)(l * 17 + bi) * 6 + n) * D; }
__device__ __forceinline__ int row_bi(int row) { return row < NLAT ? (row >> 12) : 16; }

__device__ __forceinline__ void sincos_d(double a, float& c, float& s) {
    const double TWO_OVER_PI = 0.63661977236758134308, PIO2_HI = 1.57079632679489655800e+00, PIO2_LO = 6.12323399573676603587e-17;
    const double n = __builtin_rint(a * TWO_OVER_PI); double r = (a - n * PIO2_HI) - n * PIO2_LO; const double r2 = r * r;
    double sp = -1.0 / 1307674368000.0; sp = sp * r2 + 1.0 / 6227020800.0; sp = sp * r2 - 1.0 / 39916800.0; sp = sp * r2 + 1.0 / 362880.0; sp = sp * r2 - 1.0 / 5040.0; sp = sp * r2 + 1.0 / 120.0; sp = sp * r2 - 1.0 / 6.0; sp = sp * r2 + 1.0; sp *= r;
    double cp = 1.0 / 20922789888000.0; cp = cp * r2 - 1.0 / 87178291200.0; cp = cp * r2 + 1.0 / 479001600.0; cp = cp * r2 - 1.0 / 3628800.0; cp = cp * r2 + 1.0 / 40320.0; cp = cp * r2 - 1.0 / 720.0; cp = cp * r2 + 1.0 / 24.0; cp = cp * r2 - 0.5; cp = cp * r2 + 1.0;
    const int q = ((int)n) & 3;
    const double sv = (q == 0) ? sp : (q == 1) ? cp : (q == 2) ? -sp : -cp;
    const double cv = (q == 0) ? cp : (q == 1) ? -sp : (q == 2) ? -cp : sp;
    c = (float)cv; s = (float)sv;
}
__device__ __forceinline__ void ph_ada(const Frame& F0) {
    Frame F = relaunder(F0);
    LAS float* sl = (LAS float*)F.lds;
    LAS float* red = (LAS float*)(F.lds + 17 * 1024 * 4);
    for (int idx = F.tid; idx < 17 * 1024; idx += 512) { const int bi = idx >> 10, k = idx & 1023; const float c = bi < 16 ? inptr(F, I_C)[bi * 1024 + k] : inptr(F, I_CCTX)[k]; sl[idx] = c / (1.0f + expf(-c)); }
    __syncthreads();
    for (int it = F.vcu; it < 4 * 96; it += F.G) {
        const int l = it / 96, n0 = (it % 96) * 64;
        const float* W = inptr(F, I_ADAW) + (size_t)l * 1024 * 6144 + n0 + F.lane;
        float acc[17];
#pragma unroll
        for (int b = 0; b < 17; ++b) acc[b] = 0.f;
        const int kb = F.wave * 128;
        for (int k = kb; k < kb + 128; k += 4) {
            const float w0 = __builtin_nontemporal_load(W + (size_t)k * 6144), w1 = __builtin_nontemporal_load(W + (size_t)(k + 1) * 6144), w2 = __builtin_nontemporal_load(W + (size_t)(k + 2) * 6144), w3 = __builtin_nontemporal_load(W + (size_t)(k + 3) * 6144);
#pragma unroll
            for (int b = 0; b < 17; ++b) { const f32x4 s = *(const LAS f32x4*)(sl + b * 1024 + k); acc[b] += s[0] * w0 + s[1] * w1 + s[2] * w2 + s[3] * w3; }
        }
#pragma unroll
        for (int b = 0; b < 17; ++b) red[(F.wave * 17 + b) * 64 + F.lane] = acc[b];
        __syncthreads();
        for (int idx = F.tid; idx < 17 * 64; idx += 512) { const int b = idx >> 6, ln = idx & 63; float s = 0.f;
#pragma unroll
            for (int w = 0; w < 8; ++w) s += red[(w * 17 + b) * 64 + ln];
            ((float*)(F.ws + WS_MOD))[(size_t)(l * 17 + b) * 6144 + n0 + ln] = s + inptr(F, I_ADAB)[l * 6144 + n0 + ln]; }
        __syncthreads();
    }
    if (F.vcu == F.G - 1) {
        float* rope = (float*)(F.ws + WS_ROPE);
        for (int idx = F.tid; idx < 1024; idx += 512) { const int pos = idx >> 4, f = idx & 15;
            const double base4[4] = {1.0, 0.56234132519034908, 0.31622776601683794, 0.17782794100389228};
            double inv = (f & 3) == 0 ? base4[0] : (f & 3) == 1 ? base4[1] : (f & 3) == 2 ? base4[2] : base4[3];
            const int a = f >> 2; inv *= (a == 0) ? 1.0 : (a == 1) ? 0.1 : (a == 2) ? 0.01 : 0.001;
            float c, s; sincos_d((double)pos * inv, c, s); rope[idx] = c; rope[1024 + idx] = s; }
    }
}

__device__ __forceinline__ void tr_item(const float* W, int srcN, int K, bf16* WT, int drow0, int k0, int srccol, LAS float* scr, int lane) {
    float v[32];
    const float* p = W + (size_t)(k0 + (lane >> 5)) * srcN + (srccol >= 0 ? srccol : 0);
#pragma unroll
    for (int i = 0; i < 32; ++i) v[i] = __builtin_nontemporal_load(p + (size_t)(2 * i) * srcN);
#pragma unroll
    for (int i = 0; i < 32; ++i) scr[(2 * i + (lane >> 5)) * 33 + (lane & 31)] = srccol >= 0 ? v[i] : 0.f;
    asm volatile("s_waitcnt lgkmcnt(0)" ::: "memory");
    const int c = lane & 7;
#pragma unroll
    for (int j = 0; j < 4; ++j) { const int n = (lane >> 3) + 8 * j; const LAS float* s = scr + (8 * c) * 33 + n;
        u32x4 o; o.x = pk2(s[0 * 33], s[1 * 33]); o.y = pk2(s[2 * 33], s[3 * 33]); o.z = pk2(s[4 * 33], s[5 * 33]); o.w = pk2(s[6 * 33], s[7 * 33]);
        *(u32x4*)(WT + (size_t)(drow0 + n) * K + k0 + 8 * c) = o; }
    asm volatile("s_waitcnt lgkmcnt(0)" ::: "memory");
}
__device__ __forceinline__ void tr_item8(const float* W, int srcN, int K, unsigned char* WT, int drow0, int k0, int srccol, float scale, LAS float* scr, int lane) {
    float v[32];
    const float* p = W + (size_t)(k0 + (lane >> 5)) * srcN + srccol;
#pragma unroll
    for (int i = 0; i < 32; ++i) v[i] = __builtin_nontemporal_load(p + (size_t)(2 * i) * srcN);
#pragma unroll
    for (int i = 0; i < 32; ++i) scr[(2 * i + (lane >> 5)) * 33 + (lane & 31)] = v[i] * scale;
    asm volatile("s_waitcnt lgkmcnt(0)" ::: "memory");
    const int c = lane & 3;
#pragma unroll
    for (int j = 0; j < 2; ++j) { const int n = (lane >> 2) + 16 * j; const LAS float* s = scr + (16 * c) * 33 + n;
        u32x4 o; o.x = pk4_fp8(s[0 * 33], s[1 * 33], s[2 * 33], s[3 * 33]); o.y = pk4_fp8(s[4 * 33], s[5 * 33], s[6 * 33], s[7 * 33]);
        o.z = pk4_fp8(s[8 * 33], s[9 * 33], s[10 * 33], s[11 * 33]); o.w = pk4_fp8(s[12 * 33], s[13 * 33], s[14 * 33], s[15 * 33]);
        *(u32x4*)(WT + (size_t)(drow0 + n) * K + k0 + 16 * c) = o; }
    asm volatile("s_waitcnt lgkmcnt(0)" ::: "memory");
}
__device__ __forceinline__ int even_srccol(int j) {
    if (j < 640) { const int hb = j & ~63, p = j & 63, g = p >> 3, e = p & 7; return hb + (g >> 2) * 32 + (e >> 2) * 16 + (g & 3) * 4 + (e & 3); }
    return j < EVEN_IN ? j : -1;
}
__device__ __forceinline__ int odd_srccol(int j) { const int t = j >> 8, r = j & 255; if (t < 4) return j; return (r < 128 ? 1024 : 2048 - 128) + 128 * (t - 4) + r; }
__device__ __forceinline__ void conv_dense_weights(const Frame& F0) {
    Frame F = relaunder(F0);
    LAS float* scr = (LAS float*)(F.lds + F.wave * 16384);
    const int gw = F.vcu * 8 + F.wave, NGW = F.G * 8;
    constexpr int I_EI = 16 * 80, I_SQ = 16 * 32, I_OI = 16 * 96;
    constexpr int NIT = 2 * (I_EI + I_SQ + I_OI + I_SQ);
    for (int it = gw; it < NIT; it += NGW) {
        int r = it; const int i = r & 1; r >>= 1;
        if (r < I_EI) { const int kb = r / 80, nb = r % 80; tr_item(inptr(F, I_WINE) + (size_t)i * 1024 * EVEN_IN, EVEN_IN, 1024, (bf16*)(F.ws + WS_WINE) + (size_t)i * EN * 1024, nb * 32, kb * 64, even_srccol(nb * 32 + (F.lane & 31)), scr, F.lane); continue; } r -= I_EI;
        if (r < I_SQ) { const int kb = r / 32, nb = r % 32; tr_item(inptr(F, I_WOUTE) + (size_t)i * 1024 * 1024, 1024, 1024, (bf16*)(F.ws + WS_WOUTE) + (size_t)i * 1024 * 1024, nb * 32, kb * 64, nb * 32 + (F.lane & 31), scr, F.lane); continue; } r -= I_SQ;
        if (r < I_OI) { const int kb = r / 96, nb = r % 96; tr_item(inptr(F, I_WINO) + (size_t)i * 1024 * ON, ON, 1024, (bf16*)(F.ws + WS_WINO) + (size_t)i * ON * 1024, nb * 32, kb * 64, odd_srccol(nb * 32 + (F.lane & 31)), scr, F.lane); continue; } r -= I_OI;
        { const int kb = r / 32, nb = r % 32; tr_item(inptr(F, I_WOUTO) + (size_t)i * 1024 * 1024, 1024, 1024, (bf16*)(F.ws + WS_WOUTO) + (size_t)i * 1024 * 1024, nb * 32, kb * 64, nb * 32 + (F.lane & 31), scr, F.lane); }
    }
}
constexpr float W8_SCALE = 64.0f;
__device__ __forceinline__ void conv_moe_item(const Frame& F, int l, int it, LAS float* scr) {
    constexpr int I_13 = 16 * 32, I_2 = 8 * 32;
    const int e = it / (I_13 + I_2); int r = it % (I_13 + I_2);
    const size_t eoff = ((size_t)l * NEXP + e) * 1024 * 512;
    if (r < I_13) { const int kb = r / 32, nb = r % 32; const int j0 = nb * 32, t = j0 >> 8, rr = j0 & 255;
        const float* src = (rr < 128 ? inptr(F, I_W1) : inptr(F, I_W3)) + eoff;
        tr_item8(src, 512, 1024, (unsigned char*)(F.ws + WS_W13) + (size_t)e * 1024 * 1024, j0, kb * 64, 128 * t + (rr & 127) + (F.lane & 31), W8_SCALE, scr, F.lane);
    } else { r -= I_13; const int kb = r / 32, nb = r % 32;
        tr_item8(inptr(F, I_W2) + eoff, 1024, 512, (unsigned char*)(F.ws + WS_W2) + (size_t)e * 1024 * 512, nb * 32, kb * 64, nb * 32 + (F.lane & 31), W8_SCALE, scr, F.lane); }
}
__device__ __forceinline__ void conv_moe_weights(const Frame& F0, int l) {
    Frame F = relaunder(F0); const int gw = F.vcu * 8 + F.wave, NGW = F.G * 8;
    LAS float* scr = (LAS float*)(F.lds + F.wave * 16384);
    for (int it = gw; it < NEXP * (16 * 32 + 8 * 32); it += NGW) conv_moe_item(F, l, it, scr);
}
__device__ __forceinline__ void ph_u0(const Frame& F0) {
    Frame F = relaunder(F0);
    const int gw = F.vcu * 8 + F.wave, NGW = F.G * 8;
    for (int r0 = gw * 4; r0 < NTOK; r0 += NGW * 4) {
        const int bi = row_bi(r0); const float* sh = modp(F, 0, bi, 0); const float* sc = modp(F, 0, bi, 1);
        f32x4 x[4][4];
#pragma unroll
        for (int r = 0; r < 4; ++r) { const int row = r0 + r; const float* src = row < NLAT ? inptr(F, I_X) + (size_t)row * D : inptr(F, I_CTX) + (size_t)(row - NLAT) * D;
#pragma unroll
            for (int j = 0; j < 4; ++j) x[r][j] = __builtin_nontemporal_load((const f32x4*)(src + 4 * F.lane + 256 * j)); }
#pragma unroll
        for (int j = 0; j < 4; ++j) { const int c = 4 * F.lane + 256 * j; const f32x4 a = *(const f32x4*)(sh + c), s = *(const f32x4*)(sc + c);
#pragma unroll
            for (int r = 0; r < 4; ++r) { const f32x4 u = x[r][j] * (1.0f + s) + a; u32x2 w; w.x = pk2(u[0], u[1]); w.y = pk2(u[2], u[3]); *(u32x2*)((bf16*)(F.ws + WS_U) + (size_t)(r0 + r) * D + c) = w; } }
    }
}

struct RowLN { f32x4 v[4]; };
__device__ __forceinline__ void ln_stats(f32x4 (&z)[4], float& mean, float& rstd) {
    float s = 0.f;
#pragma unroll
    for (int j = 0; j < 4; ++j) s += (z[j][0] + z[j][1]) + (z[j][2] + z[j][3]);
    mean = wave_sum(s) * (1.0f / D); float q = 0.f;
#pragma unroll
    for (int j = 0; j < 4; ++j) { z[j] = z[j] - mean; q += (z[j][0] * z[j][0] + z[j][1] * z[j][1]) + (z[j][2] * z[j][2] + z[j][3] * z[j][3]); }
    rstd = 1.0f / sqrtf(wave_sum(q) * (1.0f / D) + LN_EPS);
}
__device__ __forceinline__ void ln_rows(f32x4 (&z)[4], const float* lw, const float* lb, int lane) {
    float s = 0.f;
#pragma unroll
    for (int j = 0; j < 4; ++j) s += (z[j][0] + z[j][1]) + (z[j][2] + z[j][3]);
    const float mean = wave_sum(s) * (1.0f / D); float q = 0.f;
#pragma unroll
    for (int j = 0; j < 4; ++j) { z[j] = z[j] - mean; q += (z[j][0] * z[j][0] + z[j][1] * z[j][1]) + (z[j][2] * z[j][2] + z[j][3] * z[j][3]); }
    const float rstd = 1.0f / sqrtf(wave_sum(q) * (1.0f / D) + LN_EPS);
#pragma unroll
    for (int j = 0; j < 4; ++j) { const int c = 4 * lane + 256 * j; z[j] = z[j] * rstd * *(const f32x4*)(lw + c) + *(const f32x4*)(lb + c); }
}
__device__ __forceinline__ void ph_ln1(const Frame& F0, int l, int nrows, bool dry = false) {
    Frame F = relaunder(F0);
    LAS unsigned char* Thi = F.lds; LAS unsigned char* Tlo = F.lds + 33024;
    LAS float* red = (LAS float*)(F.lds + 66048);
    LAS float* lgt = (LAS float*)(F.lds + 82432);
    LAS int* lcnt = (LAS int*)(F.lds + 87552); LAS int* lbase = lcnt + 32;
    LAS unsigned* list = (LAS unsigned*)(F.lds + 87808);
    LAS float* LW = (LAS float*)(F.lds + 97024); LAS float* LB = LW + 1024; LAS float* WG = LB + 1024;
    const int lane = F.lane, w = F.wave;
    if (F.tid < 64) lcnt[F.tid] = 0;
    { const float* lwg = inptr(F, I_LNW) + (size_t)(l * 2 + 0) * D; const float* lbg = inptr(F, I_LNB) + (size_t)(l * 2 + 0) * D; const float* wgg = inptr(F, I_WG) + (size_t)l * 1024 * 4;
      for (int i = F.tid; i < 256; i += 512) { *(LAS f32x4*)(LW + 4 * i) = *(const f32x4*)(lwg + 4 * i); *(LAS f32x4*)(LB + 4 * i) = *(const f32x4*)(lbg + 4 * i); }
      for (int i = F.tid; i < 1024; i += 512) *(LAS f32x4*)(WG + 4 * i) = *(const f32x4*)(wgg + 4 * i); }
    bf16x8 Whi[2][4], Wlo[2][4];
    {
        const int n = lane & 15, kg = lane >> 4;
        const float* we = inptr(F, I_WE) + (size_t)l * 1024 * 32 + (size_t)(w * 128 + kg * 8) * 32 + n;
#pragma unroll
        for (int nt = 0; nt < 2; ++nt)
#pragma unroll
            for (int ks = 0; ks < 4; ++ks) { u32x4 hi, lo; unsigned hh[8], ll[8];
                const float* p = we + ks * 32 * 32 + nt * 16;
                asm volatile("" : "+v"(p));
#pragma unroll
                for (int j = 0; j < 8; ++j) {
                    const float v = p[j * 32];
                    const unsigned h = pk2(v, 0.f) & 0xffffu; const float r = v - __uint_as_float(h << 16); hh[j] = h; ll[j] = pk2(r, 0.f) & 0xffffu; }
                hi.x = hh[0] | (hh[1] << 16); hi.y = hh[2] | (hh[3] << 16); hi.z = hh[4] | (hh[5] << 16); hi.w = hh[6] | (hh[7] << 16);
                lo.x = ll[0] | (ll[1] << 16); lo.y = ll[2] | (ll[3] << 16); lo.z = ll[4] | (ll[5] << 16); lo.w = ll[6] | (ll[7] << 16);
                Whi[nt][ks] = __builtin_bit_cast(bf16x8, hi); Wlo[nt][ks] = __builtin_bit_cast(bf16x8, lo); }
    }
    const bf16* Y = (const bf16*)(F.ws + WS_P);
    const float* hsl = (l == 0 ? inptr(F, I_X) : F.out); const float* hsc = (l == 0 ? inptr(F, I_CTX) : (const float*)(F.ws + WS_HCTX));
    const float* bgp = inptr(F, I_BG) + l * 4; const float* bep = inptr(F, I_BE) + l * 32;
    const bool usey = !((l & 1) ? (KO_MASK & 4) : ((KO_MASK & 3) == 3));
    const int nbatch = nrows / 16; int nlist = 0; int prev_rbase = -1;
#define LN1_ROUTE(buf_, rbase_, slot_) do { if (F.tid < 16) { const int tk = F.tid; const LAS float* lg = lgt + (buf_) * 640 + tk * 40; \
        float gl[4]; _Pragma("unroll") for (int j = 0; j < 4; ++j) gl[j] = lg[32 + j] + bgp[j]; \
        float gmax = gl[0]; int g = 0; _Pragma("unroll") for (int j = 1; j < 4; ++j) if (gl[j] > gmax) { gmax = gl[j]; g = j; } \
        float den = 0.f; _Pragma("unroll") for (int j = 0; j < 4; ++j) den += expf(gl[j] - gmax); \
        const float pg = 1.0f / den; float el[8]; _Pragma("unroll") for (int j = 0; j < 8; ++j) el[j] = lg[g * 8 + j] + bep[g * 8 + j]; \
        float m0 = el[0]; int i0 = 0; _Pragma("unroll") for (int j = 1; j < 8; ++j) if (el[j] > m0) { m0 = el[j]; i0 = j; } \
        float m1 = -3.0e38f; int i1 = 0; _Pragma("unroll") for (int j = 0; j < 8; ++j) if (j != i0 && el[j] > m1) { m1 = el[j]; i1 = j; } \
        const float ex = expf(m1 - m0); const float w0 = pg / (1.0f + ex), w1 = pg * ex / (1.0f + ex); \
        const int e0 = g * 8 + i0, e1 = g * 8 + i1; \
        const int p0 = atomicAdd((int*)&lcnt[e0], 1), p1 = atomicAdd((int*)&lcnt[e1], 1); \
        LAS unsigned* L = list + ((slot_) * 16 + tk) * 8; \
        L[0] = (unsigned)((rbase_) + tk); L[1] = (unsigned)e0; L[2] = (unsigned)p0; L[3] = __float_as_uint(w0); L[4] = (unsigned)e1; L[5] = (unsigned)p1; L[6] = __float_as_uint(w1); } } while (0)
    __syncthreads();
    for (int bt = F.vcu; bt < nbatch; bt += F.G) {
        const int rbase = bt * 16; const int bi = row_bi(rbase);
        const float* g2 = modp(F, l, bi, 2); const float* sh = modp(F, l, bi, 3); const float* sc = modp(F, l, bi, 4);
        {
            f32x4 hv[2][4], gv[4], scv[4], shv[4]; u32x2 yv[2][4];
#pragma unroll
            for (int rr = 0; rr < 2; ++rr) { const int row = rbase + 2 * w + rr; const float* hs = row < NLAT ? hsl + (size_t)row * D : hsc + (size_t)(row - NLAT) * D;
#pragma unroll
                for (int j = 0; j < 4; ++j) { const int c = 4 * lane + 256 * j; hv[rr][j] = __builtin_nontemporal_load((const f32x4*)(hs + c)); yv[rr][j] = usey ? __builtin_nontemporal_load((const u32x2*)(Y + (size_t)row * D + c)) : (u32x2){0u, 0u}; } }
#pragma unroll
            for (int j = 0; j < 4; ++j) { const int c = 4 * lane + 256 * j; gv[j] = *(const f32x4*)(g2 + c); scv[j] = *(const f32x4*)(sc + c); shv[j] = *(const f32x4*)(sh + c); }
            f32x4 z[2][4]; float mean[2], rstd[2];
#pragma unroll
            for (int rr = 0; rr < 2; ++rr)
#pragma unroll
                for (int j = 0; j < 4; ++j) z[rr][j] = DN_ALPHA * hv[rr][j] + gv[j] * (f32x4){bflo(yv[rr][j].x), bfhi(yv[rr][j].x), bflo(yv[rr][j].y), bfhi(yv[rr][j].y)};
#pragma unroll
            for (int rr = 0; rr < 2; ++rr) ln_stats(z[rr], mean[rr], rstd[rr]);
            f32x4 ga[2] = {(f32x4){0.f, 0.f, 0.f, 0.f}, (f32x4){0.f, 0.f, 0.f, 0.f}};
#pragma unroll
            for (int j = 0; j < 4; ++j) { const int c = 4 * lane + 256 * j;
                const f32x4 lwv = *(const LAS f32x4*)(LW + c), lbv = *(const LAS f32x4*)(LB + c);
                const f32x4 g0 = *(const LAS f32x4*)(WG + 4 * c), g1 = *(const LAS f32x4*)(WG + 4 * c + 4), g2v = *(const LAS f32x4*)(WG + 4 * c + 8), g3 = *(const LAS f32x4*)(WG + 4 * c + 12);
#pragma unroll
                for (int rr = 0; rr < 2; ++rr) { const int lr = 2 * w + rr, row = rbase + lr;
                    float* hd = dry ? (float*)(F.ws + WS_GATT) + (size_t)row * D : (row < NLAT ? F.out + (size_t)row * D : (float*)(F.ws + WS_HCTX) + (size_t)(row - NLAT) * D);
                    const f32x4 zn = z[rr][j] * rstd[rr] * lwv + lbv;
                    __builtin_nontemporal_store(zn, (f32x4*)(hd + c));
                    const f32x4 t = zn * (1.0f + scv[j]) + shv[j];
                    ga[rr] += t[0] * g0 + t[1] * g1 + t[2] * g2v + t[3] * g3;
                    const unsigned h01 = pk2(t[0], t[1]), h23 = pk2(t[2], t[3]);
                    u32x2 hw; hw.x = h01; hw.y = h23;
                    *(unsigned*)((unsigned char*)(F.ws + (dry ? WS_Q : WS_U8)) + (size_t)row * D + c) = pk4_fp8(t[0], t[1], t[2], t[3]);
                    const float r0 = t[0] - bflo(h01), r1 = t[1] - bfhi(h01), r2 = t[2] - bflo(h23), r3 = t[3] - bfhi(h23);
                    u32x2 lw2; lw2.x = pk2(r0, r1); lw2.y = pk2(r2, r3);
                    *(LAS u32x2*)(Thi + lr * 2064 + c * 2) = hw; *(LAS u32x2*)(Tlo + lr * 2064 + c * 2) = lw2; } }
#pragma unroll
            for (int rr = 0; rr < 2; ++rr) { const float q0 = wave_sum(ga[rr][0]), q1 = wave_sum(ga[rr][1]), q2 = wave_sum(ga[rr][2]), q3 = wave_sum(ga[rr][3]);
                if (lane == 0) *(LAS f32x4*)(lgt + (nlist & 1) * 640 + (2 * w + rr) * 40 + 32) = (f32x4){q0, q1, q2, q3}; }
        }
        __syncthreads();
        if (prev_rbase >= 0) LN1_ROUTE((nlist - 1) & 1, prev_rbase, nlist - 1);
        {
            f32x4 acc[2];
#pragma unroll
            for (int nt = 0; nt < 2; ++nt) acc[nt] = (f32x4){0.f, 0.f, 0.f, 0.f};
            const int tk = lane & 15, kg = lane >> 4;
#pragma unroll
            for (int ks = 0; ks < 4; ++ks) {
                const bf16x8 ah = *(const LAS bf16x8*)(Thi + tk * 2064 + (w * 128 + ks * 32 + kg * 8) * 2), al = *(const LAS bf16x8*)(Tlo + tk * 2064 + (w * 128 + ks * 32 + kg * 8) * 2);
#pragma unroll
                for (int nt = 0; nt < 2; ++nt) { acc[nt] = __builtin_amdgcn_mfma_f32_16x16x32_bf16(Whi[nt][ks], ah, acc[nt], 0, 0, 0);
                    acc[nt] = __builtin_amdgcn_mfma_f32_16x16x32_bf16(Wlo[nt][ks], ah, acc[nt], 0, 0, 0); acc[nt] = __builtin_amdgcn_mfma_f32_16x16x32_bf16(Whi[nt][ks], al, acc[nt], 0, 0, 0); }
            }
#pragma unroll
            for (int nt = 0; nt < 2; ++nt) *(LAS f32x4*)(red + (w * 16 + tk) * 32 + nt * 16 + 4 * kg) = acc[nt];
        }
        __syncthreads();
        { const int tk = F.tid & 15, n = F.tid >> 4; float s = 0.f;
#pragma unroll
            for (int ww = 0; ww < 8; ++ww) s += red[(ww * 16 + tk) * 32 + n];
            lgt[(nlist & 1) * 640 + tk * 40 + n] = s; }
        prev_rbase = rbase; ++nlist;
    }
    __syncthreads();
    if (prev_rbase >= 0) LN1_ROUTE((nlist - 1) & 1, prev_rbase, nlist - 1);
#undef LN1_ROUTE
    __syncthreads();
    if (F.tid < 32) lbase[F.tid] = (int)atomicAdd((unsigned*)(F.ws + WS_CTL) + CW_CNT + l * 64 + (dry ? 32 : 0) + F.tid, (unsigned)lcnt[F.tid]);
    __syncthreads();
    if (!dry) for (int idx = F.tid; idx < nlist * 16; idx += 512) {
        const LAS unsigned* L = list + idx * 8; const unsigned row = L[0], e0 = L[1], e1 = L[4]; const unsigned p0 = L[2] + (unsigned)lbase[e0], p1 = L[5] + (unsigned)lbase[e1];
        u32x4 a; a.x = e0; a.y = p0; a.z = L[3]; a.w = e1; u32x4 b; b.x = p1; b.y = L[6]; b.z = 0u; b.w = 0u;
        unsigned* ti = (unsigned*)(F.ws + WS_TOKINFO) + (size_t)row * 8; *(u32x4*)ti = a; *(u32x4*)(ti + 4) = b;
        int* rt = (int*)(F.ws + WS_ROWTOK); rt[(size_t)e0 * NTOK + p0] = (int)row; rt[(size_t)e1 * NTOK + p1] = (int)row;
    }
}

__device__ __forceinline__ void ph_ln2(const Frame& F0, int l, int nrows, bool dry = false) {
    Frame F = relaunder(F0);
    MoeTab T = moe_tab(F.lds);
    const int gw = F.vcu * 8 + F.wave, NGW = F.G * 8, lane = F.lane;
    const float* lw = inptr(F, I_LNW) + (size_t)(l * 2 + 1) * D; const float* lb = inptr(F, I_LNB) + (size_t)(l * 2 + 1) * D;
    const bf16* O2 = (const bf16*)(F.ws + WS_P);
    for (int r0 = gw * 4; r0 < nrows; r0 += NGW * 4) {
        const int bi = row_bi(r0);
        const float* g5 = modp(F, l, bi, 5);
        f32x4 z[4][4]; u32x2 ya[4][4], yb[4][4]; float w0[4], w1[4];
#pragma unroll
        for (int r = 0; r < 4; ++r) { const int row = r0 + r;
            const unsigned* ti = (const unsigned*)(F.ws + WS_TOKINFO) + (size_t)row * 8;
            const u32x4 a = __builtin_nontemporal_load((const u32x4*)ti); const u32x2 b = __builtin_nontemporal_load((const u32x2*)(ti + 4));
            const size_t s0 = (size_t)T.ts[a.x] * 256 + a.y, s1 = (size_t)T.ts[a.w] * 256 + b.x; w0[r] = __uint_as_float(a.z); w1[r] = __uint_as_float(b.y);
            const float* hd = row < NLAT ? F.out + (size_t)row * D : (const float*)(F.ws + WS_HCTX) + (size_t)(row - NLAT) * D;
#pragma unroll
            for (int j = 0; j < 4; ++j) { const int c = 4 * lane + 256 * j; z[r][j] = __builtin_nontemporal_load((const f32x4*)(hd + c));
                if (!(KO_MASK & 8)) { ya[r][j] = __builtin_nontemporal_load((const u32x2*)(O2 + s0 * D + c)); yb[r][j] = __builtin_nontemporal_load((const u32x2*)(O2 + s1 * D + c)); } } }
#pragma unroll
        for (int j = 0; j < 4; ++j) { const f32x4 g = *(const f32x4*)(g5 + 4 * lane + 256 * j);
#pragma unroll
            for (int r = 0; r < 4; ++r) { f32x4 y = (f32x4){0.f, 0.f, 0.f, 0.f};
                if (!(KO_MASK & 8)) y = w0[r] * (f32x4){bflo(ya[r][j].x), bfhi(ya[r][j].x), bflo(ya[r][j].y), bfhi(ya[r][j].y)} + w1[r] * (f32x4){bflo(yb[r][j].x), bfhi(yb[r][j].x), bflo(yb[r][j].y), bfhi(yb[r][j].y)};
                z[r][j] = DN_ALPHA * z[r][j] + g * y; } }
        float mean[4], rstd[4];
#pragma unroll
        for (int r = 0; r < 4; ++r) ln_stats(z[r], mean[r], rstd[r]);
        const bool lat = r0 < NLAT;
        const bool wu = (l < 3) && (lat || l < 2);
        const float* sh = modp(F, l < 3 ? l + 1 : l, bi, 0); const float* sc = modp(F, l < 3 ? l + 1 : l, bi, 1);
#pragma unroll
        for (int j = 0; j < 4; ++j) { const int c = 4 * lane + 256 * j;
            const f32x4 lwv = *(const f32x4*)(lw + c), lbv = *(const f32x4*)(lb + c), scv = *(const f32x4*)(sc + c), shv = *(const f32x4*)(sh + c);
#pragma unroll
            for (int r = 0; r < 4; ++r) { const int row = r0 + r;
                float* hd = dry ? (float*)(F.ws + WS_GATT) + (size_t)row * D : (lat ? F.out + (size_t)row * D : (float*)(F.ws + WS_HCTX) + (size_t)(row - NLAT) * D);
                const f32x4 zn = z[r][j] * rstd[r] * lwv + lbv; __builtin_nontemporal_store(zn, (f32x4*)(hd + c));
                if (wu) { const f32x4 u = zn * (1.0f + scv) + shv; u32x2 hw; hw.x = pk2(u[0], u[1]); hw.y = pk2(u[2], u[3]); *(u32x2*)((bf16*)(F.ws + (dry ? WS_Q : WS_U)) + (size_t)row * D + c) = hw; } } }
    }
}

__device__ __forceinline__ f32x4 ubf_lo(const u32x4 v) { return (f32x4){bflo(v.x), bfhi(v.x), bflo(v.y), bfhi(v.y)}; }
__device__ __forceinline__ f32x4 ubf_hi(const u32x4 v) { return (f32x4){bflo(v.z), bfhi(v.z), bflo(v.w), bfhi(v.w)}; }
__device__ __forceinline__ void ph_conv(const Frame& F0, int i, int nrows) {
    Frame F = relaunder(F0);
    const int gw = F.vcu * 8 + F.wave, NGW = F.G * 8, lane = F.lane;
    const float* cw = inptr(F, I_CONVW) + (size_t)i * 3 * D; const float* cb = inptr(F, I_CONVB) + (size_t)i * D;
    const bf16* P = (const bf16*)(F.ws + WS_P); bf16* Q = (bf16*)(F.ws + WS_Q);
    for (int r0 = gw * 4; r0 < nrows; r0 += NGW * 4) {
        const int s0 = r0 < NLAT ? (r0 & (SEQ - 1)) : ((r0 - NLAT) & (CTXL - 1)); const int slen = r0 < NLAT ? SEQ : CTXL;
        const bool hp = s0 > 0, hn = s0 + 4 < slen;
#pragma unroll
        for (int j = 0; j < 2; ++j) { const int c = 8 * lane + 512 * j;
            u32x4 p[6], gb[4];
            p[0] = (u32x4){0u, 0u, 0u, 0u}; p[5] = (u32x4){0u, 0u, 0u, 0u};
            if (hp) p[0] = __builtin_nontemporal_load((const u32x4*)(P + (size_t)(r0 - 1) * 2048 + 1024 + c));
            if (hn) p[5] = __builtin_nontemporal_load((const u32x4*)(P + (size_t)(r0 + 4) * 2048 + 1024 + c));
#pragma unroll
            for (int r = 0; r < 4; ++r) { p[r + 1] = __builtin_nontemporal_load((const u32x4*)(P + (size_t)(r0 + r) * 2048 + 1024 + c)); gb[r] = __builtin_nontemporal_load((const u32x4*)(P + (size_t)(r0 + r) * 2048 + c)); }
            const f32x4 w0a = *(const f32x4*)(cw + c), w0b = *(const f32x4*)(cw + c + 4), w1a = *(const f32x4*)(cw + D + c), w1b = *(const f32x4*)(cw + D + c + 4), w2a = *(const f32x4*)(cw + 2 * D + c), w2b = *(const f32x4*)(cw + 2 * D + c + 4);
            const f32x4 ba = *(const f32x4*)(cb + c), bb = *(const f32x4*)(cb + c + 4);
#pragma unroll
            for (int r = 0; r < 4; ++r) {
                const f32x4 ya = ubf_lo(gb[r]) * (ubf_lo(p[r]) * w0a + ubf_lo(p[r + 1]) * w1a + ubf_lo(p[r + 2]) * w2a + ba);
                const f32x4 yb = ubf_hi(gb[r]) * (ubf_hi(p[r]) * w0b + ubf_hi(p[r + 1]) * w1b + ubf_hi(p[r + 2]) * w2b + bb);
                *(u32x4*)(Q + (size_t)(r0 + r) * D + c) = pack8(ya, yb); } }
    }
}
#define MFMA32(a, b, c) __builtin_amdgcn_mfma_f32_32x32x16_bf16((a), (b), (c), 0, 0, 0)
#define MFMA16(a, b, c) __builtin_amdgcn_mfma_f32_16x16x32_bf16((a), (b), (c), 0, 0, 0)
constexpr int AK_STR = 144, AV_STR = 136, AK_BUF = 64 * AK_STR, AV_BUF = 64 * AV_STR;
__device__ __forceinline__ int crow32(int reg, int hh) { return (reg & 3) + 8 * (reg >> 2) + 4 * hh; }
__device__ __forceinline__ float xhalf_max(float v) { const unsigned u = __float_as_uint(v); const auto r = __builtin_amdgcn_permlane32_swap(u, u, false, false); return fmaxf(__uint_as_float(r[0]), __uint_as_float(r[1])); }
__device__ __forceinline__ float xhalf_sum(float v) { const unsigned u = __float_as_uint(v); const auto r = __builtin_amdgcn_permlane32_swap(u, u, false, false); return __uint_as_float(r[0]) + __uint_as_float(r[1]); }
constexpr float ATT_THR = 8.0f;
__device__ __forceinline__ void attn_unit(const Frame& F, int ie, int b, int g, int qb, bool ctxq) {
    const bf16* P = (const bf16*)(F.ws + WS_P); bf16* Q = (bf16*)(F.ws + WS_Q);
    LAS unsigned char* Ks = F.lds; LAS unsigned char* Vt = F.lds + 2 * AK_BUF;
    const int w = F.wave, lane = F.lane, r = w >> 1, qh = w & 1, h = 4 * g + r, n = lane & 31, hh = lane >> 5;
    const int qpos0 = qb * 128 + qh * 64;
    const int qrow0 = ctxq ? NLAT + b * CTXL + qpos0 : b * SEQ + qpos0;
    if (KO_MASK & 1) {
#pragma unroll
        for (int nt = 0; nt < 2; ++nt)
#pragma unroll
            for (int c = 0; c < 4; ++c) *(u32x4*)(Q + (size_t)(qrow0 + 32 * nt + n) * D + h * 64 + 16 * c + 8 * hh) = (u32x4){0u, 0u, 0u, 0u};
        return;
    }
    bf16x8 qf[2][4];
#pragma unroll
    for (int nt = 0; nt < 2; ++nt)
#pragma unroll
        for (int c = 0; c < 4; ++c) qf[nt][c] = *(const bf16x8*)(P + (size_t)(qrow0 + 32 * nt + n) * EN + PC_Q + h * 64 + 16 * c + 8 * hh);
    const float sk = inptr(F, I_SINK)[ie * 8 + h] * LOG2E;
    float mrun[2] = {sk, sk}, lsum[2] = {1.f, 1.f};
    f32x16 O[2][2];
#pragma unroll
    for (int a = 0; a < 2; ++a)
#pragma unroll
        for (int c = 0; c < 2; ++c)
#pragma unroll
            for (int e = 0; e < 16; ++e) O[a][c][e] = 0.f;
    const int tw0 = ctxq ? 4 : ((qb == 0) ? 6 : 4), tw1 = ctxq ? 4 : ((qb == 31) ? 8 : 10);
    const int ntile = 4 + (tw1 - tw0);
    const int skey = F.tid >> 3, sch = F.tid & 7;
    u32x4 kreg, vreg;
#define TILE_OF(i) ((i) < 4 ? (i) : tw0 + ((i) - 4))
#define KROW_OF(t) ((t) < 4 ? NLAT + b * CTXL + 64 * (t) : b * SEQ + (qb - 1) * 128 + 64 * ((t) - 4))
    { const int kr = KROW_OF(0) + skey; kreg = *(const u32x4*)(P + (size_t)kr * EN + PC_K + g * 64 + sch * 8); vreg = *(const u32x4*)(P + (size_t)kr * EN + PC_V + g * 64 + sch * 8); }
    __syncthreads();
    {
        *(LAS u32x4*)(Ks + skey * AK_STR + sch * 16) = kreg;
        LAS unsigned short* vt = (LAS unsigned short*)(Vt + (sch * 8) * AV_STR + skey * 2);
        const unsigned vv[4] = {vreg.x, vreg.y, vreg.z, vreg.w};
#pragma unroll
        for (int e = 0; e < 4; ++e) { vt[(2 * e) * (AV_STR / 2)] = (unsigned short)(vv[e] & 0xffffu); vt[(2 * e + 1) * (AV_STR / 2)] = (unsigned short)(vv[e] >> 16); }
    }
    __syncthreads();
    const float c2 = 0.125f * LOG2E;
    for (int i = 0; i < ntile; ++i) {
        const int buf = i & 1, t = TILE_OF(i);
        if (i + 1 < ntile) { const int t1 = TILE_OF(i + 1); const int kr = KROW_OF(t1) + skey; kreg = *(const u32x4*)(P + (size_t)kr * EN + PC_K + g * 64 + sch * 8); vreg = *(const u32x4*)(P + (size_t)kr * EN + PC_V + g * 64 + sch * 8); }
        const LAS unsigned char* kb = Ks + buf * AK_BUF; const LAS unsigned char* vb = Vt + buf * AV_BUF;
        const bool msk = (t >= 4) && (t != 6) && (t != 7);
        const int kp0 = (qb - 1) * 128 + 64 * (t - 4);
        const bool skip = (qh == 0 && t == 9) || (qh == 1 && t == 4);
#pragma unroll 1
        for (int kt = 0; kt < 2; ++kt) {
            if (skip) break;
            f32x16 S[2];
#pragma unroll
            for (int c = 0; c < 2; ++c)
#pragma unroll
                for (int e = 0; e < 16; ++e) S[c][e] = 0.f;
#pragma unroll
            for (int c = 0; c < 4; ++c) { const bf16x8 kf = *(const LAS bf16x8*)(kb + (32 * kt + n) * AK_STR + (16 * c + 8 * hh) * 2);
#pragma unroll
                for (int nt = 0; nt < 2; ++nt) S[nt] = MFMA32(kf, qf[nt][c], S[nt]); }
#pragma unroll
            for (int nt = 0; nt < 2; ++nt) {
                if (msk) { const int qp = qpos0 + 32 * nt + n;
#pragma unroll
                    for (int e = 0; e < 16; ++e) { const int dd = qp - (kp0 + 32 * kt + crow32(e, hh)); if (dd > 128 || dd < -128) S[nt][e] = -INFINITY; } }
                float mx = fmaxf(fmaxf(S[nt][0], S[nt][1]), fmaxf(S[nt][2], S[nt][3]));
#pragma unroll
                for (int e = 4; e < 16; e += 4) mx = fmaxf(mx, fmaxf(fmaxf(S[nt][e], S[nt][e + 1]), fmaxf(S[nt][e + 2], S[nt][e + 3])));
                mx = xhalf_max(mx) * c2;
                if (__builtin_amdgcn_ballot_w64(mx > mrun[nt] + ATT_THR) != 0ull) {
                    const float mnew_ = fmaxf(mrun[nt], mx); const float alpha = __builtin_amdgcn_exp2f(mrun[nt] - mnew_); mrun[nt] = mnew_; lsum[nt] *= alpha;
#pragma unroll
                    for (int dt = 0; dt < 2; ++dt)
#pragma unroll
                        for (int e = 0; e < 16; ++e) O[dt][nt][e] *= alpha;
                }
                const float mu = mrun[nt];
                float rs = 0.f;
#pragma unroll
                for (int e = 0; e < 16; ++e) { const float p = __builtin_amdgcn_exp2f(__builtin_fmaf(S[nt][e], c2, -mu)); S[nt][e] = p; rs += p; }
                lsum[nt] += xhalf_sum(rs);
            }
#pragma unroll
            for (int s = 0; s < 2; ++s) {
                bf16x8 pf[2];
#pragma unroll
                for (int nt = 0; nt < 2; ++nt) { u32x4 pw; pw.x = pk2(S[nt][8 * s + 0], S[nt][8 * s + 1]); pw.y = pk2(S[nt][8 * s + 2], S[nt][8 * s + 3]); pw.z = pk2(S[nt][8 * s + 4], S[nt][8 * s + 5]); pw.w = pk2(S[nt][8 * s + 6], S[nt][8 * s + 7]); pf[nt] = __builtin_bit_cast(bf16x8, pw); }
#pragma unroll
                for (int dt = 0; dt < 2; ++dt) {
                    const LAS unsigned char* va = vb + (32 * dt + n) * AV_STR + (32 * kt + 16 * s + 4 * hh) * 2;
                    const s16x4 lo = *(const LAS s16x4*)va, hi = *(const LAS s16x4*)(va + 16);
                    const bf16x8 vf = __builtin_shufflevector(lo, hi, 0, 1, 2, 3, 4, 5, 6, 7);
#pragma unroll
                    for (int nt = 0; nt < 2; ++nt) O[dt][nt] = MFMA32(vf, pf[nt], O[dt][nt]);
                }
            }
        }
        if (i + 1 < ntile) {
            LAS unsigned char* kb2 = Ks + (buf ^ 1) * AK_BUF; LAS unsigned char* vb2 = Vt + (buf ^ 1) * AV_BUF;
            *(LAS u32x4*)(kb2 + skey * AK_STR + sch * 16) = kreg;
            LAS unsigned short* vt = (LAS unsigned short*)(vb2 + (sch * 8) * AV_STR + skey * 2);
            const unsigned vv[4] = {vreg.x, vreg.y, vreg.z, vreg.w};
#pragma unroll
            for (int e = 0; e < 4; ++e) { vt[(2 * e) * (AV_STR / 2)] = (unsigned short)(vv[e] & 0xffffu); vt[(2 * e + 1) * (AV_STR / 2)] = (unsigned short)(vv[e] >> 16); }
        }
        __syncthreads();
    }
#pragma unroll
    for (int nt = 0; nt < 2; ++nt) { const float inv = 1.0f / lsum[nt]; bf16* orow = Q + (size_t)(qrow0 + 32 * nt + n) * D + h * 64 + (hh ? 8 : 0);
#pragma unroll
        for (int dt = 0; dt < 2; ++dt)
#pragma unroll
            for (int rg = 0; rg < 4; rg += 2) {
                u32x2 a, bq; a.x = pk2(O[dt][nt][4 * rg] * inv, O[dt][nt][4 * rg + 1] * inv); a.y = pk2(O[dt][nt][4 * rg + 2] * inv, O[dt][nt][4 * rg + 3] * inv);
                bq.x = pk2(O[dt][nt][4 * rg + 4] * inv, O[dt][nt][4 * rg + 5] * inv); bq.y = pk2(O[dt][nt][4 * rg + 6] * inv, O[dt][nt][4 * rg + 7] * inv);
                { const auto r0 = __builtin_amdgcn_permlane32_swap(a.x, bq.x, false, false); a.x = r0[0]; bq.x = r0[1]; }
                { const auto r1 = __builtin_amdgcn_permlane32_swap(a.y, bq.y, false, false); a.y = r1[0]; bq.y = r1[1]; }
                *(u32x4*)(orow + 32 * dt + 8 * rg) = (u32x4){a.x, a.y, bq.x, bq.y}; } }
}

template <int d> __device__ __forceinline__ void glaA_unit(const Frame& F, int ie, int b, int c, int h) {
    const bf16* P = (const bf16*)(F.ws + WS_P);
    LAS unsigned char* QS = F.lds + F.wave * 16384; LAS unsigned char* KS = QS + 8192;
    const int lane = F.lane;
    const int row0 = c < 4 ? NLAT + b * CTXL + c * 64 : b * SEQ + (c - 4) * 64;
    const size_t U = (size_t)(b * NCHUNK + c) * 4 + h;
    bf16* gq = (bf16*)(F.ws + WS_GQIN); bf16* gk = (bf16*)(F.ws + WS_GKST); bf16* ga = (bf16*)(F.ws + WS_GATT);
    {
        const size_t UD = U * 2 + d;
        {
            u32x4 qr[8], kr[8];
#pragma unroll
            for (int it = 0; it < 8; ++it) { const int tok = it * 8 + (lane >> 3), ch = lane & 7; const size_t ro = (size_t)(row0 + tok) * EN + h * 64 + ch * 8; qr[it] = *(const u32x4*)(P + ro + PC_QG); kr[it] = *(const u32x4*)(P + ro + PC_KG); }
#pragma unroll
            for (int it = 0; it < 8; ++it) { const int tok = it * 8 + (lane >> 3), ch = lane & 7; const int so = tok * 128 + ((ch ^ (tok & 7)) << 4); *(LAS u32x4*)(QS + so) = qr[it]; *(LAS u32x4*)(KS + so) = kr[it]; }
        }
        const int ln = lane & 31, hh = lane >> 5;
        bf16x8 afr[2], bhi[2], blo[2]; float bav[2];
#pragma unroll
        for (int tt = 0; tt < 2; ++tt) afr[tt] = *(const bf16x8*)(P + (size_t)(row0 + 32 * tt + ln) * EN + PC_GG + 16 * d + 8 * hh);
#pragma unroll
        for (int dt = 0; dt < 2; ++dt) { const float* wp = inptr(F, I_WA2) + (size_t)((ie * 2 + d) * 16 + 8 * hh) * 256 + h * 64 + 32 * dt + ln;
            unsigned hh_[8], ll_[8];
#pragma unroll
            for (int j = 0; j < 8; ++j) { const float v = wp[(size_t)j * 256]; const unsigned hb = pk2(v, 0.f) & 0xffffu; hh_[j] = hb; ll_[j] = pk2(v - __uint_as_float(hb << 16), 0.f) & 0xffffu; }
            bhi[dt] = __builtin_bit_cast(bf16x8, (u32x4){hh_[0] | (hh_[1] << 16), hh_[2] | (hh_[3] << 16), hh_[4] | (hh_[5] << 16), hh_[6] | (hh_[7] << 16)});
            blo[dt] = __builtin_bit_cast(bf16x8, (u32x4){ll_[0] | (ll_[1] << 16), ll_[2] | (ll_[3] << 16), ll_[4] | (ll_[5] << 16), ll_[6] | (ll_[7] << 16)});
            bav[dt] = inptr(F, I_BA)[(ie * 2 + d) * 256 + h * 64 + 32 * dt + ln]; }
        f32x16 G[2][2];
#pragma unroll
        for (int tt = 0; tt < 2; ++tt)
#pragma unroll
            for (int dt = 0; dt < 2; ++dt) { f32x16 z16;
#pragma unroll
                for (int e = 0; e < 16; ++e) z16[e] = 0.f;
                z16 = MFMA32(afr[tt], bhi[dt], z16); G[tt][dt] = MFMA32(afr[tt], blo[dt], z16); }
        asm volatile("s_waitcnt lgkmcnt(0)" ::: "memory");
        float base[2] = {0.f, 0.f};
        int lofs[2][4];
#pragma unroll
        for (int dt = 0; dt < 2; ++dt)
#pragma unroll
            for (int e4 = 0; e4 < 4; ++e4) lofs[dt][e4] = (4 * hh + e4) * 128 + (((4 * dt + (ln >> 3)) ^ (4 * hh + e4)) << 4) + (ln & 7) * 2;
#pragma unroll
        for (int tq = 0; tq < 2; ++tq) { constexpr int dd = d; const int tt = dd ? 1 - tq : tq;
#pragma unroll
            for (int gq_ = 0; gq_ < 4; ++gq_) { const int g4 = dd ? 3 - gq_ : gq_;
                const int tokg = 32 * tt + 8 * g4;
#pragma unroll
                for (int dt = 0; dt < 2; ++dt) {
                    float la[4];
#pragma unroll
                    for (int e4 = 0; e4 < 4; ++e4) { const float g = G[tt][dt][4 * g4 + e4] + bav[dt];
                        la[e4] = (fminf(g, 0.f) * LOG2E - __builtin_amdgcn_logf(1.0f + __builtin_amdgcn_exp2f(-fabsf(g) * LOG2E))) * (1.0f / 16.0f); }
                    float cs[4];
                    if (dd == 0) { cs[0] = la[0]; cs[1] = cs[0] + la[1]; cs[2] = cs[1] + la[2]; cs[3] = cs[2] + la[3]; }
                    else { cs[3] = la[3]; cs[2] = cs[3] + la[2]; cs[1] = cs[2] + la[1]; cs[0] = cs[1] + la[0]; }
                    const float t4 = dd == 0 ? cs[3] : cs[0];
                    const float pt = __shfl_xor(t4, 32);
                    const float off = base[dt] + ((dd == 0 ? hh == 1 : hh == 0) ? pt : 0.f);
                    base[dt] += t4 + pt;
#pragma unroll
                    for (int e4 = 0; e4 < 4; ++e4) { const int so = tokg * 128 + lofs[dt][e4];
                        const float e1 = __builtin_amdgcn_exp2f(off + cs[e4]);
                        const float qi = bf2f(*(const LAS unsigned short*)(QS + so)) * 0.125f * e1, ki = bf2f(*(const LAS unsigned short*)(KS + so)) * __builtin_amdgcn_rcpf(e1);
                        const unsigned short q16 = (unsigned short)(pk2(qi, 0.f) & 0xffffu), k16 = (unsigned short)(pk2(ki, 0.f) & 0xffffu);
                        *(LAS unsigned short*)(QS + so) = q16; *(LAS unsigned short*)(KS + so) = k16; }
                }
            }
        }
        if (hh == 0) { ((float*)(F.ws + WS_GDEC))[UD * 64 + ln] = __builtin_amdgcn_exp2f(base[0]); ((float*)(F.ws + WS_GDEC))[UD * 64 + 32 + ln] = __builtin_amdgcn_exp2f(base[1]); }
        asm volatile("s_waitcnt lgkmcnt(0)" ::: "memory");
        {
            const int cc = lane & 7, dk0 = 32 * (cc >> 2) + 4 * (cc & 3);
#pragma unroll
            for (int it = 0; it < 8; ++it) { const int tok = it * 8 + (lane >> 3);
                const u32x2 lo = *(const LAS u32x2*)(QS + tok * 128 + ((((dk0 >> 3)) ^ (tok & 7)) << 4) + (dk0 & 7) * 2);
                const u32x2 hi = *(const LAS u32x2*)(QS + tok * 128 + ((((dk0 + 16) >> 3) ^ (tok & 7)) << 4) + (dk0 & 7) * 2);
                *(u32x4*)(gq + (UD * 64 + tok) * 64 + 8 * cc) = (u32x4){lo.x, lo.y, hi.x, hi.y};
                *(u32x4*)(gk + (UD * 64 + tok) * 64 + 8 * cc) = *(const LAS u32x4*)(KS + tok * 128 + ((cc ^ (tok & 7)) << 4)); }
        }
        {
            const int n = lane & 15, kg = lane >> 4;
#pragma unroll 1
            for (int I = 0; I < 4; ++I) {
                const int ti = 16 * I + n;
                bf16x8 qf[2];
#pragma unroll
                for (int ks2 = 0; ks2 < 2; ++ks2) qf[ks2] = *(const LAS bf16x8*)(QS + ti * 128 + (((4 * ks2 + kg) ^ (ti & 7)) << 4));
#pragma unroll
                for (int J = 0; J < 4; ++J) { f32x4 acc = (f32x4){0.f, 0.f, 0.f, 0.f};
                    const bool live = d == 0 ? (J <= I) : (J >= I);
                    if (live) {
                        const int tjr = 16 * J + n;
#pragma unroll
                        for (int ks2 = 0; ks2 < 2; ++ks2) { const bf16x8 kf = *(const LAS bf16x8*)(KS + tjr * 128 + (((4 * ks2 + kg) ^ (tjr & 7)) << 4)); acc = MFMA16(kf, qf[ks2], acc); }
#pragma unroll
                        for (int r = 0; r < 4; ++r) { const int tj = 16 * J + 4 * kg + r; const bool keep = d == 0 ? (tj <= ti) : (tj >= ti); if (!keep) acc[r] = 0.f; }
                    }
                    u32x2 ow; ow.x = pk2(acc[0], acc[1]); ow.y = pk2(acc[2], acc[3]);
                    *(u32x2*)(ga + (UD * 64 + ti) * 64 + 16 * J + 4 * kg) = ow; }
            }
        }
        asm volatile("s_waitcnt lgkmcnt(0)" ::: "memory");
    }
}

constexpr int GB_STG = 43008;
__device__ __forceinline__ int glaB_chunk(int d, int step) { return d == 0 ? step : (step < 4 ? 3 - step : 4 + (NCHUNK - 1 - step)); }
__device__ __forceinline__ int swz_k(int r) { return (r & 3) | (((r >> 3) & 1) << 2); }
__device__ __forceinline__ int swz_v(int r) { return ((r & 3) << 2) | ((r >> 2) & 3); }
template <int STAGE> __device__ __forceinline__ void glaB_issue(const Frame& F, int b, int h, int d, int step) {
    const int c = glaB_chunk(d, step);
    const size_t U = (size_t)(b * NCHUNK + c) * 4 + h, UD = U * 2 + d;
    const int row0 = c < 4 ? NLAT + b * CTXL + c * 64 : b * SEQ + (c - 4) * 64;
    const int tid = F.tid, row = tid >> 3, gch = (tid & 7) ^ (row & 7), gchk = (tid & 7) ^ swz_k(row);
    const int vr0 = tid >> 4, vr1 = vr0 + 32, vc0 = (tid & 15) ^ swz_v(vr0), vc1 = (tid & 15) ^ swz_v(vr1);
    LAS unsigned char* st = F.lds + STAGE * GB_STG + F.wave * 1024;
    const char* gq = (const char*)(F.ws + WS_GQIN) + UD * 8192 + row * 128 + gch * 16;
    const char* ga = (const char*)(F.ws + WS_GATT) + UD * 8192 + row * 128 + gch * 16;
    const char* gk = (const char*)(F.ws + WS_GKST) + UD * 8192 + row * 128 + gchk * 16;
    const char* gv = (const char*)(F.ws + WS_P) + (size_t)row0 * (EN * 2) + (PC_VG + h * 128) * 2;
    const char* gdc = (const char*)(F.ws + WS_GDEC) + UD * 256 + F.lane * 4;
    __builtin_amdgcn_global_load_lds((const unsigned*)gq, (LAS unsigned*)(st), 16, 0, 2);
    __builtin_amdgcn_global_load_lds((const unsigned*)ga, (LAS unsigned*)(st + 8192), 16, 0, 2);
    __builtin_amdgcn_global_load_lds((const unsigned*)gk, (LAS unsigned*)(st + 16384), 16, 0, 2);
    __builtin_amdgcn_global_load_lds((const unsigned*)(gv + (size_t)vr0 * (EN * 2) + vc0 * 16), (LAS unsigned*)(st + 24576), 16, 0, 2);
    __builtin_amdgcn_global_load_lds((const unsigned*)(gv + (size_t)vr1 * (EN * 2) + vc1 * 16), (LAS unsigned*)(st + 24576 + 8192), 16, 0, 2);
    __builtin_amdgcn_global_load_lds((const unsigned*)gdc, (LAS unsigned*)(F.lds + STAGE * GB_STG + 40960 + F.wave * 256), 4, 0, 2);
}
template <int ROWB, class SWZ> __device__ __forceinline__ bf16x8 gb_frag_tr(const LAS unsigned char* tile, int lane, int c, int ks, SWZ swz) {
    const int g = lane >> 4, q = (lane & 15) >> 2, p = lane & 3;
    const int r0 = 32 * ks + 8 * g + q, r1 = r0 + 4;
    const s16x4 lo = __builtin_amdgcn_ds_read_tr16_b64_v4i16((LAS s16x4*)(tile + ROWB * r0 + 16 * ((2 * c + (p >> 1)) ^ swz(r0)) + 8 * (p & 1)));
    const s16x4 hi = __builtin_amdgcn_ds_read_tr16_b64_v4i16((LAS s16x4*)(tile + ROWB * r1 + 16 * ((2 * c + (p >> 1)) ^ swz(r1)) + 8 * (p & 1)));
    return __builtin_shufflevector(lo, hi, 0, 1, 2, 3, 4, 5, 6, 7);
}
__device__ __forceinline__ bf16x8 gb_frag(const LAS unsigned char* tile, int row, int ch) { return *(const LAS bf16x8*)(tile + (row * 8 + (ch ^ (row & 7))) * 16); }
template <int STAGE> __device__ __forceinline__ void glaB_step(const Frame& F, int b, int h, int d, int step, f32x4 (&S)[4], bf16* od) {
    const int lane = F.lane, n = lane & 15, kg = lane >> 4, sl = F.wave;
    if (step == 0) asm volatile("s_waitcnt vmcnt(6)" ::: "memory"); else if (step == 1) asm volatile("s_waitcnt vmcnt(10)" ::: "memory"); else asm volatile("s_waitcnt vmcnt(14)" ::: "memory");
    __builtin_amdgcn_s_barrier();
    asm volatile("" ::: "memory");
    glaB_issue<(STAGE + 2) % 3>(F, b, h, d, step + 2 < NCHUNK ? step + 2 : NCHUNK - 1);
    asm volatile("" ::: "memory");
    const int c = glaB_chunk(d, step);
    const int row0 = c < 4 ? NLAT + b * CTXL + c * 64 : b * SEQ + (c - 4) * 64;
    const LAS unsigned char* st = F.lds + STAGE * GB_STG;
    bf16x8 vf[2], qf[4][2], af[4][2], kf[4][2]; f32x4 dc[4];
#pragma unroll
    for (int T = 0; T < 2; ++T) vf[T] = gb_frag_tr<256>(st + 24576, lane, sl, T, swz_v);
#pragma unroll
    for (int I = 0; I < 4; ++I)
#pragma unroll
        for (int T = 0; T < 2; ++T) { qf[I][T] = gb_frag(st, 16 * I + n, 4 * T + kg); af[I][T] = gb_frag(st + 8192, 16 * I + n, 4 * T + kg); }
#pragma unroll
    for (int I = 0; I < 4; ++I)
#pragma unroll
        for (int T = 0; T < 2; ++T) kf[I][T] = gb_frag_tr<128>(st + 16384, lane, I, T, swz_k);
#pragma unroll
    for (int q = 0; q < 4; ++q) dc[q] = *(const LAS f32x4*)(st + 40960 + sl * 256 + (16 * q + 4 * kg) * 4);
    bf16x8 sb[2];
#pragma unroll
    for (int G2 = 0; G2 < 2; ++G2) { u32x4 sw; sw.x = pk2(S[2 * G2][0], S[2 * G2][1]); sw.y = pk2(S[2 * G2][2], S[2 * G2][3]); sw.z = pk2(S[2 * G2 + 1][0], S[2 * G2 + 1][1]); sw.w = pk2(S[2 * G2 + 1][2], S[2 * G2 + 1][3]); sb[G2] = __builtin_bit_cast(bf16x8, sw); }
    asm volatile("s_waitcnt lgkmcnt(0)" ::: "memory");
    f32x4 o[4];
#pragma unroll
    for (int I = 0; I < 4; ++I) o[I] = (f32x4){0.f, 0.f, 0.f, 0.f};
#pragma unroll
    for (int I = 0; I < 4; ++I) o[I] = MFMA16(sb[0], qf[I][0], o[I]);
#pragma unroll
    for (int I = 0; I < 4; ++I) o[I] = MFMA16(sb[1], qf[I][1], o[I]);
#pragma unroll
    for (int q = 0; q < 4; ++q) S[q] = MFMA16(kf[q][0], vf[0], S[q]);
#pragma unroll
    for (int I = 0; I < 4; ++I) o[I] = MFMA16(vf[0], af[I][0], o[I]);
#pragma unroll
    for (int q = 0; q < 4; ++q) S[q] = MFMA16(kf[q][1], vf[1], S[q]);
#pragma unroll
    for (int I = 0; I < 4; ++I) o[I] = MFMA16(vf[1], af[I][1], o[I]);
#pragma unroll
    for (int q = 0; q < 4; ++q) S[q] = S[q] * dc[q];
    u32x2 ow[4];
#pragma unroll
    for (int I = 0; I < 4; ++I) { ow[I].x = pk2(o[I][0], o[I][1]); ow[I].y = pk2(o[I][2], o[I][3]); }
    asm volatile("s_waitcnt lgkmcnt(0)" ::: "memory");
#pragma unroll
    for (int I = 0; I < 4; ++I) *(u32x2*)(od + (size_t)(row0 + 16 * I + n) * 512 + h * 128 + 16 * sl + 4 * kg) = ow[I];
    asm volatile("" ::: "memory");
}
__device__ __forceinline__ void glaB_group(const Frame& F, int cg) {
    const int d = cg & 1, h = (cg >> 1) & 3, b = cg >> 3;
    bf16* od = (bf16*)(F.ws + WS_U) + (size_t)d * NTOK * 512;
    f32x4 S[4];
#pragma unroll
    for (int q = 0; q < 4; ++q) S[q] = (f32x4){0.f, 0.f, 0.f, 0.f};
    asm volatile("s_waitcnt vmcnt(0) lgkmcnt(0)" ::: "memory");
    __builtin_amdgcn_s_barrier();
    asm volatile("" ::: "memory");
    glaB_issue<0>(F, b, h, d, 0); glaB_issue<1>(F, b, h, d, 1);
    asm volatile("" ::: "memory");
    for (int s0 = 0; s0 + 2 < NCHUNK; s0 += 3) { glaB_step<0>(F, b, h, d, s0, S, od); glaB_step<1>(F, b, h, d, s0 + 1, S, od); glaB_step<2>(F, b, h, d, s0 + 2, S, od); }
    glaB_step<0>(F, b, h, d, 66, S, od); glaB_step<1>(F, b, h, d, 67, S, od);
    static_assert(NCHUNK == 68, "tail of the step loop");
    asm volatile("s_waitcnt vmcnt(0)" ::: "memory");
    __builtin_amdgcn_s_barrier();
}
__device__ __forceinline__ void conv_moe_dynamic(const Frame& F0, int l) {
    Frame F = relaunder(F0);
    LAS float* scr = (LAS float*)(F.lds + F.wave * 16384);
    unsigned* ctr = (unsigned*)(F.ws + WS_CTL) + CW_WQ + l * 64;
    constexpr int I_13 = 16 * 32, I_2 = 8 * 32, NIT = NEXP * (I_13 + I_2), CH = 8;
    for (;;) {
        unsigned t0 = 0; if (F.lane == 0) t0 = atomicAdd(ctr, (unsigned)CH);
        const int it0 = __builtin_amdgcn_readfirstlane((int)t0);
        if (it0 >= NIT) break;
        for (int it = it0; it < it0 + CH && it < NIT; ++it) conv_moe_item(F, l, it, scr);
    }
}

__device__ __forceinline__ void ph_combine(const Frame& F0, int ie, int nrows) {
    Frame F = relaunder(F0);
    const int gw = F.vcu * 8 + F.wave, NGW = F.G * 8, lane = F.lane;
    const bf16* P = (const bf16*)(F.ws + WS_P); bf16* Q = (bf16*)(F.ws + WS_Q);
    const bf16* o0 = (const bf16*)(F.ws + WS_U); const bf16* o1 = o0 + (size_t)NTOK * 512;
    const float* nw = inptr(F, I_NORMW) + (size_t)ie * 512;
    const int col = 8 * lane;
    const f32x4 nwa = *(const f32x4*)(nw + col), nwb = *(const f32x4*)(nw + col + 4);
    for (int r0 = gw * 4; r0 < nrows; r0 += NGW * 4) {
        if (KO_MASK & 2) {
#pragma unroll
            for (int r = 0; r < 4; ++r) *(u32x4*)(Q + (size_t)(r0 + r) * D + 512 + col) = (u32x4){0u, 0u, 0u, 0u};
            continue; }
        u32x4 a[4], bq[4], rr[4];
#pragma unroll
        for (int r = 0; r < 4; ++r) { const size_t row = r0 + r; a[r] = __builtin_nontemporal_load((const u32x4*)(o0 + row * 512 + col)); bq[r] = __builtin_nontemporal_load((const u32x4*)(o1 + row * 512 + col)); rr[r] = __builtin_nontemporal_load((const u32x4*)(P + row * EN + PC_RG + col)); }
#pragma unroll
        for (int r = 0; r < 4; ++r) {
            const f32x4 xa = ubf_lo(a[r]) + ubf_lo(bq[r]), xb = ubf_hi(a[r]) + ubf_hi(bq[r]);
            float ss = (xa[0] * xa[0] + xa[1] * xa[1]) + (xa[2] * xa[2] + xa[3] * xa[3]) + (xb[0] * xb[0] + xb[1] * xb[1]) + (xb[2] * xb[2] + xb[3] * xb[3]);
            ss = row16_sum(ss);
            const float rinv = 1.0f / sqrtf(ss * (1.0f / 128.0f) + RMS_EPS);
            f32x4 ra = ubf_lo(rr[r]), rb = ubf_hi(rr[r]);
#pragma unroll
            for (int j = 0; j < 4; ++j) { ra[j] = fast_silu(ra[j]); rb[j] = fast_silu(rb[j]); }
            *(u32x4*)(Q + (size_t)(r0 + r) * D + 512 + col) = pack8(xa * rinv * nwa * ra, xb * rinv * nwb * rb); }
    }
}

#if defined(FP8_PROBE)
typedef int i32x8 __attribute__((ext_vector_type(8)));
__device__ __forceinline__ unsigned fp8_of_int(int v) { const int a = v < 0 ? -v : v; const unsigned c = a == 0 ? 0x00u : a == 1 ? 0x38u : a == 2 ? 0x40u : 0x44u; return v < 0 ? (c | 0x80u) : c; }
__device__ __forceinline__ int fp8_kidx(int kg, int e) { return FP8_PROBE == 1 ? 32 * kg + e : (e < 16 ? 16 * kg + e : 64 + 16 * kg + (e - 16)); }
__device__ __forceinline__ bool fp8_layout_test(int lane) {
    const int r = lane & 15, kg = lane >> 4;
    i32x8 a, b;
#pragma unroll
    for (int w = 0; w < 8; ++w) { unsigned aw = 0, bw = 0;
#pragma unroll
        for (int by = 0; by < 4; ++by) { const int k = fp8_kidx(kg, 4 * w + by);
            const int av = (k == (7 * r + 3) % 128) ? 1 : 0; const int bv = ((k * 5 + r * 3) % 7) - 3;
            aw |= fp8_of_int(av) << (8 * by); bw |= fp8_of_int(bv) << (8 * by); }
        a[w] = (int)aw; b[w] = (int)bw; }
    f32x4 c = (f32x4){0.f, 0.f, 0.f, 0.f};
    c = __builtin_amdgcn_mfma_scale_f32_16x16x128_f8f6f4(a, b, c, 0, 0, 0, 0, 0, 0);
    bool bad = false;
#pragma unroll
    for (int q = 0; q < 4; ++q) { const int i = 4 * kg + q; const int kk = (7 * i + 3) % 128; const float ex = (float)(((kk * 5 + r * 3) % 7) - 3); if (c[q] != ex) bad = true; }
    return __builtin_amdgcn_ballot_w64(bad) != 0ull;
}
#endif
struct Args { const float* in[25]; float* out; unsigned char* ws; int ph_lo, ph_hi; };
constexpr int NPHASE = 2 + 9 * DEPTH;

__global__ void __launch_bounds__(512, 2) fwd(Args args) {
    extern __shared__ __attribute__((aligned(16))) unsigned char lds_raw[];
    Frame F;
    F.lds = (LAS unsigned char*)lds_raw;
    F.tid = threadIdx.x; F.lane = F.tid & 63; F.wave = __builtin_amdgcn_readfirstlane(F.tid >> 6);
    F.G = gridDim.x; { const int bx = blockIdx.x; F.vcu = (F.G % 8 == 0) ? (bx % 8) * (F.G / 8) + bx / 8 : bx; }
    F.out = args.out; F.ws = args.ws;
    volatile LAS unsigned* MISC = (volatile LAS unsigned*)(F.lds + MISC_OFF);
    if (F.tid < 64) MISC[F.tid] = 0u;
    if (F.tid < 25) ((LAS unsigned long long*)(F.lds + MISC_OFF + 256))[F.tid] = (unsigned long long)args.in[F.tid];
    __syncthreads();
    const int lo = args.ph_lo, hi = args.ph_hi;
    const bool multi = (hi - lo) > 1;
    XcdBarrier bar; bar.bar = (unsigned*)(F.ws + WS_CTL) + CW_BAR; bar.x = 0; bar.st = MISC + 8;
    if (multi) bar = xcd_barrier_post((unsigned*)(F.ws + WS_CTL) + CW_BAR, MISC + 8);
#ifndef PH_SEL
#define PH_SEL 0xffffffff
#endif
#define IN(k) (lo <= (k) && (k) < hi)
#define SEL(b) ((PH_SEL >> (b)) & 1)
#ifndef DUP_MASK
#define DUP_MASK 0
#endif
#define REP(bit) for (int rep_ = 0; rep_ < ((DUP_MASK & (bit)) ? 2 : 1); ++rep_)
#define SEAM(k) do { if ((k) + 1 < hi) xcd_barrier(bar); } while (0)

    if (SEL(0) && IN(0)) { REP(64) { ph_ada(F); __syncthreads(); conv_dense_weights(F); __syncthreads(); } SEAM(0); }
    if (SEL(1) && IN(1)) { REP(64) { ph_u0(F); __syncthreads(); } SEAM(1); }

    constexpr int ATT_S1 = NB * 2 * 32 * 3 / 4;
    for (int l = 0; l < DEPTH; ++l) {
        const int pb = 2 + 9 * l; const bool even = (l & 1) == 0; const int ie = l >> 1;
        const int m_in = (l < 3) ? NTOK : NLAT;
        const int m_out = (l < 2) ? NTOK : NLAT;
        if (SEL(2) && IN(pb + 0)) {
            REP(32) { if (even) {
                LinSched S; S.init(m_in, EN, 1024, F.G, (int)blockIdx.x);
                EpiEvenIn E{(bf16*)(F.ws + WS_P), (const float*)(F.ws + WS_ROPE)};
                pg8::gemm_phase(F.lds, (const char*)(F.ws + WS_U), (const char*)(F.ws + WS_WINE) + (size_t)ie * EN * 1024 * 2, 1024, S, E);
            } else {
                LinSched S; S.init(m_in, ON, 1024, F.G, (int)blockIdx.x);
                EpiOddIn E{(bf16*)(F.ws + WS_P)};
                pg8::gemm_phase(F.lds, (const char*)(F.ws + WS_U), (const char*)(F.ws + WS_WINO) + (size_t)ie * ON * 1024 * 2, 1024, S, E);
            } }
            SEAM(pb + 0);
        }
        if (SEL(3) && IN(pb + 1)) {
            if (even) {
                const Frame Fm = relaunder(F);
                const int nun = ATT_S1;
                REP(1) for (int u = Fm.vcu; u < nun; u += Fm.G) {
                    if (u < NB * 2 * 32) attn_unit(Fm, ie, u >> 6, (u >> 5) & 1, u & 31, false);
                    else { const int v = u - NB * 2 * 32; attn_unit(Fm, ie, v >> 2, (v >> 1) & 1, v & 1, true); }
                }
                __syncthreads();
                if (!(KO_MASK & 2)) REP(2) for (int u = Fm.vcu * 8 + Fm.wave; u < NB * NCHUNK * 8; u += Fm.G * 8) { if (u & 1) glaA_unit<1>(Fm, ie, u / (NCHUNK * 8), (u / 8) % NCHUNK, (u >> 1) & 3); else glaA_unit<0>(Fm, ie, u / (NCHUNK * 8), (u / 8) % NCHUNK, (u >> 1) & 3); }
                __syncthreads();
            } else {
                REP(16) { ph_conv(F, ie, m_out); __syncthreads(); }
            }
            SEAM(pb + 1);
        }
        if (even) {
            if (SEL(4) && IN(pb + 2)) {
                { const Frame Fm = relaunder(F);
                  if (!(KO_MASK & 2)) REP(4) for (int cg = Fm.vcu; cg < 128; cg += Fm.G) glaB_group(Fm, cg);
                  if (Fm.vcu >= 128) {
                      const int nun = NB * 2 * 32 + (l == 0 ? NB * 2 * 2 : 0);
                      for (int u = ATT_S1 + Fm.vcu - 128; u < nun; u += Fm.G - 128) {
                          if (u < NB * 2 * 32) attn_unit(Fm, ie, u >> 6, (u >> 5) & 1, u & 31, false);
                          else { const int v = u - NB * 2 * 32; attn_unit(Fm, ie, v >> 2, (v >> 1) & 1, v & 1, true); }
                      }
                  }
                  __syncthreads();
                  conv_moe_dynamic(Fm, l); }
                SEAM(pb + 2);
            }
            if (SEL(5) && IN(pb + 3)) { REP(16) { ph_combine(F, ie, m_out); __syncthreads(); } SEAM(pb + 3); }
        }
        if (SEL(6) && IN(pb + 4)) {
            REP(32) { LinSched S; S.init(m_out, 1024, 1024, F.G, (int)blockIdx.x);
            EpiPlain E{(bf16*)(F.ws + WS_P), 1024};
            pg8::gemm_phase(F.lds, (const char*)(F.ws + WS_Q), (const char*)(F.ws + (even ? WS_WOUTE : WS_WOUTO)) + (size_t)ie * 1024 * 1024 * 2, 1024, S, E); }
            if (!even) { __syncthreads(); conv_moe_dynamic(F, l); __syncthreads(); }
            SEAM(pb + 4);
        }
        if (SEL(7) && IN(pb + 5)) { if (DUP_MASK & 128) { ph_ln1(F, l, m_out, true); __syncthreads(); } ph_ln1(F, l, m_out); SEAM(pb + 5); }
        if (SEL(8) && IN(pb + 6)) {
            if (!(KO_MASK & 8)) REP(32) {
                moe_tables(F.lds, (const unsigned*)(F.ws + WS_CTL) + CW_CNT + l * 64);
                MoeSched<1> S; S.T = moe_tab(F.lds); S.rowtok = (const int*)(F.ws + WS_ROWTOK); S.G = F.G; S.c = F.vcu; S.bstride = (size_t)256 * 1024; S.estride = (size_t)1024 * 1024;
                EpiG1 E{(unsigned char*)(F.ws + WS_Q), 1.0f / W8_SCALE};
                pg8::gemm_phase<EpiG1, MoeSched<1>, 1>(F.lds, (const char*)(F.ws + WS_U8), (const char*)(F.ws + WS_W13), 1024, S, E);
            }
            SEAM(pb + 6);
        }
        if (SEL(9) && IN(pb + 7)) {
            if (!(KO_MASK & 8)) REP(32) {
                moe_tables(F.lds, (const unsigned*)(F.ws + WS_CTL) + CW_CNT + l * 64);
                MoeSched<0> S; S.T = moe_tab(F.lds); S.rowtok = nullptr; S.G = F.G; S.c = F.vcu; S.bstride = (size_t)256 * 512; S.estride = (size_t)1024 * 512;
                EpiPlainS E{(bf16*)(F.ws + WS_P), 1024, 1.0f / W8_SCALE};
                pg8::gemm_phase<EpiPlainS, MoeSched<0>, 1>(F.lds, (const char*)(F.ws + WS_Q), (const char*)(F.ws + WS_W2), 512, S, E);
            }
            SEAM(pb + 7);
        }
        if (SEL(10) && IN(pb + 8)) {
            moe_tables(F.lds, (const unsigned*)(F.ws + WS_CTL) + CW_CNT + l * 64);
            if (DUP_MASK & 256) { ph_ln2(F, l, m_out, true); __syncthreads(); }
            ph_ln2(F, l, m_out);
            SEAM(pb + 8);
        }
    }
#if defined(FP8_PROBE)
    if (blockIdx.x == 0) { __syncthreads(); if (F.tid < 64) { const bool bad = fp8_layout_test(F.tid); if (bad && F.tid == 0) F.out[0] = __builtin_nanf(""); } }
#endif
#undef IN
#undef SEAM
}

extern "C" void kernel_launch(void* const* d_in, const int* in_sizes, int n_in, void* d_out, int out_size, void* d_ws, size_t ws_size, hipStream_t stream) {
    static int grid = 0;
    if (grid == 0) {
        if (n_in != 25 || in_sizes[0] != NLAT * D || out_size != NLAT * D || ws_size < WS_END) { fprintf(stderr, "kernel_launch: unexpected shapes (n_in %d in0 %d out %d ws %zu)\n", n_in, n_in > 0 ? in_sizes[0] : -1, out_size, ws_size); grid = -1; return; }
        int dev = 0, cus = 0, per_cu = 0;
        if (hipGetDevice(&dev) != hipSuccess || hipDeviceGetAttribute(&cus, hipDeviceAttributeMultiprocessorCount, dev) != hipSuccess) { grid = -1; return; }
        if (hipFuncSetAttribute((const void*)fwd, hipFuncAttributeMaxDynamicSharedMemorySize, LDS_BYTES) != hipSuccess) { fprintf(stderr, "kernel_launch: hipFuncSetAttribute failed\n"); grid = -1; return; }
        if (hipOccupancyMaxActiveBlocksPerMultiprocessor(&per_cu, (const void*)fwd, 512, LDS_BYTES) != hipSuccess || per_cu < 1) fprintf(stderr, "kernel_launch: occupancy query says %d\n", per_cu);
        (void)hipGetLastError();
        grid = cus;
        if (grid < 242 || grid > 1024) { fprintf(stderr, "kernel_launch: built for a 256-CU device (got %d CUs)\n", cus); grid = -1; return; }
    }
    if (grid < 0) return;
    if (hipMemsetAsync((char*)d_ws + WS_CTL, 0, CTL_BYTES, stream) != hipSuccess) return;
    Args a{};
    for (int i = 0; i < 25; ++i) a.in[i] = (const float*)d_in[i];
    a.out = (float*)d_out; a.ws = (unsigned char*)d_ws;
#if N_LAUNCH_MODE == 1
    a.ph_lo = 0; a.ph_hi = NPHASE;
    hipLaunchKernelGGL(fwd, dim3(grid), dim3(512), LDS_BYTES, stream, a);
#else
    for (int k = 0; k < NPHASE; ++k) {
        if (k >= 2) { const int l = (k - 2) / 9, s = (k - 2) % 9; if ((l & 1) && (s == 2 || s == 3)) continue; }
        a.ph_lo = k; a.ph_hi = k + 1;
        hipLaunchKernelGGL(fwd, dim3(grid), dim3(512), LDS_BYTES, stream, a);
    }
#endif
}
```

```cpp
#include <hip/hip_runtime.h>
#define N_LAUNCH_MODE 1
#define KO_MASK 0
#define DUP_MASK 0
#include <cstdio>
#include <cstdint>

#ifndef KO_MASK
#define KO_MASK 0
#endif
#ifndef N_LAUNCH_MODE
#define N_LAUNCH_MODE 1
#endif

#define GAS __attribute__((address_space(1)))
#define LAS __attribute__((address_space(3)))
typedef unsigned short bf16;
typedef short bf16x8 __attribute__((ext_vector_type(8)));
typedef short s16x4 __attribute__((ext_vector_type(4)));
typedef float f32x2 __attribute__((ext_vector_type(2)));
typedef float f32x4 __attribute__((ext_vector_type(4)));
typedef float f32x16 __attribute__((ext_vector_type(16)));
typedef unsigned u32x2 __attribute__((ext_vector_type(2)));
typedef unsigned u32x4 __attribute__((ext_vector_type(4)));
typedef __bf16 bf16x2_t __attribute__((ext_vector_type(2)));
typedef int i32x8 __attribute__((ext_vector_type(8)));
typedef int i32x4_t __attribute__((ext_vector_type(4)));

constexpr int D = 1024, NB = 16, SEQ = 4096, CTXL = 256, DEPTH = 4;
constexpr int NLAT = NB * SEQ, NCTX = NB * CTXL, NTOK = NLAT + NCTX;
constexpr int EVEN_IN = 2336, EN = 2560, ON = 3072;
constexpr int NEXP = 32, DEXP = 512;
constexpr int SLOT_ROWS = 2 * NTOK + NEXP * 256;
constexpr float DN_ALPHA = 1.6817928305074290f;
constexpr float LN_EPS = 1e-5f, RMS_EPS = 1e-6f;
constexpr float LOG2E = 1.4426950408889634f;
constexpr int PC_Q = 0, PC_K = 512, PC_V = 640, PC_QG = 768, PC_KG = 1024, PC_VG = 1280, PC_RG = 1792, PC_GG = 2304;
constexpr int NCHUNK = 68;

constexpr size_t MiB = 1u << 20;
constexpr size_t WS_CTL = 0, CTL_BYTES = 1 * MiB;
constexpr size_t WS_MOD = 1 * MiB;
constexpr size_t WS_ROPE = 3 * MiB;
constexpr size_t WS_TOKINFO = 4 * MiB;
constexpr size_t WS_ROWTOK = 7 * MiB;
constexpr size_t WS_WINE = 16 * MiB, WS_WOUTE = 26 * MiB, WS_WINO = 30 * MiB, WS_WOUTO = 42 * MiB;
constexpr size_t WS_W13 = 46 * MiB, WS_W2 = 110 * MiB;
constexpr size_t WS_HCTX = 142 * MiB;
constexpr size_t WS_U = 158 * MiB;
constexpr size_t WS_P = 294 * MiB;
constexpr size_t WS_Q = 634 * MiB;
constexpr size_t WS_GATT = 778 * MiB, WS_GQIN = 846 * MiB, WS_GKST = 914 * MiB, WS_GVT = 982 * MiB, WS_GDEC = 1050 * MiB;
constexpr size_t WS_U8 = 1053 * MiB;
constexpr size_t WS_END = 1121 * MiB;
constexpr int CW_BAR = 4096;
constexpr int CW_CNT = 16384;
constexpr int CW_WQ = 20480;

constexpr int RING_BYTES = 131072;
constexpr int LDSX_OFF = RING_BYTES;
constexpr int MISC_OFF = LDSX_OFF + 8192;
constexpr int LDS_BYTES = 147456;

__device__ __forceinline__ unsigned pk2(float a, float b) { bf16x2_t r = __builtin_convertvector((f32x2){a, b}, bf16x2_t); return __builtin_bit_cast(unsigned, r); }
__device__ __forceinline__ unsigned pk4_fp8(float a, float b, float c, float d) { int r = __builtin_amdgcn_cvt_pk_fp8_f32(a, b, 0, false); r = __builtin_amdgcn_cvt_pk_fp8_f32(c, d, r, true); return (unsigned)r; }
__device__ __forceinline__ float bf2f(unsigned short h) { return __uint_as_float(((unsigned)h) << 16); }
__device__ __forceinline__ f32x4 unpk4_fp8(unsigned w) { const f32x2 lo = __builtin_amdgcn_cvt_pk_f32_fp8((int)w, false), hi = __builtin_amdgcn_cvt_pk_f32_fp8((int)w, true); return (f32x4){lo.x, lo.y, hi.x, hi.y}; }
__device__ __forceinline__ float bflo(unsigned w) { return __uint_as_float(w << 16); }
__device__ __forceinline__ float bfhi(unsigned w) { return __uint_as_float(w & 0xffff0000u); }
template <int CTRL> __device__ __forceinline__ float dppf(float v) { return __builtin_bit_cast(float, __builtin_amdgcn_update_dpp(0, __builtin_bit_cast(int, v), CTRL, 0xf, 0xf, false)); }
__device__ __forceinline__ float row16_sum(float v) { v += dppf<0xB1>(v); v += dppf<0x4E>(v); v += dppf<0x141>(v); v += dppf<0x140>(v); return v; }
__device__ __forceinline__ float wave_sum(float v) {
    v = row16_sum(v);
    const float s0 = __builtin_bit_cast(float, __builtin_amdgcn_readlane(__builtin_bit_cast(int, v), 0)), s1 = __builtin_bit_cast(float, __builtin_amdgcn_readlane(__builtin_bit_cast(int, v), 16));
    const float s2 = __builtin_bit_cast(float, __builtin_amdgcn_readlane(__builtin_bit_cast(int, v), 32)), s3 = __builtin_bit_cast(float, __builtin_amdgcn_readlane(__builtin_bit_cast(int, v), 48));
    return (s0 + s1) + (s2 + s3);
}
__device__ __forceinline__ float fast_silu(float x) { return x * __builtin_amdgcn_rcpf(1.0f + __builtin_amdgcn_exp2f(-x * LOG2E)); }

#define XB_TMO      128
#define XB_XCNT(j)  (256  + 64 * (j))
#define XB_XSUB(j)  (1280 + 64 * (j))
#define XB_XGEN(j)  (2304 + 64 * (j))
#define XB_TOP      3328
#define XB_TOPGEN   3392
#define XCD_BAR_WORDS 3456
#define XB_SPIN_CAP (1u << 22)
__device__ __forceinline__ unsigned xb_ld(unsigned* p)              { return __hip_atomic_load(p, __ATOMIC_RELAXED, __HIP_MEMORY_SCOPE_AGENT); }
__device__ __forceinline__ unsigned xb_add(unsigned* p, unsigned v) { return __hip_atomic_fetch_add(p, v, __ATOMIC_RELAXED, __HIP_MEMORY_SCOPE_AGENT); }
__device__ __forceinline__ unsigned xb_xcc_id() { return (unsigned)__builtin_amdgcn_s_getreg((3 << 11) | 20) & 0xFu; }
#define XB_SPIN(cond, bar) do { unsigned _sp = 0; while (cond) { __builtin_amdgcn_s_sleep(1); \
    if ((++_sp & 255u) == 0u) { if (xb_ld(&(bar)[XB_TMO])) break; if (_sp > XB_SPIN_CAP) { atomicAdd(&(bar)[XB_TMO], 1u); break; } } } } while (0)
struct XcdBarrier { unsigned* bar; unsigned x; volatile LAS unsigned* st; };
__device__ __forceinline__ XcdBarrier xcd_barrier_post(unsigned* bar, volatile LAS unsigned* st) {
    XcdBarrier b; b.bar = bar; b.x = xb_xcc_id(); b.st = st;
    if (threadIdx.x == 0) (void)xb_add(&bar[XB_XCNT(b.x)], 1u);
    return b;
}
__device__ __forceinline__ void xcd_barrier_complete(unsigned* bar, unsigned x, unsigned& nloc, unsigned& nx) {
    const unsigned G = gridDim.x * gridDim.y * gridDim.z;
    unsigned sum, cnt, mine, sp = 0u;
    for (;;) {
        sum = 0u; cnt = 0u; mine = 0u;
#pragma unroll
        for (unsigned j = 0; j < 16; ++j) { const unsigned c = xb_ld(&bar[XB_XCNT(j)]); sum += c; cnt += (c > 0u) ? 1u : 0u; mine = (j == x) ? c : mine; }
        if (sum == G) break;
        __builtin_amdgcn_s_sleep(1);
        if ((++sp & 255u) == 0u) { if (xb_ld(&bar[XB_TMO])) break; if (sp > XB_SPIN_CAP) { atomicAdd(&bar[XB_TMO], 1u); break; } }
    }
    nloc = mine > 0u ? mine : 1u; nx = cnt > 0u ? cnt : 1u;
}
__device__ __forceinline__ void xcd_barrier(const XcdBarrier& b) {
    asm volatile("s_waitcnt vmcnt(0)" ::: "memory");
    __syncthreads();
    if (threadIdx.x == 0) {
        unsigned* bar = b.bar;
        __builtin_amdgcn_s_waitcnt(0);
        unsigned nloc = b.st[0], nx = b.st[1];
        if (nloc == 0u) { xcd_barrier_complete(bar, b.x, nloc, nx); b.st[0] = nloc; b.st[1] = nx; }
        const unsigned old = xb_add(&bar[XB_XSUB(b.x)], 1u);
        const unsigned gen = old / nloc;
        if (old + 1u == (gen + 1u) * nloc) {
            __builtin_amdgcn_fence(__ATOMIC_RELEASE, "agent");
            asm volatile("s_waitcnt vmcnt(0)" ::: "memory");
            const unsigned og = xb_add(&bar[XB_TOP], 1u);
            const unsigned tg = og / nx;
            if (og + 1u == (tg + 1u) * nx) xb_add(&bar[XB_TOPGEN], 1u);
            else XB_SPIN(xb_ld(&bar[XB_TOPGEN]) == tg, bar);
            __builtin_amdgcn_fence(__ATOMIC_ACQUIRE, "agent");
            xb_add(&bar[XB_XGEN(b.x)], 1u);
            asm volatile("s_waitcnt vmcnt(0)" ::: "memory");
        } else {
            XB_SPIN(xb_ld(&bar[XB_XGEN(b.x)]) == gen, bar);
            __builtin_amdgcn_fence(__ATOMIC_ACQUIRE, "agent");
            asm volatile("s_waitcnt vmcnt(0)" ::: "memory");
        }
    }
    __syncthreads();
}

namespace pg8 {
constexpr int BM = 256, BK = 64, HALF = 128, HTB = HALF * BK * 2, STAGE_BYTES = 8 * HTB;
__device__ __forceinline__ int lds_byte(int r, int c) { const int st = (r >> 4) * 2 + (c >> 5), rr = r & 15, cc = c & 31, ob = rr * 64 + cc * 2; return st * 1024 + (ob ^ (((ob >> 9) & 1) << 5)); }
__device__ __forceinline__ void stage_rc(int b, int& R, int& C) { const int st = b / 1024, sb = b % 1024, swz = sb ^ (((sb >> 9) & 1) << 5); R = (st >> 1) * 16 + swz / 64; C = (st & 1) * 32 + (swz % 64) / 2; }
__device__ __forceinline__ int perm32(int rho) { const int n = rho >> 4, i = rho & 15; return 8 * (i >> 2) + 4 * n + (i & 3); }

struct Unit { int pn; int orow0; int mt; int e; };

template <class Epi, class Sched, int FP8 = 0>
__device__ __forceinline__ void gemm_phase(LAS unsigned char* lds, const char* Abase, const char* Bbase, const int K, const Sched& S, const Epi& E, const int skipE = 0, const int stag = 0) {
    int tid_ = threadIdx.x; asm volatile("" : "+v"(tid_));
    const int tid = tid_, wid = __builtin_amdgcn_readfirstlane(tid >> 6), lane = tid & 63, wr = wid >> 2, wc = wid & 3, fr = lane & 15, fq = lane >> 4;
    const unsigned K2 = FP8 ? (unsigned)K : (unsigned)K * 2u;
    const int nt = (int)(K2 / 128u);
    int Rr[2], Cc[2]; unsigned voffB[2];
#pragma unroll
    for (int i = 0; i < 2; ++i) { stage_rc(tid * 16 + i * 8192, Rr[i], Cc[i]); const int Rb = (Rr[i] & ~31) + perm32(Rr[i] & 31); voffB[i] = (unsigned)Rb * K2 + (unsigned)Cc[i] * 2u; }
    const size_t kstep = (size_t)(BK * 2);
    const size_t hstep = (size_t)HALF * K2;
    const unsigned ldsw = (unsigned)wid * 1024u;
    const int aoff = FP8 ? lds_byte(wr * 64 + fr, 32 * (fq >> 1) + 16 * (fq & 1)) : lds_byte(wr * 64 + fr, fq * 8), boff = FP8 ? lds_byte(wc * 32 + fr, 32 * (fq >> 1) + 16 * (fq & 1)) : lds_byte(wc * 32 + fr, fq * 8);
#define PG8_SA(b, h) (((b) * 2 + (h)) * HTB)
#define PG8_SB(b, h) ((4 + (b) * 2 + (h)) * HTB)
#define PG8_STAGE(bufoff, gbase, voff) do { _Pragma("unroll") for (int _i = 0; _i < 2; ++_i) \
        __builtin_amdgcn_global_load_lds((const unsigned*)((const char*)(gbase) + (voff)[_i]), (LAS unsigned*)(lds + (bufoff) + ldsw + _i * 8192), 16, 0, 0); } while (0)
#define PG8_LD8(ptr) __builtin_shufflevector(*(const LAS i32x4_t*)(ptr), *(const LAS i32x4_t*)((ptr) + 16), 0, 1, 2, 3, 4, 5, 6, 7)
#define PG8_LDA(dst, b, h) do { if constexpr (FP8) { _Pragma("unroll") for (int m = 0; m < 4; ++m) dst##8[m] = PG8_LD8(lds + PG8_SA(b, h) + aoff + m * 2048); } \
        else { _Pragma("unroll") for (int m = 0; m < 4; ++m) _Pragma("unroll") for (int k = 0; k < 2; ++k) dst[m][k] = *(const LAS bf16x8*)(lds + PG8_SA(b, h) + aoff + m * 2048 + k * 1024); } } while (0)
#define PG8_LDB(dst, b, h) do { if constexpr (FP8) { _Pragma("unroll") for (int n = 0; n < 2; ++n) dst##8[n] = PG8_LD8(lds + PG8_SB(b, h) + boff + n * 2048); } \
        else { _Pragma("unroll") for (int n = 0; n < 2; ++n) _Pragma("unroll") for (int k = 0; k < 2; ++k) dst[n][k] = *(const LAS bf16x8*)(lds + PG8_SB(b, h) + boff + n * 2048 + k * 1024); } } while (0)
#define PG8_MMA(ai, bj, At, Bt) do { __builtin_amdgcn_s_setprio(1); _Pragma("unroll") for (int m = 0; m < 4; ++m) _Pragma("unroll") for (int n = 0; n < 2; ++n) { \
        if constexpr (FP8) asm volatile("v_mfma_f32_16x16x128_f8f6f4 %0, %1, %2, %0" : "+v"(acc[ai][bj][m][n]) : "v"(Bt##8[n]), "v"(At##8[m])); \
        else { _Pragma("unroll") for (int k = 0; k < 2; ++k) acc[ai][bj][m][n] = __builtin_amdgcn_mfma_f32_16x16x32_bf16(Bt[n][k], At[m][k], acc[ai][bj][m][n], 0, 0, 0); } } \
        __builtin_amdgcn_s_setprio(0); } while (0)
#define PG8_WAIT_V(n) asm volatile("s_waitcnt vmcnt(" #n ")" ::: "memory")
#define PG8_WAIT_L(n) asm volatile("s_waitcnt lgkmcnt(" #n ")" ::: "memory")
#define PG8_BAR __builtin_amdgcn_s_barrier()
#define PG8_SCHED __builtin_amdgcn_sched_barrier(0)
    Unit cur, nxt; int ui = 0;
    if (!S.next(0, cur)) return;
    if (stag > 0) { const unsigned cls = (blockIdx.x >> 3) & 3u;
      if (cls) { const unsigned long long t0 = __builtin_amdgcn_s_memrealtime(); while (__builtin_amdgcn_s_memrealtime() - t0 < (unsigned long long)(cls * (unsigned)stag)) __builtin_amdgcn_s_sleep(8); } }
    f32x4 acc[2][2][4][2];
#pragma unroll
    for (int a = 0; a < 2; ++a)
#pragma unroll
        for (int b = 0; b < 2; ++b)
#pragma unroll
            for (int m = 0; m < 4; ++m)
#pragma unroll
                for (int n = 0; n < 2; ++n) { if constexpr (FP8) asm volatile("v_mov_b32 %0, 0\n\tv_mov_b32 %1, 0\n\tv_mov_b32 %2, 0\n\tv_mov_b32 %3, 0" : "=v"(acc[a][b][m][n][0]), "=v"(acc[a][b][m][n][1]), "=v"(acc[a][b][m][n][2]), "=v"(acc[a][b][m][n][3])); else acc[a][b][m][n] = (f32x4){0.f, 0.f, 0.f, 0.f}; }
    if constexpr (FP8) asm volatile("s_nop 7" ::: "memory");
    bf16x8 At[4][2], B0[2][2], B1[2][2];
    i32x8 At8[4], B08[2], B18[2];
    unsigned vAc0[2], vAc1[2], vAn0[2], vAn1[2];
#pragma unroll
    for (int i = 0; i < 2; ++i) { vAc0[i] = (unsigned)S.arow(cur, Rr[i]) * K2 + (unsigned)Cc[i] * 2u; vAc1[i] = (unsigned)S.arow(cur, HALF + Rr[i]) * K2 + (unsigned)Cc[i] * 2u; vAn0[i] = vAc0[i]; vAn1[i] = vAc1[i]; }
    const char* cB = Bbase + S.boff(cur);
    PG8_STAGE(PG8_SB(0, 0), cB, voffB); PG8_STAGE(PG8_SB(0, 1), cB + hstep, voffB); PG8_STAGE(PG8_SA(0, 0), Abase, vAc0); PG8_STAGE(PG8_SA(0, 1), Abase, vAc1);
    if (wr == 1) PG8_BAR;
    PG8_WAIT_V(2); PG8_BAR;
    PG8_STAGE(PG8_SB(1, 0), cB + kstep, voffB); PG8_STAGE(PG8_SA(1, 0), Abase + kstep, vAc0); PG8_STAGE(PG8_SB(1, 1), cB + hstep + kstep, voffB);
    PG8_WAIT_V(6); PG8_BAR;
    for (;;) {
        const bool has_next = S.next(ui + 1, nxt);
        const char* nB = has_next ? Bbase + S.boff(nxt) : cB;
        int rN0[2] = {0, 0}, rN1[2] = {0, 0};
        if (has_next) {
            if constexpr (Sched::kGather) {
                if (wid < 4) __builtin_amdgcn_global_load_lds((const unsigned*)S.gather_src(nxt, wid * 64 + lane), (LAS unsigned*)(lds + LDSX_OFF + 2048 + wid * 256), 4, 0, 0);
            } else {
#pragma unroll
                for (int i = 0; i < 2; ++i) { rN0[i] = S.arow(nxt, Rr[i]); rN1[i] = S.arow(nxt, HALF + Rr[i]); }
            }
        } else {
#pragma unroll
            for (int i = 0; i < 2; ++i) { vAn0[i] = vAc0[i]; vAn1[i] = vAc1[i]; }
        }
        for (int t = 0; t < nt; t += 2) {
            const bool last = (t == nt - 2);
            const char* a1 = Abase + (size_t)(t + 1) * kstep;
            const char* a2 = last ? Abase : Abase + (size_t)(t + 2) * kstep; const char* b2 = last ? nB : cB + (size_t)(t + 2) * kstep;
            const char* a3 = a2 + kstep; const char* b3 = b2 + kstep;
            unsigned v20[2], v21[2];
            if (last) {
                if (has_next) {
                    if constexpr (Sched::kGather) {
                        const unsigned ta0 = (unsigned)(size_t)(lds + LDSX_OFF + 2048) + (unsigned)Rr[0] * 4u, ta1 = (unsigned)(size_t)(lds + LDSX_OFF + 2048) + (unsigned)Rr[1] * 4u;
                        asm volatile("ds_read_b32 %0, %4\n\tds_read_b32 %1, %5\n\tds_read_b32 %2, %4 offset:512\n\tds_read_b32 %3, %5 offset:512\n\ts_waitcnt lgkmcnt(0)"
                                     : "=&v"(rN0[0]), "=&v"(rN0[1]), "=&v"(rN1[0]), "=&v"(rN1[1]) : "v"(ta0), "v"(ta1) : "memory");
                    }
#pragma unroll
                    for (int i = 0; i < 2; ++i) { int a_ = rN0[i], b_ = rN1[i]; asm volatile("" : "+v"(a_), "+v"(b_)); vAn0[i] = (unsigned)a_ * K2 + (unsigned)Cc[i] * 2u; vAn1[i] = (unsigned)b_ * K2 + (unsigned)Cc[i] * 2u; }
                }
#pragma unroll
                for (int i = 0; i < 2; ++i) { v20[i] = vAn0[i]; v21[i] = vAn1[i]; }
            } else {
#pragma unroll
                for (int i = 0; i < 2; ++i) { v20[i] = vAc0[i]; v21[i] = vAc1[i]; }
            }
            PG8_LDB(B0, 0, 0); PG8_LDB(B1, 0, 1); PG8_SCHED; PG8_LDA(At, 0, 0); PG8_STAGE(PG8_SA(1, 1), a1, vAc1);
            PG8_WAIT_V(8); PG8_WAIT_L(0); PG8_BAR; PG8_MMA(0, 0, At, B0); PG8_MMA(0, 1, At, B1); PG8_BAR; PG8_SCHED;
            PG8_LDA(At, 0, 1); PG8_STAGE(PG8_SB(0, 0), b2, voffB); PG8_STAGE(PG8_SB(0, 1), b2 + hstep, voffB); PG8_STAGE(PG8_SA(0, 0), a2, v20);
            PG8_WAIT_V(8); PG8_WAIT_L(0); PG8_BAR; PG8_MMA(1, 0, At, B0); PG8_MMA(1, 1, At, B1); PG8_BAR; PG8_SCHED;
            PG8_LDB(B0, 1, 0); PG8_LDB(B1, 1, 1); PG8_SCHED; PG8_LDA(At, 1, 0); PG8_STAGE(PG8_SA(0, 1), a2, v21);
            PG8_WAIT_V(8); PG8_WAIT_L(0); PG8_BAR; PG8_MMA(0, 0, At, B0); PG8_MMA(0, 1, At, B1); PG8_BAR; PG8_SCHED;
            PG8_LDA(At, 1, 1); PG8_STAGE(PG8_SB(1, 0), b3, voffB); PG8_STAGE(PG8_SB(1, 1), b3 + hstep, voffB); PG8_STAGE(PG8_SA(1, 0), a3, v20);
            PG8_WAIT_V(8); PG8_WAIT_L(0); PG8_BAR; PG8_MMA(1, 0, At, B0); PG8_MMA(1, 1, At, B1); PG8_BAR; PG8_SCHED;
        }
        if (wr == 0) PG8_BAR;
        if constexpr (FP8) asm volatile("s_nop 15\n\ts_nop 15" ::: "memory");
        if (!skipE) E(acc, cur, wr, wc, fr, fq);
        if (!has_next) break;
#pragma unroll
        for (int a = 0; a < 2; ++a)
#pragma unroll
            for (int b = 0; b < 2; ++b)
#pragma unroll
                for (int m = 0; m < 4; ++m)
#pragma unroll
                    for (int n = 0; n < 2; ++n) { if constexpr (FP8) asm volatile("v_mov_b32 %0, 0\n\tv_mov_b32 %1, 0\n\tv_mov_b32 %2, 0\n\tv_mov_b32 %3, 0" : "=v"(acc[a][b][m][n][0]), "=v"(acc[a][b][m][n][1]), "=v"(acc[a][b][m][n][2]), "=v"(acc[a][b][m][n][3])); else acc[a][b][m][n] = (f32x4){0.f, 0.f, 0.f, 0.f}; }
        if constexpr (FP8) asm volatile("s_nop 7" ::: "memory");
        cur = nxt; cB = nB; ++ui;
#pragma unroll
        for (int i = 0; i < 2; ++i) { vAc0[i] = vAn0[i]; vAc1[i] = vAn1[i]; }
        if (wr == 1) PG8_BAR;
    }
    PG8_WAIT_V(0);
    PG8_BAR;
#undef PG8_SA
#undef PG8_SB
#undef PG8_STAGE
#undef PG8_LDA
#undef PG8_LDB
#undef PG8_MMA
#undef PG8_WAIT_V
#undef PG8_WAIT_L
#undef PG8_BAR
#undef PG8_SCHED
}
}
struct LinSched {
    int nM, nN, nwg, G, c; size_t bstride;
    __device__ __forceinline__ void init(int M, int N, int K, int G_, int c_) { nM = M / 256; nN = N / 256; nwg = nM * nN; G = G_; c = c_; bstride = (size_t)256 * K * 2; }
    __device__ __forceinline__ bool next(int i, pg8::Unit& u) const {
        const long L = (long)i * G + c; if (L >= nwg) return false;
        int wgid = (int)L; { const int q = nwg / 8, r = nwg % 8, xcd = wgid % 8, off = wgid / 8; wgid = (xcd < r ? xcd * (q + 1) : r * (q + 1) + (xcd - r) * q) + off; }
        const int nig = 8 * nN, gid = wgid / nig, fm = gid * 8, gsz = (nM - fm) < 8 ? (nM - fm) : 8;
        u.mt = fm + ((wgid % nig) % gsz); u.pn = (wgid % nig) / gsz; u.orow0 = u.mt * 256; u.e = 0; return true;
    }
    __device__ __forceinline__ int arow(const pg8::Unit& u, int lr) const { return u.orow0 + lr; }
    __device__ __forceinline__ size_t boff(const pg8::Unit& u) const { return (size_t)u.pn * bstride; }
    static constexpr bool kGather = false;
    __device__ __forceinline__ const int* gather_src(const pg8::Unit&, int) const { return nullptr; }
    __device__ __forceinline__ bool slack() const { return (nwg - c + G - 1) / G < (nwg + G - 1) / G; }
};
struct MoeTab { LAS int* ts; LAS int* cnt; LAS unsigned char* tile_e; };
__device__ __forceinline__ MoeTab moe_tab(LAS unsigned char* lds) { MoeTab t; t.ts = (LAS int*)(lds + LDSX_OFF); t.cnt = (LAS int*)(lds + LDSX_OFF + 256); t.tile_e = (LAS unsigned char*)(lds + LDSX_OFF + 512); return t; }
__device__ __forceinline__ void moe_tables(LAS unsigned char* lds, const unsigned* gcnt) {
    MoeTab T = moe_tab(lds);
    __syncthreads();
    if (threadIdx.x == 0) { int s = 0; for (int e = 0; e < NEXP; ++e) { const int c = (int)gcnt[e]; T.cnt[e] = c; T.ts[e] = s; s += (c + 255) >> 8; } T.ts[NEXP] = s; }
    __syncthreads();
    const int nt = T.ts[NEXP];
    for (int mt = threadIdx.x; mt < nt; mt += blockDim.x) { int e = 0; for (int j = 1; j < NEXP; ++j) e += (mt >= T.ts[j]) ? 1 : 0; T.tile_e[mt] = (unsigned char)e; }
    __syncthreads();
}
template <int GATHER> struct MoeSched {
    MoeTab T; const int* rowtok; int G, c; size_t bstride; size_t estride;
    __device__ __forceinline__ bool next(int i, pg8::Unit& u) const {
        const int L = i * G + c; const int nt = T.ts[NEXP]; if (L >= nt * 4) return false;
        u.mt = L >> 2; u.pn = L & 3; u.orow0 = u.mt * 256; u.e = (int)T.tile_e[u.mt]; return true;
    }
    __device__ __forceinline__ int arow(const pg8::Unit& u, int lr) const {
        if (GATHER) { const int idx = (u.mt - T.ts[u.e]) * 256 + lr, last = T.cnt[u.e] - 1; return rowtok[(size_t)u.e * NTOK + (idx < last ? idx : last)]; }
        return u.orow0 + lr;
    }
    __device__ __forceinline__ size_t boff(const pg8::Unit& u) const { return (size_t)u.e * estride + (size_t)u.pn * bstride; }
    static constexpr bool kGather = GATHER != 0;
    __device__ __forceinline__ const int* gather_src(const pg8::Unit& u, int lr) const { const int idx = (u.mt - T.ts[u.e]) * 256 + lr, last = T.cnt[u.e] - 1; return rowtok + (size_t)u.e * NTOK + (idx < last ? idx : last); }
    __device__ __forceinline__ bool slack() const { const int n = T.ts[NEXP] * 4; return (n - c + G - 1) / G < (n + G - 1) / G; }
};

__device__ __forceinline__ u32x4 pack8(const f32x4 a, const f32x4 b) { u32x4 w; w.x = pk2(a[0], a[1]); w.y = pk2(a[2], a[3]); w.z = pk2(b[0], b[1]); w.w = pk2(b[2], b[3]); return w; }
struct EpiPlain {
    bf16* O; int ldc;
    __device__ __forceinline__ void operator()(const f32x4 (&acc)[2][2][4][2], const pg8::Unit& u, int wr, int wc, int fr, int fq) const {
        const int row0 = u.orow0 + wr * 64 + fr, col0 = u.pn * 256 + wc * 32 + 8 * fq;
#pragma unroll
        for (int ai = 0; ai < 2; ++ai)
#pragma unroll
            for (int m = 0; m < 4; ++m) { bf16* rowp = O + (size_t)(row0 + ai * 128 + m * 16) * ldc + col0;
#pragma unroll
                for (int bj = 0; bj < 2; ++bj) *(u32x4*)(rowp + bj * 128) = pack8(acc[ai][bj][m][0], acc[ai][bj][m][1]); }
    }
};
struct EpiPlainS {
    bf16* O; int ldc; float sc;
    __device__ __forceinline__ void operator()(const f32x4 (&acc)[2][2][4][2], const pg8::Unit& u, int wr, int wc, int fr, int fq) const {
        const int row0 = u.orow0 + wr * 64 + fr, col0 = u.pn * 256 + wc * 32 + 8 * fq;
#pragma unroll
        for (int ai = 0; ai < 2; ++ai)
#pragma unroll
            for (int m = 0; m < 4; ++m) { bf16* rowp = O + (size_t)(row0 + ai * 128 + m * 16) * ldc + col0;
#pragma unroll
                for (int bj = 0; bj < 2; ++bj) *(u32x4*)(rowp + bj * 128) = pack8(acc[ai][bj][m][0] * sc, acc[ai][bj][m][1] * sc); }
    }
};
struct EpiOut8 {
    unsigned char* O; float sc;
    __device__ __forceinline__ void operator()(const f32x4 (&acc)[2][2][4][2], const pg8::Unit& u, int wr, int wc, int fr, int fq) const {
        const int row0 = u.orow0 + wr * 64 + fr, col0 = u.pn * 256 + wc * 32 + 8 * fq;
#pragma unroll
        for (int ai = 0; ai < 2; ++ai)
#pragma unroll
            for (int m = 0; m < 4; ++m) { unsigned char* rowp = O + (size_t)(row0 + ai * 128 + m * 16) * D + col0;
#pragma unroll
                for (int bj = 0; bj < 2; ++bj) { const f32x4 a = acc[ai][bj][m][0] * sc, b = acc[ai][bj][m][1] * sc;
                    *(u32x2*)(rowp + bj * 128) = (u32x2){pk4_fp8(a[0], a[1], a[2], a[3]), pk4_fp8(b[0], b[1], b[2], b[3])}; } }
    }
};
struct EpiEvenIn {
    bf16* O; const LAS float* rc; const LAS float* rs;
    __device__ __forceinline__ void operator()(const f32x4 (&acc)[2][2][4][2], const pg8::Unit& u, int wr, int wc, int fr, int fq) const {
        const int row0 = u.orow0 + wr * 64 + fr, col0 = u.pn * 256 + wc * 32 + 8 * fq;
        const bool lat = u.orow0 < NLAT;
#pragma unroll
        for (int ai = 0; ai < 2; ++ai)
#pragma unroll
            for (int m = 0; m < 4; ++m) { const int row = row0 + ai * 128 + m * 16; bf16* rowp = O + (size_t)row * EN + col0;
                const int s = row & (SEQ - 1); const int pos = (wc & 1) ? (s & 63) : (s >> 6);
#pragma unroll
                for (int bj = 0; bj < 2; ++bj) { f32x4 v0 = acc[ai][bj][m][0], v1 = acc[ai][bj][m][1];
                    const bool rp = lat && (u.pn < 2 || (u.pn == 2 && bj == 0));
                    if (rp) { const f32x4 c = *(const LAS f32x4*)(rc + pos * 16 + 4 * fq), sn = *(const LAS f32x4*)(rs + pos * 16 + 4 * fq);
                        const f32x4 o1 = v0 * c - v1 * sn, o2 = v1 * c + v0 * sn; v0 = o1; v1 = o2; }
                    if (col0 + bj * 128 < EVEN_IN) *(u32x4*)(rowp + bj * 128) = pack8(v0, v1); }
                asm volatile("" ::: "memory"); }
    }
};
struct EpiOddIn {
    bf16* O;
    __device__ __forceinline__ void operator()(const f32x4 (&acc)[2][2][4][2], const pg8::Unit& u, int wr, int wc, int fr, int fq) const {
        const int row0 = u.orow0 + wr * 64 + fr;
#pragma unroll
        for (int ai = 0; ai < 2; ++ai)
#pragma unroll
            for (int m = 0; m < 4; ++m) { bf16* rowp = O + (size_t)(row0 + ai * 128 + m * 16) * 2048;
                if (u.pn < 4) {
#pragma unroll
                    for (int bj = 0; bj < 2; ++bj) *(u32x4*)(rowp + u.pn * 256 + bj * 128 + wc * 32 + 8 * fq) = pack8(acc[ai][bj][m][0], acc[ai][bj][m][1]);
                } else {
                    *(u32x4*)(rowp + 1024 + (u.pn - 4) * 128 + wc * 32 + 8 * fq) = pack8(acc[ai][0][m][0] * acc[ai][1][m][0], acc[ai][0][m][1] * acc[ai][1][m][1]);
                } }
    }
};
struct EpiG1 {
    unsigned char* O; float sc;
    __device__ __forceinline__ void operator()(const f32x4 (&acc)[2][2][4][2], const pg8::Unit& u, int wr, int wc, int fr, int fq) const {
        const int row0 = u.orow0 + wr * 64 + fr, col0 = u.pn * 128 + wc * 32 + 8 * fq;
#pragma unroll
        for (int ai = 0; ai < 2; ++ai)
#pragma unroll
            for (int m = 0; m < 4; ++m) { unsigned char* rowp = O + (size_t)(row0 + ai * 128 + m * 16) * DEXP + col0;
                f32x4 a0 = acc[ai][0][m][0] * sc, a1 = acc[ai][0][m][1] * sc;
#pragma unroll
                for (int j = 0; j < 4; ++j) { a0[j] = fast_silu(a0[j]); a1[j] = fast_silu(a1[j]); }
                const f32x4 h0 = a0 * (acc[ai][1][m][0] * sc), h1v = a1 * (acc[ai][1][m][1] * sc);
                *(u32x2*)rowp = (u32x2){pk4_fp8(h0[0], h0[1], h0[2], h0[3]), pk4_fp8(h1v[0], h1v[1], h1v[2], h1v[3])}; }
    }
};
struct Frame {
    LAS unsigned char* lds;
    int tid, lane, wave, vcu, G;
    float* out; unsigned char* ws;
};
__device__ __forceinline__ const float* inptr(const Frame& F, int i) {
    const unsigned long long v = ((const LAS unsigned long long*)(F.lds + MISC_OFF + 256))[i];
    const unsigned lo = __builtin_amdgcn_readfirstlane((unsigned)v), hi = __builtin_amdgcn_readfirstlane((unsigned)(v >> 32));
    return (const float*)(((unsigned long long)hi << 32) | lo);
}
enum { I_X = 0, I_C, I_CTX, I_CCTX, I_WINE, I_WOUTE, I_SINK, I_WA2, I_BA, I_NORMW, I_WINO, I_CONVW, I_CONVB, I_WOUTO, I_ADAW, I_ADAB, I_LNW, I_LNB, I_WG, I_BG, I_WE, I_BE, I_W1, I_W3, I_W2 };
__device__ __forceinline__ int launder_v(int x) { asm volatile("" : "+v"(x)); return x; }
__device__ __forceinline__ int launder_s(int x) { asm volatile("" : "+s"(x)); return x; }
__device__ __forceinline__ Frame relaunder(const Frame& F0) { Frame F = F0; F.tid = launder_v(F0.tid); F.lane = F.tid & 63; F.wave = __builtin_amdgcn_readfirstlane(F.tid >> 6); F.vcu = launder_s(F0.vcu); return F; }
__device__ __forceinline__ const float* modp(const Frame& F, int l, int bi, int n) { return (const float*)(F.ws + WS_MOD) + ((size_t)(l * 17 + bi) * 6 + n) * D; }
__device__ __forceinline__ int row_bi(int row) { return row < NLAT ? (row >> 12) : 16; }

__device__ __forceinline__ void sincos_d(double a, float& c, float& s) {
    const double TWO_OVER_PI = 0.63661977236758134308, PIO2_HI = 1.57079632679489655800e+00, PIO2_LO = 6.12323399573676603587e-17;
    const double n = __builtin_rint(a * TWO_OVER_PI); double r = (a - n * PIO2_HI) - n * PIO2_LO; const double r2 = r * r;
    double sp = -1.0 / 1307674368000.0; sp = sp * r2 + 1.0 / 6227020800.0; sp = sp * r2 - 1.0 / 39916800.0; sp = sp * r2 + 1.0 / 362880.0; sp = sp * r2 - 1.0 / 5040.0; sp = sp * r2 + 1.0 / 120.0; sp = sp * r2 - 1.0 / 6.0; sp = sp * r2 + 1.0; sp *= r;
    double cp = 1.0 / 20922789888000.0; cp = cp * r2 - 1.0 / 87178291200.0; cp = cp * r2 + 1.0 / 479001600.0; cp = cp * r2 - 1.0 / 3628800.0; cp = cp * r2 + 1.0 / 40320.0; cp = cp * r2 - 1.0 / 720.0; cp = cp * r2 + 1.0 / 24.0; cp = cp * r2 - 0.5; cp = cp * r2 + 1.0;
    const int q = ((int)n) & 3;
    const double sv = (q == 0) ? sp : (q == 1) ? cp : (q == 2) ? -sp : -cp;
    const double cv = (q == 0) ? cp : (q == 1) ? -sp : (q == 2) ? -cp : sp;
    c = (float)cv; s = (float)sv;
}
__device__ __forceinline__ void ph_ada(const Frame& F0) {
    Frame F = relaunder(F0);
    LAS float* sl = (LAS float*)F.lds;
    LAS float* red = (LAS float*)(F.lds + 17 * 1024 * 4);
    for (int idx = F.tid; idx < 17 * 1024; idx += 512) { const int bi = idx >> 10, k = idx & 1023; const float c = bi < 16 ? inptr(F, I_C)[bi * 1024 + k] : inptr(F, I_CCTX)[k]; sl[idx] = c / (1.0f + expf(-c)); }
    __syncthreads();
    for (int it = F.vcu; it < 4 * 96; it += F.G) {
        const int l = it / 96, n0 = (it % 96) * 64;
        const float* W = inptr(F, I_ADAW) + (size_t)l * 1024 * 6144 + n0 + F.lane;
        float acc[17];
#pragma unroll
        for (int b = 0; b < 17; ++b) acc[b] = 0.f;
        const int kb = F.wave * 128;
        for (int k = kb; k < kb + 128; k += 4) {
            const float w0 = __builtin_nontemporal_load(W + (size_t)k * 6144), w1 = __builtin_nontemporal_load(W + (size_t)(k + 1) * 6144), w2 = __builtin_nontemporal_load(W + (size_t)(k + 2) * 6144), w3 = __builtin_nontemporal_load(W + (size_t)(k + 3) * 6144);
#pragma unroll
            for (int b = 0; b < 17; ++b) { const f32x4 s = *(const LAS f32x4*)(sl + b * 1024 + k); acc[b] += s[0] * w0 + s[1] * w1 + s[2] * w2 + s[3] * w3; }
        }
#pragma unroll
        for (int b = 0; b < 17; ++b) red[(F.wave * 17 + b) * 64 + F.lane] = acc[b];
        __syncthreads();
        for (int idx = F.tid; idx < 17 * 64; idx += 512) { const int b = idx >> 6, ln = idx & 63; float s = 0.f;
#pragma unroll
            for (int w = 0; w < 8; ++w) s += red[(w * 17 + b) * 64 + ln];
            ((float*)(F.ws + WS_MOD))[(size_t)(l * 17 + b) * 6144 + n0 + ln] = s + inptr(F, I_ADAB)[l * 6144 + n0 + ln]; }
        __syncthreads();
    }
    if (F.vcu == F.G - 1) {
        float* rope = (float*)(F.ws + WS_ROPE);
        for (int idx = F.tid; idx < 1024; idx += 512) { const int pos = idx >> 4, f = idx & 15;
            const double base4[4] = {1.0, 0.56234132519034908, 0.31622776601683794, 0.17782794100389228};
            double inv = (f & 3) == 0 ? base4[0] : (f & 3) == 1 ? base4[1] : (f & 3) == 2 ? base4[2] : base4[3];
            const int a = f >> 2; inv *= (a == 0) ? 1.0 : (a == 1) ? 0.1 : (a == 2) ? 0.01 : 0.001;
            float c, s; sincos_d((double)pos * inv, c, s); rope[idx] = c; rope[1024 + idx] = s; }
    }
}

__device__ __forceinline__ void tr_item(const float* W, int srcN, int K, bf16* WT, int drow0, int k0, int srccol, LAS float* scr, int lane) {
    float v[32];
    const float* p = W + (size_t)(k0 + (lane >> 5)) * srcN + (srccol >= 0 ? srccol : 0);
#pragma unroll
    for (int i = 0; i < 32; ++i) v[i] = __builtin_nontemporal_load(p + (size_t)(2 * i) * srcN);
#pragma unroll
    for (int i = 0; i < 32; ++i) scr[(2 * i + (lane >> 5)) * 33 + (lane & 31)] = srccol >= 0 ? v[i] : 0.f;
    asm volatile("s_waitcnt lgkmcnt(0)" ::: "memory");
    const int c = lane & 7;
#pragma unroll
    for (int j = 0; j < 4; ++j) { const int n = (lane >> 3) + 8 * j; const LAS float* s = scr + (8 * c) * 33 + n;
        u32x4 o; o.x = pk2(s[0 * 33], s[1 * 33]); o.y = pk2(s[2 * 33], s[3 * 33]); o.z = pk2(s[4 * 33], s[5 * 33]); o.w = pk2(s[6 * 33], s[7 * 33]);
        *(u32x4*)(WT + (size_t)(drow0 + n) * K + k0 + 8 * c) = o; }
    asm volatile("s_waitcnt lgkmcnt(0)" ::: "memory");
}
__device__ __forceinline__ void tr_item8(const float* W, int srcN, int K, unsigned char* WT, int drow0, int k0, int srccol, float scale, LAS float* scr, int lane) {
    float v[32];
    const float* p = W + (size_t)(k0 + (lane >> 5)) * srcN + srccol;
#pragma unroll
    for (int i = 0; i < 32; ++i) v[i] = __builtin_nontemporal_load(p + (size_t)(2 * i) * srcN);
#pragma unroll
    for (int i = 0; i < 32; ++i) scr[(2 * i + (lane >> 5)) * 33 + (lane & 31)] = v[i] * scale;
    asm volatile("s_waitcnt lgkmcnt(0)" ::: "memory");
    const int c = lane & 3;
#pragma unroll
    for (int j = 0; j < 2; ++j) { const int n = (lane >> 2) + 16 * j; const LAS float* s = scr + (16 * c) * 33 + n;
        u32x4 o; o.x = pk4_fp8(s[0 * 33], s[1 * 33], s[2 * 33], s[3 * 33]); o.y = pk4_fp8(s[4 * 33], s[5 * 33], s[6 * 33], s[7 * 33]);
        o.z = pk4_fp8(s[8 * 33], s[9 * 33], s[10 * 33], s[11 * 33]); o.w = pk4_fp8(s[12 * 33], s[13 * 33], s[14 * 33], s[15 * 33]);
        *(u32x4*)(WT + (size_t)(drow0 + n) * K + k0 + 16 * c) = o; }
    asm volatile("s_waitcnt lgkmcnt(0)" ::: "memory");
}
__device__ __forceinline__ int even_srccol(int j) {
    if (j < 640) { const int hb = j & ~63, p = j & 63, g = p >> 3, e = p & 7; return hb + (g >> 2) * 32 + (e >> 2) * 16 + (g & 3) * 4 + (e & 3); }
    return j < EVEN_IN ? j : -1;
}
__device__ __forceinline__ int odd_srccol(int j) { const int t = j >> 8, r = j & 255; if (t < 4) return j; return (r < 128 ? 1024 : 2048 - 128) + 128 * (t - 4) + r; }
__device__ __forceinline__ void conv_dense_weights(const Frame& F0) {
    Frame F = relaunder(F0);
    LAS float* scr = (LAS float*)(F.lds + F.wave * 16384);
    const int gw = F.vcu * 8 + F.wave, NGW = F.G * 8;
    constexpr int I_EI = 16 * 80, I_SQ = 16 * 32, I_OI = 16 * 96;
    constexpr int NIT = 2 * (I_EI + I_SQ + I_OI + I_SQ);
    for (int it = gw; it < NIT; it += NGW) {
        int r = it; const int i = r & 1; r >>= 1;
        if (r < I_EI) { const int kb = r / 80, nb = r % 80; tr_item(inptr(F, I_WINE) + (size_t)i * 1024 * EVEN_IN, EVEN_IN, 1024, (bf16*)(F.ws + WS_WINE) + (size_t)i * EN * 1024, nb * 32, kb * 64, even_srccol(nb * 32 + (F.lane & 31)), scr, F.lane); continue; } r -= I_EI;
        if (r < I_SQ) { const int kb = r / 32, nb = r % 32; tr_item(inptr(F, I_WOUTE) + (size_t)i * 1024 * 1024, 1024, 1024, (bf16*)(F.ws + WS_WOUTE) + (size_t)i * 1024 * 1024, nb * 32, kb * 64, nb * 32 + (F.lane & 31), scr, F.lane); continue; } r -= I_SQ;
        if (r < I_OI) { const int kb = r / 96, nb = r % 96; tr_item(inptr(F, I_WINO) + (size_t)i * 1024 * ON, ON, 1024, (bf16*)(F.ws + WS_WINO) + (size_t)i * ON * 1024, nb * 32, kb * 64, odd_srccol(nb * 32 + (F.lane & 31)), scr, F.lane); continue; } r -= I_OI;
        { const int kb = r / 32, nb = r % 32; tr_item(inptr(F, I_WOUTO) + (size_t)i * 1024 * 1024, 1024, 1024, (bf16*)(F.ws + WS_WOUTO) + (size_t)i * 1024 * 1024, nb * 32, kb * 64, nb * 32 + (F.lane & 31), scr, F.lane); }
    }
}
constexpr float OUT8_SCALE = 32.0f;
constexpr float W8_SCALE = 64.0f;
__device__ __forceinline__ void conv_moe_item(const Frame& F, int l, int it, LAS float* scr) {
    constexpr int I_13 = 16 * 32, I_2 = 8 * 32;
    const int e = it / (I_13 + I_2); int r = it % (I_13 + I_2);
    const size_t eoff = ((size_t)l * NEXP + e) * 1024 * 512;
    if (r < I_13) { const int kb = r / 32, nb = r % 32; const int j0 = nb * 32, t = j0 >> 8, rr = j0 & 255;
        const float* src = (rr < 128 ? inptr(F, I_W1) : inptr(F, I_W3)) + eoff;
        tr_item8(src, 512, 1024, (unsigned char*)(F.ws + WS_W13) + (size_t)e * 1024 * 1024, j0, kb * 64, 128 * t + (rr & 127) + (F.lane & 31), W8_SCALE, scr, F.lane);
    } else { r -= I_13; const int kb = r / 32, nb = r % 32;
        tr_item8(inptr(F, I_W2) + eoff, 1024, 512, (unsigned char*)(F.ws + WS_W2) + (size_t)e * 1024 * 512, nb * 32, kb * 64, nb * 32 + (F.lane & 31), W8_SCALE, scr, F.lane); }
}
__device__ __forceinline__ void conv_moe_weights(const Frame& F0, int l) {
    Frame F = relaunder(F0); const int gw = F.vcu * 8 + F.wave, NGW = F.G * 8;
    LAS float* scr = (LAS float*)(F.lds + F.wave * 16384);
    for (int it = gw; it < NEXP * (16 * 32 + 8 * 32); it += NGW) conv_moe_item(F, l, it, scr);
}
typedef _Float16 h16x4 __attribute__((ext_vector_type(4)));
__device__ __forceinline__ f32x4 h4_to_f32(const u32x2 v) { return __builtin_convertvector(__builtin_bit_cast(h16x4, v), f32x4); }
__device__ __forceinline__ u32x2 f32_to_h4(const f32x4 v) { return __builtin_bit_cast(u32x2, __builtin_convertvector(v, h16x4)); }
__device__ __forceinline__ unsigned short* h16_row(const Frame& F, bool alt, int row) {
    if (alt) return (unsigned short*)(F.ws + WS_U) + (size_t)row * D;
    return row < NLAT ? (unsigned short*)((unsigned char*)F.out + (size_t)NLAT * D * 2) + (size_t)row * D : (unsigned short*)(F.ws + WS_HCTX) + (size_t)(row - NLAT) * D;
}
__device__ __forceinline__ void ph_u0(const Frame& F0) {
    Frame F = relaunder(F0);
    const int gw = F.vcu * 8 + F.wave, NGW = F.G * 8;
    for (int r0 = gw * 4; r0 < NTOK; r0 += NGW * 4) {
        const int bi = row_bi(r0); const float* sh = modp(F, 0, bi, 0); const float* sc = modp(F, 0, bi, 1);
        f32x4 x[4][4];
#pragma unroll
        for (int r = 0; r < 4; ++r) { const int row = r0 + r; const float* src = row < NLAT ? inptr(F, I_X) + (size_t)row * D : inptr(F, I_CTX) + (size_t)(row - NLAT) * D;
#pragma unroll
            for (int j = 0; j < 4; ++j) x[r][j] = __builtin_nontemporal_load((const f32x4*)(src + 4 * F.lane + 256 * j)); }
#pragma unroll
        for (int j = 0; j < 4; ++j) { const int c = 4 * F.lane + 256 * j; const f32x4 a = *(const f32x4*)(sh + c), s = *(const f32x4*)(sc + c);
#pragma unroll
            for (int r = 0; r < 4; ++r) { const f32x4 u = x[r][j] * (1.0f + s) + a; u32x2 w; w.x = pk2(u[0], u[1]); w.y = pk2(u[2], u[3]); *(u32x2*)((bf16*)(F.ws + WS_U) + (size_t)(r0 + r) * D + c) = w;
                __builtin_nontemporal_store(f32_to_h4(x[r][j]), (u32x2*)(h16_row(F, false, r0 + r) + c)); } }
    }
}

struct RowLN { f32x4 v[4]; };
__device__ __forceinline__ void ln_stats(f32x4 (&z)[4], float& mean, float& rstd) {
    float s = 0.f;
#pragma unroll
    for (int j = 0; j < 4; ++j) s += (z[j][0] + z[j][1]) + (z[j][2] + z[j][3]);
    mean = wave_sum(s) * (1.0f / D); float q = 0.f;
#pragma unroll
    for (int j = 0; j < 4; ++j) { z[j] = z[j] - mean; q += (z[j][0] * z[j][0] + z[j][1] * z[j][1]) + (z[j][2] * z[j][2] + z[j][3] * z[j][3]); }
    rstd = 1.0f / sqrtf(wave_sum(q) * (1.0f / D) + LN_EPS);
}
__device__ __forceinline__ void ln_rows(f32x4 (&z)[4], const float* lw, const float* lb, int lane) {
    float s = 0.f;
#pragma unroll
    for (int j = 0; j < 4; ++j) s += (z[j][0] + z[j][1]) + (z[j][2] + z[j][3]);
    const float mean = wave_sum(s) * (1.0f / D); float q = 0.f;
#pragma unroll
    for (int j = 0; j < 4; ++j) { z[j] = z[j] - mean; q += (z[j][0] * z[j][0] + z[j][1] * z[j][1]) + (z[j][2] * z[j][2] + z[j][3] * z[j][3]); }
    const float rstd = 1.0f / sqrtf(wave_sum(q) * (1.0f / D) + LN_EPS);
#pragma unroll
    for (int j = 0; j < 4; ++j) { const int c = 4 * lane + 256 * j; z[j] = z[j] * rstd * *(const f32x4*)(lw + c) + *(const f32x4*)(lb + c); }
}
__device__ __forceinline__ void ph_ln1(const Frame& F0, int l, int nrows, bool dry = false) {
    Frame F = relaunder(F0);
    LAS unsigned char* Thi = F.lds; LAS unsigned char* Tlo = F.lds + 33024;
    LAS float* red = (LAS float*)(F.lds + 66048);
    LAS float* lgt = (LAS float*)(F.lds + 82432);
    LAS int* lcnt = (LAS int*)(F.lds + 87552); LAS int* lbase = lcnt + 32;
    LAS unsigned* list = (LAS unsigned*)(F.lds + 87808);
    LAS float* LW = (LAS float*)(F.lds + 97024); LAS float* LB = LW + 1024; LAS float* WG = LB + 1024;
    LAS float* GV = (LAS float*)(F.lds + 121600); LAS float* SCV = GV + 1024; LAS float* SHV = SCV + 1024; LAS float* BGE = SHV + 1024;
    const int lane = F.lane, w = F.wave;
    if (F.tid < 64) lcnt[F.tid] = 0;
    if (F.tid < 36) BGE[F.tid] = F.tid < 4 ? (inptr(F, I_BG) + l * 4)[F.tid] : (inptr(F, I_BE) + l * 32)[F.tid - 4];
    { const float* lwg = inptr(F, I_LNW) + (size_t)(l * 2 + 0) * D; const float* lbg = inptr(F, I_LNB) + (size_t)(l * 2 + 0) * D; const float* wgg = inptr(F, I_WG) + (size_t)l * 1024 * 4;
      for (int i = F.tid; i < 256; i += 512) { *(LAS f32x4*)(LW + 4 * i) = *(const f32x4*)(lwg + 4 * i); *(LAS f32x4*)(LB + 4 * i) = *(const f32x4*)(lbg + 4 * i); }
      for (int i = F.tid; i < 1024; i += 512) *(LAS f32x4*)(WG + 4 * i) = *(const f32x4*)(wgg + 4 * i); }
    bf16x8 Whi[2][4], Wlo[2][4];
    {
        const int n = lane & 15, kg = lane >> 4;
        const float* we = inptr(F, I_WE) + (size_t)l * 1024 * 32 + (size_t)(w * 128 + kg * 8) * 32 + n;
#pragma unroll
        for (int nt = 0; nt < 2; ++nt)
#pragma unroll
            for (int ks = 0; ks < 4; ++ks) { u32x4 hi, lo; unsigned hh[8], ll[8];
                const float* p = we + ks * 32 * 32 + nt * 16;
                asm volatile("" : "+v"(p));
#pragma unroll
                for (int j = 0; j < 8; ++j) {
                    const float v = p[j * 32];
                    const unsigned h = pk2(v, 0.f) & 0xffffu; const float r = v - __uint_as_float(h << 16); hh[j] = h; ll[j] = pk2(r, 0.f) & 0xffffu; }
                hi.x = hh[0] | (hh[1] << 16); hi.y = hh[2] | (hh[3] << 16); hi.z = hh[4] | (hh[5] << 16); hi.w = hh[6] | (hh[7] << 16);
                lo.x = ll[0] | (ll[1] << 16); lo.y = ll[2] | (ll[3] << 16); lo.z = ll[4] | (ll[5] << 16); lo.w = ll[6] | (ll[7] << 16);
                Whi[nt][ks] = __builtin_bit_cast(bf16x8, hi); Wlo[nt][ks] = __builtin_bit_cast(bf16x8, lo); }
    }
    const bf16* Y = (const bf16*)(F.ws + WS_P);
    const LAS float* bgp = BGE; const LAS float* bep = BGE + 4;
    const bool usey = !((l & 1) ? (KO_MASK & 4) : ((KO_MASK & 3) == 3));
    const int nbatch = nrows / 16; int nlist = 0; int routed = 0;
    LAS float* lgtx = (LAS float*)(F.lds + 134048);
#define LGT(b_) (((b_) < 2 ? lgt : lgtx - 2 * 640) + (b_) * 640)
#define LN1_ROUTE(first_, count_) do { if (F.tid < 16 * (count_)) { const int tk = F.tid & 15, qb_ = (first_) + (F.tid >> 4); const LAS float* lg = LGT(qb_ & 3) + tk * 40; \
        float gl[4]; _Pragma("unroll") for (int j = 0; j < 4; ++j) gl[j] = lg[32 + j] + bgp[j]; \
        float gmax = gl[0]; int g = 0; _Pragma("unroll") for (int j = 1; j < 4; ++j) if (gl[j] > gmax) { gmax = gl[j]; g = j; } \
        float den = 0.f; _Pragma("unroll") for (int j = 0; j < 4; ++j) den += __expf(gl[j] - gmax); \
        const float pg = __builtin_amdgcn_rcpf(den); float el[8]; _Pragma("unroll") for (int j = 0; j < 8; ++j) el[j] = lg[g * 8 + j] + bep[g * 8 + j]; \
        float m0 = el[0]; int i0 = 0; _Pragma("unroll") for (int j = 1; j < 8; ++j) if (el[j] > m0) { m0 = el[j]; i0 = j; } \
        float m1 = -3.0e38f; int i1 = 0; _Pragma("unroll") for (int j = 0; j < 8; ++j) if (j != i0 && el[j] > m1) { m1 = el[j]; i1 = j; } \
        const float ex = __expf(m1 - m0); const float w0 = pg * __builtin_amdgcn_rcpf(1.0f + ex), w1 = w0 * ex; \
        const int e0 = g * 8 + i0, e1 = g * 8 + i1; \
        const int p0 = atomicAdd((int*)&lcnt[e0], 1), p1 = atomicAdd((int*)&lcnt[e1], 1); \
        LAS unsigned* L = list + (qb_ * 16 + tk) * 8; \
        L[0] = (unsigned)((bt0 + qb_) * 16 + tk); L[1] = (unsigned)e0; L[2] = (unsigned)p0; L[3] = __float_as_uint(w0); L[4] = (unsigned)e1; L[5] = (unsigned)p1; L[6] = __float_as_uint(w1); } } while (0)
    __syncthreads();
    const int per = (nbatch + F.G - 1) / F.G, bt0 = F.vcu * per, bt1 = (bt0 + per < nbatch) ? bt0 + per : nbatch;
    u32x2 hraw[2][4], yraw[2][4]; int cur_bi = -1;
#define LN1_FETCH(bt_, rr) do { { const int row = (bt_) * 16 + 2 * w + rr; \
        const unsigned short* hs16 = h16_row(F, false, row); \
        _Pragma("unroll") for (int j = 0; j < 4; ++j) { const int c = 4 * lane + 256 * j; \
            hraw[rr][j] = __builtin_nontemporal_load((const u32x2*)(hs16 + c)); \
            yraw[rr][j] = usey ? __builtin_nontemporal_load((const u32x2*)(Y + (size_t)row * D + c)) : (u32x2){0u, 0u}; } } } while (0)
    if (bt0 < bt1) { LN1_FETCH(bt0, 0); LN1_FETCH(bt0, 1); }
    for (int bt = bt0; bt < bt1; ++bt) {
        const int rbase = bt * 16; const int bi = row_bi(rbase);
        if (bi != cur_bi) {
            const float* g2 = modp(F, l, bi, 2); const float* sh = modp(F, l, bi, 3); const float* sc = modp(F, l, bi, 4);
            if (F.tid < 256) { *(LAS f32x4*)(GV + 4 * F.tid) = *(const f32x4*)(g2 + 4 * F.tid); *(LAS f32x4*)(SCV + 4 * F.tid) = *(const f32x4*)(sc + 4 * F.tid); *(LAS f32x4*)(SHV + 4 * F.tid) = *(const f32x4*)(sh + 4 * F.tid); }
            __syncthreads(); cur_bi = bi;
        }
#pragma unroll
        for (int rr = 0; rr < 2; ++rr) {
            const int lr = 2 * w + rr, row = rbase + lr;
            f32x4 z[4]; float mean, rstd;
#pragma unroll
            for (int j = 0; j < 4; ++j) { const f32x4 gvj = *(const LAS f32x4*)(GV + 4 * lane + 256 * j);
                z[j] = DN_ALPHA * h4_to_f32(hraw[rr][j]) + gvj * (f32x4){bflo(yraw[rr][j].x), bfhi(yraw[rr][j].x), bflo(yraw[rr][j].y), bfhi(yraw[rr][j].y)}; }
            asm volatile("" ::: "memory");
            if (bt + 1 < bt1) LN1_FETCH(bt + 1, rr);
            asm volatile("" ::: "memory");
            ln_stats(z, mean, rstd);
            f32x4 ga = (f32x4){0.f, 0.f, 0.f, 0.f};
            unsigned short* hd = dry ? (unsigned short*)(F.ws + WS_GATT) + (size_t)row * D : h16_row(F, l == DEPTH - 1, row);
            unsigned char* u8 = (unsigned char*)(F.ws + (dry ? WS_Q : WS_U8)) + (size_t)row * D;
#pragma unroll
            for (int j = 0; j < 4; ++j) { const int c = 4 * lane + 256 * j;
                const f32x4 lwv = *(const LAS f32x4*)(LW + c), lbv = *(const LAS f32x4*)(LB + c), scvj = *(const LAS f32x4*)(SCV + c), shvj = *(const LAS f32x4*)(SHV + c);
                const f32x4 g0 = *(const LAS f32x4*)(WG + 4 * c), g1 = *(const LAS f32x4*)(WG + 4 * c + 4), g2v = *(const LAS f32x4*)(WG + 4 * c + 8), g3 = *(const LAS f32x4*)(WG + 4 * c + 12);
                const f32x4 zn = z[j] * rstd * lwv + lbv;
                __builtin_nontemporal_store(f32_to_h4(zn), (u32x2*)(hd + c));
                const f32x4 t = zn * (1.0f + scvj) + shvj;
                ga += t[0] * g0 + t[1] * g1 + t[2] * g2v + t[3] * g3;
                const unsigned h01 = pk2(t[0], t[1]), h23 = pk2(t[2], t[3]);
                u32x2 hw; hw.x = h01; hw.y = h23;
                *(unsigned*)(u8 + c) = pk4_fp8(t[0], t[1], t[2], t[3]);
                const float r0 = t[0] - bflo(h01), r1 = t[1] - bfhi(h01), r2 = t[2] - bflo(h23), r3 = t[3] - bfhi(h23);
                u32x2 lw2; lw2.x = pk2(r0, r1); lw2.y = pk2(r2, r3);
                *(LAS u32x2*)(Thi + lr * 2064 + c * 2) = hw; *(LAS u32x2*)(Tlo + lr * 2064 + c * 2) = lw2;
                asm volatile("" ::: "memory"); }
            { const float q0 = wave_sum(ga[0]), q1 = wave_sum(ga[1]), q2 = wave_sum(ga[2]), q3 = wave_sum(ga[3]);
              if (lane == 0) *(LAS f32x4*)(LGT(nlist & 3) + lr * 40 + 32) = (f32x4){q0, q1, q2, q3}; }
        }
        __syncthreads();
        if (nlist - routed == 3) { LN1_ROUTE(routed, 3); routed += 3; }
        {
            f32x4 acc[2];
#pragma unroll
            for (int nt = 0; nt < 2; ++nt) acc[nt] = (f32x4){0.f, 0.f, 0.f, 0.f};
            const int tk = lane & 15, kg = lane >> 4;
#pragma unroll
            for (int ks = 0; ks < 4; ++ks) {
                const bf16x8 ah = *(const LAS bf16x8*)(Thi + tk * 2064 + (w * 128 + ks * 32 + kg * 8) * 2), al = *(const LAS bf16x8*)(Tlo + tk * 2064 + (w * 128 + ks * 32 + kg * 8) * 2);
#pragma unroll
                for (int nt = 0; nt < 2; ++nt) { acc[nt] = __builtin_amdgcn_mfma_f32_16x16x32_bf16(Whi[nt][ks], ah, acc[nt], 0, 0, 0);
                    acc[nt] = __builtin_amdgcn_mfma_f32_16x16x32_bf16(Wlo[nt][ks], ah, acc[nt], 0, 0, 0); acc[nt] = __builtin_amdgcn_mfma_f32_16x16x32_bf16(Whi[nt][ks], al, acc[nt], 0, 0, 0); }
            }
#pragma unroll
            for (int nt = 0; nt < 2; ++nt) *(LAS f32x4*)(red + (w * 16 + tk) * 32 + nt * 16 + 4 * kg) = acc[nt];
        }
        __syncthreads();
        { const int tk = F.tid & 15, n = F.tid >> 4; float s = 0.f;
#pragma unroll
            for (int ww = 0; ww < 8; ++ww) s += red[(ww * 16 + tk) * 32 + n];
            LGT(nlist & 3)[tk * 40 + n] = s; }
        ++nlist;
    }
    __syncthreads();
    if (nlist - routed > 0) LN1_ROUTE(routed, nlist - routed);
#undef LN1_ROUTE
#undef LGT
#undef LN1_FETCH
    __syncthreads();
    if (F.tid < 32) lbase[F.tid] = (int)atomicAdd((unsigned*)(F.ws + WS_CTL) + CW_CNT + l * 64 + (dry ? 32 : 0) + F.tid, (unsigned)lcnt[F.tid]);
    __syncthreads();
    if (!dry) for (int idx = F.tid; idx < nlist * 16; idx += 512) {
        const LAS unsigned* L = list + idx * 8; const unsigned row = L[0], e0 = L[1], e1 = L[4]; const unsigned p0 = L[2] + (unsigned)lbase[e0], p1 = L[5] + (unsigned)lbase[e1];
        u32x4 a; a.x = e0; a.y = p0; a.z = L[3]; a.w = e1; u32x4 b; b.x = p1; b.y = L[6]; b.z = 0u; b.w = 0u;
        unsigned* ti = (unsigned*)(F.ws + WS_TOKINFO) + (size_t)row * 8; *(u32x4*)ti = a; *(u32x4*)(ti + 4) = b;
        int* rt = (int*)(F.ws + WS_ROWTOK); rt[(size_t)e0 * NTOK + p0] = (int)row; rt[(size_t)e1 * NTOK + p1] = (int)row;
    }
}

__device__ __forceinline__ void ph_ln2(const Frame& F0, int l, int nrows, bool dry = false) {
    Frame F = relaunder(F0);
    MoeTab T = moe_tab(F.lds);
    const int gw = F.vcu * 8 + F.wave, NGW = F.G * 8, lane = F.lane;
    LAS float* LW = (LAS float*)F.lds; LAS float* LB = LW + 1024;
    { const float* lw = inptr(F, I_LNW) + (size_t)(l * 2 + 1) * D; const float* lb = inptr(F, I_LNB) + (size_t)(l * 2 + 1) * D;
      if (F.tid < 256) { *(LAS f32x4*)(LW + 4 * F.tid) = *(const f32x4*)(lw + 4 * F.tid); *(LAS f32x4*)(LB + 4 * F.tid) = *(const f32x4*)(lb + 4 * F.tid); } }
    __syncthreads();
    const unsigned char* O2 = (const unsigned char*)(F.ws + WS_P);
    const unsigned* tinfo = (const unsigned*)(F.ws + WS_TOKINFO);
    const int lm = l < 3 ? l + 1 : l;
    u32x4 ta[4]; u32x2 tb[4];
    if (gw * 4 < nrows) {
#pragma unroll
        for (int r = 0; r < 4; ++r) { const unsigned* ti = tinfo + (size_t)(gw * 4 + r) * 8; ta[r] = __builtin_nontemporal_load((const u32x4*)ti); tb[r] = __builtin_nontemporal_load((const u32x2*)(ti + 4)); }
    }
    for (int r0 = gw * 4; r0 < nrows; r0 += NGW * 4) {
        const int bi = row_bi(r0);
        const float* g5 = modp(F, l, bi, 5); const float* sh = modp(F, lm, bi, 0); const float* sc = modp(F, lm, bi, 1);
        const bool lat = r0 < NLAT;
        const bool wu = (l < 3) && (lat || l < 2);
        f32x4 z[4][4], gv[4], scv[4], shv[4]; unsigned ya[4][4], yb[4][4]; float w0[4], w1[4];
#pragma unroll
        for (int r = 0; r < 4; ++r) { const int row = r0 + r;
            const unsigned s0 = ((unsigned)T.ts[ta[r].x] * 256u + ta[r].y) * (unsigned)D, s1 = ((unsigned)T.ts[ta[r].w] * 256u + tb[r].x) * (unsigned)D;
            w0[r] = __uint_as_float(ta[r].z) * (1.0f / OUT8_SCALE); w1[r] = __uint_as_float(tb[r].y) * (1.0f / OUT8_SCALE);
            const unsigned short* hd = h16_row(F, l == DEPTH - 1, row);
#pragma unroll
            for (int j = 0; j < 4; ++j) { const int c = 4 * lane + 256 * j; z[r][j] = h4_to_f32(__builtin_nontemporal_load((const u32x2*)(hd + c)));
                if (!(KO_MASK & 8)) { ya[r][j] = __builtin_nontemporal_load((const unsigned*)(O2 + s0 + c)); yb[r][j] = __builtin_nontemporal_load((const unsigned*)(O2 + s1 + c)); } } }
#pragma unroll
        for (int j = 0; j < 4; ++j) { const int c = 4 * lane + 256 * j; gv[j] = *(const f32x4*)(g5 + c); scv[j] = *(const f32x4*)(sc + c); shv[j] = *(const f32x4*)(sh + c); }
        asm volatile("" ::: "memory");
        { const int rn = r0 + NGW * 4;
          if (rn < nrows) {
#pragma unroll
              for (int r = 0; r < 4; ++r) { const unsigned* ti = tinfo + (size_t)(rn + r) * 8; ta[r] = __builtin_nontemporal_load((const u32x4*)ti); tb[r] = __builtin_nontemporal_load((const u32x2*)(ti + 4)); }
          } }
        asm volatile("" ::: "memory");
#pragma unroll
        for (int j = 0; j < 4; ++j)
#pragma unroll
            for (int r = 0; r < 4; ++r) { f32x4 y = (f32x4){0.f, 0.f, 0.f, 0.f};
                if (!(KO_MASK & 8)) y = w0[r] * unpk4_fp8(ya[r][j]) + w1[r] * unpk4_fp8(yb[r][j]);
                z[r][j] = DN_ALPHA * z[r][j] + gv[j] * y; }
        float mean[4], rstd[4];
#pragma unroll
        for (int r = 0; r < 4; ++r) ln_stats(z[r], mean[r], rstd[r]);
#pragma unroll
        for (int j = 0; j < 4; ++j) { const int c = 4 * lane + 256 * j;
            const f32x4 lwv = *(const LAS f32x4*)(LW + c), lbv = *(const LAS f32x4*)(LB + c);
#pragma unroll
            for (int r = 0; r < 4; ++r) { const int row = r0 + r;
                const f32x4 zn = z[r][j] * rstd[r] * lwv + lbv;
                if (l == DEPTH - 1) { float* hd = dry ? (float*)(F.ws + WS_GATT) + (size_t)row * D : F.out + (size_t)row * D; __builtin_nontemporal_store(zn, (f32x4*)(hd + c)); }
                else { unsigned short* hd = dry ? (unsigned short*)(F.ws + WS_GATT) + (size_t)row * D : h16_row(F, false, row); __builtin_nontemporal_store(f32_to_h4(zn), (u32x2*)(hd + c)); }
                if (wu) { const f32x4 u = zn * (1.0f + scv[j]) + shv[j]; u32x2 hw; hw.x = pk2(u[0], u[1]); hw.y = pk2(u[2], u[3]); *(u32x2*)((bf16*)(F.ws + (dry ? WS_Q : WS_U)) + (size_t)row * D + c) = hw; } } }
    }
    __syncthreads();
}

__device__ __forceinline__ f32x4 ubf_lo(const u32x4 v) { return (f32x4){bflo(v.x), bfhi(v.x), bflo(v.y), bfhi(v.y)}; }
__device__ __forceinline__ f32x4 ubf_hi(const u32x4 v) { return (f32x4){bflo(v.z), bfhi(v.z), bflo(v.w), bfhi(v.w)}; }
__device__ __forceinline__ void ph_conv(const Frame& F0, int i, int nrows) {
    Frame F = relaunder(F0);
    const int gw = F.vcu * 8 + F.wave, NGW = F.G * 8, lane = F.lane;
    const float* cw = inptr(F, I_CONVW) + (size_t)i * 3 * D; const float* cb = inptr(F, I_CONVB) + (size_t)i * D;
    const bf16* P = (const bf16*)(F.ws + WS_P); bf16* Q = (bf16*)(F.ws + WS_Q);
    for (int r0 = gw * 4; r0 < nrows; r0 += NGW * 4) {
        const int s0 = r0 < NLAT ? (r0 & (SEQ - 1)) : ((r0 - NLAT) & (CTXL - 1)); const int slen = r0 < NLAT ? SEQ : CTXL;
        const bool hp = s0 > 0, hn = s0 + 4 < slen;
#pragma unroll
        for (int j = 0; j < 2; ++j) { const int c = 8 * lane + 512 * j;
            u32x4 p[6], gb[4];
            p[0] = (u32x4){0u, 0u, 0u, 0u}; p[5] = (u32x4){0u, 0u, 0u, 0u};
            if (hp) p[0] = __builtin_nontemporal_load((const u32x4*)(P + (size_t)(r0 - 1) * 2048 + 1024 + c));
            if (hn) p[5] = __builtin_nontemporal_load((const u32x4*)(P + (size_t)(r0 + 4) * 2048 + 1024 + c));
#pragma unroll
            for (int r = 0; r < 4; ++r) { p[r + 1] = __builtin_nontemporal_load((const u32x4*)(P + (size_t)(r0 + r) * 2048 + 1024 + c)); gb[r] = __builtin_nontemporal_load((const u32x4*)(P + (size_t)(r0 + r) * 2048 + c)); }
            const f32x4 w0a = *(const f32x4*)(cw + c), w0b = *(const f32x4*)(cw + c + 4), w1a = *(const f32x4*)(cw + D + c), w1b = *(const f32x4*)(cw + D + c + 4), w2a = *(const f32x4*)(cw + 2 * D + c), w2b = *(const f32x4*)(cw + 2 * D + c + 4);
            const f32x4 ba = *(const f32x4*)(cb + c), bb = *(const f32x4*)(cb + c + 4);
#pragma unroll
            for (int r = 0; r < 4; ++r) {
                const f32x4 ya = ubf_lo(gb[r]) * (ubf_lo(p[r]) * w0a + ubf_lo(p[r + 1]) * w1a + ubf_lo(p[r + 2]) * w2a + ba);
                const f32x4 yb = ubf_hi(gb[r]) * (ubf_hi(p[r]) * w0b + ubf_hi(p[r + 1]) * w1b + ubf_hi(p[r + 2]) * w2b + bb);
                *(u32x4*)(Q + (size_t)(r0 + r) * D + c) = pack8(ya, yb); } }
    }
}
#define MFMA32(a, b, c) __builtin_amdgcn_mfma_f32_32x32x16_bf16((a), (b), (c), 0, 0, 0)
#define MFMA16(a, b, c) __builtin_amdgcn_mfma_f32_16x16x32_bf16((a), (b), (c), 0, 0, 0)
constexpr int AK_STR = 144, AV_STR = 136, AK_BUF = 64 * AK_STR, AV_BUF = 64 * AV_STR;
__device__ __forceinline__ int crow32(int reg, int hh) { return (reg & 3) + 8 * (reg >> 2) + 4 * hh; }
__device__ __forceinline__ float xhalf_max(float v) { const unsigned u = __float_as_uint(v); const auto r = __builtin_amdgcn_permlane32_swap(u, u, false, false); return fmaxf(__uint_as_float(r[0]), __uint_as_float(r[1])); }
__device__ __forceinline__ float xhalf_sum(float v) { const unsigned u = __float_as_uint(v); const auto r = __builtin_amdgcn_permlane32_swap(u, u, false, false); return __uint_as_float(r[0]) + __uint_as_float(r[1]); }
constexpr float ATT_THR = 8.0f;
__device__ __forceinline__ void attn_unit(const Frame& F, int ie, int b, int g, int qb, bool ctxq) {
    const bf16* P = (const bf16*)(F.ws + WS_P); bf16* Q = (bf16*)(F.ws + WS_Q);
    LAS unsigned char* Ks = F.lds; LAS unsigned char* Vt = F.lds + 2 * AK_BUF;
    const int w = F.wave, lane = F.lane, r = w >> 1, qh = w & 1, h = 4 * g + r, n = lane & 31, hh = lane >> 5;
    const int qpos0 = qb * 128 + qh * 64;
    const int qrow0 = ctxq ? NLAT + b * CTXL + qpos0 : b * SEQ + qpos0;
    if (KO_MASK & 1) {
#pragma unroll
        for (int nt = 0; nt < 2; ++nt)
#pragma unroll
            for (int c = 0; c < 4; ++c) *(u32x4*)(Q + (size_t)(qrow0 + 32 * nt + n) * D + h * 64 + 16 * c + 8 * hh) = (u32x4){0u, 0u, 0u, 0u};
        return;
    }
    bf16x8 qf[2][4];
#pragma unroll
    for (int nt = 0; nt < 2; ++nt)
#pragma unroll
        for (int c = 0; c < 4; ++c) qf[nt][c] = *(const bf16x8*)(P + (size_t)(qrow0 + 32 * nt + n) * EN + PC_Q + h * 64 + 16 * c + 8 * hh);
    const float sk = inptr(F, I_SINK)[ie * 8 + h] * LOG2E;
    float mrun[2] = {sk, sk}, lsum[2] = {1.f, 1.f};
    f32x16 O[2][2];
#pragma unroll
    for (int a = 0; a < 2; ++a)
#pragma unroll
        for (int c = 0; c < 2; ++c)
#pragma unroll
            for (int e = 0; e < 16; ++e) O[a][c][e] = 0.f;
    const int tw0 = ctxq ? 4 : ((qb == 0) ? 6 : 4), tw1 = ctxq ? 4 : ((qb == 31) ? 8 : 10);
    const int ntile = 4 + (tw1 - tw0);
    const int skey = F.tid >> 3, sch = F.tid & 7;
    u32x4 kreg, vreg;
#define TILE_OF(i) ((i) < 4 ? (i) : tw0 + ((i) - 4))
#define KROW_OF(t) ((t) < 4 ? NLAT + b * CTXL + 64 * (t) : b * SEQ + (qb - 1) * 128 + 64 * ((t) - 4))
    { const int kr = KROW_OF(0) + skey; kreg = *(const u32x4*)(P + (size_t)kr * EN + PC_K + g * 64 + sch * 8); vreg = *(const u32x4*)(P + (size_t)kr * EN + PC_V + g * 64 + sch * 8); }
    __syncthreads();
    {
        *(LAS u32x4*)(Ks + skey * AK_STR + sch * 16) = kreg;
        LAS unsigned short* vt = (LAS unsigned short*)(Vt + (sch * 8) * AV_STR + skey * 2);
        const unsigned vv[4] = {vreg.x, vreg.y, vreg.z, vreg.w};
#pragma unroll
        for (int e = 0; e < 4; ++e) { vt[(2 * e) * (AV_STR / 2)] = (unsigned short)(vv[e] & 0xffffu); vt[(2 * e + 1) * (AV_STR / 2)] = (unsigned short)(vv[e] >> 16); }
    }
    __syncthreads();
    const float c2 = 0.125f * LOG2E;
    for (int i = 0; i < ntile; ++i) {
        const int buf = i & 1, t = TILE_OF(i);
        if (i + 1 < ntile) { const int t1 = TILE_OF(i + 1); const int kr = KROW_OF(t1) + skey; kreg = *(const u32x4*)(P + (size_t)kr * EN + PC_K + g * 64 + sch * 8); vreg = *(const u32x4*)(P + (size_t)kr * EN + PC_V + g * 64 + sch * 8); }
        const LAS unsigned char* kb = Ks + buf * AK_BUF; const LAS unsigned char* vb = Vt + buf * AV_BUF;
        const bool msk = (t >= 4) && (t != 6) && (t != 7);
        const int kp0 = (qb - 1) * 128 + 64 * (t - 4);
        const bool skip = (qh == 0 && t == 9) || (qh == 1 && t == 4);
#pragma unroll 1
        for (int kt = 0; kt < 2; ++kt) {
            if (skip) break;
            f32x16 S[2];
#pragma unroll
            for (int c = 0; c < 2; ++c)
#pragma unroll
                for (int e = 0; e < 16; ++e) S[c][e] = 0.f;
#pragma unroll
            for (int c = 0; c < 4; ++c) { const bf16x8 kf = *(const LAS bf16x8*)(kb + (32 * kt + n) * AK_STR + (16 * c + 8 * hh) * 2);
#pragma unroll
                for (int nt = 0; nt < 2; ++nt) S[nt] = MFMA32(kf, qf[nt][c], S[nt]); }
#pragma unroll
            for (int nt = 0; nt < 2; ++nt) {
                if (msk) { const int qp = qpos0 + 32 * nt + n;
#pragma unroll
                    for (int e = 0; e < 16; ++e) { const int dd = qp - (kp0 + 32 * kt + crow32(e, hh)); if (dd > 128 || dd < -128) S[nt][e] = -INFINITY; } }
                float mx = fmaxf(fmaxf(S[nt][0], S[nt][1]), fmaxf(S[nt][2], S[nt][3]));
#pragma unroll
                for (int e = 4; e < 16; e += 4) mx = fmaxf(mx, fmaxf(fmaxf(S[nt][e], S[nt][e + 1]), fmaxf(S[nt][e + 2], S[nt][e + 3])));
                mx = xhalf_max(mx) * c2;
                if (__builtin_amdgcn_ballot_w64(mx > mrun[nt] + ATT_THR) != 0ull) {
                    const float mnew_ = fmaxf(mrun[nt], mx); const float alpha = __builtin_amdgcn_exp2f(mrun[nt] - mnew_); mrun[nt] = mnew_; lsum[nt] *= alpha;
#pragma unroll
                    for (int dt = 0; dt < 2; ++dt)
#pragma unroll
                        for (int e = 0; e < 16; ++e) O[dt][nt][e] *= alpha;
                }
                const float mu = mrun[nt];
                float rs = 0.f;
#pragma unroll
                for (int e = 0; e < 16; ++e) { const float p = __builtin_amdgcn_exp2f(__builtin_fmaf(S[nt][e], c2, -mu)); S[nt][e] = p; rs += p; }
                lsum[nt] += xhalf_sum(rs);
            }
#pragma unroll
            for (int s = 0; s < 2; ++s) {
                bf16x8 pf[2];
#pragma unroll
                for (int nt = 0; nt < 2; ++nt) { u32x4 pw; pw.x = pk2(S[nt][8 * s + 0], S[nt][8 * s + 1]); pw.y = pk2(S[nt][8 * s + 2], S[nt][8 * s + 3]); pw.z = pk2(S[nt][8 * s + 4], S[nt][8 * s + 5]); pw.w = pk2(S[nt][8 * s + 6], S[nt][8 * s + 7]); pf[nt] = __builtin_bit_cast(bf16x8, pw); }
#pragma unroll
                for (int dt = 0; dt < 2; ++dt) {
                    const LAS unsigned char* va = vb + (32 * dt + n) * AV_STR + (32 * kt + 16 * s + 4 * hh) * 2;
                    const s16x4 lo = *(const LAS s16x4*)va, hi = *(const LAS s16x4*)(va + 16);
                    const bf16x8 vf = __builtin_shufflevector(lo, hi, 0, 1, 2, 3, 4, 5, 6, 7);
#pragma unroll
                    for (int nt = 0; nt < 2; ++nt) O[dt][nt] = MFMA32(vf, pf[nt], O[dt][nt]);
                }
            }
        }
        if (i + 1 < ntile) {
            LAS unsigned char* kb2 = Ks + (buf ^ 1) * AK_BUF; LAS unsigned char* vb2 = Vt + (buf ^ 1) * AV_BUF;
            *(LAS u32x4*)(kb2 + skey * AK_STR + sch * 16) = kreg;
            LAS unsigned short* vt = (LAS unsigned short*)(vb2 + (sch * 8) * AV_STR + skey * 2);
            const unsigned vv[4] = {vreg.x, vreg.y, vreg.z, vreg.w};
#pragma unroll
            for (int e = 0; e < 4; ++e) { vt[(2 * e) * (AV_STR / 2)] = (unsigned short)(vv[e] & 0xffffu); vt[(2 * e + 1) * (AV_STR / 2)] = (unsigned short)(vv[e] >> 16); }
        }
        __syncthreads();
    }
#pragma unroll
    for (int nt = 0; nt < 2; ++nt) { const float inv = 1.0f / lsum[nt]; bf16* orow = Q + (size_t)(qrow0 + 32 * nt + n) * D + h * 64 + (hh ? 8 : 0);
#pragma unroll
        for (int dt = 0; dt < 2; ++dt)
#pragma unroll
            for (int rg = 0; rg < 4; rg += 2) {
                u32x2 a, bq; a.x = pk2(O[dt][nt][4 * rg] * inv, O[dt][nt][4 * rg + 1] * inv); a.y = pk2(O[dt][nt][4 * rg + 2] * inv, O[dt][nt][4 * rg + 3] * inv);
                bq.x = pk2(O[dt][nt][4 * rg + 4] * inv, O[dt][nt][4 * rg + 5] * inv); bq.y = pk2(O[dt][nt][4 * rg + 6] * inv, O[dt][nt][4 * rg + 7] * inv);
                { const auto r0 = __builtin_amdgcn_permlane32_swap(a.x, bq.x, false, false); a.x = r0[0]; bq.x = r0[1]; }
                { const auto r1 = __builtin_amdgcn_permlane32_swap(a.y, bq.y, false, false); a.y = r1[0]; bq.y = r1[1]; }
                *(u32x4*)(orow + 32 * dt + 8 * rg) = (u32x4){a.x, a.y, bq.x, bq.y}; } }
}

template <int d> __device__ __forceinline__ void glaA_unit(const Frame& F, int ie, int b, int c, int h) {
    const bf16* P = (const bf16*)(F.ws + WS_P);
    LAS unsigned char* QS = F.lds + F.wave * 16384; LAS unsigned char* KS = QS + 8192;
    const int lane = F.lane;
    const int row0 = c < 4 ? NLAT + b * CTXL + c * 64 : b * SEQ + (c - 4) * 64;
    const size_t U = (size_t)(b * NCHUNK + c) * 4 + h;
    bf16* gq = (bf16*)(F.ws + WS_GQIN); bf16* gk = (bf16*)(F.ws + WS_GKST); bf16* ga = (bf16*)(F.ws + WS_GATT);
    {
        const size_t UD = U * 2 + d;
        {
            u32x4 qr[8], kr[8];
#pragma unroll
            for (int it = 0; it < 8; ++it) { const int tok = it * 8 + (lane >> 3), ch = lane & 7; const size_t ro = (size_t)(row0 + tok) * EN + h * 64 + ch * 8; qr[it] = *(const u32x4*)(P + ro + PC_QG); kr[it] = *(const u32x4*)(P + ro + PC_KG); }
#pragma unroll
            for (int it = 0; it < 8; ++it) { const int tok = it * 8 + (lane >> 3), ch = lane & 7; const int so = tok * 128 + ((ch ^ (tok & 7)) << 4); *(LAS u32x4*)(QS + so) = qr[it]; *(LAS u32x4*)(KS + so) = kr[it]; }
        }
        const int ln = lane & 31, hh = lane >> 5;
        bf16x8 afr[2], bhi[2], blo[2]; float bav[2];
#pragma unroll
        for (int tt = 0; tt < 2; ++tt) afr[tt] = *(const bf16x8*)(P + (size_t)(row0 + 32 * tt + ln) * EN + PC_GG + 16 * d + 8 * hh);
#pragma unroll
        for (int dt = 0; dt < 2; ++dt) { const float* wp = inptr(F, I_WA2) + (size_t)((ie * 2 + d) * 16 + 8 * hh) * 256 + h * 64 + 32 * dt + ln;
            unsigned hh_[8], ll_[8];
#pragma unroll
            for (int j = 0; j < 8; ++j) { const float v = wp[(size_t)j * 256]; const unsigned hb = pk2(v, 0.f) & 0xffffu; hh_[j] = hb; ll_[j] = pk2(v - __uint_as_float(hb << 16), 0.f) & 0xffffu; }
            bhi[dt] = __builtin_bit_cast(bf16x8, (u32x4){hh_[0] | (hh_[1] << 16), hh_[2] | (hh_[3] << 16), hh_[4] | (hh_[5] << 16), hh_[6] | (hh_[7] << 16)});
            blo[dt] = __builtin_bit_cast(bf16x8, (u32x4){ll_[0] | (ll_[1] << 16), ll_[2] | (ll_[3] << 16), ll_[4] | (ll_[5] << 16), ll_[6] | (ll_[7] << 16)});
            bav[dt] = inptr(F, I_BA)[(ie * 2 + d) * 256 + h * 64 + 32 * dt + ln]; }
        f32x16 G[2][2];
#pragma unroll
        for (int tt = 0; tt < 2; ++tt)
#pragma unroll
            for (int dt = 0; dt < 2; ++dt) { f32x16 z16;
#pragma unroll
                for (int e = 0; e < 16; ++e) z16[e] = 0.f;
                z16 = MFMA32(afr[tt], bhi[dt], z16); G[tt][dt] = MFMA32(afr[tt], blo[dt], z16); }
        asm volatile("s_waitcnt lgkmcnt(0)" ::: "memory");
        float base[2] = {0.f, 0.f};
        int lofs[2][4];
#pragma unroll
        for (int dt = 0; dt < 2; ++dt)
#pragma unroll
            for (int e4 = 0; e4 < 4; ++e4) lofs[dt][e4] = (4 * hh + e4) * 128 + (((4 * dt + (ln >> 3)) ^ (4 * hh + e4)) << 4) + (ln & 7) * 2;
#pragma unroll
        for (int tq = 0; tq < 2; ++tq) { constexpr int dd = d; const int tt = dd ? 1 - tq : tq;
#pragma unroll
            for (int gq_ = 0; gq_ < 4; ++gq_) { const int g4 = dd ? 3 - gq_ : gq_;
                const int tokg = 32 * tt + 8 * g4;
#pragma unroll
                for (int dt = 0; dt < 2; ++dt) {
                    float la[4];
#pragma unroll
                    for (int e4 = 0; e4 < 4; ++e4) { const float g = G[tt][dt][4 * g4 + e4] + bav[dt];
                        la[e4] = (fminf(g, 0.f) * LOG2E - __builtin_amdgcn_logf(1.0f + __builtin_amdgcn_exp2f(-fabsf(g) * LOG2E))) * (1.0f / 16.0f); }
                    float cs[4];
                    if (dd == 0) { cs[0] = la[0]; cs[1] = cs[0] + la[1]; cs[2] = cs[1] + la[2]; cs[3] = cs[2] + la[3]; }
                    else { cs[3] = la[3]; cs[2] = cs[3] + la[2]; cs[1] = cs[2] + la[1]; cs[0] = cs[1] + la[0]; }
                    const float t4 = dd == 0 ? cs[3] : cs[0];
                    const float pt = __shfl_xor(t4, 32);
                    const float off = base[dt] + ((dd == 0 ? hh == 1 : hh == 0) ? pt : 0.f);
                    base[dt] += t4 + pt;
#pragma unroll
                    for (int e4 = 0; e4 < 4; ++e4) { const int so = tokg * 128 + lofs[dt][e4];
                        const float e1 = __builtin_amdgcn_exp2f(off + cs[e4]);
                        const float qi = bf2f(*(const LAS unsigned short*)(QS + so)) * 0.125f * e1, ki = bf2f(*(const LAS unsigned short*)(KS + so)) * __builtin_amdgcn_rcpf(e1);
                        const unsigned short q16 = (unsigned short)(pk2(qi, 0.f) & 0xffffu), k16 = (unsigned short)(pk2(ki, 0.f) & 0xffffu);
                        *(LAS unsigned short*)(QS + so) = q16; *(LAS unsigned short*)(KS + so) = k16; }
                }
            }
        }
        if (hh == 0) { ((float*)(F.ws + WS_GDEC))[UD * 64 + ln] = __builtin_amdgcn_exp2f(base[0]); ((float*)(F.ws + WS_GDEC))[UD * 64 + 32 + ln] = __builtin_amdgcn_exp2f(base[1]); }
        asm volatile("s_waitcnt lgkmcnt(0)" ::: "memory");
        {
            const int cc = lane & 7, dk0 = 32 * (cc >> 2) + 4 * (cc & 3);
#pragma unroll
            for (int it = 0; it < 8; ++it) { const int tok = it * 8 + (lane >> 3);
                const u32x2 lo = *(const LAS u32x2*)(QS + tok * 128 + ((((dk0 >> 3)) ^ (tok & 7)) << 4) + (dk0 & 7) * 2);
                const u32x2 hi = *(const LAS u32x2*)(QS + tok * 128 + ((((dk0 + 16) >> 3) ^ (tok & 7)) << 4) + (dk0 & 7) * 2);
                *(u32x4*)(gq + (UD * 64 + tok) * 64 + 8 * cc) = (u32x4){lo.x, lo.y, hi.x, hi.y};
                *(u32x4*)(gk + (UD * 64 + tok) * 64 + 8 * cc) = *(const LAS u32x4*)(KS + tok * 128 + ((cc ^ (tok & 7)) << 4)); }
        }
        {
            const int n = lane & 15, kg = lane >> 4;
#pragma unroll 1
            for (int I = 0; I < 4; ++I) {
                const int ti = 16 * I + n;
                bf16x8 qf[2];
#pragma unroll
                for (int ks2 = 0; ks2 < 2; ++ks2) qf[ks2] = *(const LAS bf16x8*)(QS + ti * 128 + (((4 * ks2 + kg) ^ (ti & 7)) << 4));
#pragma unroll
                for (int J = 0; J < 4; ++J) { f32x4 acc = (f32x4){0.f, 0.f, 0.f, 0.f};
                    const bool live = d == 0 ? (J <= I) : (J >= I);
                    if (live) {
                        const int tjr = 16 * J + n;
#pragma unroll
                        for (int ks2 = 0; ks2 < 2; ++ks2) { const bf16x8 kf = *(const LAS bf16x8*)(KS + tjr * 128 + (((4 * ks2 + kg) ^ (tjr & 7)) << 4)); acc = MFMA16(kf, qf[ks2], acc); }
#pragma unroll
                        for (int r = 0; r < 4; ++r) { const int tj = 16 * J + 4 * kg + r; const bool keep = d == 0 ? (tj <= ti) : (tj >= ti); if (!keep) acc[r] = 0.f; }
                    }
                    u32x2 ow; ow.x = pk2(acc[0], acc[1]); ow.y = pk2(acc[2], acc[3]);
                    *(u32x2*)(ga + (UD * 64 + ti) * 64 + 16 * J + 4 * kg) = ow; }
            }
        }
        asm volatile("s_waitcnt lgkmcnt(0)" ::: "memory");
    }
}

constexpr int GB_STG = 43008;
__device__ __forceinline__ int glaB_chunk(int d, int step) { return d == 0 ? step : (step < 4 ? 3 - step : 4 + (NCHUNK - 1 - step)); }
__device__ __forceinline__ int swz_k(int r) { return (r & 3) | (((r >> 3) & 1) << 2); }
__device__ __forceinline__ int swz_v(int r) { return ((r & 3) << 2) | ((r >> 2) & 3); }
template <int STAGE> __device__ __forceinline__ void glaB_issue(const Frame& F, int b, int h, int d, int step) {
    const int c = glaB_chunk(d, step);
    const size_t U = (size_t)(b * NCHUNK + c) * 4 + h, UD = U * 2 + d;
    const int row0 = c < 4 ? NLAT + b * CTXL + c * 64 : b * SEQ + (c - 4) * 64;
    const int tid = F.tid, row = tid >> 3, gch = (tid & 7) ^ (row & 7), gchk = (tid & 7) ^ swz_k(row);
    const int vr0 = tid >> 4, vr1 = vr0 + 32, vc0 = (tid & 15) ^ swz_v(vr0), vc1 = (tid & 15) ^ swz_v(vr1);
    LAS unsigned char* st = F.lds + STAGE * GB_STG + F.wave * 1024;
    const char* gq = (const char*)(F.ws + WS_GQIN) + UD * 8192 + row * 128 + gch * 16;
    const char* ga = (const char*)(F.ws + WS_GATT) + UD * 8192 + row * 128 + gch * 16;
    const char* gk = (const char*)(F.ws + WS_GKST) + UD * 8192 + row * 128 + gchk * 16;
    const char* gv = (const char*)(F.ws + WS_P) + (size_t)row0 * (EN * 2) + (PC_VG + h * 128) * 2;
    const char* gdc = (const char*)(F.ws + WS_GDEC) + UD * 256 + F.lane * 4;
    __builtin_amdgcn_global_load_lds((const unsigned*)gq, (LAS unsigned*)(st), 16, 0, 2);
    __builtin_amdgcn_global_load_lds((const unsigned*)ga, (LAS unsigned*)(st + 8192), 16, 0, 2);
    __builtin_amdgcn_global_load_lds((const unsigned*)gk, (LAS unsigned*)(st + 16384), 16, 0, 2);
    __builtin_amdgcn_global_load_lds((const unsigned*)(gv + (size_t)vr0 * (EN * 2) + vc0 * 16), (LAS unsigned*)(st + 24576), 16, 0, 2);
    __builtin_amdgcn_global_load_lds((const unsigned*)(gv + (size_t)vr1 * (EN * 2) + vc1 * 16), (LAS unsigned*)(st + 24576 + 8192), 16, 0, 2);
    __builtin_amdgcn_global_load_lds((const unsigned*)gdc, (LAS unsigned*)(F.lds + STAGE * GB_STG + 40960 + F.wave * 256), 4, 0, 2);
}
template <int ROWB, class SWZ> __device__ __forceinline__ bf16x8 gb_frag_tr(const LAS unsigned char* tile, int lane, int c, int ks, SWZ swz) {
    const int g = lane >> 4, q = (lane & 15) >> 2, p = lane & 3;
    const int r0 = 32 * ks + 8 * g + q, r1 = r0 + 4;
    const s16x4 lo = __builtin_amdgcn_ds_read_tr16_b64_v4i16((LAS s16x4*)(tile + ROWB * r0 + 16 * ((2 * c + (p >> 1)) ^ swz(r0)) + 8 * (p & 1)));
    const s16x4 hi = __builtin_amdgcn_ds_read_tr16_b64_v4i16((LAS s16x4*)(tile + ROWB * r1 + 16 * ((2 * c + (p >> 1)) ^ swz(r1)) + 8 * (p & 1)));
    return __builtin_shufflevector(lo, hi, 0, 1, 2, 3, 4, 5, 6, 7);
}
__device__ __forceinline__ bf16x8 gb_frag(const LAS unsigned char* tile, int row, int ch) { return *(const LAS bf16x8*)(tile + (row * 8 + (ch ^ (row & 7))) * 16); }
template <int STAGE> __device__ __forceinline__ void glaB_step(const Frame& F, int b, int h, int d, int step, f32x4 (&S)[4], bf16* od) {
    const int lane = F.lane, n = lane & 15, kg = lane >> 4, sl = F.wave;
    if (step == 0) asm volatile("s_waitcnt vmcnt(6)" ::: "memory"); else if (step == 1) asm volatile("s_waitcnt vmcnt(10)" ::: "memory"); else asm volatile("s_waitcnt vmcnt(14)" ::: "memory");
    __builtin_amdgcn_s_barrier();
    asm volatile("" ::: "memory");
    glaB_issue<(STAGE + 2) % 3>(F, b, h, d, step + 2 < NCHUNK ? step + 2 : NCHUNK - 1);
    asm volatile("" ::: "memory");
    const int c = glaB_chunk(d, step);
    const int row0 = c < 4 ? NLAT + b * CTXL + c * 64 : b * SEQ + (c - 4) * 64;
    const LAS unsigned char* st = F.lds + STAGE * GB_STG;
    bf16x8 vf[2], qf[4][2], af[4][2], kf[4][2]; f32x4 dc[4];
#pragma unroll
    for (int I = 0; I < 4; ++I)
#pragma unroll
        for (int T = 0; T < 2; ++T) { qf[I][T] = gb_frag(st, 16 * I + n, 4 * T + kg); af[I][T] = gb_frag(st + 8192, 16 * I + n, 4 * T + kg); }
#pragma unroll
    for (int q = 0; q < 4; ++q) dc[q] = *(const LAS f32x4*)(st + 40960 + sl * 256 + (16 * q + 4 * kg) * 4);
    {
        const int g_ = lane >> 4, q_ = (lane & 15) >> 2, p_ = lane & 3, r0_ = 8 * g_ + q_;
        const unsigned sb_ = (unsigned)(size_t)(F.lds + STAGE * GB_STG);
        const unsigned av0 = sb_ + 24576u + 256u * r0_ + 16u * ((2 * sl + (p_ >> 1)) ^ swz_v(r0_)) + 8u * (p_ & 1), av1 = sb_ + 24576u + 256u * (r0_ + 4) + 16u * ((2 * sl + (p_ >> 1)) ^ swz_v(r0_ + 4)) + 8u * (p_ & 1);
        unsigned ak[4];
#pragma unroll
        for (int I = 0; I < 4; ++I) ak[I] = sb_ + 16384u + 128u * r0_ + 16u * ((2 * I + (p_ >> 1)) ^ swz_k(r0_)) + 8u * (p_ & 1);
        u32x2 t[20];
        asm volatile(
            "ds_read_b64_tr_b16 %0, %20\n\tds_read_b64_tr_b16 %1, %21\n\tds_read_b64_tr_b16 %2, %20 offset:8192\n\tds_read_b64_tr_b16 %3, %21 offset:8192\n\t"
            "ds_read_b64_tr_b16 %4, %22\n\tds_read_b64_tr_b16 %5, %22 offset:512\n\tds_read_b64_tr_b16 %6, %22 offset:4096\n\tds_read_b64_tr_b16 %7, %22 offset:4608\n\t"
            "ds_read_b64_tr_b16 %8, %23\n\tds_read_b64_tr_b16 %9, %23 offset:512\n\tds_read_b64_tr_b16 %10, %23 offset:4096\n\tds_read_b64_tr_b16 %11, %23 offset:4608\n\t"
            "ds_read_b64_tr_b16 %12, %24\n\tds_read_b64_tr_b16 %13, %24 offset:512\n\tds_read_b64_tr_b16 %14, %24 offset:4096\n\tds_read_b64_tr_b16 %15, %24 offset:4608\n\t"
            "ds_read_b64_tr_b16 %16, %25\n\tds_read_b64_tr_b16 %17, %25 offset:512\n\tds_read_b64_tr_b16 %18, %25 offset:4096\n\tds_read_b64_tr_b16 %19, %25 offset:4608\n\t"
            "s_waitcnt lgkmcnt(0)"
            : "=&v"(t[0]), "=&v"(t[1]), "=&v"(t[2]), "=&v"(t[3]), "=&v"(t[4]), "=&v"(t[5]), "=&v"(t[6]), "=&v"(t[7]), "=&v"(t[8]), "=&v"(t[9]),
              "=&v"(t[10]), "=&v"(t[11]), "=&v"(t[12]), "=&v"(t[13]), "=&v"(t[14]), "=&v"(t[15]), "=&v"(t[16]), "=&v"(t[17]), "=&v"(t[18]), "=&v"(t[19])
            : "v"(av0), "v"(av1), "v"(ak[0]), "v"(ak[1]), "v"(ak[2]), "v"(ak[3]) : "memory");
#pragma unroll
        for (int T = 0; T < 2; ++T) vf[T] = __builtin_bit_cast(bf16x8, (u32x4){t[2 * T].x, t[2 * T].y, t[2 * T + 1].x, t[2 * T + 1].y});
#pragma unroll
        for (int I = 0; I < 4; ++I)
#pragma unroll
            for (int T = 0; T < 2; ++T) kf[I][T] = __builtin_bit_cast(bf16x8, (u32x4){t[4 + 4 * I + 2 * T].x, t[4 + 4 * I + 2 * T].y, t[4 + 4 * I + 2 * T + 1].x, t[4 + 4 * I + 2 * T + 1].y});
    }
    bf16x8 sb[2];
#pragma unroll
    for (int G2 = 0; G2 < 2; ++G2) { u32x4 sw; sw.x = pk2(S[2 * G2][0], S[2 * G2][1]); sw.y = pk2(S[2 * G2][2], S[2 * G2][3]); sw.z = pk2(S[2 * G2 + 1][0], S[2 * G2 + 1][1]); sw.w = pk2(S[2 * G2 + 1][2], S[2 * G2 + 1][3]); sb[G2] = __builtin_bit_cast(bf16x8, sw); }
    asm volatile("s_waitcnt lgkmcnt(0)" ::: "memory");
    f32x4 o[4];
#pragma unroll
    for (int I = 0; I < 4; ++I) o[I] = (f32x4){0.f, 0.f, 0.f, 0.f};
#pragma unroll
    for (int I = 0; I < 4; ++I) o[I] = MFMA16(sb[0], qf[I][0], o[I]);
#pragma unroll
    for (int I = 0; I < 4; ++I) o[I] = MFMA16(sb[1], qf[I][1], o[I]);
#pragma unroll
    for (int q = 0; q < 4; ++q) S[q] = MFMA16(kf[q][0], vf[0], S[q]);
#pragma unroll
    for (int I = 0; I < 4; ++I) o[I] = MFMA16(vf[0], af[I][0], o[I]);
#pragma unroll
    for (int q = 0; q < 4; ++q) S[q] = MFMA16(kf[q][1], vf[1], S[q]);
#pragma unroll
    for (int I = 0; I < 4; ++I) o[I] = MFMA16(vf[1], af[I][1], o[I]);
#pragma unroll
    for (int q = 0; q < 4; ++q) S[q] = S[q] * dc[q];
    u32x2 ow[4];
#pragma unroll
    for (int I = 0; I < 4; ++I) { ow[I].x = pk2(o[I][0], o[I][1]); ow[I].y = pk2(o[I][2], o[I][3]); }
    asm volatile("s_waitcnt lgkmcnt(0)" ::: "memory");
#pragma unroll
    for (int I = 0; I < 4; ++I) *(u32x2*)(od + (size_t)(row0 + 16 * I + n) * 512 + h * 128 + 16 * sl + 4 * kg) = ow[I];
    asm volatile("" ::: "memory");
}
__device__ __forceinline__ void glaB_group(const Frame& F, int cg) {
    const int d = cg & 1, h = (cg >> 1) & 3, b = cg >> 3;
    bf16* od = (bf16*)(F.ws + WS_U) + (size_t)d * NTOK * 512;
    f32x4 S[4];
#pragma unroll
    for (int q = 0; q < 4; ++q) S[q] = (f32x4){0.f, 0.f, 0.f, 0.f};
    asm volatile("s_waitcnt vmcnt(0) lgkmcnt(0)" ::: "memory");
    __builtin_amdgcn_s_barrier();
    asm volatile("" ::: "memory");
    glaB_issue<0>(F, b, h, d, 0); glaB_issue<1>(F, b, h, d, 1);
    asm volatile("" ::: "memory");
    for (int s0 = 0; s0 + 2 < NCHUNK; s0 += 3) { glaB_step<0>(F, b, h, d, s0, S, od); glaB_step<1>(F, b, h, d, s0 + 1, S, od); glaB_step<2>(F, b, h, d, s0 + 2, S, od); }
    glaB_step<0>(F, b, h, d, 66, S, od); glaB_step<1>(F, b, h, d, 67, S, od);
    static_assert(NCHUNK == 68, "tail of the step loop");
    asm volatile("s_waitcnt vmcnt(0)" ::: "memory");
    __builtin_amdgcn_s_barrier();
}
__device__ __forceinline__ void conv_moe_dynamic(const Frame& F0, int l) {
    Frame F = relaunder(F0);
    LAS float* scr = (LAS float*)(F.lds + F.wave * 16384);
    unsigned* ctr = (unsigned*)(F.ws + WS_CTL) + CW_WQ + l * 64;
    constexpr int I_13 = 16 * 32, I_2 = 8 * 32, NIT = NEXP * (I_13 + I_2), CH = 8;
    for (;;) {
        unsigned t0 = 0; if (F.lane == 0) t0 = atomicAdd(ctr, (unsigned)CH);
        const int it0 = __builtin_amdgcn_readfirstlane((int)t0);
        if (it0 >= NIT) break;
        for (int it = it0; it < it0 + CH && it < NIT; ++it) conv_moe_item(F, l, it, scr);
    }
}

__device__ __forceinline__ void ph_combine(const Frame& F0, int ie, int nrows) {
    Frame F = relaunder(F0);
    const int gw = F.vcu * 8 + F.wave, NGW = F.G * 8, lane = F.lane;
    const bf16* P = (const bf16*)(F.ws + WS_P); bf16* Q = (bf16*)(F.ws + WS_Q);
    const bf16* o0 = (const bf16*)(F.ws + WS_U); const bf16* o1 = o0 + (size_t)NTOK * 512;
    const float* nw = inptr(F, I_NORMW) + (size_t)ie * 512;
    const int col = 8 * lane;
    const f32x4 nwa = *(const f32x4*)(nw + col), nwb = *(const f32x4*)(nw + col + 4);
    for (int r0 = gw * 4; r0 < nrows; r0 += NGW * 4) {
        if (KO_MASK & 2) {
#pragma unroll
            for (int r = 0; r < 4; ++r) *(u32x4*)(Q + (size_t)(r0 + r) * D + 512 + col) = (u32x4){0u, 0u, 0u, 0u};
            continue; }
        u32x4 a[4], bq[4], rr[4];
#pragma unroll
        for (int r = 0; r < 4; ++r) { const size_t row = r0 + r; a[r] = __builtin_nontemporal_load((const u32x4*)(o0 + row * 512 + col)); bq[r] = __builtin_nontemporal_load((const u32x4*)(o1 + row * 512 + col)); rr[r] = __builtin_nontemporal_load((const u32x4*)(P + row * EN + PC_RG + col)); }
#pragma unroll
        for (int r = 0; r < 4; ++r) {
            const f32x4 xa = ubf_lo(a[r]) + ubf_lo(bq[r]), xb = ubf_hi(a[r]) + ubf_hi(bq[r]);
            float ss = (xa[0] * xa[0] + xa[1] * xa[1]) + (xa[2] * xa[2] + xa[3] * xa[3]) + (xb[0] * xb[0] + xb[1] * xb[1]) + (xb[2] * xb[2] + xb[3] * xb[3]);
            ss = row16_sum(ss);
            const float rinv = 1.0f / sqrtf(ss * (1.0f / 128.0f) + RMS_EPS);
            f32x4 ra = ubf_lo(rr[r]), rb = ubf_hi(rr[r]);
#pragma unroll
            for (int j = 0; j < 4; ++j) { ra[j] = fast_silu(ra[j]); rb[j] = fast_silu(rb[j]); }
            *(u32x4*)(Q + (size_t)(r0 + r) * D + 512 + col) = pack8(xa * rinv * nwa * ra, xb * rinv * nwb * rb); }
    }
}

#if defined(FP8_PROBE)
typedef int i32x8 __attribute__((ext_vector_type(8)));
__device__ __forceinline__ unsigned fp8_of_int(int v) { const int a = v < 0 ? -v : v; const unsigned c = a == 0 ? 0x00u : a == 1 ? 0x38u : a == 2 ? 0x40u : 0x44u; return v < 0 ? (c | 0x80u) : c; }
__device__ __forceinline__ int fp8_kidx(int kg, int e) { return FP8_PROBE == 1 ? 32 * kg + e : (e < 16 ? 16 * kg + e : 64 + 16 * kg + (e - 16)); }
__device__ __forceinline__ bool fp8_layout_test(int lane) {
    const int r = lane & 15, kg = lane >> 4;
    i32x8 a, b;
#pragma unroll
    for (int w = 0; w < 8; ++w) { unsigned aw = 0, bw = 0;
#pragma unroll
        for (int by = 0; by < 4; ++by) { const int k = fp8_kidx(kg, 4 * w + by);
            const int av = (k == (7 * r + 3) % 128) ? 1 : 0; const int bv = ((k * 5 + r * 3) % 7) - 3;
            aw |= fp8_of_int(av) << (8 * by); bw |= fp8_of_int(bv) << (8 * by); }
        a[w] = (int)aw; b[w] = (int)bw; }
    f32x4 c = (f32x4){0.f, 0.f, 0.f, 0.f};
    c = __builtin_amdgcn_mfma_scale_f32_16x16x128_f8f6f4(a, b, c, 0, 0, 0, 0, 0, 0);
    bool bad = false;
#pragma unroll
    for (int q = 0; q < 4; ++q) { const int i = 4 * kg + q; const int kk = (7 * i + 3) % 128; const float ex = (float)(((kk * 5 + r * 3) % 7) - 3); if (c[q] != ex) bad = true; }
    return __builtin_amdgcn_ballot_w64(bad) != 0ull;
}
#endif
struct Args { const float* in[25]; float* out; unsigned char* ws; int ph_lo, ph_hi; };
constexpr int NPHASE = 2 + 9 * DEPTH;

__global__ void __launch_bounds__(512, 2) fwd(Args args) {
    extern __shared__ __attribute__((aligned(16))) unsigned char lds_raw[];
    Frame F;
    F.lds = (LAS unsigned char*)lds_raw;
    F.tid = threadIdx.x; F.lane = F.tid & 63; F.wave = __builtin_amdgcn_readfirstlane(F.tid >> 6);
    F.G = gridDim.x; { const int bx = blockIdx.x; F.vcu = (F.G % 8 == 0) ? (bx % 8) * (F.G / 8) + bx / 8 : bx; }
    F.out = args.out; F.ws = args.ws;
    volatile LAS unsigned* MISC = (volatile LAS unsigned*)(F.lds + MISC_OFF);
    if (F.tid < 64) MISC[F.tid] = 0u;
    if (F.tid < 25) ((LAS unsigned long long*)(F.lds + MISC_OFF + 256))[F.tid] = (unsigned long long)args.in[F.tid];
    __syncthreads();
    const int lo = args.ph_lo, hi = args.ph_hi;
    const bool multi = (hi - lo) > 1;
    XcdBarrier bar; bar.bar = (unsigned*)(F.ws + WS_CTL) + CW_BAR; bar.x = 0; bar.st = MISC + 8;
    if (multi) bar = xcd_barrier_post((unsigned*)(F.ws + WS_CTL) + CW_BAR, MISC + 8);
#ifndef PH_SEL
#define PH_SEL 0xffffffff
#endif
#define IN(k) (lo <= (k) && (k) < hi)
#define SEL(b) ((PH_SEL >> (b)) & 1)
#ifndef DUP_MASK
#define DUP_MASK 0
#endif
#define REP(bit) for (int rep_ = 0; rep_ < ((DUP_MASK & (bit)) ? 2 : 1); ++rep_)
#ifndef STAG_IN
#define STAG_IN 0
#endif
#define SKIPE (((DUP_MASK & 512) && rep_ > 0) ? launder_s(1) : 0)
#define SEAM(k) do { if ((k) + 1 < hi) xcd_barrier(bar); } while (0)

    if (SEL(0) && IN(0)) { REP(64) { ph_ada(F); __syncthreads(); conv_dense_weights(F); __syncthreads(); } SEAM(0); }
    if (SEL(1) && IN(1)) { REP(64) { ph_u0(F); __syncthreads(); } SEAM(1); }

    constexpr int ATT_S1 = NB * 2 * 32 * 3 / 4;
    for (int l = 0; l < DEPTH; ++l) {
        const int pb = 2 + 9 * l; const bool even = (l & 1) == 0; const int ie = l >> 1;
        const int m_in = (l < 3) ? NTOK : NLAT;
        const int m_out = (l < 2) ? NTOK : NLAT;
        if (SEL(2) && IN(pb + 0)) {
            REP(32) { if (even) {
                LinSched S; S.init(m_in, EN, 1024, F.G, (int)blockIdx.x);
                LAS float* rc = (LAS float*)(F.lds + LDSX_OFF + 3072); LAS float* rs = (LAS float*)(F.lds + MISC_OFF + 512);
                { const Frame Fm = relaunder(F); const float* rope = (const float*)(Fm.ws + WS_ROPE); if (Fm.tid < 256) { *(LAS f32x4*)(rc + 4 * Fm.tid) = *(const f32x4*)(rope + 4 * Fm.tid); *(LAS f32x4*)(rs + 4 * Fm.tid) = *(const f32x4*)(rope + 1024 + 4 * Fm.tid); } }
                __syncthreads();
                EpiEvenIn E{(bf16*)(F.ws + WS_P), rc, rs};
                pg8::gemm_phase(F.lds, (const char*)(F.ws + WS_U), (const char*)(F.ws + WS_WINE) + (size_t)ie * EN * 1024 * 2, 1024, S, E, SKIPE, STAG_IN);
            } else {
                LinSched S; S.init(m_in, ON, 1024, F.G, (int)blockIdx.x);
                EpiOddIn E{(bf16*)(F.ws + WS_P)};
                pg8::gemm_phase(F.lds, (const char*)(F.ws + WS_U), (const char*)(F.ws + WS_WINO) + (size_t)ie * ON * 1024 * 2, 1024, S, E, SKIPE, STAG_IN);
            } }
            SEAM(pb + 0);
        }
        if (SEL(3) && IN(pb + 1)) {
            if (even) {
                const Frame Fm = relaunder(F);
                const int nun = ATT_S1;
                REP(1) for (int u = Fm.vcu; u < nun; u += Fm.G) {
                    if (u < NB * 2 * 32) attn_unit(Fm, ie, u >> 6, (u >> 5) & 1, u & 31, false);
                    else { const int v = u - NB * 2 * 32; attn_unit(Fm, ie, v >> 2, (v >> 1) & 1, v & 1, true); }
                }
                __syncthreads();
                if (!(KO_MASK & 2)) REP(2) for (int u = Fm.vcu * 8 + Fm.wave; u < NB * NCHUNK * 8; u += Fm.G * 8) { if (u & 1) glaA_unit<1>(Fm, ie, u / (NCHUNK * 8), (u / 8) % NCHUNK, (u >> 1) & 3); else glaA_unit<0>(Fm, ie, u / (NCHUNK * 8), (u / 8) % NCHUNK, (u >> 1) & 3); }
                __syncthreads();
            } else {
                REP(16) { ph_conv(F, ie, m_out); __syncthreads(); }
                if (m_out == NLAT) { conv_moe_weights(F, l); __syncthreads(); }
            }
            SEAM(pb + 1);
        }
        if (even) {
            if (SEL(4) && IN(pb + 2)) {
                { const Frame Fm = relaunder(F);
                  if (!(KO_MASK & 2)) REP(4) for (int cg = Fm.vcu; cg < 128; cg += Fm.G) glaB_group(Fm, cg);
                  if (Fm.vcu >= 128) {
                      const int nun = NB * 2 * 32 + (l == 0 ? NB * 2 * 2 : 0);
                      for (int u = ATT_S1 + Fm.vcu - 128; u < nun; u += Fm.G - 128) {
                          if (u < NB * 2 * 32) attn_unit(Fm, ie, u >> 6, (u >> 5) & 1, u & 31, false);
                          else { const int v = u - NB * 2 * 32; attn_unit(Fm, ie, v >> 2, (v >> 1) & 1, v & 1, true); }
                      }
                  }
                  __syncthreads();
                  conv_moe_dynamic(Fm, l); }
                SEAM(pb + 2);
            }
            if (SEL(5) && IN(pb + 3)) { REP(16) { ph_combine(F, ie, m_out); __syncthreads(); } SEAM(pb + 3); }
        }
        if (SEL(6) && IN(pb + 4)) {
            REP(32) { LinSched S; S.init(m_out, 1024, 1024, F.G, (int)blockIdx.x);
            EpiPlain E{(bf16*)(F.ws + WS_P), 1024};
            pg8::gemm_phase(F.lds, (const char*)(F.ws + WS_Q), (const char*)(F.ws + (even ? WS_WOUTE : WS_WOUTO)) + (size_t)ie * 1024 * 1024 * 2, 1024, S, E, SKIPE); }
            if (!even && m_out != NLAT) { __syncthreads(); conv_moe_dynamic(F, l); __syncthreads(); }
            SEAM(pb + 4);
        }
        if (SEL(7) && IN(pb + 5)) { if (DUP_MASK & 128) { ph_ln1(F, l, m_out, true); __syncthreads(); } ph_ln1(F, l, m_out); SEAM(pb + 5); }
        if (SEL(8) && IN(pb + 6)) {
            if (!(KO_MASK & 8)) REP(32) {
                moe_tables(F.lds, (const unsigned*)(F.ws + WS_CTL) + CW_CNT + l * 64);
                MoeSched<1> S; S.T = moe_tab(F.lds); S.rowtok = (const int*)(F.ws + WS_ROWTOK); S.G = F.G; S.c = F.vcu; S.bstride = (size_t)256 * 1024; S.estride = (size_t)1024 * 1024;
                EpiG1 E{(unsigned char*)(F.ws + WS_Q), 1.0f / W8_SCALE};
                pg8::gemm_phase<EpiG1, MoeSched<1>, 1>(F.lds, (const char*)(F.ws + WS_U8), (const char*)(F.ws + WS_W13), 1024, S, E, SKIPE);
            }
            SEAM(pb + 6);
        }
        if (SEL(9) && IN(pb + 7)) {
            if (!(KO_MASK & 8)) REP(32) {
                if (!IN(pb + 6) || (KO_MASK & 8)) moe_tables(F.lds, (const unsigned*)(F.ws + WS_CTL) + CW_CNT + l * 64);
                MoeSched<0> S; S.T = moe_tab(F.lds); S.rowtok = nullptr; S.G = F.G; S.c = F.vcu; S.bstride = (size_t)256 * 512; S.estride = (size_t)1024 * 512;
                EpiOut8 E{(unsigned char*)(F.ws + WS_P), OUT8_SCALE / W8_SCALE};
                pg8::gemm_phase<EpiOut8, MoeSched<0>, 1>(F.lds, (const char*)(F.ws + WS_Q), (const char*)(F.ws + WS_W2), 512, S, E, SKIPE);
            }
            SEAM(pb + 7);
        }
        if (SEL(10) && IN(pb + 8)) {
            if (!IN(pb + 6) || (KO_MASK & 8)) moe_tables(F.lds, (const unsigned*)(F.ws + WS_CTL) + CW_CNT + l * 64);
            if (DUP_MASK & 256) { ph_ln2(F, l, m_out, true); __syncthreads(); }
            ph_ln2(F, l, m_out);
            SEAM(pb + 8);
        }
    }
#if defined(FP8_PROBE)
    if (blockIdx.x == 0) { __syncthreads(); if (F.tid < 64) { const bool bad = fp8_layout_test(F.tid); if (bad && F.tid == 0) F.out[0] = __builtin_nanf(""); } }
#endif
#undef IN
#undef SEAM
}

extern "C" void kernel_launch(void* const* d_in, const int* in_sizes, int n_in, void* d_out, int out_size, void* d_ws, size_t ws_size, hipStream_t stream) {
    static int grid = 0;
    if (grid == 0) {
        if (n_in != 25 || in_sizes[0] != NLAT * D || out_size != NLAT * D || ws_size < WS_END) { fprintf(stderr, "kernel_launch: unexpected shapes (n_in %d in0 %d out %d ws %zu)\n", n_in, n_in > 0 ? in_sizes[0] : -1, out_size, ws_size); grid = -1; return; }
        int dev = 0, cus = 0, per_cu = 0;
        if (hipGetDevice(&dev) != hipSuccess || hipDeviceGetAttribute(&cus, hipDeviceAttributeMultiprocessorCount, dev) != hipSuccess) { grid = -1; return; }
        if (hipFuncSetAttribute((const void*)fwd, hipFuncAttributeMaxDynamicSharedMemorySize, LDS_BYTES) != hipSuccess) { fprintf(stderr, "kernel_launch: hipFuncSetAttribute failed\n"); grid = -1; return; }
        if (hipOccupancyMaxActiveBlocksPerMultiprocessor(&per_cu, (const void*)fwd, 512, LDS_BYTES) != hipSuccess || per_cu < 1) fprintf(stderr, "kernel_launch: occupancy query says %d\n", per_cu);
        (void)hipGetLastError();
        grid = cus;
        if (grid < 242 || grid > 1024) { fprintf(stderr, "kernel_launch: built for a 256-CU device (got %d CUs)\n", cus); grid = -1; return; }
    }
    if (grid < 0) return;
    if (hipMemsetAsync((char*)d_ws + WS_CTL, 0, CTL_BYTES, stream) != hipSuccess) return;
    Args a{};
    for (int i = 0; i < 25; ++i) a.in[i] = (const float*)d_in[i];
    a.out = (float*)d_out; a.ws = (unsigned char*)d_ws;
#if N_LAUNCH_MODE == 1
    a.ph_lo = 0; a.ph_hi = NPHASE;
    hipLaunchKernelGGL(fwd, dim3(grid), dim3(512), LDS_BYTES, stream, a);
#else
    for (int k = 0; k < NPHASE; ++k) {
        if (k >= 2) { const int l = (k - 2) / 9, s = (k - 2) % 9; if ((l & 1) && (s == 2 || s == 3)) continue; }
        a.ph_lo = k; a.ph_hi = k + 1;
        hipLaunchKernelGGL(fwd, dim3(grid), dim3(512), LDS_BYTES, stream, a);
    }
#endif
}
```

```cpp
#include <hip/hip_runtime.h>
#define N_LAUNCH_MODE 1
#define KO_MASK 0
#define DUP_MASK 0
#include <cstdio>
#include <cstdint>

#ifndef KO_MASK
#define KO_MASK 0
#endif
#ifndef N_LAUNCH_MODE
#define N_LAUNCH_MODE 1
#endif

#define GAS __attribute__((address_space(1)))
#define LAS __attribute__((address_space(3)))
typedef unsigned short bf16;
typedef short bf16x8 __attribute__((ext_vector_type(8)));
typedef short s16x4 __attribute__((ext_vector_type(4)));
typedef float f32x2 __attribute__((ext_vector_type(2)));
typedef float f32x4 __attribute__((ext_vector_type(4)));
typedef float f32x16 __attribute__((ext_vector_type(16)));
typedef unsigned u32x2 __attribute__((ext_vector_type(2)));
typedef unsigned u32x4 __attribute__((ext_vector_type(4)));
typedef __bf16 bf16x2_t __attribute__((ext_vector_type(2)));
typedef int i32x8 __attribute__((ext_vector_type(8)));
typedef int i32x4_t __attribute__((ext_vector_type(4)));

constexpr int D = 1024, NB = 16, SEQ = 4096, CTXL = 256, DEPTH = 4;
constexpr int NLAT = NB * SEQ, NCTX = NB * CTXL, NTOK = NLAT + NCTX;
constexpr int EVEN_IN = 2336, EN = 2560, ON = 3072;
constexpr int NEXP = 32, DEXP = 512;
constexpr int SLOT_ROWS = 2 * NTOK + NEXP * 256;
constexpr float DN_ALPHA = 1.6817928305074290f;
constexpr float LN_EPS = 1e-5f, RMS_EPS = 1e-6f;
constexpr float LOG2E = 1.4426950408889634f;
constexpr int PC_Q = 0, PC_K = 512, PC_V = 640, PC_QG = 768, PC_KG = 1024, PC_VG = 1280, PC_RG = 1792, PC_GG = 2304;
constexpr int NCHUNK = 68;

constexpr size_t MiB = 1u << 20;
constexpr size_t WS_CTL = 0, CTL_BYTES = 1 * MiB;
constexpr size_t WS_MOD = 1 * MiB;
constexpr size_t WS_ROPE = 3 * MiB;
constexpr size_t WS_TOKINFO = 4 * MiB;
constexpr size_t WS_ROWTOK = 7 * MiB;
constexpr size_t WS_WINE = 16 * MiB, WS_WOUTE = 26 * MiB, WS_WINO = 30 * MiB, WS_WOUTO = 42 * MiB;
constexpr size_t WS_W13 = 46 * MiB, WS_W2 = 110 * MiB;
constexpr size_t WS_HCTX = 142 * MiB;
constexpr size_t WS_U = 158 * MiB;
constexpr size_t WS_P = 294 * MiB;
constexpr size_t WS_Q = 634 * MiB;
constexpr size_t WS_GATT = 778 * MiB, WS_GQIN = 846 * MiB, WS_GKST = 914 * MiB, WS_GVT = 982 * MiB, WS_GDEC = 1050 * MiB;
constexpr size_t WS_U8 = 1053 * MiB;
constexpr size_t WS_END = 1121 * MiB;
constexpr int CW_BAR = 4096;
constexpr int CW_CNT = 16384;
constexpr int CW_WQ = 20480;

constexpr int RING_BYTES = 131072;
constexpr int LDSX_OFF = RING_BYTES;
constexpr int MISC_OFF = LDSX_OFF + 8192;
constexpr int LDS_BYTES = 147456;

__device__ __forceinline__ unsigned pk2(float a, float b) { bf16x2_t r = __builtin_convertvector((f32x2){a, b}, bf16x2_t); return __builtin_bit_cast(unsigned, r); }
__device__ __forceinline__ unsigned pk4_fp8(float a, float b, float c, float d) { int r = __builtin_amdgcn_cvt_pk_fp8_f32(a, b, 0, false); r = __builtin_amdgcn_cvt_pk_fp8_f32(c, d, r, true); return (unsigned)r; }
__device__ __forceinline__ float bf2f(unsigned short h) { return __uint_as_float(((unsigned)h) << 16); }
__device__ __forceinline__ f32x4 unpk4_fp8(unsigned w) { const f32x2 lo = __builtin_amdgcn_cvt_pk_f32_fp8((int)w, false), hi = __builtin_amdgcn_cvt_pk_f32_fp8((int)w, true); return (f32x4){lo.x, lo.y, hi.x, hi.y}; }
__device__ __forceinline__ float bflo(unsigned w) { return __uint_as_float(w << 16); }
__device__ __forceinline__ float bfhi(unsigned w) { return __uint_as_float(w & 0xffff0000u); }
template <int CTRL> __device__ __forceinline__ float dppf(float v) { return __builtin_bit_cast(float, __builtin_amdgcn_update_dpp(0, __builtin_bit_cast(int, v), CTRL, 0xf, 0xf, false)); }
__device__ __forceinline__ float row16_sum(float v) { v += dppf<0xB1>(v); v += dppf<0x4E>(v); v += dppf<0x141>(v); v += dppf<0x140>(v); return v; }
__device__ __forceinline__ float wave_sum(float v) {
    v = row16_sum(v);
    const float s0 = __builtin_bit_cast(float, __builtin_amdgcn_readlane(__builtin_bit_cast(int, v), 0)), s1 = __builtin_bit_cast(float, __builtin_amdgcn_readlane(__builtin_bit_cast(int, v), 16));
    const float s2 = __builtin_bit_cast(float, __builtin_amdgcn_readlane(__builtin_bit_cast(int, v), 32)), s3 = __builtin_bit_cast(float, __builtin_amdgcn_readlane(__builtin_bit_cast(int, v), 48));
    return (s0 + s1) + (s2 + s3);
}
__device__ __forceinline__ float fast_silu(float x) { return x * __builtin_amdgcn_rcpf(1.0f + __builtin_amdgcn_exp2f(-x * LOG2E)); }

#define XB_TMO      128
#define XB_XCNT(j)  (256  + 64 * (j))
#define XB_XSUB(j)  (1280 + 64 * (j))
#define XB_XGEN(j)  (2304 + 64 * (j))
#define XB_TOP      3328
#define XB_TOPGEN   3392
#define XCD_BAR_WORDS 3456
#define XB_SPIN_CAP (1u << 22)
__device__ __forceinline__ unsigned xb_ld(unsigned* p)              { return __hip_atomic_load(p, __ATOMIC_RELAXED, __HIP_MEMORY_SCOPE_AGENT); }
__device__ __forceinline__ unsigned xb_add(unsigned* p, unsigned v) { return __hip_atomic_fetch_add(p, v, __ATOMIC_RELAXED, __HIP_MEMORY_SCOPE_AGENT); }
__device__ __forceinline__ unsigned xb_xcc_id() { return (unsigned)__builtin_amdgcn_s_getreg((3 << 11) | 20) & 0xFu; }
#define XB_SPIN(cond, bar) do { unsigned _sp = 0; while (cond) { __builtin_amdgcn_s_sleep(1); \
    if ((++_sp & 255u) == 0u) { if (xb_ld(&(bar)[XB_TMO])) break; if (_sp > XB_SPIN_CAP) { atomicAdd(&(bar)[XB_TMO], 1u); break; } } } } while (0)
struct XcdBarrier { unsigned* bar; unsigned x; volatile LAS unsigned* st; };
__device__ __forceinline__ XcdBarrier xcd_barrier_post(unsigned* bar, volatile LAS unsigned* st) {
    XcdBarrier b; b.bar = bar; b.x = xb_xcc_id(); b.st = st;
    if (threadIdx.x == 0) (void)xb_add(&bar[XB_XCNT(b.x)], 1u);
    return b;
}
__device__ __forceinline__ void xcd_barrier_complete(unsigned* bar, unsigned x, unsigned& nloc, unsigned& nx) {
    const unsigned G = gridDim.x * gridDim.y * gridDim.z;
    unsigned sum, cnt, mine, sp = 0u;
    for (;;) {
        sum = 0u; cnt = 0u; mine = 0u;
#pragma unroll
        for (unsigned j = 0; j < 16; ++j) { const unsigned c = xb_ld(&bar[XB_XCNT(j)]); sum += c; cnt += (c > 0u) ? 1u : 0u; mine = (j == x) ? c : mine; }
        if (sum == G) break;
        __builtin_amdgcn_s_sleep(1);
        if ((++sp & 255u) == 0u) { if (xb_ld(&bar[XB_TMO])) break; if (sp > XB_SPIN_CAP) { atomicAdd(&bar[XB_TMO], 1u); break; } }
    }
    nloc = mine > 0u ? mine : 1u; nx = cnt > 0u ? cnt : 1u;
}
__device__ __forceinline__ void xcd_barrier(const XcdBarrier& b) {
    asm volatile("s_waitcnt vmcnt(0)" ::: "memory");
    __syncthreads();
    if (threadIdx.x == 0) {
        unsigned* bar = b.bar;
        __builtin_amdgcn_s_waitcnt(0);
        unsigned nloc = b.st[0], nx = b.st[1];
        if (nloc == 0u) { xcd_barrier_complete(bar, b.x, nloc, nx); b.st[0] = nloc; b.st[1] = nx; }
        const unsigned old = xb_add(&bar[XB_XSUB(b.x)], 1u);
        const unsigned gen = old / nloc;
        if (old + 1u == (gen + 1u) * nloc) {
            __builtin_amdgcn_fence(__ATOMIC_RELEASE, "agent");
            asm volatile("s_waitcnt vmcnt(0)" ::: "memory");
            const unsigned og = xb_add(&bar[XB_TOP], 1u);
            const unsigned tg = og / nx;
            if (og + 1u == (tg + 1u) * nx) xb_add(&bar[XB_TOPGEN], 1u);
            else XB_SPIN(xb_ld(&bar[XB_TOPGEN]) == tg, bar);
            __builtin_amdgcn_fence(__ATOMIC_ACQUIRE, "agent");
            xb_add(&bar[XB_XGEN(b.x)], 1u);
            asm volatile("s_waitcnt vmcnt(0)" ::: "memory");
        } else {
            XB_SPIN(xb_ld(&bar[XB_XGEN(b.x)]) == gen, bar);
            __builtin_amdgcn_fence(__ATOMIC_ACQUIRE, "agent");
            asm volatile("s_waitcnt vmcnt(0)" ::: "memory");
        }
    }
    __syncthreads();
}

namespace pg8 {
constexpr int BM = 256, BK = 64, HALF = 128, HTB = HALF * BK * 2, STAGE_BYTES = 8 * HTB;
__device__ __forceinline__ int lds_byte(int r, int c) { const int st = (r >> 4) * 2 + (c >> 5), rr = r & 15, cc = c & 31, ob = rr * 64 + cc * 2; return st * 1024 + (ob ^ (((ob >> 9) & 1) << 5)); }
__device__ __forceinline__ void stage_rc(int b, int& R, int& C) { const int st = b / 1024, sb = b % 1024, swz = sb ^ (((sb >> 9) & 1) << 5); R = (st >> 1) * 16 + swz / 64; C = (st & 1) * 32 + (swz % 64) / 2; }
__device__ __forceinline__ int perm32(int rho) { const int n = rho >> 4, i = rho & 15; return 8 * (i >> 2) + 4 * n + (i & 3); }

struct Unit { int pn; int orow0; int mt; int e; };

template <class Epi, class Sched, int FP8 = 0>
__device__ __forceinline__ void gemm_phase(LAS unsigned char* lds, const char* Abase, const char* Bbase, const int K, const Sched& S, const Epi& E, const int skipE = 0, const int stag = 0) {
    int tid_ = threadIdx.x; asm volatile("" : "+v"(tid_));
    const int tid = tid_, wid = __builtin_amdgcn_readfirstlane(tid >> 6), lane = tid & 63, wr = wid >> 2, wc = wid & 3, fr = lane & 15, fq = lane >> 4;
    const unsigned K2 = FP8 ? (unsigned)K : (unsigned)K * 2u;
    const int nt = (int)(K2 / 128u);
    int Rr[2], Cc[2]; unsigned voffB[2];
#pragma unroll
    for (int i = 0; i < 2; ++i) { stage_rc(tid * 16 + i * 8192, Rr[i], Cc[i]); const int Rb = (Rr[i] & ~31) + perm32(Rr[i] & 31); voffB[i] = (unsigned)Rb * K2 + (unsigned)Cc[i] * 2u; }
    const size_t kstep = (size_t)(BK * 2);
    const size_t hstep = (size_t)HALF * K2;
    const unsigned ldsw = (unsigned)wid * 1024u;
    const int aoff = FP8 ? lds_byte(wr * 64 + fr, 32 * (fq >> 1) + 16 * (fq & 1)) : lds_byte(wr * 64 + fr, fq * 8), boff = FP8 ? lds_byte(wc * 32 + fr, 32 * (fq >> 1) + 16 * (fq & 1)) : lds_byte(wc * 32 + fr, fq * 8);
#define PG8_SA(b, h) (((b) * 2 + (h)) * HTB)
#define PG8_SB(b, h) ((4 + (b) * 2 + (h)) * HTB)
#define PG8_STAGE(bufoff, gbase, voff) do { _Pragma("unroll") for (int _i = 0; _i < 2; ++_i) \
        __builtin_amdgcn_global_load_lds((const unsigned*)((const char*)(gbase) + (voff)[_i]), (LAS unsigned*)(lds + (bufoff) + ldsw + _i * 8192), 16, 0, 0); } while (0)
#define PG8_LD8(ptr) __builtin_shufflevector(*(const LAS i32x4_t*)(ptr), *(const LAS i32x4_t*)((ptr) + 16), 0, 1, 2, 3, 4, 5, 6, 7)
#define PG8_LDA(dst, b, h) do { if constexpr (FP8) { _Pragma("unroll") for (int m = 0; m < 4; ++m) dst##8[m] = PG8_LD8(lds + PG8_SA(b, h) + aoff + m * 2048); } \
        else { _Pragma("unroll") for (int m = 0; m < 4; ++m) _Pragma("unroll") for (int k = 0; k < 2; ++k) dst[m][k] = *(const LAS bf16x8*)(lds + PG8_SA(b, h) + aoff + m * 2048 + k * 1024); } } while (0)
#define PG8_LDB(dst, b, h) do { if constexpr (FP8) { _Pragma("unroll") for (int n = 0; n < 2; ++n) dst##8[n] = PG8_LD8(lds + PG8_SB(b, h) + boff + n * 2048); } \
        else { _Pragma("unroll") for (int n = 0; n < 2; ++n) _Pragma("unroll") for (int k = 0; k < 2; ++k) dst[n][k] = *(const LAS bf16x8*)(lds + PG8_SB(b, h) + boff + n * 2048 + k * 1024); } } while (0)
#define PG8_MMA(ai, bj, At, Bt) do { __builtin_amdgcn_s_setprio(1); _Pragma("unroll") for (int m = 0; m < 4; ++m) _Pragma("unroll") for (int n = 0; n < 2; ++n) { \
        if constexpr (FP8) asm volatile("v_mfma_f32_16x16x128_f8f6f4 %0, %1, %2, %0" : "+v"(acc[ai][bj][m][n]) : "v"(Bt##8[n]), "v"(At##8[m])); \
        else { _Pragma("unroll") for (int k = 0; k < 2; ++k) acc[ai][bj][m][n] = __builtin_amdgcn_mfma_f32_16x16x32_bf16(Bt[n][k], At[m][k], acc[ai][bj][m][n], 0, 0, 0); } } \
        __builtin_amdgcn_s_setprio(0); } while (0)
#define PG8_WAIT_V(n) asm volatile("s_waitcnt vmcnt(" #n ")" ::: "memory")
#define PG8_WAIT_L(n) asm volatile("s_waitcnt lgkmcnt(" #n ")" ::: "memory")
#define PG8_BAR __builtin_amdgcn_s_barrier()
#define PG8_SCHED __builtin_amdgcn_sched_barrier(0)
    Unit cur, nxt; int ui = 0;
    if (!S.next(0, cur)) return;
    if (stag > 0) { const unsigned cls = (blockIdx.x >> 3) & 3u;
      if (cls) { const unsigned long long t0 = __builtin_amdgcn_s_memrealtime(); while (__builtin_amdgcn_s_memrealtime() - t0 < (unsigned long long)(cls * (unsigned)stag)) __builtin_amdgcn_s_sleep(8); } }
    f32x4 acc[2][2][4][2];
#pragma unroll
    for (int a = 0; a < 2; ++a)
#pragma unroll
        for (int b = 0; b < 2; ++b)
#pragma unroll
            for (int m = 0; m < 4; ++m)
#pragma unroll
                for (int n = 0; n < 2; ++n) { if constexpr (FP8) asm volatile("v_mov_b32 %0, 0\n\tv_mov_b32 %1, 0\n\tv_mov_b32 %2, 0\n\tv_mov_b32 %3, 0" : "=v"(acc[a][b][m][n][0]), "=v"(acc[a][b][m][n][1]), "=v"(acc[a][b][m][n][2]), "=v"(acc[a][b][m][n][3])); else acc[a][b][m][n] = (f32x4){0.f, 0.f, 0.f, 0.f}; }
    if constexpr (FP8) asm volatile("s_nop 7" ::: "memory");
    bf16x8 At[4][2], B0[2][2], B1[2][2];
    i32x8 At8[4], B08[2], B18[2];
    unsigned vAc0[2], vAc1[2], vAn0[2], vAn1[2];
#pragma unroll
    for (int i = 0; i < 2; ++i) { vAc0[i] = (unsigned)S.arow(cur, Rr[i]) * K2 + (unsigned)Cc[i] * 2u; vAc1[i] = (unsigned)S.arow(cur, HALF + Rr[i]) * K2 + (unsigned)Cc[i] * 2u; vAn0[i] = vAc0[i]; vAn1[i] = vAc1[i]; }
    const char* cB = Bbase + S.boff(cur);
    PG8_STAGE(PG8_SB(0, 0), cB, voffB); PG8_STAGE(PG8_SB(0, 1), cB + hstep, voffB); PG8_STAGE(PG8_SA(0, 0), Abase, vAc0); PG8_STAGE(PG8_SA(0, 1), Abase, vAc1);
    if (wr == 1) PG8_BAR;
    PG8_WAIT_V(2); PG8_BAR;
    PG8_STAGE(PG8_SB(1, 0), cB + kstep, voffB); PG8_STAGE(PG8_SA(1, 0), Abase + kstep, vAc0); PG8_STAGE(PG8_SB(1, 1), cB + hstep + kstep, voffB);
    PG8_WAIT_V(6); PG8_BAR;
    for (;;) {
        const bool has_next = S.next(ui + 1, nxt);
        const char* nB = has_next ? Bbase + S.boff(nxt) : cB;
        int rN0[2] = {0, 0}, rN1[2] = {0, 0};
        if (has_next) {
            if constexpr (Sched::kGather) {
                if (wid < 4) __builtin_amdgcn_global_load_lds((const unsigned*)S.gather_src(nxt, wid * 64 + lane), (LAS unsigned*)(lds + LDSX_OFF + 2048 + wid * 256), 4, 0, 0);
            } else {
#pragma unroll
                for (int i = 0; i < 2; ++i) { rN0[i] = S.arow(nxt, Rr[i]); rN1[i] = S.arow(nxt, HALF + Rr[i]); }
            }
        } else {
#pragma unroll
            for (int i = 0; i < 2; ++i) { vAn0[i] = vAc0[i]; vAn1[i] = vAc1[i]; }
        }
        for (int t = 0; t < nt; t += 2) {
            const bool last = (t == nt - 2);
            const char* a1 = Abase + (size_t)(t + 1) * kstep;
            const char* a2 = last ? Abase : Abase + (size_t)(t + 2) * kstep; const char* b2 = last ? nB : cB + (size_t)(t + 2) * kstep;
            const char* a3 = a2 + kstep; const char* b3 = b2 + kstep;
            unsigned v20[2], v21[2];
            if (last) {
                if (has_next) {
                    if constexpr (Sched::kGather) {
                        const unsigned ta0 = (unsigned)(size_t)(lds + LDSX_OFF + 2048) + (unsigned)Rr[0] * 4u, ta1 = (unsigned)(size_t)(lds + LDSX_OFF + 2048) + (unsigned)Rr[1] * 4u;
                        asm volatile("ds_read_b32 %0, %4\n\tds_read_b32 %1, %5\n\tds_read_b32 %2, %4 offset:512\n\tds_read_b32 %3, %5 offset:512\n\ts_waitcnt lgkmcnt(0)"
                                     : "=&v"(rN0[0]), "=&v"(rN0[1]), "=&v"(rN1[0]), "=&v"(rN1[1]) : "v"(ta0), "v"(ta1) : "memory");
                    }
#pragma unroll
                    for (int i = 0; i < 2; ++i) { int a_ = rN0[i], b_ = rN1[i]; asm volatile("" : "+v"(a_), "+v"(b_)); vAn0[i] = (unsigned)a_ * K2 + (unsigned)Cc[i] * 2u; vAn1[i] = (unsigned)b_ * K2 + (unsigned)Cc[i] * 2u; }
                }
#pragma unroll
                for (int i = 0; i < 2; ++i) { v20[i] = vAn0[i]; v21[i] = vAn1[i]; }
            } else {
#pragma unroll
                for (int i = 0; i < 2; ++i) { v20[i] = vAc0[i]; v21[i] = vAc1[i]; }
            }
            PG8_LDB(B0, 0, 0); PG8_LDB(B1, 0, 1); PG8_SCHED; PG8_LDA(At, 0, 0); PG8_STAGE(PG8_SA(1, 1), a1, vAc1);
            PG8_WAIT_V(8); PG8_WAIT_L(0); PG8_BAR; PG8_MMA(0, 0, At, B0); PG8_MMA(0, 1, At, B1); PG8_BAR; PG8_SCHED;
            PG8_LDA(At, 0, 1); PG8_STAGE(PG8_SB(0, 0), b2, voffB); PG8_STAGE(PG8_SB(0, 1), b2 + hstep, voffB); PG8_STAGE(PG8_SA(0, 0), a2, v20);
            PG8_WAIT_V(8); PG8_WAIT_L(0); PG8_BAR; PG8_MMA(1, 0, At, B0); PG8_MMA(1, 1, At, B1); PG8_BAR; PG8_SCHED;
            PG8_LDB(B0, 1, 0); PG8_LDB(B1, 1, 1); PG8_SCHED; PG8_LDA(At, 1, 0); PG8_STAGE(PG8_SA(0, 1), a2, v21);
            PG8_WAIT_V(8); PG8_WAIT_L(0); PG8_BAR; PG8_MMA(0, 0, At, B0); PG8_MMA(0, 1, At, B1); PG8_BAR; PG8_SCHED;
            PG8_LDA(At, 1, 1); PG8_STAGE(PG8_SB(1, 0), b3, voffB); PG8_STAGE(PG8_SB(1, 1), b3 + hstep, voffB); PG8_STAGE(PG8_SA(1, 0), a3, v20);
            PG8_WAIT_V(8); PG8_WAIT_L(0); PG8_BAR; PG8_MMA(1, 0, At, B0); PG8_MMA(1, 1, At, B1); PG8_BAR; PG8_SCHED;
        }
        if (wr == 0) PG8_BAR;
        if constexpr (FP8) asm volatile("s_nop 15\n\ts_nop 15" ::: "memory");
        if (!skipE) E(acc, cur, wr, wc, fr, fq);
        if (!has_next) break;
#pragma unroll
        for (int a = 0; a < 2; ++a)
#pragma unroll
            for (int b = 0; b < 2; ++b)
#pragma unroll
                for (int m = 0; m < 4; ++m)
#pragma unroll
                    for (int n = 0; n < 2; ++n) { if constexpr (FP8) asm volatile("v_mov_b32 %0, 0\n\tv_mov_b32 %1, 0\n\tv_mov_b32 %2, 0\n\tv_mov_b32 %3, 0" : "=v"(acc[a][b][m][n][0]), "=v"(acc[a][b][m][n][1]), "=v"(acc[a][b][m][n][2]), "=v"(acc[a][b][m][n][3])); else acc[a][b][m][n] = (f32x4){0.f, 0.f, 0.f, 0.f}; }
        if constexpr (FP8) asm volatile("s_nop 7" ::: "memory");
        cur = nxt; cB = nB; ++ui;
#pragma unroll
        for (int i = 0; i < 2; ++i) { vAc0[i] = vAn0[i]; vAc1[i] = vAn1[i]; }
        if (wr == 1) PG8_BAR;
    }
    PG8_WAIT_V(0);
    PG8_BAR;
#undef PG8_SA
#undef PG8_SB
#undef PG8_STAGE
#undef PG8_LDA
#undef PG8_LDB
#undef PG8_MMA
#undef PG8_WAIT_V
#undef PG8_WAIT_L
#undef PG8_BAR
#undef PG8_SCHED
}
}
struct LinSched {
    int nM, nN, nwg, G, c; size_t bstride;
    __device__ __forceinline__ void init(int M, int N, int K, int G_, int c_) { nM = M / 256; nN = N / 256; nwg = nM * nN; G = G_; c = c_; bstride = (size_t)256 * K * 2; }
    __device__ __forceinline__ bool next(int i, pg8::Unit& u) const {
        const long L = (long)i * G + c; if (L >= nwg) return false;
        int wgid = (int)L; { const int q = nwg / 8, r = nwg % 8, xcd = wgid % 8, off = wgid / 8; wgid = (xcd < r ? xcd * (q + 1) : r * (q + 1) + (xcd - r) * q) + off; }
        const int nig = 8 * nN, gid = wgid / nig, fm = gid * 8, gsz = (nM - fm) < 8 ? (nM - fm) : 8;
        u.mt = fm + ((wgid % nig) % gsz); u.pn = (wgid % nig) / gsz; u.orow0 = u.mt * 256; u.e = 0; return true;
    }
    __device__ __forceinline__ int arow(const pg8::Unit& u, int lr) const { return u.orow0 + lr; }
    __device__ __forceinline__ size_t boff(const pg8::Unit& u) const { return (size_t)u.pn * bstride; }
    static constexpr bool kGather = false;
    __device__ __forceinline__ const int* gather_src(const pg8::Unit&, int) const { return nullptr; }
    __device__ __forceinline__ bool slack() const { return (nwg - c + G - 1) / G < (nwg + G - 1) / G; }
};
struct MoeTab { LAS int* ts; LAS int* cnt; LAS unsigned char* tile_e; };
__device__ __forceinline__ MoeTab moe_tab(LAS unsigned char* lds) { MoeTab t; t.ts = (LAS int*)(lds + LDSX_OFF); t.cnt = (LAS int*)(lds + LDSX_OFF + 256); t.tile_e = (LAS unsigned char*)(lds + LDSX_OFF + 512); return t; }
__device__ __forceinline__ void moe_tables(LAS unsigned char* lds, const unsigned* gcnt) {
    MoeTab T = moe_tab(lds);
    __syncthreads();
    if (threadIdx.x == 0) { int s = 0; for (int e = 0; e < NEXP; ++e) { const int c = (int)gcnt[e]; T.cnt[e] = c; T.ts[e] = s; s += (c + 255) >> 8; } T.ts[NEXP] = s; }
    __syncthreads();
    const int nt = T.ts[NEXP];
    for (int mt = threadIdx.x; mt < nt; mt += blockDim.x) { int e = 0; for (int j = 1; j < NEXP; ++j) e += (mt >= T.ts[j]) ? 1 : 0; T.tile_e[mt] = (unsigned char)e; }
    __syncthreads();
}
template <int GATHER> struct MoeSched {
    MoeTab T; const int* rowtok; int G, c; size_t bstride; size_t estride;
    __device__ __forceinline__ bool next(int i, pg8::Unit& u) const {
        const int L = i * G + c; const int nt = T.ts[NEXP]; if (L >= nt * 4) return false;
        u.mt = L >> 2; u.pn = L & 3; u.orow0 = u.mt * 256; u.e = (int)T.tile_e[u.mt]; return true;
    }
    __device__ __forceinline__ int arow(const pg8::Unit& u, int lr) const {
        if (GATHER) { const int idx = (u.mt - T.ts[u.e]) * 256 + lr, last = T.cnt[u.e] - 1; return rowtok[(size_t)u.e * NTOK + (idx < last ? idx : last)]; }
        return u.orow0 + lr;
    }
    __device__ __forceinline__ size_t boff(const pg8::Unit& u) const { return (size_t)u.e * estride + (size_t)u.pn * bstride; }
    static constexpr bool kGather = GATHER != 0;
    __device__ __forceinline__ const int* gather_src(const pg8::Unit& u, int lr) const { const int idx = (u.mt - T.ts[u.e]) * 256 + lr, last = T.cnt[u.e] - 1; return rowtok + (size_t)u.e * NTOK + (idx < last ? idx : last); }
    __device__ __forceinline__ bool slack() const { const int n = T.ts[NEXP] * 4; return (n - c + G - 1) / G < (n + G - 1) / G; }
};

__device__ __forceinline__ u32x4 pack8(const f32x4 a, const f32x4 b) { u32x4 w; w.x = pk2(a[0], a[1]); w.y = pk2(a[2], a[3]); w.z = pk2(b[0], b[1]); w.w = pk2(b[2], b[3]); return w; }
struct EpiPlain {
    bf16* O; int ldc;
    __device__ __forceinline__ void operator()(const f32x4 (&acc)[2][2][4][2], const pg8::Unit& u, int wr, int wc, int fr, int fq) const {
        const int row0 = u.orow0 + wr * 64 + fr, col0 = u.pn * 256 + wc * 32 + 8 * fq;
#pragma unroll
        for (int ai = 0; ai < 2; ++ai)
#pragma unroll
            for (int m = 0; m < 4; ++m) { bf16* rowp = O + (size_t)(row0 + ai * 128 + m * 16) * ldc + col0;
#pragma unroll
                for (int bj = 0; bj < 2; ++bj) *(u32x4*)(rowp + bj * 128) = pack8(acc[ai][bj][m][0], acc[ai][bj][m][1]); }
    }
};
struct EpiPlainS {
    bf16* O; int ldc; float sc;
    __device__ __forceinline__ void operator()(const f32x4 (&acc)[2][2][4][2], const pg8::Unit& u, int wr, int wc, int fr, int fq) const {
        const int row0 = u.orow0 + wr * 64 + fr, col0 = u.pn * 256 + wc * 32 + 8 * fq;
#pragma unroll
        for (int ai = 0; ai < 2; ++ai)
#pragma unroll
            for (int m = 0; m < 4; ++m) { bf16* rowp = O + (size_t)(row0 + ai * 128 + m * 16) * ldc + col0;
#pragma unroll
                for (int bj = 0; bj < 2; ++bj) *(u32x4*)(rowp + bj * 128) = pack8(acc[ai][bj][m][0] * sc, acc[ai][bj][m][1] * sc); }
    }
};
struct EpiOut8 {
    unsigned char* O; float sc;
    __device__ __forceinline__ void operator()(const f32x4 (&acc)[2][2][4][2], const pg8::Unit& u, int wr, int wc, int fr, int fq) const {
        const int row0 = u.orow0 + wr * 64 + fr, col0 = u.pn * 256 + wc * 32 + 8 * fq;
#pragma unroll
        for (int ai = 0; ai < 2; ++ai)
#pragma unroll
            for (int m = 0; m < 4; ++m) { unsigned char* rowp = O + (size_t)(row0 + ai * 128 + m * 16) * D + col0;
#pragma unroll
                for (int bj = 0; bj < 2; ++bj) { const f32x4 a = acc[ai][bj][m][0] * sc, b = acc[ai][bj][m][1] * sc;
                    *(u32x2*)(rowp + bj * 128) = (u32x2){pk4_fp8(a[0], a[1], a[2], a[3]), pk4_fp8(b[0], b[1], b[2], b[3])}; } }
    }
};
struct EpiEvenIn {
    bf16* O; const LAS float* rc; const LAS float* rs;
    __device__ __forceinline__ void operator()(const f32x4 (&acc)[2][2][4][2], const pg8::Unit& u, int wr, int wc, int fr, int fq) const {
        const int row0 = u.orow0 + wr * 64 + fr, col0 = u.pn * 256 + wc * 32 + 8 * fq;
        const bool lat = u.orow0 < NLAT;
#pragma unroll
        for (int ai = 0; ai < 2; ++ai)
#pragma unroll
            for (int m = 0; m < 4; ++m) { const int row = row0 + ai * 128 + m * 16; bf16* rowp = O + (size_t)row * EN + col0;
                const int s = row & (SEQ - 1); const int pos = (wc & 1) ? (s & 63) : (s >> 6);
#pragma unroll
                for (int bj = 0; bj < 2; ++bj) { f32x4 v0 = acc[ai][bj][m][0], v1 = acc[ai][bj][m][1];
                    const bool rp = lat && (u.pn < 2 || (u.pn == 2 && bj == 0));
                    if (rp) { const f32x4 c = *(const LAS f32x4*)(rc + pos * 16 + 4 * fq), sn = *(const LAS f32x4*)(rs + pos * 16 + 4 * fq);
                        const f32x4 o1 = v0 * c - v1 * sn, o2 = v1 * c + v0 * sn; v0 = o1; v1 = o2; }
                    if (col0 + bj * 128 < EVEN_IN) *(u32x4*)(rowp + bj * 128) = pack8(v0, v1); }
                asm volatile("" ::: "memory"); }
    }
};
struct EpiOddIn {
    bf16* O;
    __device__ __forceinline__ void operator()(const f32x4 (&acc)[2][2][4][2], const pg8::Unit& u, int wr, int wc, int fr, int fq) const {
        const int row0 = u.orow0 + wr * 64 + fr;
#pragma unroll
        for (int ai = 0; ai < 2; ++ai)
#pragma unroll
            for (int m = 0; m < 4; ++m) { bf16* rowp = O + (size_t)(row0 + ai * 128 + m * 16) * 2048;
                if (u.pn < 4) {
#pragma unroll
                    for (int bj = 0; bj < 2; ++bj) *(u32x4*)(rowp + u.pn * 256 + bj * 128 + wc * 32 + 8 * fq) = pack8(acc[ai][bj][m][0], acc[ai][bj][m][1]);
                } else {
                    *(u32x4*)(rowp + 1024 + (u.pn - 4) * 128 + wc * 32 + 8 * fq) = pack8(acc[ai][0][m][0] * acc[ai][1][m][0], acc[ai][0][m][1] * acc[ai][1][m][1]);
                } }
    }
};
struct EpiG1 {
    unsigned char* O; float sc;
    __device__ __forceinline__ void operator()(const f32x4 (&acc)[2][2][4][2], const pg8::Unit& u, int wr, int wc, int fr, int fq) const {
        const int row0 = u.orow0 + wr * 64 + fr, col0 = u.pn * 128 + wc * 32 + 8 * fq;
#pragma unroll
        for (int ai = 0; ai < 2; ++ai)
#pragma unroll
            for (int m = 0; m < 4; ++m) { unsigned char* rowp = O + (size_t)(row0 + ai * 128 + m * 16) * DEXP + col0;
                f32x4 a0 = acc[ai][0][m][0] * sc, a1 = acc[ai][0][m][1] * sc;
#pragma unroll
                for (int j = 0; j < 4; ++j) { a0[j] = fast_silu(a0[j]); a1[j] = fast_silu(a1[j]); }
                const f32x4 h0 = a0 * (acc[ai][1][m][0] * sc), h1v = a1 * (acc[ai][1][m][1] * sc);
                *(u32x2*)rowp = (u32x2){pk4_fp8(h0[0], h0[1], h0[2], h0[3]), pk4_fp8(h1v[0], h1v[1], h1v[2], h1v[3])}; }
    }
};
struct Frame {
    LAS unsigned char* lds;
    int tid, lane, wave, vcu, G;
    float* out; unsigned char* ws;
};
__device__ __forceinline__ const float* inptr(const Frame& F, int i) {
    const unsigned long long v = ((const LAS unsigned long long*)(F.lds + MISC_OFF + 256))[i];
    const unsigned lo = __builtin_amdgcn_readfirstlane((unsigned)v), hi = __builtin_amdgcn_readfirstlane((unsigned)(v >> 32));
    return (const float*)(((unsigned long long)hi << 32) | lo);
}
enum { I_X = 0, I_C, I_CTX, I_CCTX, I_WINE, I_WOUTE, I_SINK, I_WA2, I_BA, I_NORMW, I_WINO, I_CONVW, I_CONVB, I_WOUTO, I_ADAW, I_ADAB, I_LNW, I_LNB, I_WG, I_BG, I_WE, I_BE, I_W1, I_W3, I_W2 };
__device__ __forceinline__ int launder_v(int x) { asm volatile("" : "+v"(x)); return x; }
__device__ __forceinline__ int launder_s(int x) { asm volatile("" : "+s"(x)); return x; }
__device__ __forceinline__ Frame relaunder(const Frame& F0) { Frame F = F0; F.tid = launder_v(F0.tid); F.lane = F.tid & 63; F.wave = __builtin_amdgcn_readfirstlane(F.tid >> 6); F.vcu = launder_s(F0.vcu); return F; }
__device__ __forceinline__ const float* modp(const Frame& F, int l, int bi, int n) { return (const float*)(F.ws + WS_MOD) + ((size_t)(l * 17 + bi) * 6 + n) * D; }
__device__ __forceinline__ int row_bi(int row) { return row < NLAT ? (row >> 12) : 16; }

__device__ __forceinline__ void sincos_d(double a, float& c, float& s) {
    const double TWO_OVER_PI = 0.63661977236758134308, PIO2_HI = 1.57079632679489655800e+00, PIO2_LO = 6.12323399573676603587e-17;
    const double n = __builtin_rint(a * TWO_OVER_PI); double r = (a - n * PIO2_HI) - n * PIO2_LO; const double r2 = r * r;
    double sp = -1.0 / 1307674368000.0; sp = sp * r2 + 1.0 / 6227020800.0; sp = sp * r2 - 1.0 / 39916800.0; sp = sp * r2 + 1.0 / 362880.0; sp = sp * r2 - 1.0 / 5040.0; sp = sp * r2 + 1.0 / 120.0; sp = sp * r2 - 1.0 / 6.0; sp = sp * r2 + 1.0; sp *= r;
    double cp = 1.0 / 20922789888000.0; cp = cp * r2 - 1.0 / 87178291200.0; cp = cp * r2 + 1.0 / 479001600.0; cp = cp * r2 - 1.0 / 3628800.0; cp = cp * r2 + 1.0 / 40320.0; cp = cp * r2 - 1.0 / 720.0; cp = cp * r2 + 1.0 / 24.0; cp = cp * r2 - 0.5; cp = cp * r2 + 1.0;
    const int q = ((int)n) & 3;
    const double sv = (q == 0) ? sp : (q == 1) ? cp : (q == 2) ? -sp : -cp;
    const double cv = (q == 0) ? cp : (q == 1) ? -sp : (q == 2) ? -cp : sp;
    c = (float)cv; s = (float)sv;
}
__device__ __forceinline__ void ph_ada(const Frame& F0) {
    Frame F = relaunder(F0);
    LAS float* sl = (LAS float*)F.lds;
    LAS float* red = (LAS float*)(F.lds + 17 * 1024 * 4);
    for (int idx = F.tid; idx < 17 * 1024; idx += 512) { const int bi = idx >> 10, k = idx & 1023; const float c = bi < 16 ? inptr(F, I_C)[bi * 1024 + k] : inptr(F, I_CCTX)[k]; sl[idx] = c / (1.0f + expf(-c)); }
    __syncthreads();
    for (int it = F.vcu; it < 4 * 96; it += F.G) {
        const int l = it / 96, n0 = (it % 96) * 64;
        const float* W = inptr(F, I_ADAW) + (size_t)l * 1024 * 6144 + n0 + F.lane;
        float acc[17];
#pragma unroll
        for (int b = 0; b < 17; ++b) acc[b] = 0.f;
        const int kb = F.wave * 128;
        for (int k = kb; k < kb + 128; k += 4) {
            const float w0 = __builtin_nontemporal_load(W + (size_t)k * 6144), w1 = __builtin_nontemporal_load(W + (size_t)(k + 1) * 6144), w2 = __builtin_nontemporal_load(W + (size_t)(k + 2) * 6144), w3 = __builtin_nontemporal_load(W + (size_t)(k + 3) * 6144);
#pragma unroll
            for (int b = 0; b < 17; ++b) { const f32x4 s = *(const LAS f32x4*)(sl + b * 1024 + k); acc[b] += s[0] * w0 + s[1] * w1 + s[2] * w2 + s[3] * w3; }
        }
#pragma unroll
        for (int b = 0; b < 17; ++b) red[(F.wave * 17 + b) * 64 + F.lane] = acc[b];
        __syncthreads();
        for (int idx = F.tid; idx < 17 * 64; idx += 512) { const int b = idx >> 6, ln = idx & 63; float s = 0.f;
#pragma unroll
            for (int w = 0; w < 8; ++w) s += red[(w * 17 + b) * 64 + ln];
            ((float*)(F.ws + WS_MOD))[(size_t)(l * 17 + b) * 6144 + n0 + ln] = s + inptr(F, I_ADAB)[l * 6144 + n0 + ln]; }
        __syncthreads();
    }
    if (F.vcu == F.G - 1) {
        float* rope = (float*)(F.ws + WS_ROPE);
        for (int idx = F.tid; idx < 1024; idx += 512) { const int pos = idx >> 4, f = idx & 15;
            const double base4[4] = {1.0, 0.56234132519034908, 0.31622776601683794, 0.17782794100389228};
            double inv = (f & 3) == 0 ? base4[0] : (f & 3) == 1 ? base4[1] : (f & 3) == 2 ? base4[2] : base4[3];
            const int a = f >> 2; inv *= (a == 0) ? 1.0 : (a == 1) ? 0.1 : (a == 2) ? 0.01 : 0.001;
            float c, s; sincos_d((double)pos * inv, c, s); rope[idx] = c; rope[1024 + idx] = s; }
    }
}

__device__ __forceinline__ void tr_item(const float* W, int srcN, int K, bf16* WT, int drow0, int k0, int srccol, LAS float* scr, int lane) {
    float v[32];
    const float* p = W + (size_t)(k0 + (lane >> 5)) * srcN + (srccol >= 0 ? srccol : 0);
#pragma unroll
    for (int i = 0; i < 32; ++i) v[i] = __builtin_nontemporal_load(p + (size_t)(2 * i) * srcN);
#pragma unroll
    for (int i = 0; i < 32; ++i) scr[(2 * i + (lane >> 5)) * 33 + (lane & 31)] = srccol >= 0 ? v[i] : 0.f;
    asm volatile("s_waitcnt lgkmcnt(0)" ::: "memory");
    const int c = lane & 7;
#pragma unroll
    for (int j = 0; j < 4; ++j) { const int n = (lane >> 3) + 8 * j; const LAS float* s = scr + (8 * c) * 33 + n;
        u32x4 o; o.x = pk2(s[0 * 33], s[1 * 33]); o.y = pk2(s[2 * 33], s[3 * 33]); o.z = pk2(s[4 * 33], s[5 * 33]); o.w = pk2(s[6 * 33], s[7 * 33]);
        *(u32x4*)(WT + (size_t)(drow0 + n) * K + k0 + 8 * c) = o; }
    asm volatile("s_waitcnt lgkmcnt(0)" ::: "memory");
}
__device__ __forceinline__ void tr_item8(const float* W, int srcN, int K, unsigned char* WT, int drow0, int k0, int srccol, float scale, LAS float* scr, int lane) {
    float v[32];
    const float* p = W + (size_t)(k0 + (lane >> 5)) * srcN + srccol;
#pragma unroll
    for (int i = 0; i < 32; ++i) v[i] = __builtin_nontemporal_load(p + (size_t)(2 * i) * srcN);
#pragma unroll
    for (int i = 0; i < 32; ++i) scr[(2 * i + (lane >> 5)) * 33 + (lane & 31)] = v[i] * scale;
    asm volatile("s_waitcnt lgkmcnt(0)" ::: "memory");
    const int c = lane & 3;
#pragma unroll
    for (int j = 0; j < 2; ++j) { const int n = (lane >> 2) + 16 * j; const LAS float* s = scr + (16 * c) * 33 + n;
        u32x4 o; o.x = pk4_fp8(s[0 * 33], s[1 * 33], s[2 * 33], s[3 * 33]); o.y = pk4_fp8(s[4 * 33], s[5 * 33], s[6 * 33], s[7 * 33]);
        o.z = pk4_fp8(s[8 * 33], s[9 * 33], s[10 * 33], s[11 * 33]); o.w = pk4_fp8(s[12 * 33], s[13 * 33], s[14 * 33], s[15 * 33]);
        *(u32x4*)(WT + (size_t)(drow0 + n) * K + k0 + 16 * c) = o; }
    asm volatile("s_waitcnt lgkmcnt(0)" ::: "memory");
}
__device__ __forceinline__ int even_srccol(int j) {
    if (j < 640) { const int hb = j & ~63, p = j & 63, g = p >> 3, e = p & 7; return hb + (g >> 2) * 32 + (e >> 2) * 16 + (g & 3) * 4 + (e & 3); }
    return j < EVEN_IN ? j : -1;
}
__device__ __forceinline__ int odd_srccol(int j) { const int t = j >> 8, r = j & 255; if (t < 4) return j; return (r < 128 ? 1024 : 2048 - 128) + 128 * (t - 4) + r; }
__device__ __forceinline__ void conv_dense_weights(const Frame& F0) {
    Frame F = relaunder(F0);
    LAS float* scr = (LAS float*)(F.lds + F.wave * 16384);
    const int gw = F.vcu * 8 + F.wave, NGW = F.G * 8;
    constexpr int I_EI = 16 * 80, I_SQ = 16 * 32, I_OI = 16 * 96;
    constexpr int NIT = 2 * (I_EI + I_SQ + I_OI + I_SQ);
    for (int it = gw; it < NIT; it += NGW) {
        int r = it; const int i = r & 1; r >>= 1;
        if (r < I_EI) { const int kb = r / 80, nb = r % 80; tr_item(inptr(F, I_WINE) + (size_t)i * 1024 * EVEN_IN, EVEN_IN, 1024, (bf16*)(F.ws + WS_WINE) + (size_t)i * EN * 1024, nb * 32, kb * 64, even_srccol(nb * 32 + (F.lane & 31)), scr, F.lane); continue; } r -= I_EI;
        if (r < I_SQ) { const int kb = r / 32, nb = r % 32; tr_item(inptr(F, I_WOUTE) + (size_t)i * 1024 * 1024, 1024, 1024, (bf16*)(F.ws + WS_WOUTE) + (size_t)i * 1024 * 1024, nb * 32, kb * 64, nb * 32 + (F.lane & 31), scr, F.lane); continue; } r -= I_SQ;
        if (r < I_OI) { const int kb = r / 96, nb = r % 96; tr_item(inptr(F, I_WINO) + (size_t)i * 1024 * ON, ON, 1024, (bf16*)(F.ws + WS_WINO) + (size_t)i * ON * 1024, nb * 32, kb * 64, odd_srccol(nb * 32 + (F.lane & 31)), scr, F.lane); continue; } r -= I_OI;
        { const int kb = r / 32, nb = r % 32; tr_item(inptr(F, I_WOUTO) + (size_t)i * 1024 * 1024, 1024, 1024, (bf16*)(F.ws + WS_WOUTO) + (size_t)i * 1024 * 1024, nb * 32, kb * 64, nb * 32 + (F.lane & 31), scr, F.lane); }
    }
}
constexpr float OUT8_SCALE = 32.0f;
constexpr float W8_SCALE = 64.0f;
__device__ __forceinline__ void conv_moe_item(const Frame& F, int l, int it, LAS float* scr) {
    constexpr int I_13 = 16 * 32, I_2 = 8 * 32;
    const int e = it / (I_13 + I_2); int r = it % (I_13 + I_2);
    const size_t eoff = ((size_t)l * NEXP + e) * 1024 * 512;
    if (r < I_13) { const int kb = r / 32, nb = r % 32; const int j0 = nb * 32, t = j0 >> 8, rr = j0 & 255;
        const float* src = (rr < 128 ? inptr(F, I_W1) : inptr(F, I_W3)) + eoff;
        tr_item8(src, 512, 1024, (unsigned char*)(F.ws + WS_W13) + (size_t)e * 1024 * 1024, j0, kb * 64, 128 * t + (rr & 127) + (F.lane & 31), W8_SCALE, scr, F.lane);
    } else { r -= I_13; const int kb = r / 32, nb = r % 32;
        tr_item8(inptr(F, I_W2) + eoff, 1024, 512, (unsigned char*)(F.ws + WS_W2) + (size_t)e * 1024 * 512, nb * 32, kb * 64, nb * 32 + (F.lane & 31), W8_SCALE, scr, F.lane); }
}
__device__ __forceinline__ void conv_moe_weights(const Frame& F0, int l) {
    Frame F = relaunder(F0); const int gw = F.vcu * 8 + F.wave, NGW = F.G * 8;
    LAS float* scr = (LAS float*)(F.lds + F.wave * 16384);
    for (int it = gw; it < NEXP * (16 * 32 + 8 * 32); it += NGW) conv_moe_item(F, l, it, scr);
}
typedef _Float16 h16x4 __attribute__((ext_vector_type(4)));
__device__ __forceinline__ f32x4 h4_to_f32(const u32x2 v) { return __builtin_convertvector(__builtin_bit_cast(h16x4, v), f32x4); }
__device__ __forceinline__ u32x2 f32_to_h4(const f32x4 v) { return __builtin_bit_cast(u32x2, __builtin_convertvector(v, h16x4)); }
__device__ __forceinline__ unsigned short* h16_row(const Frame& F, bool alt, int row) {
    if (alt) return (unsigned short*)(F.ws + WS_U) + (size_t)row * D;
    return row < NLAT ? (unsigned short*)((unsigned char*)F.out + (size_t)NLAT * D * 2) + (size_t)row * D : (unsigned short*)(F.ws + WS_HCTX) + (size_t)(row - NLAT) * D;
}
__device__ __forceinline__ void ph_u0(const Frame& F0) {
    Frame F = relaunder(F0);
    const int gw = F.vcu * 8 + F.wave, NGW = F.G * 8;
    for (int r0 = gw * 4; r0 < NTOK; r0 += NGW * 4) {
        const int bi = row_bi(r0); const float* sh = modp(F, 0, bi, 0); const float* sc = modp(F, 0, bi, 1);
        f32x4 x[4][4];
#pragma unroll
        for (int r = 0; r < 4; ++r) { const int row = r0 + r; const float* src = row < NLAT ? inptr(F, I_X) + (size_t)row * D : inptr(F, I_CTX) + (size_t)(row - NLAT) * D;
#pragma unroll
            for (int j = 0; j < 4; ++j) x[r][j] = __builtin_nontemporal_load((const f32x4*)(src + 4 * F.lane + 256 * j)); }
#pragma unroll
        for (int j = 0; j < 4; ++j) { const int c = 4 * F.lane + 256 * j; const f32x4 a = *(const f32x4*)(sh + c), s = *(const f32x4*)(sc + c);
#pragma unroll
            for (int r = 0; r < 4; ++r) { const f32x4 u = x[r][j] * (1.0f + s) + a; u32x2 w; w.x = pk2(u[0], u[1]); w.y = pk2(u[2], u[3]); *(u32x2*)((bf16*)(F.ws + WS_U) + (size_t)(r0 + r) * D + c) = w;
                __builtin_nontemporal_store(f32_to_h4(x[r][j]), (u32x2*)(h16_row(F, false, r0 + r) + c)); } }
    }
}

struct RowLN { f32x4 v[4]; };
__device__ __forceinline__ void ln_stats(f32x4 (&z)[4], float& mean, float& rstd) {
    float s = 0.f;
#pragma unroll
    for (int j = 0; j < 4; ++j) s += (z[j][0] + z[j][1]) + (z[j][2] + z[j][3]);
    mean = wave_sum(s) * (1.0f / D); float q = 0.f;
#pragma unroll
    for (int j = 0; j < 4; ++j) { z[j] = z[j] - mean; q += (z[j][0] * z[j][0] + z[j][1] * z[j][1]) + (z[j][2] * z[j][2] + z[j][3] * z[j][3]); }
    rstd = 1.0f / sqrtf(wave_sum(q) * (1.0f / D) + LN_EPS);
}
__device__ __forceinline__ void ln_rows(f32x4 (&z)[4], const float* lw, const float* lb, int lane) {
    float s = 0.f;
#pragma unroll
    for (int j = 0; j < 4; ++j) s += (z[j][0] + z[j][1]) + (z[j][2] + z[j][3]);
    const float mean = wave_sum(s) * (1.0f / D); float q = 0.f;
#pragma unroll
    for (int j = 0; j < 4; ++j) { z[j] = z[j] - mean; q += (z[j][0] * z[j][0] + z[j][1] * z[j][1]) + (z[j][2] * z[j][2] + z[j][3] * z[j][3]); }
    const float rstd = 1.0f / sqrtf(wave_sum(q) * (1.0f / D) + LN_EPS);
#pragma unroll
    for (int j = 0; j < 4; ++j) { const int c = 4 * lane + 256 * j; z[j] = z[j] * rstd * *(const f32x4*)(lw + c) + *(const f32x4*)(lb + c); }
}
__device__ __forceinline__ void ph_ln1(const Frame& F0, int l, int nrows, bool dry = false) {
    Frame F = relaunder(F0);
    LAS unsigned char* Thi = F.lds; LAS unsigned char* Tlo = F.lds + 33024;
    LAS float* red = (LAS float*)(F.lds + 66048);
    LAS float* lgt = (LAS float*)(F.lds + 82432);
    LAS int* lcnt = (LAS int*)(F.lds + 87552); LAS int* lbase = lcnt + 32;
    LAS unsigned* list = (LAS unsigned*)(F.lds + 87808);
    LAS float* LW = (LAS float*)(F.lds + 97024); LAS float* LB = LW + 1024; LAS float* WG = LB + 1024;
    LAS float* GV = (LAS float*)(F.lds + 121600); LAS float* SCV = GV + 1024; LAS float* SHV = SCV + 1024; LAS float* BGE = SHV + 1024;
    const int lane = F.lane, w = F.wave;
    if (F.tid < 64) lcnt[F.tid] = 0;
    if (F.tid < 36) BGE[F.tid] = F.tid < 4 ? (inptr(F, I_BG) + l * 4)[F.tid] : (inptr(F, I_BE) + l * 32)[F.tid - 4];
    { const float* lwg = inptr(F, I_LNW) + (size_t)(l * 2 + 0) * D; const float* lbg = inptr(F, I_LNB) + (size_t)(l * 2 + 0) * D; const float* wgg = inptr(F, I_WG) + (size_t)l * 1024 * 4;
      for (int i = F.tid; i < 256; i += 512) { *(LAS f32x4*)(LW + 4 * i) = *(const f32x4*)(lwg + 4 * i); *(LAS f32x4*)(LB + 4 * i) = *(const f32x4*)(lbg + 4 * i); }
      for (int i = F.tid; i < 1024; i += 512) *(LAS f32x4*)(WG + 4 * i) = *(const f32x4*)(wgg + 4 * i); }
    bf16x8 Whi[2][4], Wlo[2][4];
    {
        const int n = lane & 15, kg = lane >> 4;
        const float* we = inptr(F, I_WE) + (size_t)l * 1024 * 32 + (size_t)(w * 128 + kg * 8) * 32 + n;
#pragma unroll
        for (int nt = 0; nt < 2; ++nt) {
            float raw[4][8];
            { const float* p = we + nt * 16;
              asm volatile("" : "+v"(p));
#pragma unroll
              for (int ks = 0; ks < 4; ++ks)
#pragma unroll
                  for (int j = 0; j < 8; ++j) raw[ks][j] = p[ks * 32 * 32 + j * 32]; }
#pragma unroll
            for (int ks = 0; ks < 4; ++ks) { u32x4 hi, lo; unsigned hh[8], ll[8];
#pragma unroll
                for (int j = 0; j < 8; ++j) {
                    const float v = raw[ks][j];
                    const unsigned h = pk2(v, 0.f) & 0xffffu; const float r = v - __uint_as_float(h << 16); hh[j] = h; ll[j] = pk2(r, 0.f) & 0xffffu; }
                hi.x = hh[0] | (hh[1] << 16); hi.y = hh[2] | (hh[3] << 16); hi.z = hh[4] | (hh[5] << 16); hi.w = hh[6] | (hh[7] << 16);
                lo.x = ll[0] | (ll[1] << 16); lo.y = ll[2] | (ll[3] << 16); lo.z = ll[4] | (ll[5] << 16); lo.w = ll[6] | (ll[7] << 16);
                Whi[nt][ks] = __builtin_bit_cast(bf16x8, hi); Wlo[nt][ks] = __builtin_bit_cast(bf16x8, lo); }
        }
    }
    const bf16* Y = (const bf16*)(F.ws + WS_P);
    const LAS float* bgp = BGE; const LAS float* bep = BGE + 4;
    const bool usey = !((l & 1) ? (KO_MASK & 4) : ((KO_MASK & 3) == 3));
    const int nbatch = nrows / 16; int nlist = 0; int routed = 0;
    LAS float* lgtx = (LAS float*)(F.lds + 134048);
#define LGT(b_) (((b_) < 2 ? lgt : lgtx - 2 * 640) + (b_) * 640)
#define LN1_ROUTE(first_, count_) do { if (F.tid < 16 * (count_)) { const int tk = F.tid & 15, qb_ = (first_) + (F.tid >> 4); const LAS float* lg = LGT(qb_ & 3) + tk * 40; \
        float gl[4]; _Pragma("unroll") for (int j = 0; j < 4; ++j) gl[j] = lg[32 + j] + bgp[j]; \
        float gmax = gl[0]; int g = 0; _Pragma("unroll") for (int j = 1; j < 4; ++j) if (gl[j] > gmax) { gmax = gl[j]; g = j; } \
        float den = 0.f; _Pragma("unroll") for (int j = 0; j < 4; ++j) den += __expf(gl[j] - gmax); \
        const float pg = __builtin_amdgcn_rcpf(den); float el[8]; _Pragma("unroll") for (int j = 0; j < 8; ++j) el[j] = lg[g * 8 + j] + bep[g * 8 + j]; \
        float m0 = el[0]; int i0 = 0; _Pragma("unroll") for (int j = 1; j < 8; ++j) if (el[j] > m0) { m0 = el[j]; i0 = j; } \
        float m1 = -3.0e38f; int i1 = 0; _Pragma("unroll") for (int j = 0; j < 8; ++j) if (j != i0 && el[j] > m1) { m1 = el[j]; i1 = j; } \
        const float ex = __expf(m1 - m0); const float w0 = pg * __builtin_amdgcn_rcpf(1.0f + ex), w1 = w0 * ex; \
        const int e0 = g * 8 + i0, e1 = g * 8 + i1; \
        const int p0 = atomicAdd((int*)&lcnt[e0], 1), p1 = atomicAdd((int*)&lcnt[e1], 1); \
        LAS unsigned* L = list + (qb_ * 16 + tk) * 8; \
        L[0] = (unsigned)((bt0 + qb_) * 16 + tk); L[1] = (unsigned)e0; L[2] = (unsigned)p0; L[3] = __float_as_uint(w0); L[4] = (unsigned)e1; L[5] = (unsigned)p1; L[6] = __float_as_uint(w1); } } while (0)
    __syncthreads();
    const int per = (nbatch + F.G - 1) / F.G, bt0 = F.vcu * per, bt1 = (bt0 + per < nbatch) ? bt0 + per : nbatch;
    u32x2 hraw[2][4], yraw[2][4]; int cur_bi = -1;
#define LN1_FETCH(bt_, rr) do { { const int row = (bt_) * 16 + 2 * w + rr; \
        const unsigned short* hs16 = h16_row(F, false, row); \
        _Pragma("unroll") for (int j = 0; j < 4; ++j) { const int c = 4 * lane + 256 * j; \
            hraw[rr][j] = __builtin_nontemporal_load((const u32x2*)(hs16 + c)); \
            yraw[rr][j] = usey ? __builtin_nontemporal_load((const u32x2*)(Y + (size_t)row * D + c)) : (u32x2){0u, 0u}; } } } while (0)
    if (bt0 < bt1) { LN1_FETCH(bt0, 0); LN1_FETCH(bt0, 1); }
    for (int bt = bt0; bt < bt1; ++bt) {
        const int rbase = bt * 16; const int bi = row_bi(rbase);
        if (bi != cur_bi) {
            const float* g2 = modp(F, l, bi, 2); const float* sh = modp(F, l, bi, 3); const float* sc = modp(F, l, bi, 4);
            if (F.tid < 256) { *(LAS f32x4*)(GV + 4 * F.tid) = *(const f32x4*)(g2 + 4 * F.tid); *(LAS f32x4*)(SCV + 4 * F.tid) = *(const f32x4*)(sc + 4 * F.tid); *(LAS f32x4*)(SHV + 4 * F.tid) = *(const f32x4*)(sh + 4 * F.tid); }
            __syncthreads(); cur_bi = bi;
        }
#pragma unroll
        for (int rr = 0; rr < 2; ++rr) {
            const int lr = 2 * w + rr, row = rbase + lr;
            f32x4 z[4]; float mean, rstd;
#pragma unroll
            for (int j = 0; j < 4; ++j) { const f32x4 gvj = *(const LAS f32x4*)(GV + 4 * lane + 256 * j);
                z[j] = DN_ALPHA * h4_to_f32(hraw[rr][j]) + gvj * (f32x4){bflo(yraw[rr][j].x), bfhi(yraw[rr][j].x), bflo(yraw[rr][j].y), bfhi(yraw[rr][j].y)}; }
            asm volatile("" ::: "memory");
            if (bt + 1 < bt1) LN1_FETCH(bt + 1, rr);
            asm volatile("" ::: "memory");
            ln_stats(z, mean, rstd);
            f32x4 ga = (f32x4){0.f, 0.f, 0.f, 0.f};
            unsigned short* hd = dry ? (unsigned short*)(F.ws + WS_GATT) + (size_t)row * D : h16_row(F, l == DEPTH - 1, row);
            unsigned char* u8 = (unsigned char*)(F.ws + (dry ? WS_Q : WS_U8)) + (size_t)row * D;
#pragma unroll
            for (int j = 0; j < 4; ++j) { const int c = 4 * lane + 256 * j;
                const f32x4 lwv = *(const LAS f32x4*)(LW + c), lbv = *(const LAS f32x4*)(LB + c), scvj = *(const LAS f32x4*)(SCV + c), shvj = *(const LAS f32x4*)(SHV + c);
                const f32x4 g0 = *(const LAS f32x4*)(WG + 4 * c), g1 = *(const LAS f32x4*)(WG + 4 * c + 4), g2v = *(const LAS f32x4*)(WG + 4 * c + 8), g3 = *(const LAS f32x4*)(WG + 4 * c + 12);
                const f32x4 zn = z[j] * rstd * lwv + lbv;
                __builtin_nontemporal_store(f32_to_h4(zn), (u32x2*)(hd + c));
                const f32x4 t = zn * (1.0f + scvj) + shvj;
                ga += t[0] * g0 + t[1] * g1 + t[2] * g2v + t[3] * g3;
                const unsigned h01 = pk2(t[0], t[1]), h23 = pk2(t[2], t[3]);
                u32x2 hw; hw.x = h01; hw.y = h23;
                *(unsigned*)(u8 + c) = pk4_fp8(t[0], t[1], t[2], t[3]);
                const float r0 = t[0] - bflo(h01), r1 = t[1] - bfhi(h01), r2 = t[2] - bflo(h23), r3 = t[3] - bfhi(h23);
                u32x2 lw2; lw2.x = pk2(r0, r1); lw2.y = pk2(r2, r3);
                *(LAS u32x2*)(Thi + lr * 2064 + c * 2) = hw; *(LAS u32x2*)(Tlo + lr * 2064 + c * 2) = lw2;
                asm volatile("" ::: "memory"); }
            { const float q0 = wave_sum(ga[0]), q1 = wave_sum(ga[1]), q2 = wave_sum(ga[2]), q3 = wave_sum(ga[3]);
              if (lane == 0) *(LAS f32x4*)(LGT(nlist & 3) + lr * 40 + 32) = (f32x4){q0, q1, q2, q3}; }
        }
        __syncthreads();
        if (nlist - routed == 3) { LN1_ROUTE(routed, 3); routed += 3; }
        {
            f32x4 acc[2];
#pragma unroll
            for (int nt = 0; nt < 2; ++nt) acc[nt] = (f32x4){0.f, 0.f, 0.f, 0.f};
            const int tk = lane & 15, kg = lane >> 4;
#pragma unroll
            for (int ks = 0; ks < 4; ++ks) {
                const bf16x8 ah = *(const LAS bf16x8*)(Thi + tk * 2064 + (w * 128 + ks * 32 + kg * 8) * 2), al = *(const LAS bf16x8*)(Tlo + tk * 2064 + (w * 128 + ks * 32 + kg * 8) * 2);
#pragma unroll
                for (int nt = 0; nt < 2; ++nt) { acc[nt] = __builtin_amdgcn_mfma_f32_16x16x32_bf16(Whi[nt][ks], ah, acc[nt], 0, 0, 0);
                    acc[nt] = __builtin_amdgcn_mfma_f32_16x16x32_bf16(Wlo[nt][ks], ah, acc[nt], 0, 0, 0); acc[nt] = __builtin_amdgcn_mfma_f32_16x16x32_bf16(Whi[nt][ks], al, acc[nt], 0, 0, 0); }
            }
#pragma unroll
            for (int nt = 0; nt < 2; ++nt) *(LAS f32x4*)(red + (w * 16 + tk) * 32 + nt * 16 + 4 * kg) = acc[nt];
        }
        __syncthreads();
        { const int tk = F.tid & 15, n = F.tid >> 4; float s = 0.f;
#pragma unroll
            for (int ww = 0; ww < 8; ++ww) s += red[(ww * 16 + tk) * 32 + n];
            LGT(nlist & 3)[tk * 40 + n] = s; }
        ++nlist;
    }
    __syncthreads();
    if (nlist - routed > 0) LN1_ROUTE(routed, nlist - routed);
#undef LN1_ROUTE
#undef LGT
#undef LN1_FETCH
    __syncthreads();
    if (F.tid < 32) lbase[F.tid] = (int)atomicAdd((unsigned*)(F.ws + WS_CTL) + CW_CNT + l * 64 + (dry ? 32 : 0) + F.tid, (unsigned)lcnt[F.tid]);
    __syncthreads();
    if (!dry) for (int idx = F.tid; idx < nlist * 16; idx += 512) {
        const LAS unsigned* L = list + idx * 8; const unsigned row = L[0], e0 = L[1], e1 = L[4]; const unsigned p0 = L[2] + (unsigned)lbase[e0], p1 = L[5] + (unsigned)lbase[e1];
        u32x4 a; a.x = e0; a.y = p0; a.z = L[3]; a.w = e1; u32x4 b; b.x = p1; b.y = L[6]; b.z = 0u; b.w = 0u;
        unsigned* ti = (unsigned*)(F.ws + WS_TOKINFO) + (size_t)row * 8; *(u32x4*)ti = a; *(u32x4*)(ti + 4) = b;
        int* rt = (int*)(F.ws + WS_ROWTOK); rt[(size_t)e0 * NTOK + p0] = (int)row; rt[(size_t)e1 * NTOK + p1] = (int)row;
    }
}

__device__ __forceinline__ void ph_ln2(const Frame& F0, int l, int nrows, bool dry = false) {
    Frame F = relaunder(F0);
    MoeTab T = moe_tab(F.lds);
    const int gw = F.vcu * 8 + F.wave, NGW = F.G * 8, lane = F.lane;
    LAS float* LW = (LAS float*)F.lds; LAS float* LB = LW + 1024;
    { const float* lw = inptr(F, I_LNW) + (size_t)(l * 2 + 1) * D; const float* lb = inptr(F, I_LNB) + (size_t)(l * 2 + 1) * D;
      if (F.tid < 256) { *(LAS f32x4*)(LW + 4 * F.tid) = *(const f32x4*)(lw + 4 * F.tid); *(LAS f32x4*)(LB + 4 * F.tid) = *(const f32x4*)(lb + 4 * F.tid); } }
    __syncthreads();
    const unsigned char* O2 = (const unsigned char*)(F.ws + WS_P);
    const unsigned* tinfo = (const unsigned*)(F.ws + WS_TOKINFO);
    const int lm = l < 3 ? l + 1 : l;
    u32x4 ta[4]; u32x2 tb[4];
    if (gw * 4 < nrows) {
#pragma unroll
        for (int r = 0; r < 4; ++r) { const unsigned* ti = tinfo + (size_t)(gw * 4 + r) * 8; ta[r] = __builtin_nontemporal_load((const u32x4*)ti); tb[r] = __builtin_nontemporal_load((const u32x2*)(ti + 4)); }
    }
    for (int r0 = gw * 4; r0 < nrows; r0 += NGW * 4) {
        const int bi = row_bi(r0);
        const float* g5 = modp(F, l, bi, 5); const float* sh = modp(F, lm, bi, 0); const float* sc = modp(F, lm, bi, 1);
        const bool lat = r0 < NLAT;
        const bool wu = (l < 3) && (lat || l < 2);
        f32x4 z[4][4], gv[4], scv[4], shv[4]; unsigned ya[4][4], yb[4][4]; float w0[4], w1[4];
#pragma unroll
        for (int r = 0; r < 4; ++r) { const int row = r0 + r;
            const unsigned s0 = ((unsigned)T.ts[ta[r].x] * 256u + ta[r].y) * (unsigned)D, s1 = ((unsigned)T.ts[ta[r].w] * 256u + tb[r].x) * (unsigned)D;
            w0[r] = __uint_as_float(ta[r].z) * (1.0f / OUT8_SCALE); w1[r] = __uint_as_float(tb[r].y) * (1.0f / OUT8_SCALE);
            const unsigned short* hd = h16_row(F, l == DEPTH - 1, row);
#pragma unroll
            for (int j = 0; j < 4; ++j) { const int c = 4 * lane + 256 * j; z[r][j] = h4_to_f32(__builtin_nontemporal_load((const u32x2*)(hd + c)));
                if (!(KO_MASK & 8)) { ya[r][j] = __builtin_nontemporal_load((const unsigned*)(O2 + s0 + c)); yb[r][j] = __builtin_nontemporal_load((const unsigned*)(O2 + s1 + c)); } } }
#pragma unroll
        for (int j = 0; j < 4; ++j) { const int c = 4 * lane + 256 * j; gv[j] = *(const f32x4*)(g5 + c); scv[j] = *(const f32x4*)(sc + c); shv[j] = *(const f32x4*)(sh + c); }
        asm volatile("" ::: "memory");
        { const int rn = r0 + NGW * 4;
          if (rn < nrows) {
#pragma unroll
              for (int r = 0; r < 4; ++r) { const unsigned* ti = tinfo + (size_t)(rn + r) * 8; ta[r] = __builtin_nontemporal_load((const u32x4*)ti); tb[r] = __builtin_nontemporal_load((const u32x2*)(ti + 4)); }
          } }
        asm volatile("" ::: "memory");
#pragma unroll
        for (int j = 0; j < 4; ++j)
#pragma unroll
            for (int r = 0; r < 4; ++r) { f32x4 y = (f32x4){0.f, 0.f, 0.f, 0.f};
                if (!(KO_MASK & 8)) y = w0[r] * unpk4_fp8(ya[r][j]) + w1[r] * unpk4_fp8(yb[r][j]);
                z[r][j] = DN_ALPHA * z[r][j] + gv[j] * y; }
        float mean[4], rstd[4];
#pragma unroll
        for (int r = 0; r < 4; ++r) ln_stats(z[r], mean[r], rstd[r]);
#pragma unroll
        for (int j = 0; j < 4; ++j) { const int c = 4 * lane + 256 * j;
            const f32x4 lwv = *(const LAS f32x4*)(LW + c), lbv = *(const LAS f32x4*)(LB + c);
#pragma unroll
            for (int r = 0; r < 4; ++r) { const int row = r0 + r;
                const f32x4 zn = z[r][j] * rstd[r] * lwv + lbv;
                if (l == DEPTH - 1) { float* hd = dry ? (float*)(F.ws + WS_GATT) + (size_t)row * D : F.out + (size_t)row * D; __builtin_nontemporal_store(zn, (f32x4*)(hd + c)); }
                else { unsigned short* hd = dry ? (unsigned short*)(F.ws + WS_GATT) + (size_t)row * D : h16_row(F, false, row); __builtin_nontemporal_store(f32_to_h4(zn), (u32x2*)(hd + c)); }
                if (wu) { const f32x4 u = zn * (1.0f + scv[j]) + shv[j]; u32x2 hw; hw.x = pk2(u[0], u[1]); hw.y = pk2(u[2], u[3]); *(u32x2*)((bf16*)(F.ws + (dry ? WS_Q : WS_U)) + (size_t)row * D + c) = hw; } } }
    }
    __syncthreads();
}

__device__ __forceinline__ f32x4 ubf_lo(const u32x4 v) { return (f32x4){bflo(v.x), bfhi(v.x), bflo(v.y), bfhi(v.y)}; }
__device__ __forceinline__ f32x4 ubf_hi(const u32x4 v) { return (f32x4){bflo(v.z), bfhi(v.z), bflo(v.w), bfhi(v.w)}; }
__device__ __forceinline__ void ph_conv(const Frame& F0, int i, int nrows) {
    Frame F = relaunder(F0);
    const int gw = F.vcu * 8 + F.wave, NGW = F.G * 8, lane = F.lane;
    const float* cw = inptr(F, I_CONVW) + (size_t)i * 3 * D; const float* cb = inptr(F, I_CONVB) + (size_t)i * D;
    const bf16* P = (const bf16*)(F.ws + WS_P); bf16* Q = (bf16*)(F.ws + WS_Q);
    for (int r0 = gw * 4; r0 < nrows; r0 += NGW * 4) {
        const int s0 = r0 < NLAT ? (r0 & (SEQ - 1)) : ((r0 - NLAT) & (CTXL - 1)); const int slen = r0 < NLAT ? SEQ : CTXL;
        const bool hp = s0 > 0, hn = s0 + 4 < slen;
#pragma unroll
        for (int j = 0; j < 2; ++j) { const int c = 8 * lane + 512 * j;
            u32x4 p[6], gb[4];
            p[0] = (u32x4){0u, 0u, 0u, 0u}; p[5] = (u32x4){0u, 0u, 0u, 0u};
            if (hp) p[0] = __builtin_nontemporal_load((const u32x4*)(P + (size_t)(r0 - 1) * 2048 + 1024 + c));
            if (hn) p[5] = __builtin_nontemporal_load((const u32x4*)(P + (size_t)(r0 + 4) * 2048 + 1024 + c));
#pragma unroll
            for (int r = 0; r < 4; ++r) { p[r + 1] = __builtin_nontemporal_load((const u32x4*)(P + (size_t)(r0 + r) * 2048 + 1024 + c)); gb[r] = __builtin_nontemporal_load((const u32x4*)(P + (size_t)(r0 + r) * 2048 + c)); }
            const f32x4 w0a = *(const f32x4*)(cw + c), w0b = *(const f32x4*)(cw + c + 4), w1a = *(const f32x4*)(cw + D + c), w1b = *(const f32x4*)(cw + D + c + 4), w2a = *(const f32x4*)(cw + 2 * D + c), w2b = *(const f32x4*)(cw + 2 * D + c + 4);
            const f32x4 ba = *(const f32x4*)(cb + c), bb = *(const f32x4*)(cb + c + 4);
#pragma unroll
            for (int r = 0; r < 4; ++r) {
                const f32x4 ya = ubf_lo(gb[r]) * (ubf_lo(p[r]) * w0a + ubf_lo(p[r + 1]) * w1a + ubf_lo(p[r + 2]) * w2a + ba);
                const f32x4 yb = ubf_hi(gb[r]) * (ubf_hi(p[r]) * w0b + ubf_hi(p[r + 1]) * w1b + ubf_hi(p[r + 2]) * w2b + bb);
                *(u32x4*)(Q + (size_t)(r0 + r) * D + c) = pack8(ya, yb); } }
    }
}
#define MFMA32(a, b, c) __builtin_amdgcn_mfma_f32_32x32x16_bf16((a), (b), (c), 0, 0, 0)
#define MFMA16(a, b, c) __builtin_amdgcn_mfma_f32_16x16x32_bf16((a), (b), (c), 0, 0, 0)
constexpr int AK_STR = 144, AV_STR = 136, AK_BUF = 64 * AK_STR, AV_BUF = 64 * AV_STR;
__device__ __forceinline__ int crow32(int reg, int hh) { return (reg & 3) + 8 * (reg >> 2) + 4 * hh; }
__device__ __forceinline__ float xhalf_max(float v) { const unsigned u = __float_as_uint(v); const auto r = __builtin_amdgcn_permlane32_swap(u, u, false, false); return fmaxf(__uint_as_float(r[0]), __uint_as_float(r[1])); }
__device__ __forceinline__ float xhalf_sum(float v) { const unsigned u = __float_as_uint(v); const auto r = __builtin_amdgcn_permlane32_swap(u, u, false, false); return __uint_as_float(r[0]) + __uint_as_float(r[1]); }
constexpr float ATT_THR = 8.0f;
__device__ __forceinline__ void attn_unit(const Frame& F, int ie, int b, int g, int qb, bool ctxq) {
    const bf16* P = (const bf16*)(F.ws + WS_P); bf16* Q = (bf16*)(F.ws + WS_Q);
    LAS unsigned char* Ks = F.lds; LAS unsigned char* Vt = F.lds + 2 * AK_BUF;
    const int w = F.wave, lane = F.lane, r = w >> 1, qh = w & 1, h = 4 * g + r, n = lane & 31, hh = lane >> 5;
    const int qpos0 = qb * 128 + qh * 64;
    const int qrow0 = ctxq ? NLAT + b * CTXL + qpos0 : b * SEQ + qpos0;
    if (KO_MASK & 1) {
#pragma unroll
        for (int nt = 0; nt < 2; ++nt)
#pragma unroll
            for (int c = 0; c < 4; ++c) *(u32x4*)(Q + (size_t)(qrow0 + 32 * nt + n) * D + h * 64 + 16 * c + 8 * hh) = (u32x4){0u, 0u, 0u, 0u};
        return;
    }
    bf16x8 qf[2][4];
#pragma unroll
    for (int nt = 0; nt < 2; ++nt)
#pragma unroll
        for (int c = 0; c < 4; ++c) qf[nt][c] = *(const bf16x8*)(P + (size_t)(qrow0 + 32 * nt + n) * EN + PC_Q + h * 64 + 16 * c + 8 * hh);
    const float sk = inptr(F, I_SINK)[ie * 8 + h] * LOG2E;
    float mrun[2] = {sk, sk}, lsum[2] = {1.f, 1.f};
    f32x16 O[2][2];
#pragma unroll
    for (int a = 0; a < 2; ++a)
#pragma unroll
        for (int c = 0; c < 2; ++c)
#pragma unroll
            for (int e = 0; e < 16; ++e) O[a][c][e] = 0.f;
    const int tw0 = ctxq ? 4 : ((qb == 0) ? 6 : 4), tw1 = ctxq ? 4 : ((qb == 31) ? 8 : 10);
    const int ntile = 4 + (tw1 - tw0);
    const int skey = F.tid >> 3, sch = F.tid & 7;
    u32x4 kreg, vreg;
#define TILE_OF(i) ((i) < 4 ? (i) : tw0 + ((i) - 4))
#define KROW_OF(t) ((t) < 4 ? NLAT + b * CTXL + 64 * (t) : b * SEQ + (qb - 1) * 128 + 64 * ((t) - 4))
    { const int kr = KROW_OF(0) + skey; kreg = *(const u32x4*)(P + (size_t)kr * EN + PC_K + g * 64 + sch * 8); vreg = *(const u32x4*)(P + (size_t)kr * EN + PC_V + g * 64 + sch * 8); }
    __syncthreads();
    {
        *(LAS u32x4*)(Ks + skey * AK_STR + sch * 16) = kreg;
        LAS unsigned short* vt = (LAS unsigned short*)(Vt + (sch * 8) * AV_STR + skey * 2);
        const unsigned vv[4] = {vreg.x, vreg.y, vreg.z, vreg.w};
#pragma unroll
        for (int e = 0; e < 4; ++e) { vt[(2 * e) * (AV_STR / 2)] = (unsigned short)(vv[e] & 0xffffu); vt[(2 * e + 1) * (AV_STR / 2)] = (unsigned short)(vv[e] >> 16); }
    }
    __syncthreads();
    const float c2 = 0.125f * LOG2E;
    for (int i = 0; i < ntile; ++i) {
        const int buf = i & 1, t = TILE_OF(i);
        if (i + 1 < ntile) { const int t1 = TILE_OF(i + 1); const int kr = KROW_OF(t1) + skey; kreg = *(const u32x4*)(P + (size_t)kr * EN + PC_K + g * 64 + sch * 8); vreg = *(const u32x4*)(P + (size_t)kr * EN + PC_V + g * 64 + sch * 8); }
        const LAS unsigned char* kb = Ks + buf * AK_BUF; const LAS unsigned char* vb = Vt + buf * AV_BUF;
        const bool msk = (t >= 4) && (t != 6) && (t != 7);
        const int kp0 = (qb - 1) * 128 + 64 * (t - 4);
        const bool skip = (qh == 0 && t == 9) || (qh == 1 && t == 4);
#pragma unroll 1
        for (int kt = 0; kt < 2; ++kt) {
            if (skip) break;
            f32x16 S[2];
#pragma unroll
            for (int c = 0; c < 2; ++c)
#pragma unroll
                for (int e = 0; e < 16; ++e) S[c][e] = 0.f;
#pragma unroll
            for (int c = 0; c < 4; ++c) { const bf16x8 kf = *(const LAS bf16x8*)(kb + (32 * kt + n) * AK_STR + (16 * c + 8 * hh) * 2);
#pragma unroll
                for (int nt = 0; nt < 2; ++nt) S[nt] = MFMA32(kf, qf[nt][c], S[nt]); }
#pragma unroll
            for (int nt = 0; nt < 2; ++nt) {
                if (msk) { const int qp = qpos0 + 32 * nt + n;
#pragma unroll
                    for (int e = 0; e < 16; ++e) { const int dd = qp - (kp0 + 32 * kt + crow32(e, hh)); if (dd > 128 || dd < -128) S[nt][e] = -INFINITY; } }
                float mx = fmaxf(fmaxf(S[nt][0], S[nt][1]), fmaxf(S[nt][2], S[nt][3]));
#pragma unroll
                for (int e = 4; e < 16; e += 4) mx = fmaxf(mx, fmaxf(fmaxf(S[nt][e], S[nt][e + 1]), fmaxf(S[nt][e + 2], S[nt][e + 3])));
                mx = xhalf_max(mx) * c2;
                if (__builtin_amdgcn_ballot_w64(mx > mrun[nt] + ATT_THR) != 0ull) {
                    const float mnew_ = fmaxf(mrun[nt], mx); const float alpha = __builtin_amdgcn_exp2f(mrun[nt] - mnew_); mrun[nt] = mnew_; lsum[nt] *= alpha;
#pragma unroll
                    for (int dt = 0; dt < 2; ++dt)
#pragma unroll
                        for (int e = 0; e < 16; ++e) O[dt][nt][e] *= alpha;
                }
                const float mu = mrun[nt];
                float rs = 0.f;
#pragma unroll
                for (int e = 0; e < 16; ++e) { const float p = __builtin_amdgcn_exp2f(__builtin_fmaf(S[nt][e], c2, -mu)); S[nt][e] = p; rs += p; }
                lsum[nt] += xhalf_sum(rs);
            }
#pragma unroll
            for (int s = 0; s < 2; ++s) {
                bf16x8 pf[2];
#pragma unroll
                for (int nt = 0; nt < 2; ++nt) { u32x4 pw; pw.x = pk2(S[nt][8 * s + 0], S[nt][8 * s + 1]); pw.y = pk2(S[nt][8 * s + 2], S[nt][8 * s + 3]); pw.z = pk2(S[nt][8 * s + 4], S[nt][8 * s + 5]); pw.w = pk2(S[nt][8 * s + 6], S[nt][8 * s + 7]); pf[nt] = __builtin_bit_cast(bf16x8, pw); }
#pragma unroll
                for (int dt = 0; dt < 2; ++dt) {
                    const LAS unsigned char* va = vb + (32 * dt + n) * AV_STR + (32 * kt + 16 * s + 4 * hh) * 2;
                    const s16x4 lo = *(const LAS s16x4*)va, hi = *(const LAS s16x4*)(va + 16);
                    const bf16x8 vf = __builtin_shufflevector(lo, hi, 0, 1, 2, 3, 4, 5, 6, 7);
#pragma unroll
                    for (int nt = 0; nt < 2; ++nt) O[dt][nt] = MFMA32(vf, pf[nt], O[dt][nt]);
                }
            }
        }
        if (i + 1 < ntile) {
            LAS unsigned char* kb2 = Ks + (buf ^ 1) * AK_BUF; LAS unsigned char* vb2 = Vt + (buf ^ 1) * AV_BUF;
            *(LAS u32x4*)(kb2 + skey * AK_STR + sch * 16) = kreg;
            LAS unsigned short* vt = (LAS unsigned short*)(vb2 + (sch * 8) * AV_STR + skey * 2);
            const unsigned vv[4] = {vreg.x, vreg.y, vreg.z, vreg.w};
#pragma unroll
            for (int e = 0; e < 4; ++e) { vt[(2 * e) * (AV_STR / 2)] = (unsigned short)(vv[e] & 0xffffu); vt[(2 * e + 1) * (AV_STR / 2)] = (unsigned short)(vv[e] >> 16); }
        }
        __syncthreads();
    }
#pragma unroll
    for (int nt = 0; nt < 2; ++nt) { const float inv = 1.0f / lsum[nt]; bf16* orow = Q + (size_t)(qrow0 + 32 * nt + n) * D + h * 64 + (hh ? 8 : 0);
#pragma unroll
        for (int dt = 0; dt < 2; ++dt)
#pragma unroll
            for (int rg = 0; rg < 4; rg += 2) {
                u32x2 a, bq; a.x = pk2(O[dt][nt][4 * rg] * inv, O[dt][nt][4 * rg + 1] * inv); a.y = pk2(O[dt][nt][4 * rg + 2] * inv, O[dt][nt][4 * rg + 3] * inv);
                bq.x = pk2(O[dt][nt][4 * rg + 4] * inv, O[dt][nt][4 * rg + 5] * inv); bq.y = pk2(O[dt][nt][4 * rg + 6] * inv, O[dt][nt][4 * rg + 7] * inv);
                { const auto r0 = __builtin_amdgcn_permlane32_swap(a.x, bq.x, false, false); a.x = r0[0]; bq.x = r0[1]; }
                { const auto r1 = __builtin_amdgcn_permlane32_swap(a.y, bq.y, false, false); a.y = r1[0]; bq.y = r1[1]; }
                *(u32x4*)(orow + 32 * dt + 8 * rg) = (u32x4){a.x, a.y, bq.x, bq.y}; } }
}

template <int d> __device__ __forceinline__ void glaA_unit(const Frame& F, int ie, int b, int c, int h) {
    const bf16* P = (const bf16*)(F.ws + WS_P);
    LAS unsigned char* QS = F.lds + F.wave * 16384; LAS unsigned char* KS = QS + 8192;
    const int lane = F.lane;
    const int row0 = c < 4 ? NLAT + b * CTXL + c * 64 : b * SEQ + (c - 4) * 64;
    const size_t U = (size_t)(b * NCHUNK + c) * 4 + h;
    bf16* gq = (bf16*)(F.ws + WS_GQIN); bf16* gk = (bf16*)(F.ws + WS_GKST); bf16* ga = (bf16*)(F.ws + WS_GATT);
    {
        const size_t UD = U * 2 + d;
        {
            u32x4 qr[8], kr[8];
#pragma unroll
            for (int it = 0; it < 8; ++it) { const int tok = it * 8 + (lane >> 3), ch = lane & 7; const size_t ro = (size_t)(row0 + tok) * EN + h * 64 + ch * 8; qr[it] = *(const u32x4*)(P + ro + PC_QG); kr[it] = *(const u32x4*)(P + ro + PC_KG); }
#pragma unroll
            for (int it = 0; it < 8; ++it) { const int tok = it * 8 + (lane >> 3), ch = lane & 7; const int so = tok * 128 + ((ch ^ (tok & 7)) << 4); *(LAS u32x4*)(QS + so) = qr[it]; *(LAS u32x4*)(KS + so) = kr[it]; }
        }
        const int ln = lane & 31, hh = lane >> 5;
        bf16x8 afr[2], bhi[2], blo[2]; float bav[2];
#pragma unroll
        for (int tt = 0; tt < 2; ++tt) afr[tt] = *(const bf16x8*)(P + (size_t)(row0 + 32 * tt + ln) * EN + PC_GG + 16 * d + 8 * hh);
#pragma unroll
        for (int dt = 0; dt < 2; ++dt) { const float* wp = inptr(F, I_WA2) + (size_t)((ie * 2 + d) * 16 + 8 * hh) * 256 + h * 64 + 32 * dt + ln;
            unsigned hh_[8], ll_[8];
#pragma unroll
            for (int j = 0; j < 8; ++j) { const float v = wp[(size_t)j * 256]; const unsigned hb = pk2(v, 0.f) & 0xffffu; hh_[j] = hb; ll_[j] = pk2(v - __uint_as_float(hb << 16), 0.f) & 0xffffu; }
            bhi[dt] = __builtin_bit_cast(bf16x8, (u32x4){hh_[0] | (hh_[1] << 16), hh_[2] | (hh_[3] << 16), hh_[4] | (hh_[5] << 16), hh_[6] | (hh_[7] << 16)});
            blo[dt] = __builtin_bit_cast(bf16x8, (u32x4){ll_[0] | (ll_[1] << 16), ll_[2] | (ll_[3] << 16), ll_[4] | (ll_[5] << 16), ll_[6] | (ll_[7] << 16)});
            bav[dt] = inptr(F, I_BA)[(ie * 2 + d) * 256 + h * 64 + 32 * dt + ln]; }
        f32x16 G[2][2];
#pragma unroll
        for (int tt = 0; tt < 2; ++tt)
#pragma unroll
            for (int dt = 0; dt < 2; ++dt) { f32x16 z16;
#pragma unroll
                for (int e = 0; e < 16; ++e) z16[e] = 0.f;
                z16 = MFMA32(afr[tt], bhi[dt], z16); G[tt][dt] = MFMA32(afr[tt], blo[dt], z16); }
        asm volatile("s_waitcnt lgkmcnt(0)" ::: "memory");
        float base[2] = {0.f, 0.f};
        int lofs[2][4];
#pragma unroll
        for (int dt = 0; dt < 2; ++dt)
#pragma unroll
            for (int e4 = 0; e4 < 4; ++e4) lofs[dt][e4] = (4 * hh + e4) * 128 + (((4 * dt + (ln >> 3)) ^ (4 * hh + e4)) << 4) + (ln & 7) * 2;
#pragma unroll
        for (int tq = 0; tq < 2; ++tq) { constexpr int dd = d; const int tt = dd ? 1 - tq : tq;
#pragma unroll
            for (int gq_ = 0; gq_ < 4; ++gq_) { const int g4 = dd ? 3 - gq_ : gq_;
                const int tokg = 32 * tt + 8 * g4;
#pragma unroll
                for (int dt = 0; dt < 2; ++dt) {
                    float la[4];
#pragma unroll
                    for (int e4 = 0; e4 < 4; ++e4) { const float g = G[tt][dt][4 * g4 + e4] + bav[dt];
                        la[e4] = (fminf(g, 0.f) * LOG2E - __builtin_amdgcn_logf(1.0f + __builtin_amdgcn_exp2f(-fabsf(g) * LOG2E))) * (1.0f / 16.0f); }
                    float cs[4];
                    if (dd == 0) { cs[0] = la[0]; cs[1] = cs[0] + la[1]; cs[2] = cs[1] + la[2]; cs[3] = cs[2] + la[3]; }
                    else { cs[3] = la[3]; cs[2] = cs[3] + la[2]; cs[1] = cs[2] + la[1]; cs[0] = cs[1] + la[0]; }
                    const float t4 = dd == 0 ? cs[3] : cs[0];
                    const float pt = __shfl_xor(t4, 32);
                    const float off = base[dt] + ((dd == 0 ? hh == 1 : hh == 0) ? pt : 0.f);
                    base[dt] += t4 + pt;
#pragma unroll
                    for (int e4 = 0; e4 < 4; ++e4) { const int so = tokg * 128 + lofs[dt][e4];
                        const float e1 = __builtin_amdgcn_exp2f(off + cs[e4]);
                        const float qi = bf2f(*(const LAS unsigned short*)(QS + so)) * 0.125f * e1, ki = bf2f(*(const LAS unsigned short*)(KS + so)) * __builtin_amdgcn_rcpf(e1);
                        const unsigned short q16 = (unsigned short)(pk2(qi, 0.f) & 0xffffu), k16 = (unsigned short)(pk2(ki, 0.f) & 0xffffu);
                        *(LAS unsigned short*)(QS + so) = q16; *(LAS unsigned short*)(KS + so) = k16; }
                }
            }
        }
        if (hh == 0) { ((float*)(F.ws + WS_GDEC))[UD * 64 + ln] = __builtin_amdgcn_exp2f(base[0]); ((float*)(F.ws + WS_GDEC))[UD * 64 + 32 + ln] = __builtin_amdgcn_exp2f(base[1]); }
        asm volatile("s_waitcnt lgkmcnt(0)" ::: "memory");
        {
            const int cc = lane & 7, dk0 = 32 * (cc >> 2) + 4 * (cc & 3);
#pragma unroll
            for (int it = 0; it < 8; ++it) { const int tok = it * 8 + (lane >> 3);
                const u32x2 lo = *(const LAS u32x2*)(QS + tok * 128 + ((((dk0 >> 3)) ^ (tok & 7)) << 4) + (dk0 & 7) * 2);
                const u32x2 hi = *(const LAS u32x2*)(QS + tok * 128 + ((((dk0 + 16) >> 3) ^ (tok & 7)) << 4) + (dk0 & 7) * 2);
                *(u32x4*)(gq + (UD * 64 + tok) * 64 + 8 * cc) = (u32x4){lo.x, lo.y, hi.x, hi.y};
                *(u32x4*)(gk + (UD * 64 + tok) * 64 + 8 * cc) = *(const LAS u32x4*)(KS + tok * 128 + ((cc ^ (tok & 7)) << 4)); }
        }
        {
            const int n = lane & 15, kg = lane >> 4;
#pragma unroll 1
            for (int I = 0; I < 4; ++I) {
                const int ti = 16 * I + n;
                bf16x8 qf[2];
#pragma unroll
                for (int ks2 = 0; ks2 < 2; ++ks2) qf[ks2] = *(const LAS bf16x8*)(QS + ti * 128 + (((4 * ks2 + kg) ^ (ti & 7)) << 4));
#pragma unroll
                for (int J = 0; J < 4; ++J) { f32x4 acc = (f32x4){0.f, 0.f, 0.f, 0.f};
                    const bool live = d == 0 ? (J <= I) : (J >= I);
                    if (live) {
                        const int tjr = 16 * J + n;
#pragma unroll
                        for (int ks2 = 0; ks2 < 2; ++ks2) { const bf16x8 kf = *(const LAS bf16x8*)(KS + tjr * 128 + (((4 * ks2 + kg) ^ (tjr & 7)) << 4)); acc = MFMA16(kf, qf[ks2], acc); }
#pragma unroll
                        for (int r = 0; r < 4; ++r) { const int tj = 16 * J + 4 * kg + r; const bool keep = d == 0 ? (tj <= ti) : (tj >= ti); if (!keep) acc[r] = 0.f; }
                    }
                    u32x2 ow; ow.x = pk2(acc[0], acc[1]); ow.y = pk2(acc[2], acc[3]);
                    *(u32x2*)(ga + (UD * 64 + ti) * 64 + 16 * J + 4 * kg) = ow; }
            }
        }
        asm volatile("s_waitcnt lgkmcnt(0)" ::: "memory");
    }
}

constexpr int GB_STG = 43008;
__device__ __forceinline__ int glaB_chunk(int d, int step) { return d == 0 ? step : (step < 4 ? 3 - step : 4 + (NCHUNK - 1 - step)); }
__device__ __forceinline__ int swz_k(int r) { return (r & 3) | (((r >> 3) & 1) << 2); }
__device__ __forceinline__ int swz_v(int r) { return ((r & 3) << 2) | ((r >> 2) & 3); }
template <int STAGE> __device__ __forceinline__ void glaB_issue(const Frame& F, int b, int h, int d, int step) {
    const int c = glaB_chunk(d, step);
    const size_t U = (size_t)(b * NCHUNK + c) * 4 + h, UD = U * 2 + d;
    const int row0 = c < 4 ? NLAT + b * CTXL + c * 64 : b * SEQ + (c - 4) * 64;
    const int tid = F.tid, row = tid >> 3, gch = (tid & 7) ^ (row & 7), gchk = (tid & 7) ^ swz_k(row);
    const int vr0 = tid >> 4, vr1 = vr0 + 32, vc0 = (tid & 15) ^ swz_v(vr0), vc1 = (tid & 15) ^ swz_v(vr1);
    LAS unsigned char* st = F.lds + STAGE * GB_STG + F.wave * 1024;
    const char* gq = (const char*)(F.ws + WS_GQIN) + UD * 8192 + row * 128 + gch * 16;
    const char* ga = (const char*)(F.ws + WS_GATT) + UD * 8192 + row * 128 + gch * 16;
    const char* gk = (const char*)(F.ws + WS_GKST) + UD * 8192 + row * 128 + gchk * 16;
    const char* gv = (const char*)(F.ws + WS_P) + (size_t)row0 * (EN * 2) + (PC_VG + h * 128) * 2;
    const char* gdc = (const char*)(F.ws + WS_GDEC) + UD * 256 + F.lane * 4;
    __builtin_amdgcn_global_load_lds((const unsigned*)gq, (LAS unsigned*)(st), 16, 0, 2);
    __builtin_amdgcn_global_load_lds((const unsigned*)ga, (LAS unsigned*)(st + 8192), 16, 0, 2);
    __builtin_amdgcn_global_load_lds((const unsigned*)gk, (LAS unsigned*)(st + 16384), 16, 0, 2);
    __builtin_amdgcn_global_load_lds((const unsigned*)(gv + (size_t)vr0 * (EN * 2) + vc0 * 16), (LAS unsigned*)(st + 24576), 16, 0, 2);
    __builtin_amdgcn_global_load_lds((const unsigned*)(gv + (size_t)vr1 * (EN * 2) + vc1 * 16), (LAS unsigned*)(st + 24576 + 8192), 16, 0, 2);
    __builtin_amdgcn_global_load_lds((const unsigned*)gdc, (LAS unsigned*)(F.lds + STAGE * GB_STG + 40960 + F.wave * 256), 4, 0, 2);
}
template <int ROWB, class SWZ> __device__ __forceinline__ bf16x8 gb_frag_tr(const LAS unsigned char* tile, int lane, int c, int ks, SWZ swz) {
    const int g = lane >> 4, q = (lane & 15) >> 2, p = lane & 3;
    const int r0 = 32 * ks + 8 * g + q, r1 = r0 + 4;
    const s16x4 lo = __builtin_amdgcn_ds_read_tr16_b64_v4i16((LAS s16x4*)(tile + ROWB * r0 + 16 * ((2 * c + (p >> 1)) ^ swz(r0)) + 8 * (p & 1)));
    const s16x4 hi = __builtin_amdgcn_ds_read_tr16_b64_v4i16((LAS s16x4*)(tile + ROWB * r1 + 16 * ((2 * c + (p >> 1)) ^ swz(r1)) + 8 * (p & 1)));
    return __builtin_shufflevector(lo, hi, 0, 1, 2, 3, 4, 5, 6, 7);
}
__device__ __forceinline__ bf16x8 gb_frag(const LAS unsigned char* tile, int row, int ch) { return *(const LAS bf16x8*)(tile + (row * 8 + (ch ^ (row & 7))) * 16); }
template <int STAGE> __device__ __forceinline__ void glaB_step(const Frame& F, int b, int h, int d, int step, f32x4 (&S)[4], bf16* od) {
    const int lane = F.lane, n = lane & 15, kg = lane >> 4, sl = F.wave;
    if (step == 0) asm volatile("s_waitcnt vmcnt(6)" ::: "memory"); else if (step == 1) asm volatile("s_waitcnt vmcnt(10)" ::: "memory"); else asm volatile("s_waitcnt vmcnt(14)" ::: "memory");
    __builtin_amdgcn_s_barrier();
    asm volatile("" ::: "memory");
    glaB_issue<(STAGE + 2) % 3>(F, b, h, d, step + 2 < NCHUNK ? step + 2 : NCHUNK - 1);
    asm volatile("" ::: "memory");
    const int c = glaB_chunk(d, step);
    const int row0 = c < 4 ? NLAT + b * CTXL + c * 64 : b * SEQ + (c - 4) * 64;
    const LAS unsigned char* st = F.lds + STAGE * GB_STG;
    bf16x8 vf[2], qf[4][2], af[4][2], kf[4][2]; f32x4 dc[4];
#pragma unroll
    for (int I = 0; I < 4; ++I)
#pragma unroll
        for (int T = 0; T < 2; ++T) { qf[I][T] = gb_frag(st, 16 * I + n, 4 * T + kg); af[I][T] = gb_frag(st + 8192, 16 * I + n, 4 * T + kg); }
#pragma unroll
    for (int q = 0; q < 4; ++q) dc[q] = *(const LAS f32x4*)(st + 40960 + sl * 256 + (16 * q + 4 * kg) * 4);
    {
        const int g_ = lane >> 4, q_ = (lane & 15) >> 2, p_ = lane & 3, r0_ = 8 * g_ + q_;
        const unsigned sb_ = (unsigned)(size_t)(F.lds + STAGE * GB_STG);
        const unsigned av0 = sb_ + 24576u + 256u * r0_ + 16u * ((2 * sl + (p_ >> 1)) ^ swz_v(r0_)) + 8u * (p_ & 1), av1 = sb_ + 24576u + 256u * (r0_ + 4) + 16u * ((2 * sl + (p_ >> 1)) ^ swz_v(r0_ + 4)) + 8u * (p_ & 1);
        unsigned ak[4];
#pragma unroll
        for (int I = 0; I < 4; ++I) ak[I] = sb_ + 16384u + 128u * r0_ + 16u * ((2 * I + (p_ >> 1)) ^ swz_k(r0_)) + 8u * (p_ & 1);
        u32x2 t[20];
        asm volatile(
            "ds_read_b64_tr_b16 %0, %20\n\tds_read_b64_tr_b16 %1, %21\n\tds_read_b64_tr_b16 %2, %20 offset:8192\n\tds_read_b64_tr_b16 %3, %21 offset:8192\n\t"
            "ds_read_b64_tr_b16 %4, %22\n\tds_read_b64_tr_b16 %5, %22 offset:512\n\tds_read_b64_tr_b16 %6, %22 offset:4096\n\tds_read_b64_tr_b16 %7, %22 offset:4608\n\t"
            "ds_read_b64_tr_b16 %8, %23\n\tds_read_b64_tr_b16 %9, %23 offset:512\n\tds_read_b64_tr_b16 %10, %23 offset:4096\n\tds_read_b64_tr_b16 %11, %23 offset:4608\n\t"
            "ds_read_b64_tr_b16 %12, %24\n\tds_read_b64_tr_b16 %13, %24 offset:512\n\tds_read_b64_tr_b16 %14, %24 offset:4096\n\tds_read_b64_tr_b16 %15, %24 offset:4608\n\t"
            "ds_read_b64_tr_b16 %16, %25\n\tds_read_b64_tr_b16 %17, %25 offset:512\n\tds_read_b64_tr_b16 %18, %25 offset:4096\n\tds_read_b64_tr_b16 %19, %25 offset:4608\n\t"
            "s_waitcnt lgkmcnt(0)"
            : "=&v"(t[0]), "=&v"(t[1]), "=&v"(t[2]), "=&v"(t[3]), "=&v"(t[4]), "=&v"(t[5]), "=&v"(t[6]), "=&v"(t[7]), "=&v"(t[8]), "=&v"(t[9]),
              "=&v"(t[10]), "=&v"(t[11]), "=&v"(t[12]), "=&v"(t[13]), "=&v"(t[14]), "=&v"(t[15]), "=&v"(t[16]), "=&v"(t[17]), "=&v"(t[18]), "=&v"(t[19])
            : "v"(av0), "v"(av1), "v"(ak[0]), "v"(ak[1]), "v"(ak[2]), "v"(ak[3]) : "memory");
#pragma unroll
        for (int T = 0; T < 2; ++T) vf[T] = __builtin_bit_cast(bf16x8, (u32x4){t[2 * T].x, t[2 * T].y, t[2 * T + 1].x, t[2 * T + 1].y});
#pragma unroll
        for (int I = 0; I < 4; ++I)
#pragma unroll
            for (int T = 0; T < 2; ++T) kf[I][T] = __builtin_bit_cast(bf16x8, (u32x4){t[4 + 4 * I + 2 * T].x, t[4 + 4 * I + 2 * T].y, t[4 + 4 * I + 2 * T + 1].x, t[4 + 4 * I + 2 * T + 1].y});
    }
    bf16x8 sb[2];
#pragma unroll
    for (int G2 = 0; G2 < 2; ++G2) { u32x4 sw; sw.x = pk2(S[2 * G2][0], S[2 * G2][1]); sw.y = pk2(S[2 * G2][2], S[2 * G2][3]); sw.z = pk2(S[2 * G2 + 1][0], S[2 * G2 + 1][1]); sw.w = pk2(S[2 * G2 + 1][2], S[2 * G2 + 1][3]); sb[G2] = __builtin_bit_cast(bf16x8, sw); }
    asm volatile("s_waitcnt lgkmcnt(0)" ::: "memory");
    f32x4 o[4];
#pragma unroll
    for (int I = 0; I < 4; ++I) o[I] = (f32x4){0.f, 0.f, 0.f, 0.f};
#pragma unroll
    for (int I = 0; I < 4; ++I) o[I] = MFMA16(sb[0], qf[I][0], o[I]);
#pragma unroll
    for (int I = 0; I < 4; ++I) o[I] = MFMA16(sb[1], qf[I][1], o[I]);
#pragma unroll
    for (int q = 0; q < 4; ++q) S[q] = MFMA16(kf[q][0], vf[0], S[q]);
#pragma unroll
    for (int I = 0; I < 4; ++I) o[I] = MFMA16(vf[0], af[I][0], o[I]);
#pragma unroll
    for (int q = 0; q < 4; ++q) S[q] = MFMA16(kf[q][1], vf[1], S[q]);
#pragma unroll
    for (int I = 0; I < 4; ++I) o[I] = MFMA16(vf[1], af[I][1], o[I]);
#pragma unroll
    for (int q = 0; q < 4; ++q) S[q] = S[q] * dc[q];
    u32x2 ow[4];
#pragma unroll
    for (int I = 0; I < 4; ++I) { ow[I].x = pk2(o[I][0], o[I][1]); ow[I].y = pk2(o[I][2], o[I][3]); }
    asm volatile("s_waitcnt lgkmcnt(0)" ::: "memory");
#pragma unroll
    for (int I = 0; I < 4; ++I) *(u32x2*)(od + (size_t)(row0 + 16 * I + n) * 512 + h * 128 + 16 * sl + 4 * kg) = ow[I];
    asm volatile("" ::: "memory");
}
__device__ __forceinline__ void glaB_group(const Frame& F, int cg) {
    const int d = cg & 1, h = (cg >> 1) & 3, b = cg >> 3;
    bf16* od = (bf16*)(F.ws + WS_U) + (size_t)d * NTOK * 512;
    f32x4 S[4];
#pragma unroll
    for (int q = 0; q < 4; ++q) S[q] = (f32x4){0.f, 0.f, 0.f, 0.f};
    asm volatile("s_waitcnt vmcnt(0) lgkmcnt(0)" ::: "memory");
    __builtin_amdgcn_s_barrier();
    asm volatile("" ::: "memory");
    glaB_issue<0>(F, b, h, d, 0); glaB_issue<1>(F, b, h, d, 1);
    asm volatile("" ::: "memory");
    for (int s0 = 0; s0 + 2 < NCHUNK; s0 += 3) { glaB_step<0>(F, b, h, d, s0, S, od); glaB_step<1>(F, b, h, d, s0 + 1, S, od); glaB_step<2>(F, b, h, d, s0 + 2, S, od); }
    glaB_step<0>(F, b, h, d, 66, S, od); glaB_step<1>(F, b, h, d, 67, S, od);
    static_assert(NCHUNK == 68, "tail of the step loop");
    asm volatile("s_waitcnt vmcnt(0)" ::: "memory");
    __builtin_amdgcn_s_barrier();
}
__device__ __forceinline__ void conv_moe_dynamic(const Frame& F0, int l) {
    Frame F = relaunder(F0);
    LAS float* scr = (LAS float*)(F.lds + F.wave * 16384);
    unsigned* ctr = (unsigned*)(F.ws + WS_CTL) + CW_WQ + l * 64;
    constexpr int I_13 = 16 * 32, I_2 = 8 * 32, NIT = NEXP * (I_13 + I_2), CH = 8;
    for (;;) {
        unsigned t0 = 0; if (F.lane == 0) t0 = atomicAdd(ctr, (unsigned)CH);
        const int it0 = __builtin_amdgcn_readfirstlane((int)t0);
        if (it0 >= NIT) break;
        for (int it = it0; it < it0 + CH && it < NIT; ++it) conv_moe_item(F, l, it, scr);
    }
}

__device__ __forceinline__ void ph_combine(const Frame& F0, int ie, int nrows) {
    Frame F = relaunder(F0);
    const int gw = F.vcu * 8 + F.wave, NGW = F.G * 8, lane = F.lane;
    const bf16* P = (const bf16*)(F.ws + WS_P); bf16* Q = (bf16*)(F.ws + WS_Q);
    const bf16* o0 = (const bf16*)(F.ws + WS_U); const bf16* o1 = o0 + (size_t)NTOK * 512;
    const float* nw = inptr(F, I_NORMW) + (size_t)ie * 512;
    const int col = 8 * lane;
    const f32x4 nwa = *(const f32x4*)(nw + col), nwb = *(const f32x4*)(nw + col + 4);
    for (int r0 = gw * 4; r0 < nrows; r0 += NGW * 4) {
        if (KO_MASK & 2) {
#pragma unroll
            for (int r = 0; r < 4; ++r) *(u32x4*)(Q + (size_t)(r0 + r) * D + 512 + col) = (u32x4){0u, 0u, 0u, 0u};
            continue; }
        u32x4 a[4], bq[4], rr[4];
#pragma unroll
        for (int r = 0; r < 4; ++r) { const size_t row = r0 + r; a[r] = __builtin_nontemporal_load((const u32x4*)(o0 + row * 512 + col)); bq[r] = __builtin_nontemporal_load((const u32x4*)(o1 + row * 512 + col)); rr[r] = __builtin_nontemporal_load((const u32x4*)(P + row * EN + PC_RG + col)); }
#pragma unroll
        for (int r = 0; r < 4; ++r) {
            const f32x4 xa = ubf_lo(a[r]) + ubf_lo(bq[r]), xb = ubf_hi(a[r]) + ubf_hi(bq[r]);
            float ss = (xa[0] * xa[0] + xa[1] * xa[1]) + (xa[2] * xa[2] + xa[3] * xa[3]) + (xb[0] * xb[0] + xb[1] * xb[1]) + (xb[2] * xb[2] + xb[3] * xb[3]);
            ss = row16_sum(ss);
            const float rinv = 1.0f / sqrtf(ss * (1.0f / 128.0f) + RMS_EPS);
            f32x4 ra = ubf_lo(rr[r]), rb = ubf_hi(rr[r]);
#pragma unroll
            for (int j = 0; j < 4; ++j) { ra[j] = fast_silu(ra[j]); rb[j] = fast_silu(rb[j]); }
            *(u32x4*)(Q + (size_t)(r0 + r) * D + 512 + col) = pack8(xa * rinv * nwa * ra, xb * rinv * nwb * rb); }
    }
}

#if defined(FP8_PROBE)
typedef int i32x8 __attribute__((ext_vector_type(8)));
__device__ __forceinline__ unsigned fp8_of_int(int v) { const int a = v < 0 ? -v : v; const unsigned c = a == 0 ? 0x00u : a == 1 ? 0x38u : a == 2 ? 0x40u : 0x44u; return v < 0 ? (c | 0x80u) : c; }
__device__ __forceinline__ int fp8_kidx(int kg, int e) { return FP8_PROBE == 1 ? 32 * kg + e : (e < 16 ? 16 * kg + e : 64 + 16 * kg + (e - 16)); }
__device__ __forceinline__ bool fp8_layout_test(int lane) {
    const int r = lane & 15, kg = lane >> 4;
    i32x8 a, b;
#pragma unroll
    for (int w = 0; w < 8; ++w) { unsigned aw = 0, bw = 0;
#pragma unroll
        for (int by = 0; by < 4; ++by) { const int k = fp8_kidx(kg, 4 * w + by);
            const int av = (k == (7 * r + 3) % 128) ? 1 : 0; const int bv = ((k * 5 + r * 3) % 7) - 3;
            aw |= fp8_of_int(av) << (8 * by); bw |= fp8_of_int(bv) << (8 * by); }
        a[w] = (int)aw; b[w] = (int)bw; }
    f32x4 c = (f32x4){0.f, 0.f, 0.f, 0.f};
    c = __builtin_amdgcn_mfma_scale_f32_16x16x128_f8f6f4(a, b, c, 0, 0, 0, 0, 0, 0);
    bool bad = false;
#pragma unroll
    for (int q = 0; q < 4; ++q) { const int i = 4 * kg + q; const int kk = (7 * i + 3) % 128; const float ex = (float)(((kk * 5 + r * 3) % 7) - 3); if (c[q] != ex) bad = true; }
    return __builtin_amdgcn_ballot_w64(bad) != 0ull;
}
#endif
struct Args { const float* in[25]; float* out; unsigned char* ws; int ph_lo, ph_hi; };
constexpr int NPHASE = 2 + 9 * DEPTH;

__global__ void __launch_bounds__(512, 2) fwd(Args args) {
    extern __shared__ __attribute__((aligned(16))) unsigned char lds_raw[];
    Frame F;
    F.lds = (LAS unsigned char*)lds_raw;
    F.tid = threadIdx.x; F.lane = F.tid & 63; F.wave = __builtin_amdgcn_readfirstlane(F.tid >> 6);
    F.G = gridDim.x; { const int bx = blockIdx.x; F.vcu = (F.G % 8 == 0) ? (bx % 8) * (F.G / 8) + bx / 8 : bx; }
    F.out = args.out; F.ws = args.ws;
    volatile LAS unsigned* MISC = (volatile LAS unsigned*)(F.lds + MISC_OFF);
    if (F.tid < 64) MISC[F.tid] = 0u;
    if (F.tid < 25) ((LAS unsigned long long*)(F.lds + MISC_OFF + 256))[F.tid] = (unsigned long long)args.in[F.tid];
    __syncthreads();
    const int lo = args.ph_lo, hi = args.ph_hi;
    const bool multi = (hi - lo) > 1;
    XcdBarrier bar; bar.bar = (unsigned*)(F.ws + WS_CTL) + CW_BAR; bar.x = 0; bar.st = MISC + 8;
    if (multi) bar = xcd_barrier_post((unsigned*)(F.ws + WS_CTL) + CW_BAR, MISC + 8);
#ifndef PH_SEL
#define PH_SEL 0xffffffff
#endif
#define IN(k) (lo <= (k) && (k) < hi)
#define SEL(b) ((PH_SEL >> (b)) & 1)
#ifndef DUP_MASK
#define DUP_MASK 0
#endif
#define REP(bit) for (int rep_ = 0; rep_ < ((DUP_MASK & (bit)) ? 2 : 1); ++rep_)
#ifndef STAG_IN
#define STAG_IN 0
#endif
#define SKIPE (((DUP_MASK & 512) && rep_ > 0) ? launder_s(1) : 0)
#define SEAM(k) do { if ((k) + 1 < hi) xcd_barrier(bar); } while (0)

    if (SEL(0) && IN(0)) { REP(64) { ph_ada(F); __syncthreads(); conv_dense_weights(F); __syncthreads(); } SEAM(0); }
    if (SEL(1) && IN(1)) { REP(64) { ph_u0(F); __syncthreads(); } SEAM(1); }

    constexpr int ATT_S1 = NB * 2 * 32 * 3 / 4;
    for (int l = 0; l < DEPTH; ++l) {
        const int pb = 2 + 9 * l; const bool even = (l & 1) == 0; const int ie = l >> 1;
        const int m_in = (l < 3) ? NTOK : NLAT;
        const int m_out = (l < 2) ? NTOK : NLAT;
        if (SEL(2) && IN(pb + 0)) {
            REP(32) { if (even) {
                LinSched S; S.init(m_in, EN, 1024, F.G, (int)blockIdx.x);
                LAS float* rc = (LAS float*)(F.lds + LDSX_OFF + 3072); LAS float* rs = (LAS float*)(F.lds + MISC_OFF + 512);
                { const Frame Fm = relaunder(F); const float* rope = (const float*)(Fm.ws + WS_ROPE); if (Fm.tid < 256) { *(LAS f32x4*)(rc + 4 * Fm.tid) = *(const f32x4*)(rope + 4 * Fm.tid); *(LAS f32x4*)(rs + 4 * Fm.tid) = *(const f32x4*)(rope + 1024 + 4 * Fm.tid); } }
                __syncthreads();
                EpiEvenIn E{(bf16*)(F.ws + WS_P), rc, rs};
                pg8::gemm_phase(F.lds, (const char*)(F.ws + WS_U), (const char*)(F.ws + WS_WINE) + (size_t)ie * EN * 1024 * 2, 1024, S, E, SKIPE, STAG_IN);
            } else {
                LinSched S; S.init(m_in, ON, 1024, F.G, (int)blockIdx.x);
                EpiOddIn E{(bf16*)(F.ws + WS_P)};
                pg8::gemm_phase(F.lds, (const char*)(F.ws + WS_U), (const char*)(F.ws + WS_WINO) + (size_t)ie * ON * 1024 * 2, 1024, S, E, SKIPE, STAG_IN);
            } }
            SEAM(pb + 0);
        }
        if (SEL(3) && IN(pb + 1)) {
            if (even) {
                const Frame Fm = relaunder(F);
                const int nun = ATT_S1;
                REP(1) for (int u = Fm.vcu; u < nun; u += Fm.G) {
                    if (u < NB * 2 * 32) attn_unit(Fm, ie, u >> 6, (u >> 5) & 1, u & 31, false);
                    else { const int v = u - NB * 2 * 32; attn_unit(Fm, ie, v >> 2, (v >> 1) & 1, v & 1, true); }
                }
                __syncthreads();
                if (!(KO_MASK & 2)) REP(2) for (int u = Fm.vcu * 8 + Fm.wave; u < NB * NCHUNK * 8; u += Fm.G * 8) { if (u & 1) glaA_unit<1>(Fm, ie, u / (NCHUNK * 8), (u / 8) % NCHUNK, (u >> 1) & 3); else glaA_unit<0>(Fm, ie, u / (NCHUNK * 8), (u / 8) % NCHUNK, (u >> 1) & 3); }
                __syncthreads();
            } else {
                REP(16) { ph_conv(F, ie, m_out); __syncthreads(); }
                if (m_out == NLAT) { conv_moe_weights(F, l); __syncthreads(); }
            }
            SEAM(pb + 1);
        }
        if (even) {
            if (SEL(4) && IN(pb + 2)) {
                { const Frame Fm = relaunder(F);
                  if (!(KO_MASK & 2)) REP(4) for (int cg = Fm.vcu; cg < 128; cg += Fm.G) glaB_group(Fm, cg);
                  if (Fm.vcu >= 128) {
                      const int nun = NB * 2 * 32 + (l == 0 ? NB * 2 * 2 : 0);
                      for (int u = ATT_S1 + Fm.vcu - 128; u < nun; u += Fm.G - 128) {
                          if (u < NB * 2 * 32) attn_unit(Fm, ie, u >> 6, (u >> 5) & 1, u & 31, false);
                          else { const int v = u - NB * 2 * 32; attn_unit(Fm, ie, v >> 2, (v >> 1) & 1, v & 1, true); }
                      }
                  }
                  __syncthreads();
                  conv_moe_dynamic(Fm, l); }
                SEAM(pb + 2);
            }
            if (SEL(5) && IN(pb + 3)) { REP(16) { ph_combine(F, ie, m_out); __syncthreads(); } SEAM(pb + 3); }
        }
        if (SEL(6) && IN(pb + 4)) {
            REP(32) { LinSched S; S.init(m_out, 1024, 1024, F.G, (int)blockIdx.x);
            EpiPlain E{(bf16*)(F.ws + WS_P), 1024};
            pg8::gemm_phase(F.lds, (const char*)(F.ws + WS_Q), (const char*)(F.ws + (even ? WS_WOUTE : WS_WOUTO)) + (size_t)ie * 1024 * 1024 * 2, 1024, S, E, SKIPE); }
            if (!even && m_out != NLAT) { __syncthreads(); conv_moe_dynamic(F, l); __syncthreads(); }
            SEAM(pb + 4);
        }
        if (SEL(7) && IN(pb + 5)) { if (DUP_MASK & 128) { ph_ln1(F, l, m_out, true); __syncthreads(); } ph_ln1(F, l, m_out); SEAM(pb + 5); }
        if (SEL(8) && IN(pb + 6)) {
            if (!(KO_MASK & 8)) REP(32) {
                moe_tables(F.lds, (const unsigned*)(F.ws + WS_CTL) + CW_CNT + l * 64);
                MoeSched<1> S; S.T = moe_tab(F.lds); S.rowtok = (const int*)(F.ws + WS_ROWTOK); S.G = F.G; S.c = F.vcu; S.bstride = (size_t)256 * 1024; S.estride = (size_t)1024 * 1024;
                EpiG1 E{(unsigned char*)(F.ws + WS_Q), 1.0f / W8_SCALE};
                pg8::gemm_phase<EpiG1, MoeSched<1>, 1>(F.lds, (const char*)(F.ws + WS_U8), (const char*)(F.ws + WS_W13), 1024, S, E, SKIPE);
            }
            SEAM(pb + 6);
        }
        if (SEL(9) && IN(pb + 7)) {
            if (!(KO_MASK & 8)) REP(32) {
                if (!IN(pb + 6) || (KO_MASK & 8)) moe_tables(F.lds, (const unsigned*)(F.ws + WS_CTL) + CW_CNT + l * 64);
                MoeSched<0> S; S.T = moe_tab(F.lds); S.rowtok = nullptr; S.G = F.G; S.c = F.vcu; S.bstride = (size_t)256 * 512; S.estride = (size_t)1024 * 512;
                EpiOut8 E{(unsigned char*)(F.ws + WS_P), OUT8_SCALE / W8_SCALE};
                pg8::gemm_phase<EpiOut8, MoeSched<0>, 1>(F.lds, (const char*)(F.ws + WS_Q), (const char*)(F.ws + WS_W2), 512, S, E, SKIPE);
            }
            SEAM(pb + 7);
        }
        if (SEL(10) && IN(pb + 8)) {
            if (!IN(pb + 6) || (KO_MASK & 8)) moe_tables(F.lds, (const unsigned*)(F.ws + WS_CTL) + CW_CNT + l * 64);
            if (DUP_MASK & 256) { ph_ln2(F, l, m_out, true); __syncthreads(); }
            ph_ln2(F, l, m_out);
            SEAM(pb + 8);
        }
    }
#if defined(FP8_PROBE)
    if (blockIdx.x == 0) { __syncthreads(); if (F.tid < 64) { const bool bad = fp8_layout_test(F.tid); if (bad && F.tid == 0) F.out[0] = __builtin_nanf(""); } }
#endif
#undef IN
#undef SEAM
}

extern "C" void kernel_launch(void* const* d_in, const int* in_sizes, int n_in, void* d_out, int out_size, void* d_ws, size_t ws_size, hipStream_t stream) {
    static int grid = 0;
    if (grid == 0) {
        if (n_in != 25 || in_sizes[0] != NLAT * D || out_size != NLAT * D || ws_size < WS_END) { fprintf(stderr, "kernel_launch: unexpected shapes (n_in %d in0 %d out %d ws %zu)\n", n_in, n_in > 0 ? in_sizes[0] : -1, out_size, ws_size); grid = -1; return; }
        int dev = 0, cus = 0, per_cu = 0;
        if (hipGetDevice(&dev) != hipSuccess || hipDeviceGetAttribute(&cus, hipDeviceAttributeMultiprocessorCount, dev) != hipSuccess) { grid = -1; return; }
        if (hipFuncSetAttribute((const void*)fwd, hipFuncAttributeMaxDynamicSharedMemorySize, LDS_BYTES) != hipSuccess) { fprintf(stderr, "kernel_launch: hipFuncSetAttribute failed\n"); grid = -1; return; }
        if (hipOccupancyMaxActiveBlocksPerMultiprocessor(&per_cu, (const void*)fwd, 512, LDS_BYTES) != hipSuccess || per_cu < 1) fprintf(stderr, "kernel_launch: occupancy query says %d\n", per_cu);
        (void)hipGetLastError();
        grid = cus;
        if (grid < 242 || grid > 1024) { fprintf(stderr, "kernel_launch: built for a 256-CU device (got %d CUs)\n", cus); grid = -1; return; }
    }
    if (grid < 0) return;
    if (hipMemsetAsync((char*)d_ws + WS_CTL, 0, CTL_BYTES, stream) != hipSuccess) return;
    Args a{};
    for (int i = 0; i < 25; ++i) a.in[i] = (const float*)d_in[i];
    a.out = (float*)d_out; a.ws = (unsigned char*)d_ws;
#if N_LAUNCH_MODE == 1
    a.ph_lo = 0; a.ph_hi = NPHASE;
    hipLaunchKernelGGL(fwd, dim3(grid), dim3(512), LDS_BYTES, stream, a);
#else
    for (int k = 0; k < NPHASE; ++k) {
        if (k >= 2) { const int l = (k - 2) / 9, s = (k - 2) % 9; if ((l & 1) && (s == 2 || s == 3)) continue; }
        a.ph_lo = k; a.ph_hi = k + 1;
        hipLaunchKernelGGL(fwd, dim3(grid), dim3(512), LDS_BYTES, stream, a);
    }
#endif
}
```

```cpp
#include <hip/hip_runtime.h>
#define N_LAUNCH_MODE 1
#define KO_MASK 0
#define DUP_MASK 0
#include <cstdio>
#include <cstdint>

#ifndef KO_MASK
#define KO_MASK 0
#endif
#ifndef N_LAUNCH_MODE
#define N_LAUNCH_MODE 1
#endif

#define GAS __attribute__((address_space(1)))
#define LAS __attribute__((address_space(3)))
typedef unsigned short bf16;
typedef short bf16x8 __attribute__((ext_vector_type(8)));
typedef short s16x4 __attribute__((ext_vector_type(4)));
typedef float f32x2 __attribute__((ext_vector_type(2)));
typedef float f32x4 __attribute__((ext_vector_type(4)));
typedef float f32x16 __attribute__((ext_vector_type(16)));
typedef unsigned u32x2 __attribute__((ext_vector_type(2)));
typedef unsigned u32x4 __attribute__((ext_vector_type(4)));
typedef __bf16 bf16x2_t __attribute__((ext_vector_type(2)));
typedef int i32x8 __attribute__((ext_vector_type(8)));
typedef int i32x4_t __attribute__((ext_vector_type(4)));

constexpr int D = 1024, NB = 16, SEQ = 4096, CTXL = 256, DEPTH = 4;
constexpr int NLAT = NB * SEQ, NCTX = NB * CTXL, NTOK = NLAT + NCTX;
constexpr int EVEN_IN = 2336, EN = 2560, ON = 3072;
constexpr int NEXP = 32, DEXP = 512;
constexpr int SLOT_ROWS = 2 * NTOK + NEXP * 256;
constexpr float DN_ALPHA = 1.6817928305074290f;
constexpr float LN_EPS = 1e-5f, RMS_EPS = 1e-6f;
constexpr float LOG2E = 1.4426950408889634f;
constexpr int PC_Q = 0, PC_K = 512, PC_V = 640, PC_QG = 768, PC_KG = 1024, PC_VG = 1280, PC_RG = 1792, PC_GG = 2304;
constexpr int NCHUNK = 68;

constexpr size_t MiB = 1u << 20;
constexpr size_t WS_CTL = 0, CTL_BYTES = 1 * MiB;
constexpr size_t WS_MOD = 1 * MiB;
constexpr size_t WS_ROPE = 3 * MiB;
constexpr size_t WS_TOKINFO = 4 * MiB;
constexpr size_t WS_ROWTOK = 7 * MiB;
constexpr size_t WS_WINE = 16 * MiB, WS_WOUTE = 26 * MiB, WS_WINO = 30 * MiB, WS_WOUTO = 42 * MiB;
constexpr size_t WS_W13 = 46 * MiB, WS_W2 = 110 * MiB;
constexpr size_t WS_HCTX = 142 * MiB;
constexpr size_t WS_U = 158 * MiB;
constexpr size_t WS_P = 294 * MiB;
constexpr size_t WS_Q = 634 * MiB;
constexpr size_t WS_GATT = 778 * MiB, WS_GQIN = 846 * MiB, WS_GKST = 914 * MiB, WS_GVT = 982 * MiB, WS_GDEC = 1050 * MiB;
constexpr size_t WS_U8 = 1053 * MiB;
constexpr size_t WS_END = 1121 * MiB;
constexpr int CW_BAR = 4096;
constexpr int CW_CNT = 32768;
constexpr int MOE_CSTR = 1088;
constexpr int MOE_NG = 8, MOE_RCAP = 9216;
constexpr int CW_WQ = 20480;

constexpr int RING_BYTES = 131072;
constexpr int LDSX_OFF = RING_BYTES;
constexpr int MISC_OFF = LDSX_OFF + 8192;
constexpr int LDS_BYTES = 147456;

__device__ __forceinline__ unsigned pk2(float a, float b) { bf16x2_t r = __builtin_convertvector((f32x2){a, b}, bf16x2_t); return __builtin_bit_cast(unsigned, r); }
__device__ __forceinline__ unsigned pk4_fp8(float a, float b, float c, float d) { int r = __builtin_amdgcn_cvt_pk_fp8_f32(a, b, 0, false); r = __builtin_amdgcn_cvt_pk_fp8_f32(c, d, r, true); return (unsigned)r; }
__device__ __forceinline__ float bf2f(unsigned short h) { return __uint_as_float(((unsigned)h) << 16); }
__device__ __forceinline__ f32x4 unpk4_fp8(unsigned w) { const f32x2 lo = __builtin_amdgcn_cvt_pk_f32_fp8((int)w, false), hi = __builtin_amdgcn_cvt_pk_f32_fp8((int)w, true); return (f32x4){lo.x, lo.y, hi.x, hi.y}; }
__device__ __forceinline__ float bflo(unsigned w) { return __uint_as_float(w << 16); }
__device__ __forceinline__ float bfhi(unsigned w) { return __uint_as_float(w & 0xffff0000u); }
template <int CTRL> __device__ __forceinline__ float dppf(float v) { return __builtin_bit_cast(float, __builtin_amdgcn_update_dpp(0, __builtin_bit_cast(int, v), CTRL, 0xf, 0xf, false)); }
__device__ __forceinline__ float row16_sum(float v) { v += dppf<0xB1>(v); v += dppf<0x4E>(v); v += dppf<0x141>(v); v += dppf<0x140>(v); return v; }
__device__ __forceinline__ float wave_sum(float v) {
    v = row16_sum(v);
    const float s0 = __builtin_bit_cast(float, __builtin_amdgcn_readlane(__builtin_bit_cast(int, v), 0)), s1 = __builtin_bit_cast(float, __builtin_amdgcn_readlane(__builtin_bit_cast(int, v), 16));
    const float s2 = __builtin_bit_cast(float, __builtin_amdgcn_readlane(__builtin_bit_cast(int, v), 32)), s3 = __builtin_bit_cast(float, __builtin_amdgcn_readlane(__builtin_bit_cast(int, v), 48));
    return (s0 + s1) + (s2 + s3);
}
__device__ __forceinline__ float fast_silu(float x) { return x * __builtin_amdgcn_rcpf(1.0f + __builtin_amdgcn_exp2f(-x * LOG2E)); }

#define XB_TMO      128
#define XB_XCNT(j)  (256  + 64 * (j))
#define XB_XSUB(j)  (1280 + 64 * (j))
#define XB_XGEN(j)  (2304 + 64 * (j))
#define XB_TOP      3328
#define XB_TOPGEN   3392
#define XCD_BAR_WORDS 3456
#define XB_SPIN_CAP (1u << 22)
__device__ __forceinline__ unsigned xb_ld(unsigned* p)              { return __hip_atomic_load(p, __ATOMIC_RELAXED, __HIP_MEMORY_SCOPE_AGENT); }
__device__ __forceinline__ unsigned xb_add(unsigned* p, unsigned v) { return __hip_atomic_fetch_add(p, v, __ATOMIC_RELAXED, __HIP_MEMORY_SCOPE_AGENT); }
__device__ __forceinline__ unsigned xb_xcc_id() { return (unsigned)__builtin_amdgcn_s_getreg((3 << 11) | 20) & 0xFu; }
#define XB_SPIN(cond, bar) do { unsigned _sp = 0; while (cond) { __builtin_amdgcn_s_sleep(1); \
    if ((++_sp & 255u) == 0u) { if (xb_ld(&(bar)[XB_TMO])) break; if (_sp > XB_SPIN_CAP) { atomicAdd(&(bar)[XB_TMO], 1u); break; } } } } while (0)
struct XcdBarrier { unsigned* bar; unsigned x; volatile LAS unsigned* st; };
__device__ __forceinline__ XcdBarrier xcd_barrier_post(unsigned* bar, volatile LAS unsigned* st) {
    XcdBarrier b; b.bar = bar; b.x = xb_xcc_id(); b.st = st;
    if (threadIdx.x == 0) (void)xb_add(&bar[XB_XCNT(b.x)], 1u);
    return b;
}
__device__ __forceinline__ void xcd_barrier_complete(unsigned* bar, unsigned x, unsigned& nloc, unsigned& nx) {
    const unsigned G = gridDim.x * gridDim.y * gridDim.z;
    unsigned sum, cnt, mine, sp = 0u;
    for (;;) {
        sum = 0u; cnt = 0u; mine = 0u;
#pragma unroll
        for (unsigned j = 0; j < 16; ++j) { const unsigned c = xb_ld(&bar[XB_XCNT(j)]); sum += c; cnt += (c > 0u) ? 1u : 0u; mine = (j == x) ? c : mine; }
        if (sum == G) break;
        __builtin_amdgcn_s_sleep(1);
        if ((++sp & 255u) == 0u) { if (xb_ld(&bar[XB_TMO])) break; if (sp > XB_SPIN_CAP) { atomicAdd(&bar[XB_TMO], 1u); break; } }
    }
    nloc = mine > 0u ? mine : 1u; nx = cnt > 0u ? cnt : 1u;
}
__device__ __forceinline__ void xcd_barrier(const XcdBarrier& b) {
    asm volatile("s_waitcnt vmcnt(0)" ::: "memory");
    __syncthreads();
    if (threadIdx.x == 0) {
        unsigned* bar = b.bar;
        __builtin_amdgcn_s_waitcnt(0);
        unsigned nloc = b.st[0], nx = b.st[1];
        if (nloc == 0u) { xcd_barrier_complete(bar, b.x, nloc, nx); b.st[0] = nloc; b.st[1] = nx; }
        const unsigned old = xb_add(&bar[XB_XSUB(b.x)], 1u);
        const unsigned gen = old / nloc;
        if (old + 1u == (gen + 1u) * nloc) {
            __builtin_amdgcn_fence(__ATOMIC_RELEASE, "agent");
            asm volatile("s_waitcnt vmcnt(0)" ::: "memory");
            const unsigned og = xb_add(&bar[XB_TOP], 1u);
            const unsigned tg = og / nx;
            if (og + 1u == (tg + 1u) * nx) xb_add(&bar[XB_TOPGEN], 1u);
            else XB_SPIN(xb_ld(&bar[XB_TOPGEN]) == tg, bar);
            __builtin_amdgcn_fence(__ATOMIC_ACQUIRE, "agent");
            xb_add(&bar[XB_XGEN(b.x)], 1u);
            asm volatile("s_waitcnt vmcnt(0)" ::: "memory");
        } else {
            XB_SPIN(xb_ld(&bar[XB_XGEN(b.x)]) == gen, bar);
            __builtin_amdgcn_fence(__ATOMIC_ACQUIRE, "agent");
            asm volatile("s_waitcnt vmcnt(0)" ::: "memory");
        }
    }
    __syncthreads();
}

namespace pg8 {
constexpr int BM = 256, BK = 64, HALF = 128, HTB = HALF * BK * 2, STAGE_BYTES = 8 * HTB;
__device__ __forceinline__ int lds_byte(int r, int c) { const int st = (r >> 4) * 2 + (c >> 5), rr = r & 15, cc = c & 31, ob = rr * 64 + cc * 2; return st * 1024 + (ob ^ (((ob >> 9) & 1) << 5)); }
__device__ __forceinline__ void stage_rc(int b, int& R, int& C) { const int st = b / 1024, sb = b % 1024, swz = sb ^ (((sb >> 9) & 1) << 5); R = (st >> 1) * 16 + swz / 64; C = (st & 1) * 32 + (swz % 64) / 2; }
__device__ __forceinline__ int perm32(int rho) { const int n = rho >> 4, i = rho & 15; return 8 * (i >> 2) + 4 * n + (i & 3); }

struct Unit { int pn; int orow0; int mt; int e; };

template <class Epi, class Sched, int FP8 = 0>
__device__ __forceinline__ void gemm_phase(LAS unsigned char* lds, const char* Abase, const char* Bbase, const int K, const Sched& S, const Epi& E, const int skipE = 0, const int stag = 0) {
    int tid_ = threadIdx.x; asm volatile("" : "+v"(tid_));
    const int tid = tid_, wid = __builtin_amdgcn_readfirstlane(tid >> 6), lane = tid & 63, wr = wid >> 2, wc = wid & 3, fr = lane & 15, fq = lane >> 4;
    const unsigned K2 = FP8 ? (unsigned)K : (unsigned)K * 2u;
    const int nt = (int)(K2 / 128u);
    int Rr[2], Cc[2]; unsigned voffB[2];
#pragma unroll
    for (int i = 0; i < 2; ++i) { stage_rc(tid * 16 + i * 8192, Rr[i], Cc[i]); const int Rb = (Rr[i] & ~31) + perm32(Rr[i] & 31); voffB[i] = (unsigned)Rb * K2 + (unsigned)Cc[i] * 2u; }
    const size_t kstep = (size_t)(BK * 2);
    const size_t hstep = (size_t)HALF * K2;
    const unsigned ldsw = (unsigned)wid * 1024u;
    const int aoff = FP8 ? lds_byte(wr * 64 + fr, 32 * (fq >> 1) + 16 * (fq & 1)) : lds_byte(wr * 64 + fr, fq * 8), boff = FP8 ? lds_byte(wc * 32 + fr, 32 * (fq >> 1) + 16 * (fq & 1)) : lds_byte(wc * 32 + fr, fq * 8);
#define PG8_SA(b, h) (((b) * 2 + (h)) * HTB)
#define PG8_SB(b, h) ((4 + (b) * 2 + (h)) * HTB)
#define PG8_STAGE(bufoff, gbase, voff) do { _Pragma("unroll") for (int _i = 0; _i < 2; ++_i) \
        __builtin_amdgcn_global_load_lds((const unsigned*)((const char*)(gbase) + (voff)[_i]), (LAS unsigned*)(lds + (bufoff) + ldsw + _i * 8192), 16, 0, 0); } while (0)
#define PG8_LD8(ptr) __builtin_shufflevector(*(const LAS i32x4_t*)(ptr), *(const LAS i32x4_t*)((ptr) + 16), 0, 1, 2, 3, 4, 5, 6, 7)
#define PG8_LDA(dst, b, h) do { if constexpr (FP8) { _Pragma("unroll") for (int m = 0; m < 4; ++m) dst##8[m] = PG8_LD8(lds + PG8_SA(b, h) + aoff + m * 2048); } \
        else { _Pragma("unroll") for (int m = 0; m < 4; ++m) _Pragma("unroll") for (int k = 0; k < 2; ++k) dst[m][k] = *(const LAS bf16x8*)(lds + PG8_SA(b, h) + aoff + m * 2048 + k * 1024); } } while (0)
#define PG8_LDB(dst, b, h) do { if constexpr (FP8) { _Pragma("unroll") for (int n = 0; n < 2; ++n) dst##8[n] = PG8_LD8(lds + PG8_SB(b, h) + boff + n * 2048); } \
        else { _Pragma("unroll") for (int n = 0; n < 2; ++n) _Pragma("unroll") for (int k = 0; k < 2; ++k) dst[n][k] = *(const LAS bf16x8*)(lds + PG8_SB(b, h) + boff + n * 2048 + k * 1024); } } while (0)
#define PG8_MMA(ai, bj, At, Bt) do { __builtin_amdgcn_s_setprio(1); _Pragma("unroll") for (int m = 0; m < 4; ++m) _Pragma("unroll") for (int n = 0; n < 2; ++n) { \
        if constexpr (FP8) asm volatile("v_mfma_f32_16x16x128_f8f6f4 %0, %1, %2, %0" : "+v"(acc[ai][bj][m][n]) : "v"(Bt##8[n]), "v"(At##8[m])); \
        else { _Pragma("unroll") for (int k = 0; k < 2; ++k) acc[ai][bj][m][n] = __builtin_amdgcn_mfma_f32_16x16x32_bf16(Bt[n][k], At[m][k], acc[ai][bj][m][n], 0, 0, 0); } } \
        __builtin_amdgcn_s_setprio(0); } while (0)
#define PG8_WAIT_V(n) asm volatile("s_waitcnt vmcnt(" #n ")" ::: "memory")
#define PG8_WAIT_L(n) asm volatile("s_waitcnt lgkmcnt(" #n ")" ::: "memory")
#define PG8_BAR __builtin_amdgcn_s_barrier()
#define PG8_SCHED __builtin_amdgcn_sched_barrier(0)
    Unit cur, nxt; int ui = 0;
    if (!S.next(0, cur)) return;
    if (stag > 0) { const unsigned cls = (blockIdx.x >> 3) & 3u;
      if (cls) { const unsigned long long t0 = __builtin_amdgcn_s_memrealtime(); while (__builtin_amdgcn_s_memrealtime() - t0 < (unsigned long long)(cls * (unsigned)stag)) __builtin_amdgcn_s_sleep(8); } }
    f32x4 acc[2][2][4][2];
#pragma unroll
    for (int a = 0; a < 2; ++a)
#pragma unroll
        for (int b = 0; b < 2; ++b)
#pragma unroll
            for (int m = 0; m < 4; ++m)
#pragma unroll
                for (int n = 0; n < 2; ++n) { if constexpr (FP8) asm volatile("v_mov_b32 %0, 0\n\tv_mov_b32 %1, 0\n\tv_mov_b32 %2, 0\n\tv_mov_b32 %3, 0" : "=v"(acc[a][b][m][n][0]), "=v"(acc[a][b][m][n][1]), "=v"(acc[a][b][m][n][2]), "=v"(acc[a][b][m][n][3])); else acc[a][b][m][n] = (f32x4){0.f, 0.f, 0.f, 0.f}; }
    if constexpr (FP8) asm volatile("s_nop 7" ::: "memory");
    bf16x8 At[4][2], B0[2][2], B1[2][2];
    i32x8 At8[4], B08[2], B18[2];
    unsigned vAc0[2], vAc1[2], vAn0[2], vAn1[2];
#pragma unroll
    for (int i = 0; i < 2; ++i) { vAc0[i] = (unsigned)S.arow(cur, Rr[i]) * K2 + (unsigned)Cc[i] * 2u; vAc1[i] = (unsigned)S.arow(cur, HALF + Rr[i]) * K2 + (unsigned)Cc[i] * 2u; vAn0[i] = vAc0[i]; vAn1[i] = vAc1[i]; }
    const char* cB = Bbase + S.boff(cur);
    PG8_STAGE(PG8_SB(0, 0), cB, voffB); PG8_STAGE(PG8_SB(0, 1), cB + hstep, voffB); PG8_STAGE(PG8_SA(0, 0), Abase, vAc0); PG8_STAGE(PG8_SA(0, 1), Abase, vAc1);
    if (wr == 1) PG8_BAR;
    PG8_WAIT_V(2); PG8_BAR;
    PG8_STAGE(PG8_SB(1, 0), cB + kstep, voffB); PG8_STAGE(PG8_SA(1, 0), Abase + kstep, vAc0); PG8_STAGE(PG8_SB(1, 1), cB + hstep + kstep, voffB);
    PG8_WAIT_V(6); PG8_BAR;
    for (;;) {
        const bool has_next = S.next(ui + 1, nxt);
        const char* nB = has_next ? Bbase + S.boff(nxt) : cB;
        int rN0[2] = {0, 0}, rN1[2] = {0, 0};
        if (has_next) {
            if constexpr (Sched::kGather) {
                if (wid < 4) __builtin_amdgcn_global_load_lds((const unsigned*)S.gather_src(nxt, wid * 64 + lane), (LAS unsigned*)(lds + LDSX_OFF + 2048 + wid * 256), 4, 0, 0);
            } else {
#pragma unroll
                for (int i = 0; i < 2; ++i) { rN0[i] = S.arow(nxt, Rr[i]); rN1[i] = S.arow(nxt, HALF + Rr[i]); }
            }
        } else {
#pragma unroll
            for (int i = 0; i < 2; ++i) { vAn0[i] = vAc0[i]; vAn1[i] = vAc1[i]; }
        }
        for (int t = 0; t < nt; t += 2) {
            const bool last = (t == nt - 2);
            const char* a1 = Abase + (size_t)(t + 1) * kstep;
            const char* a2 = last ? Abase : Abase + (size_t)(t + 2) * kstep; const char* b2 = last ? nB : cB + (size_t)(t + 2) * kstep;
            const char* a3 = a2 + kstep; const char* b3 = b2 + kstep;
            unsigned v20[2], v21[2];
            if (last) {
                if (has_next) {
                    if constexpr (Sched::kGather) {
                        const unsigned ta0 = (unsigned)(size_t)(lds + LDSX_OFF + 2048) + (unsigned)Rr[0] * 4u, ta1 = (unsigned)(size_t)(lds + LDSX_OFF + 2048) + (unsigned)Rr[1] * 4u;
                        asm volatile("ds_read_b32 %0, %4\n\tds_read_b32 %1, %5\n\tds_read_b32 %2, %4 offset:512\n\tds_read_b32 %3, %5 offset:512\n\ts_waitcnt lgkmcnt(0)"
                                     : "=&v"(rN0[0]), "=&v"(rN0[1]), "=&v"(rN1[0]), "=&v"(rN1[1]) : "v"(ta0), "v"(ta1) : "memory");
                    }
#pragma unroll
                    for (int i = 0; i < 2; ++i) { int a_ = rN0[i], b_ = rN1[i]; asm volatile("" : "+v"(a_), "+v"(b_)); vAn0[i] = (unsigned)a_ * K2 + (unsigned)Cc[i] * 2u; vAn1[i] = (unsigned)b_ * K2 + (unsigned)Cc[i] * 2u; }
                }
#pragma unroll
                for (int i = 0; i < 2; ++i) { v20[i] = vAn0[i]; v21[i] = vAn1[i]; }
            } else {
#pragma unroll
                for (int i = 0; i < 2; ++i) { v20[i] = vAc0[i]; v21[i] = vAc1[i]; }
            }
            PG8_LDB(B0, 0, 0); PG8_LDB(B1, 0, 1); PG8_SCHED; PG8_LDA(At, 0, 0); PG8_STAGE(PG8_SA(1, 1), a1, vAc1);
            PG8_WAIT_V(8); PG8_WAIT_L(0); PG8_BAR; PG8_MMA(0, 0, At, B0); PG8_MMA(0, 1, At, B1); PG8_BAR; PG8_SCHED;
            PG8_LDA(At, 0, 1); PG8_STAGE(PG8_SB(0, 0), b2, voffB); PG8_STAGE(PG8_SB(0, 1), b2 + hstep, voffB); PG8_STAGE(PG8_SA(0, 0), a2, v20);
            PG8_WAIT_V(8); PG8_WAIT_L(0); PG8_BAR; PG8_MMA(1, 0, At, B0); PG8_MMA(1, 1, At, B1); PG8_BAR; PG8_SCHED;
            PG8_LDB(B0, 1, 0); PG8_LDB(B1, 1, 1); PG8_SCHED; PG8_LDA(At, 1, 0); PG8_STAGE(PG8_SA(0, 1), a2, v21);
            PG8_WAIT_V(8); PG8_WAIT_L(0); PG8_BAR; PG8_MMA(0, 0, At, B0); PG8_MMA(0, 1, At, B1); PG8_BAR; PG8_SCHED;
            PG8_LDA(At, 1, 1); PG8_STAGE(PG8_SB(1, 0), b3, voffB); PG8_STAGE(PG8_SB(1, 1), b3 + hstep, voffB); PG8_STAGE(PG8_SA(1, 0), a3, v20);
            PG8_WAIT_V(8); PG8_WAIT_L(0); PG8_BAR; PG8_MMA(1, 0, At, B0); PG8_MMA(1, 1, At, B1); PG8_BAR; PG8_SCHED;
        }
        if (wr == 0) PG8_BAR;
        if constexpr (FP8) asm volatile("s_nop 15\n\ts_nop 15" ::: "memory");
        if (!skipE) E(acc, cur, wr, wc, fr, fq);
        if (!has_next) break;
#pragma unroll
        for (int a = 0; a < 2; ++a)
#pragma unroll
            for (int b = 0; b < 2; ++b)
#pragma unroll
                for (int m = 0; m < 4; ++m)
#pragma unroll
                    for (int n = 0; n < 2; ++n) { if constexpr (FP8) asm volatile("v_mov_b32 %0, 0\n\tv_mov_b32 %1, 0\n\tv_mov_b32 %2, 0\n\tv_mov_b32 %3, 0" : "=v"(acc[a][b][m][n][0]), "=v"(acc[a][b][m][n][1]), "=v"(acc[a][b][m][n][2]), "=v"(acc[a][b][m][n][3])); else acc[a][b][m][n] = (f32x4){0.f, 0.f, 0.f, 0.f}; }
        if constexpr (FP8) asm volatile("s_nop 7" ::: "memory");
        cur = nxt; cB = nB; ++ui;
#pragma unroll
        for (int i = 0; i < 2; ++i) { vAc0[i] = vAn0[i]; vAc1[i] = vAn1[i]; }
        if (wr == 1) PG8_BAR;
    }
    PG8_WAIT_V(0);
    PG8_BAR;
#undef PG8_SA
#undef PG8_SB
#undef PG8_STAGE
#undef PG8_LDA
#undef PG8_LDB
#undef PG8_MMA
#undef PG8_WAIT_V
#undef PG8_WAIT_L
#undef PG8_BAR
#undef PG8_SCHED
}
}
struct LinSched {
    int nM, nN, nwg, G, c; size_t bstride;
    __device__ __forceinline__ void init(int M, int N, int K, int G_, int c_) { nM = M / 256; nN = N / 256; nwg = nM * nN; G = G_; c = c_; bstride = (size_t)256 * K * 2; }
    __device__ __forceinline__ bool next(int i, pg8::Unit& u) const {
        const long L = (long)i * G + c; if (L >= nwg) return false;
        int wgid = (int)L; { const int q = nwg / 8, r = nwg % 8, xcd = wgid % 8, off = wgid / 8; wgid = (xcd < r ? xcd * (q + 1) : r * (q + 1) + (xcd - r) * q) + off; }
        const int nig = 8 * nN, gid = wgid / nig, fm = gid * 8, gsz = (nM - fm) < 8 ? (nM - fm) : 8;
        u.mt = fm + ((wgid % nig) % gsz); u.pn = (wgid % nig) / gsz; u.orow0 = u.mt * 256; u.e = 0; return true;
    }
    __device__ __forceinline__ int arow(const pg8::Unit& u, int lr) const { return u.orow0 + lr; }
    __device__ __forceinline__ size_t boff(const pg8::Unit& u) const { return (size_t)u.pn * bstride; }
    static constexpr bool kGather = false;
    __device__ __forceinline__ const int* gather_src(const pg8::Unit&, int) const { return nullptr; }
    __device__ __forceinline__ bool slack() const { return (nwg - c + G - 1) / G < (nwg + G - 1) / G; }
};
struct MoeTab { LAS int* ts; LAS int* cnt; LAS unsigned char* tile_e; LAS int* xo; };
__device__ __forceinline__ MoeTab moe_tab(LAS unsigned char* lds) { MoeTab t; t.ts = (LAS int*)(lds + LDSX_OFF); t.cnt = (LAS int*)(lds + LDSX_OFF + 256); t.tile_e = (LAS unsigned char*)(lds + LDSX_OFF + 512); t.xo = (LAS int*)(lds + LDSX_OFF + 7168); return t; }
__device__ __forceinline__ void moe_tables(LAS unsigned char* lds, const unsigned* gcnt) {
    MoeTab T = moe_tab(lds);
    int tid_ = threadIdx.x; asm volatile("" : "+v"(tid_));
    const unsigned tix = (unsigned)tid_;
    __syncthreads();
    if (tix < MOE_NG * NEXP) T.xo[tix] = (int)gcnt[(tix >> 5) * MOE_CSTR + (tix & 31)];
    __syncthreads();
    if (tix < NEXP) { int s = 0; for (int g = 0; g < MOE_NG; ++g) { const int c = T.xo[g * 32 + tix]; T.xo[g * 32 + tix] = s; s += c; } T.cnt[tix] = s; }
    __syncthreads();
    if (tix == 0) { int s = 0; for (int e = 0; e < NEXP; ++e) { const int c = T.cnt[e]; T.ts[e] = s; s += (c + 255) >> 8; } T.ts[NEXP] = s; }
    __syncthreads();
    const int nt = T.ts[NEXP];
    for (int mt = tix; mt < nt; mt += blockDim.x) { int e = 0; for (int j = 1; j < NEXP; ++j) e += (mt >= T.ts[j]) ? 1 : 0; T.tile_e[mt] = (unsigned char)e; }
    __syncthreads();
}
template <int GATHER> struct MoeSched {
    MoeTab T; const int* rowtok; int G, c; size_t bstride; size_t estride;
    __device__ __forceinline__ bool next(int i, pg8::Unit& u) const {
        const int L = i * G + c; const int nt = T.ts[NEXP]; if (L >= nt * 4) return false;
        u.mt = L >> 2; u.pn = L & 3; u.orow0 = u.mt * 256; u.e = (int)T.tile_e[u.mt]; return true;
    }
    __device__ __forceinline__ int arow(const pg8::Unit& u, int lr) const {
        if (GATHER) return *gather_src(u, lr);
        return u.orow0 + lr;
    }
    __device__ __forceinline__ size_t boff(const pg8::Unit& u) const { return (size_t)u.e * estride + (size_t)u.pn * bstride; }
    static constexpr bool kGather = GATHER != 0;
    __device__ __forceinline__ const int* gather_src(const pg8::Unit& u, int lr) const {
        const int i0 = (u.mt - T.ts[u.e]) * 256 + lr, last = T.cnt[u.e] - 1, idx = i0 < last ? i0 : last;
        int g = 0;
#pragma unroll
        for (int j = 1; j < MOE_NG; ++j) g += (idx >= T.xo[j * 32 + u.e]) ? 1 : 0;
        return rowtok + (size_t)(g * 32 + u.e) * MOE_RCAP + (idx - T.xo[g * 32 + u.e]);
    }
    __device__ __forceinline__ bool slack() const { const int n = T.ts[NEXP] * 4; return (n - c + G - 1) / G < (n + G - 1) / G; }
};

__device__ __forceinline__ u32x4 pack8(const f32x4 a, const f32x4 b) { u32x4 w; w.x = pk2(a[0], a[1]); w.y = pk2(a[2], a[3]); w.z = pk2(b[0], b[1]); w.w = pk2(b[2], b[3]); return w; }
struct EpiPlain {
    bf16* O; int ldc;
    __device__ __forceinline__ void operator()(const f32x4 (&acc)[2][2][4][2], const pg8::Unit& u, int wr, int wc, int fr, int fq) const {
        const int row0 = u.orow0 + wr * 64 + fr, col0 = u.pn * 256 + wc * 32 + 8 * fq;
#pragma unroll
        for (int ai = 0; ai < 2; ++ai)
#pragma unroll
            for (int m = 0; m < 4; ++m) { bf16* rowp = O + (size_t)(row0 + ai * 128 + m * 16) * ldc + col0;
#pragma unroll
                for (int bj = 0; bj < 2; ++bj) *(u32x4*)(rowp + bj * 128) = pack8(acc[ai][bj][m][0], acc[ai][bj][m][1]); }
    }
};
struct EpiPlainS {
    bf16* O; int ldc; float sc;
    __device__ __forceinline__ void operator()(const f32x4 (&acc)[2][2][4][2], const pg8::Unit& u, int wr, int wc, int fr, int fq) const {
        const int row0 = u.orow0 + wr * 64 + fr, col0 = u.pn * 256 + wc * 32 + 8 * fq;
#pragma unroll
        for (int ai = 0; ai < 2; ++ai)
#pragma unroll
            for (int m = 0; m < 4; ++m) { bf16* rowp = O + (size_t)(row0 + ai * 128 + m * 16) * ldc + col0;
#pragma unroll
                for (int bj = 0; bj < 2; ++bj) *(u32x4*)(rowp + bj * 128) = pack8(acc[ai][bj][m][0] * sc, acc[ai][bj][m][1] * sc); }
    }
};
struct EpiOut8 {
    unsigned char* O; float sc;
    __device__ __forceinline__ void operator()(const f32x4 (&acc)[2][2][4][2], const pg8::Unit& u, int wr, int wc, int fr, int fq) const {
        const int row0 = u.orow0 + wr * 64 + fr, col0 = u.pn * 256 + wc * 32 + 8 * fq;
#pragma unroll
        for (int ai = 0; ai < 2; ++ai)
#pragma unroll
            for (int m = 0; m < 4; ++m) { unsigned char* rowp = O + (size_t)(row0 + ai * 128 + m * 16) * D + col0;
#pragma unroll
                for (int bj = 0; bj < 2; ++bj) { const f32x4 a = acc[ai][bj][m][0] * sc, b = acc[ai][bj][m][1] * sc;
                    *(u32x2*)(rowp + bj * 128) = (u32x2){pk4_fp8(a[0], a[1], a[2], a[3]), pk4_fp8(b[0], b[1], b[2], b[3])}; } }
    }
};
struct EpiEvenIn {
    bf16* O; const LAS float* rc; const LAS float* rs;
    __device__ __forceinline__ void operator()(const f32x4 (&acc)[2][2][4][2], const pg8::Unit& u, int wr, int wc, int fr, int fq) const {
        const int row0 = u.orow0 + wr * 64 + fr, col0 = u.pn * 256 + wc * 32 + 8 * fq;
        const bool lat = u.orow0 < NLAT;
#pragma unroll
        for (int ai = 0; ai < 2; ++ai)
#pragma unroll
            for (int m = 0; m < 4; ++m) { const int row = row0 + ai * 128 + m * 16; bf16* rowp = O + (size_t)row * EN + col0;
                const int s = row & (SEQ - 1); const int pos = (wc & 1) ? (s & 63) : (s >> 6);
#pragma unroll
                for (int bj = 0; bj < 2; ++bj) { f32x4 v0 = acc[ai][bj][m][0], v1 = acc[ai][bj][m][1];
                    const bool rp = lat && (u.pn < 2 || (u.pn == 2 && bj == 0));
                    if (rp) { const f32x4 c = *(const LAS f32x4*)(rc + pos * 16 + 4 * fq), sn = *(const LAS f32x4*)(rs + pos * 16 + 4 * fq);
                        const f32x4 o1 = v0 * c - v1 * sn, o2 = v1 * c + v0 * sn; v0 = o1; v1 = o2; }
                    if (col0 + bj * 128 < EVEN_IN) *(u32x4*)(rowp + bj * 128) = pack8(v0, v1); }
                asm volatile("" ::: "memory"); }
    }
};
struct EpiOddIn {
    bf16* O;
    __device__ __forceinline__ void operator()(const f32x4 (&acc)[2][2][4][2], const pg8::Unit& u, int wr, int wc, int fr, int fq) const {
        const int row0 = u.orow0 + wr * 64 + fr;
#pragma unroll
        for (int ai = 0; ai < 2; ++ai)
#pragma unroll
            for (int m = 0; m < 4; ++m) { bf16* rowp = O + (size_t)(row0 + ai * 128 + m * 16) * 2048;
                if (u.pn < 4) {
#pragma unroll
                    for (int bj = 0; bj < 2; ++bj) *(u32x4*)(rowp + u.pn * 256 + bj * 128 + wc * 32 + 8 * fq) = pack8(acc[ai][bj][m][0], acc[ai][bj][m][1]);
                } else {
                    *(u32x4*)(rowp + 1024 + (u.pn - 4) * 128 + wc * 32 + 8 * fq) = pack8(acc[ai][0][m][0] * acc[ai][1][m][0], acc[ai][0][m][1] * acc[ai][1][m][1]);
                } }
    }
};
struct EpiG1 {
    unsigned char* O; float sc;
    __device__ __forceinline__ void operator()(const f32x4 (&acc)[2][2][4][2], const pg8::Unit& u, int wr, int wc, int fr, int fq) const {
        const int row0 = u.orow0 + wr * 64 + fr, col0 = u.pn * 128 + wc * 32 + 8 * fq;
#pragma unroll
        for (int ai = 0; ai < 2; ++ai)
#pragma unroll
            for (int m = 0; m < 4; ++m) { unsigned char* rowp = O + (size_t)(row0 + ai * 128 + m * 16) * DEXP + col0;
                f32x4 a0 = acc[ai][0][m][0] * sc, a1 = acc[ai][0][m][1] * sc;
#pragma unroll
                for (int j = 0; j < 4; ++j) { a0[j] = fast_silu(a0[j]); a1[j] = fast_silu(a1[j]); }
                const f32x4 h0 = a0 * (acc[ai][1][m][0] * sc), h1v = a1 * (acc[ai][1][m][1] * sc);
                *(u32x2*)rowp = (u32x2){pk4_fp8(h0[0], h0[1], h0[2], h0[3]), pk4_fp8(h1v[0], h1v[1], h1v[2], h1v[3])}; }
    }
};
struct Frame {
    LAS unsigned char* lds;
    int tid, lane, wave, vcu, G;
    float* out; unsigned char* ws;
};
__device__ __forceinline__ const float* inptr(const Frame& F, int i) {
    const unsigned long long v = ((const LAS unsigned long long*)(F.lds + MISC_OFF + 256))[i];
    const unsigned lo = __builtin_amdgcn_readfirstlane((unsigned)v), hi = __builtin_amdgcn_readfirstlane((unsigned)(v >> 32));
    return (const float*)(((unsigned long long)hi << 32) | lo);
}
enum { I_X = 0, I_C, I_CTX, I_CCTX, I_WINE, I_WOUTE, I_SINK, I_WA2, I_BA, I_NORMW, I_WINO, I_CONVW, I_CONVB, I_WOUTO, I_ADAW, I_ADAB, I_LNW, I_LNB, I_WG, I_BG, I_WE, I_BE, I_W1, I_W3, I_W2 };
__device__ __forceinline__ int launder_v(int x) { asm volatile("" : "+v"(x)); return x; }
__device__ __forceinline__ int launder_s(int x) { asm volatile("" : "+s"(x)); return x; }
__device__ __forceinline__ Frame relaunder(const Frame& F0) { Frame F = F0; F.tid = launder_v(F0.tid); F.lane = F.tid & 63; F.wave = __builtin_amdgcn_readfirstlane(F.tid >> 6); F.vcu = launder_s(F0.vcu); return F; }
__device__ __forceinline__ const float* modp(const Frame& F, int l, int bi, int n) { return (const float*)(F.ws + WS_MOD) + ((size_t)(l * 17 + bi) * 6 + n) * D; }
__device__ __forceinline__ int row_bi(int row) { return row < NLAT ? (row >> 12) : 16; }

__device__ __forceinline__ void sincos_d(double a, float& c, float& s) {
    const double TWO_OVER_PI = 0.63661977236758134308, PIO2_HI = 1.57079632679489655800e+00, PIO2_LO = 6.12323399573676603587e-17;
    const double n = __builtin_rint(a * TWO_OVER_PI); double r = (a - n * PIO2_HI) - n * PIO2_LO; const double r2 = r * r;
    double sp = -1.0 / 1307674368000.0; sp = sp * r2 + 1.0 / 6227020800.0; sp = sp * r2 - 1.0 / 39916800.0; sp = sp * r2 + 1.0 / 362880.0; sp = sp * r2 - 1.0 / 5040.0; sp = sp * r2 + 1.0 / 120.0; sp = sp * r2 - 1.0 / 6.0; sp = sp * r2 + 1.0; sp *= r;
    double cp = 1.0 / 20922789888000.0; cp = cp * r2 - 1.0 / 87178291200.0; cp = cp * r2 + 1.0 / 479001600.0; cp = cp * r2 - 1.0 / 3628800.0; cp = cp * r2 + 1.0 / 40320.0; cp = cp * r2 - 1.0 / 720.0; cp = cp * r2 + 1.0 / 24.0; cp = cp * r2 - 0.5; cp = cp * r2 + 1.0;
    const int q = ((int)n) & 3;
    const double sv = (q == 0) ? sp : (q == 1) ? cp : (q == 2) ? -sp : -cp;
    const double cv = (q == 0) ? cp : (q == 1) ? -sp : (q == 2) ? -cp : sp;
    c = (float)cv; s = (float)sv;
}
__device__ __forceinline__ void ph_ada(const Frame& F0) {
    Frame F = relaunder(F0);
    LAS float* sl = (LAS float*)F.lds;
    LAS float* red = (LAS float*)(F.lds + 17 * 1024 * 4);
    for (int idx = F.tid; idx < 17 * 1024; idx += 512) { const int bi = idx >> 10, k = idx & 1023; const float c = bi < 16 ? inptr(F, I_C)[bi * 1024 + k] : inptr(F, I_CCTX)[k]; sl[idx] = c / (1.0f + expf(-c)); }
    __syncthreads();
    for (int it = F.vcu; it < 4 * 96; it += F.G) {
        const int l = it / 96, n0 = (it % 96) * 64;
        const float* W = inptr(F, I_ADAW) + (size_t)l * 1024 * 6144 + n0 + F.lane;
        float acc[17];
#pragma unroll
        for (int b = 0; b < 17; ++b) acc[b] = 0.f;
        const int kb = F.wave * 128;
        for (int k = kb; k < kb + 128; k += 4) {
            const float w0 = __builtin_nontemporal_load(W + (size_t)k * 6144), w1 = __builtin_nontemporal_load(W + (size_t)(k + 1) * 6144), w2 = __builtin_nontemporal_load(W + (size_t)(k + 2) * 6144), w3 = __builtin_nontemporal_load(W + (size_t)(k + 3) * 6144);
#pragma unroll
            for (int b = 0; b < 17; ++b) { const f32x4 s = *(const LAS f32x4*)(sl + b * 1024 + k); acc[b] += s[0] * w0 + s[1] * w1 + s[2] * w2 + s[3] * w3; }
        }
#pragma unroll
        for (int b = 0; b < 17; ++b) red[(F.wave * 17 + b) * 64 + F.lane] = acc[b];
        __syncthreads();
        for (int idx = F.tid; idx < 17 * 64; idx += 512) { const int b = idx >> 6, ln = idx & 63; float s = 0.f;
#pragma unroll
            for (int w = 0; w < 8; ++w) s += red[(w * 17 + b) * 64 + ln];
            ((float*)(F.ws + WS_MOD))[(size_t)(l * 17 + b) * 6144 + n0 + ln] = s + inptr(F, I_ADAB)[l * 6144 + n0 + ln]; }
        __syncthreads();
    }
    if (F.vcu == F.G - 1) {
        float* rope = (float*)(F.ws + WS_ROPE);
        for (int idx = F.tid; idx < 1024; idx += 512) { const int pos = idx >> 4, f = idx & 15;
            const double base4[4] = {1.0, 0.56234132519034908, 0.31622776601683794, 0.17782794100389228};
            double inv = (f & 3) == 0 ? base4[0] : (f & 3) == 1 ? base4[1] : (f & 3) == 2 ? base4[2] : base4[3];
            const int a = f >> 2; inv *= (a == 0) ? 1.0 : (a == 1) ? 0.1 : (a == 2) ? 0.01 : 0.001;
            float c, s; sincos_d((double)pos * inv, c, s); rope[idx] = c; rope[1024 + idx] = s; }
    }
}

__device__ __forceinline__ void tr_item(const float* W, int srcN, int K, bf16* WT, int drow0, int k0, int srccol, LAS float* scr, int lane) {
    float v[32];
    const float* p = W + (size_t)(k0 + (lane >> 5)) * srcN + (srccol >= 0 ? srccol : 0);
#pragma unroll
    for (int i = 0; i < 32; ++i) v[i] = __builtin_nontemporal_load(p + (size_t)(2 * i) * srcN);
#pragma unroll
    for (int i = 0; i < 32; ++i) scr[(2 * i + (lane >> 5)) * 33 + (lane & 31)] = srccol >= 0 ? v[i] : 0.f;
    asm volatile("s_waitcnt lgkmcnt(0)" ::: "memory");
    const int c = lane & 7;
#pragma unroll
    for (int j = 0; j < 4; ++j) { const int n = (lane >> 3) + 8 * j; const LAS float* s = scr + (8 * c) * 33 + n;
        u32x4 o; o.x = pk2(s[0 * 33], s[1 * 33]); o.y = pk2(s[2 * 33], s[3 * 33]); o.z = pk2(s[4 * 33], s[5 * 33]); o.w = pk2(s[6 * 33], s[7 * 33]);
        *(u32x4*)(WT + (size_t)(drow0 + n) * K + k0 + 8 * c) = o; }
    asm volatile("s_waitcnt lgkmcnt(0)" ::: "memory");
}
__device__ __forceinline__ void tr_item8(const float* W, int srcN, int K, unsigned char* WT, int drow0, int k0, int srccol, float scale, LAS float* scr, int lane) {
    float v[32];
    const float* p = W + (size_t)(k0 + (lane >> 5)) * srcN + srccol;
#pragma unroll
    for (int i = 0; i < 32; ++i) v[i] = __builtin_nontemporal_load(p + (size_t)(2 * i) * srcN);
#pragma unroll
    for (int i = 0; i < 32; ++i) scr[(2 * i + (lane >> 5)) * 33 + (lane & 31)] = v[i] * scale;
    asm volatile("s_waitcnt lgkmcnt(0)" ::: "memory");
    const int c = lane & 3;
#pragma unroll
    for (int j = 0; j < 2; ++j) { const int n = (lane >> 2) + 16 * j; const LAS float* s = scr + (16 * c) * 33 + n;
        u32x4 o; o.x = pk4_fp8(s[0 * 33], s[1 * 33], s[2 * 33], s[3 * 33]); o.y = pk4_fp8(s[4 * 33], s[5 * 33], s[6 * 33], s[7 * 33]);
        o.z = pk4_fp8(s[8 * 33], s[9 * 33], s[10 * 33], s[11 * 33]); o.w = pk4_fp8(s[12 * 33], s[13 * 33], s[14 * 33], s[15 * 33]);
        *(u32x4*)(WT + (size_t)(drow0 + n) * K + k0 + 16 * c) = o; }
    asm volatile("s_waitcnt lgkmcnt(0)" ::: "memory");
}
__device__ __forceinline__ int even_srccol(int j) {
    if (j < 640) { const int hb = j & ~63, p = j & 63, g = p >> 3, e = p & 7; return hb + (g >> 2) * 32 + (e >> 2) * 16 + (g & 3) * 4 + (e & 3); }
    return j < EVEN_IN ? j : -1;
}
__device__ __forceinline__ int odd_srccol(int j) { const int t = j >> 8, r = j & 255; if (t < 4) return j; return (r < 128 ? 1024 : 2048 - 128) + 128 * (t - 4) + r; }
__device__ __forceinline__ void conv_dense_weights(const Frame& F0) {
    Frame F = relaunder(F0);
    LAS float* scr = (LAS float*)(F.lds + F.wave * 16384);
    const int gw = F.vcu * 8 + F.wave, NGW = F.G * 8;
    constexpr int I_EI = 16 * 80, I_SQ = 16 * 32, I_OI = 16 * 96;
    constexpr int NIT = 2 * (I_EI + I_SQ + I_OI + I_SQ);
    for (int it = gw; it < NIT; it += NGW) {
        int r = it; const int i = r & 1; r >>= 1;
        if (r < I_EI) { const int kb = r / 80, nb = r % 80; tr_item(inptr(F, I_WINE) + (size_t)i * 1024 * EVEN_IN, EVEN_IN, 1024, (bf16*)(F.ws + WS_WINE) + (size_t)i * EN * 1024, nb * 32, kb * 64, even_srccol(nb * 32 + (F.lane & 31)), scr, F.lane); continue; } r -= I_EI;
        if (r < I_SQ) { const int kb = r / 32, nb = r % 32; tr_item(inptr(F, I_WOUTE) + (size_t)i * 1024 * 1024, 1024, 1024, (bf16*)(F.ws + WS_WOUTE) + (size_t)i * 1024 * 1024, nb * 32, kb * 64, nb * 32 + (F.lane & 31), scr, F.lane); continue; } r -= I_SQ;
        if (r < I_OI) { const int kb = r / 96, nb = r % 96; tr_item(inptr(F, I_WINO) + (size_t)i * 1024 * ON, ON, 1024, (bf16*)(F.ws + WS_WINO) + (size_t)i * ON * 1024, nb * 32, kb * 64, odd_srccol(nb * 32 + (F.lane & 31)), scr, F.lane); continue; } r -= I_OI;
        { const int kb = r / 32, nb = r % 32; tr_item(inptr(F, I_WOUTO) + (size_t)i * 1024 * 1024, 1024, 1024, (bf16*)(F.ws + WS_WOUTO) + (size_t)i * 1024 * 1024, nb * 32, kb * 64, nb * 32 + (F.lane & 31), scr, F.lane); }
    }
}
constexpr float OUT8_SCALE = 32.0f;
constexpr float W8_SCALE = 64.0f;
__device__ __forceinline__ void conv_moe_item(const Frame& F, int l, int it, LAS float* scr) {
    constexpr int I_13 = 16 * 32, I_2 = 8 * 32;
    const int e = it / (I_13 + I_2); int r = it % (I_13 + I_2);
    const size_t eoff = ((size_t)l * NEXP + e) * 1024 * 512;
    if (r < I_13) { const int kb = r / 32, nb = r % 32; const int j0 = nb * 32, t = j0 >> 8, rr = j0 & 255;
        const float* src = (rr < 128 ? inptr(F, I_W1) : inptr(F, I_W3)) + eoff;
        tr_item8(src, 512, 1024, (unsigned char*)(F.ws + WS_W13) + (size_t)e * 1024 * 1024, j0, kb * 64, 128 * t + (rr & 127) + (F.lane & 31), W8_SCALE, scr, F.lane);
    } else { r -= I_13; const int kb = r / 32, nb = r % 32;
        tr_item8(inptr(F, I_W2) + eoff, 1024, 512, (unsigned char*)(F.ws + WS_W2) + (size_t)e * 1024 * 512, nb * 32, kb * 64, nb * 32 + (F.lane & 31), W8_SCALE, scr, F.lane); }
}
__device__ __forceinline__ void conv_moe_weights(const Frame& F0, int l) {
    Frame F = relaunder(F0); const int gw = F.vcu * 8 + F.wave, NGW = F.G * 8;
    LAS float* scr = (LAS float*)(F.lds + F.wave * 16384);
    for (int it = gw; it < NEXP * (16 * 32 + 8 * 32); it += NGW) conv_moe_item(F, l, it, scr);
}
typedef _Float16 h16x4 __attribute__((ext_vector_type(4)));
__device__ __forceinline__ f32x4 h4_to_f32(const u32x2 v) { return __builtin_convertvector(__builtin_bit_cast(h16x4, v), f32x4); }
__device__ __forceinline__ u32x2 f32_to_h4(const f32x4 v) { return __builtin_bit_cast(u32x2, __builtin_convertvector(v, h16x4)); }
__device__ __forceinline__ unsigned short* h16_row(const Frame& F, bool alt, int row) {
    if (alt) return (unsigned short*)(F.ws + WS_U) + (size_t)row * D;
    return row < NLAT ? (unsigned short*)((unsigned char*)F.out + (size_t)NLAT * D * 2) + (size_t)row * D : (unsigned short*)(F.ws + WS_HCTX) + (size_t)(row - NLAT) * D;
}
__device__ __forceinline__ void ph_u0(const Frame& F0) {
    Frame F = relaunder(F0);
    const int gw = F.vcu * 8 + F.wave, NGW = F.G * 8;
    for (int r0 = gw * 4; r0 < NTOK; r0 += NGW * 4) {
        const int bi = row_bi(r0); const float* sh = modp(F, 0, bi, 0); const float* sc = modp(F, 0, bi, 1);
        f32x4 x[4][4];
#pragma unroll
        for (int r = 0; r < 4; ++r) { const int row = r0 + r; const float* src = row < NLAT ? inptr(F, I_X) + (size_t)row * D : inptr(F, I_CTX) + (size_t)(row - NLAT) * D;
#pragma unroll
            for (int j = 0; j < 4; ++j) x[r][j] = __builtin_nontemporal_load((const f32x4*)(src + 4 * F.lane + 256 * j)); }
#pragma unroll
        for (int j = 0; j < 4; ++j) { const int c = 4 * F.lane + 256 * j; const f32x4 a = *(const f32x4*)(sh + c), s = *(const f32x4*)(sc + c);
#pragma unroll
            for (int r = 0; r < 4; ++r) { const f32x4 u = x[r][j] * (1.0f + s) + a; u32x2 w; w.x = pk2(u[0], u[1]); w.y = pk2(u[2], u[3]); *(u32x2*)((bf16*)(F.ws + WS_U) + (size_t)(r0 + r) * D + c) = w;
                __builtin_nontemporal_store(f32_to_h4(x[r][j]), (u32x2*)(h16_row(F, false, r0 + r) + c)); } }
    }
}

struct RowLN { f32x4 v[4]; };
__device__ __forceinline__ void ln_stats(f32x4 (&z)[4], float& mean, float& rstd) {
    float s = 0.f;
#pragma unroll
    for (int j = 0; j < 4; ++j) s += (z[j][0] + z[j][1]) + (z[j][2] + z[j][3]);
    mean = wave_sum(s) * (1.0f / D); float q = 0.f;
#pragma unroll
    for (int j = 0; j < 4; ++j) { z[j] = z[j] - mean; q += (z[j][0] * z[j][0] + z[j][1] * z[j][1]) + (z[j][2] * z[j][2] + z[j][3] * z[j][3]); }
    rstd = 1.0f / sqrtf(wave_sum(q) * (1.0f / D) + LN_EPS);
}
__device__ __forceinline__ void ln_rows(f32x4 (&z)[4], const float* lw, const float* lb, int lane) {
    float s = 0.f;
#pragma unroll
    for (int j = 0; j < 4; ++j) s += (z[j][0] + z[j][1]) + (z[j][2] + z[j][3]);
    const float mean = wave_sum(s) * (1.0f / D); float q = 0.f;
#pragma unroll
    for (int j = 0; j < 4; ++j) { z[j] = z[j] - mean; q += (z[j][0] * z[j][0] + z[j][1] * z[j][1]) + (z[j][2] * z[j][2] + z[j][3] * z[j][3]); }
    const float rstd = 1.0f / sqrtf(wave_sum(q) * (1.0f / D) + LN_EPS);
#pragma unroll
    for (int j = 0; j < 4; ++j) { const int c = 4 * lane + 256 * j; z[j] = z[j] * rstd * *(const f32x4*)(lw + c) + *(const f32x4*)(lb + c); }
}
__device__ __forceinline__ void ph_ln1(const Frame& F0, int l, int nrows, bool dry = false) {
    Frame F = relaunder(F0);
    LAS unsigned char* Thi = F.lds; LAS unsigned char* Tlo = F.lds + 33024;
    LAS float* red = (LAS float*)(F.lds + 66048);
    LAS float* lgt = (LAS float*)(F.lds + 82432);
    LAS int* lcnt = (LAS int*)(F.lds + 87552); LAS int* lbase = lcnt + 32;
    LAS unsigned* list = (LAS unsigned*)(F.lds + 87808);
    LAS float* LW = (LAS float*)(F.lds + 97024); LAS float* LB = LW + 1024; LAS float* WG = LB + 1024;
    LAS float* GV = (LAS float*)(F.lds + 121600); LAS float* SCV = GV + 1024; LAS float* SHV = SCV + 1024; LAS float* BGE = SHV + 1024;
    const int lane = F.lane, w = F.wave;
    if (F.tid < 64) lcnt[F.tid] = 0;
    if (F.tid < 36) BGE[F.tid] = F.tid < 4 ? (inptr(F, I_BG) + l * 4)[F.tid] : (inptr(F, I_BE) + l * 32)[F.tid - 4];
    { const float* lwg = inptr(F, I_LNW) + (size_t)(l * 2 + 0) * D; const float* lbg = inptr(F, I_LNB) + (size_t)(l * 2 + 0) * D; const float* wgg = inptr(F, I_WG) + (size_t)l * 1024 * 4;
      for (int i = F.tid; i < 256; i += 512) { *(LAS f32x4*)(LW + 4 * i) = *(const f32x4*)(lwg + 4 * i); *(LAS f32x4*)(LB + 4 * i) = *(const f32x4*)(lbg + 4 * i); }
      for (int i = F.tid; i < 1024; i += 512) *(LAS f32x4*)(WG + 4 * i) = *(const f32x4*)(wgg + 4 * i); }
    bf16x8 Whi[2][4], Wlo[2][4];
    {
        const int n = lane & 15, kg = lane >> 4;
        const float* we = inptr(F, I_WE) + (size_t)l * 1024 * 32 + (size_t)(w * 128 + kg * 8) * 32 + n;
#pragma unroll
        for (int nt = 0; nt < 2; ++nt) {
            float raw[4][8];
            { const float* p = we + nt * 16;
              asm volatile("" : "+v"(p));
#pragma unroll
              for (int ks = 0; ks < 4; ++ks)
#pragma unroll
                  for (int j = 0; j < 8; ++j) raw[ks][j] = p[ks * 32 * 32 + j * 32]; }
#pragma unroll
            for (int ks = 0; ks < 4; ++ks) { u32x4 hi, lo; unsigned hh[8], ll[8];
#pragma unroll
                for (int j = 0; j < 8; ++j) {
                    const float v = raw[ks][j];
                    const unsigned h = pk2(v, 0.f) & 0xffffu; const float r = v - __uint_as_float(h << 16); hh[j] = h; ll[j] = pk2(r, 0.f) & 0xffffu; }
                hi.x = hh[0] | (hh[1] << 16); hi.y = hh[2] | (hh[3] << 16); hi.z = hh[4] | (hh[5] << 16); hi.w = hh[6] | (hh[7] << 16);
                lo.x = ll[0] | (ll[1] << 16); lo.y = ll[2] | (ll[3] << 16); lo.z = ll[4] | (ll[5] << 16); lo.w = ll[6] | (ll[7] << 16);
                Whi[nt][ks] = __builtin_bit_cast(bf16x8, hi); Wlo[nt][ks] = __builtin_bit_cast(bf16x8, lo); }
        }
    }
    const bf16* Y = (const bf16*)(F.ws + WS_P);
    const LAS float* bgp = BGE; const LAS float* bep = BGE + 4;
    const bool usey = !((l & 1) ? (KO_MASK & 4) : ((KO_MASK & 3) == 3));
    const int nbatch = nrows / 16; int nlist = 0; int routed = 0;
    LAS float* lgtx = (LAS float*)(F.lds + 134048);
#define LGT(b_) (((b_) < 2 ? lgt : lgtx - 2 * 640) + (b_) * 640)
#define LN1_ROUTE(first_, count_) do { if (F.tid < 16 * (count_)) { const int tk = F.tid & 15, qb_ = (first_) + (F.tid >> 4); const LAS float* lg = LGT(qb_ & 3) + tk * 40; \
        float gl[4]; _Pragma("unroll") for (int j = 0; j < 4; ++j) gl[j] = lg[32 + j] + bgp[j]; \
        float gmax = gl[0]; int g = 0; _Pragma("unroll") for (int j = 1; j < 4; ++j) if (gl[j] > gmax) { gmax = gl[j]; g = j; } \
        float den = 0.f; _Pragma("unroll") for (int j = 0; j < 4; ++j) den += __expf(gl[j] - gmax); \
        const float pg = __builtin_amdgcn_rcpf(den); float el[8]; _Pragma("unroll") for (int j = 0; j < 8; ++j) el[j] = lg[g * 8 + j] + bep[g * 8 + j]; \
        float m0 = el[0]; int i0 = 0; _Pragma("unroll") for (int j = 1; j < 8; ++j) if (el[j] > m0) { m0 = el[j]; i0 = j; } \
        float m1 = -3.0e38f; int i1 = 0; _Pragma("unroll") for (int j = 0; j < 8; ++j) if (j != i0 && el[j] > m1) { m1 = el[j]; i1 = j; } \
        const float ex = __expf(m1 - m0); const float w0 = pg * __builtin_amdgcn_rcpf(1.0f + ex), w1 = w0 * ex; \
        const int e0 = g * 8 + i0, e1 = g * 8 + i1; \
        const int p0 = atomicAdd((int*)&lcnt[e0], 1), p1 = atomicAdd((int*)&lcnt[e1], 1); \
        LAS unsigned* L = list + (qb_ * 16 + tk) * 8; \
        L[0] = (unsigned)((bt0 + qb_) * 16 + tk); L[1] = (unsigned)e0; L[2] = (unsigned)p0; L[3] = __float_as_uint(w0); L[4] = (unsigned)e1; L[5] = (unsigned)p1; L[6] = __float_as_uint(w1); } } while (0)
    __syncthreads();
    const int per = (nbatch + F.G - 1) / F.G, bt0 = F.vcu * per, bt1 = (bt0 + per < nbatch) ? bt0 + per : nbatch;
    u32x2 hraw[2][4], yraw[2][4]; int cur_bi = -1;
#define LN1_FETCH(bt_, rr) do { { const int row = (bt_) * 16 + 2 * w + rr; \
        const unsigned short* hs16 = h16_row(F, false, row); \
        _Pragma("unroll") for (int j = 0; j < 4; ++j) { const int c = 4 * lane + 256 * j; \
            hraw[rr][j] = __builtin_nontemporal_load((const u32x2*)(hs16 + c)); \
            yraw[rr][j] = usey ? __builtin_nontemporal_load((const u32x2*)(Y + (size_t)row * D + c)) : (u32x2){0u, 0u}; } } } while (0)
    if (bt0 < bt1) { LN1_FETCH(bt0, 0); LN1_FETCH(bt0, 1); }
    for (int bt = bt0; bt < bt1; ++bt) {
        const int rbase = bt * 16; const int bi = row_bi(rbase);
        if (bi != cur_bi) {
            const float* g2 = modp(F, l, bi, 2); const float* sh = modp(F, l, bi, 3); const float* sc = modp(F, l, bi, 4);
            if (F.tid < 256) { *(LAS f32x4*)(GV + 4 * F.tid) = *(const f32x4*)(g2 + 4 * F.tid); *(LAS f32x4*)(SCV + 4 * F.tid) = *(const f32x4*)(sc + 4 * F.tid); *(LAS f32x4*)(SHV + 4 * F.tid) = *(const f32x4*)(sh + 4 * F.tid); }
            __syncthreads(); cur_bi = bi;
        }
#pragma unroll
        for (int rr = 0; rr < 2; ++rr) {
            const int lr = 2 * w + rr, row = rbase + lr;
            f32x4 z[4]; float mean, rstd;
#pragma unroll
            for (int j = 0; j < 4; ++j) { const f32x4 gvj = *(const LAS f32x4*)(GV + 4 * lane + 256 * j);
                z[j] = DN_ALPHA * h4_to_f32(hraw[rr][j]) + gvj * (f32x4){bflo(yraw[rr][j].x), bfhi(yraw[rr][j].x), bflo(yraw[rr][j].y), bfhi(yraw[rr][j].y)}; }
            asm volatile("" ::: "memory");
            if (bt + 1 < bt1) LN1_FETCH(bt + 1, rr);
            asm volatile("" ::: "memory");
            ln_stats(z, mean, rstd);
            f32x4 ga = (f32x4){0.f, 0.f, 0.f, 0.f};
            unsigned short* hd = dry ? (unsigned short*)(F.ws + WS_GATT) + (size_t)row * D : h16_row(F, l == DEPTH - 1, row);
            unsigned char* u8 = (unsigned char*)(F.ws + (dry ? WS_Q : WS_U8)) + (size_t)row * D;
#pragma unroll
            for (int j = 0; j < 4; ++j) { const int c = 4 * lane + 256 * j;
                const f32x4 lwv = *(const LAS f32x4*)(LW + c), lbv = *(const LAS f32x4*)(LB + c), scvj = *(const LAS f32x4*)(SCV + c), shvj = *(const LAS f32x4*)(SHV + c);
                const f32x4 g0 = *(const LAS f32x4*)(WG + 4 * c), g1 = *(const LAS f32x4*)(WG + 4 * c + 4), g2v = *(const LAS f32x4*)(WG + 4 * c + 8), g3 = *(const LAS f32x4*)(WG + 4 * c + 12);
                const f32x4 zn = z[j] * rstd * lwv + lbv;
                __builtin_nontemporal_store(f32_to_h4(zn), (u32x2*)(hd + c));
                const f32x4 t = zn * (1.0f + scvj) + shvj;
                ga += t[0] * g0 + t[1] * g1 + t[2] * g2v + t[3] * g3;
                const unsigned h01 = pk2(t[0], t[1]), h23 = pk2(t[2], t[3]);
                u32x2 hw; hw.x = h01; hw.y = h23;
                *(unsigned*)(u8 + c) = pk4_fp8(t[0], t[1], t[2], t[3]);
                const float r0 = t[0] - bflo(h01), r1 = t[1] - bfhi(h01), r2 = t[2] - bflo(h23), r3 = t[3] - bfhi(h23);
                u32x2 lw2; lw2.x = pk2(r0, r1); lw2.y = pk2(r2, r3);
                *(LAS u32x2*)(Thi + lr * 2064 + c * 2) = hw; *(LAS u32x2*)(Tlo + lr * 2064 + c * 2) = lw2;
                asm volatile("" ::: "memory"); }
            { const float q0 = wave_sum(ga[0]), q1 = wave_sum(ga[1]), q2 = wave_sum(ga[2]), q3 = wave_sum(ga[3]);
              if (lane == 0) *(LAS f32x4*)(LGT(nlist & 3) + lr * 40 + 32) = (f32x4){q0, q1, q2, q3}; }
        }
        __syncthreads();
        if (nlist - routed == 3) { LN1_ROUTE(routed, 3); routed += 3; }
        {
            f32x4 acc[2];
#pragma unroll
            for (int nt = 0; nt < 2; ++nt) acc[nt] = (f32x4){0.f, 0.f, 0.f, 0.f};
            const int tk = lane & 15, kg = lane >> 4;
#pragma unroll
            for (int ks = 0; ks < 4; ++ks) {
                const bf16x8 ah = *(const LAS bf16x8*)(Thi + tk * 2064 + (w * 128 + ks * 32 + kg * 8) * 2), al = *(const LAS bf16x8*)(Tlo + tk * 2064 + (w * 128 + ks * 32 + kg * 8) * 2);
#pragma unroll
                for (int nt = 0; nt < 2; ++nt) { acc[nt] = __builtin_amdgcn_mfma_f32_16x16x32_bf16(Whi[nt][ks], ah, acc[nt], 0, 0, 0);
                    acc[nt] = __builtin_amdgcn_mfma_f32_16x16x32_bf16(Wlo[nt][ks], ah, acc[nt], 0, 0, 0); acc[nt] = __builtin_amdgcn_mfma_f32_16x16x32_bf16(Whi[nt][ks], al, acc[nt], 0, 0, 0); }
            }
#pragma unroll
            for (int nt = 0; nt < 2; ++nt) *(LAS f32x4*)(red + (w * 16 + tk) * 32 + nt * 16 + 4 * kg) = acc[nt];
        }
        __syncthreads();
        { const int tk = F.tid & 15, n = F.tid >> 4; float s = 0.f;
#pragma unroll
            for (int ww = 0; ww < 8; ++ww) s += red[(ww * 16 + tk) * 32 + n];
            LGT(nlist & 3)[tk * 40 + n] = s; }
        ++nlist;
    }
    __syncthreads();
    if (nlist - routed > 0) LN1_ROUTE(routed, nlist - routed);
#undef LN1_ROUTE
#undef LGT
#undef LN1_FETCH
    __syncthreads();
    const unsigned grp = (unsigned)F.vcu & (MOE_NG - 1);
    if (F.tid < 32) lbase[F.tid] = (int)atomicAdd((unsigned*)(F.ws + WS_CTL) + CW_CNT + (l * MOE_NG + (int)grp) * MOE_CSTR + (dry ? 32 : 0) + F.tid, (unsigned)lcnt[F.tid]);
    __syncthreads();
    if (!dry) for (int idx = F.tid; idx < nlist * 16; idx += 512) {
        const LAS unsigned* L = list + idx * 8; const unsigned row = L[0], e0 = L[1], e1 = L[4]; const unsigned p0 = L[2] + (unsigned)lbase[e0], p1 = L[5] + (unsigned)lbase[e1];
        u32x4 a; a.x = e0; a.y = p0 | (grp << 24); a.z = L[3]; a.w = e1; u32x4 b; b.x = p1 | (grp << 24); b.y = L[6]; b.z = 0u; b.w = 0u;
        unsigned* ti = (unsigned*)(F.ws + WS_TOKINFO) + (size_t)row * 8; *(u32x4*)ti = a; *(u32x4*)(ti + 4) = b;
        int* rt = (int*)(F.ws + WS_ROWTOK); rt[(size_t)(grp * 32 + e0) * MOE_RCAP + p0] = (int)row; rt[(size_t)(grp * 32 + e1) * MOE_RCAP + p1] = (int)row;
    }
}

__device__ __forceinline__ void ph_ln2(const Frame& F0, int l, int nrows, bool dry = false) {
    Frame F = relaunder(F0);
    MoeTab T = moe_tab(F.lds);
    const int gw = F.vcu * 8 + F.wave, NGW = F.G * 8, lane = F.lane;
    LAS float* LW = (LAS float*)F.lds; LAS float* LB = LW + 1024;
    { const float* lw = inptr(F, I_LNW) + (size_t)(l * 2 + 1) * D; const float* lb = inptr(F, I_LNB) + (size_t)(l * 2 + 1) * D;
      if (F.tid < 256) { *(LAS f32x4*)(LW + 4 * F.tid) = *(const f32x4*)(lw + 4 * F.tid); *(LAS f32x4*)(LB + 4 * F.tid) = *(const f32x4*)(lb + 4 * F.tid); } }
    __syncthreads();
    const unsigned char* O2 = (const unsigned char*)(F.ws + WS_P);
    const unsigned* tinfo = (const unsigned*)(F.ws + WS_TOKINFO);
    const int lm = l < 3 ? l + 1 : l;
    u32x4 ta[4]; u32x2 tb[4];
    if (gw * 4 < nrows) {
#pragma unroll
        for (int r = 0; r < 4; ++r) { const unsigned* ti = tinfo + (size_t)(gw * 4 + r) * 8; ta[r] = __builtin_nontemporal_load((const u32x4*)ti); tb[r] = __builtin_nontemporal_load((const u32x2*)(ti + 4)); }
    }
    for (int r0 = gw * 4; r0 < nrows; r0 += NGW * 4) {
        const int bi = row_bi(r0);
        const float* g5 = modp(F, l, bi, 5); const float* sh = modp(F, lm, bi, 0); const float* sc = modp(F, lm, bi, 1);
        const bool lat = r0 < NLAT;
        const bool wu = (l < 3) && (lat || l < 2);
        f32x4 z[4][4], gv[4], scv[4], shv[4]; unsigned ya[4][4], yb[4][4]; float w0[4], w1[4];
#pragma unroll
        for (int r = 0; r < 4; ++r) { const int row = r0 + r;
            const unsigned s0 = ((unsigned)T.ts[ta[r].x] * 256u + (unsigned)T.xo[(ta[r].y >> 24) * 32 + ta[r].x] + (ta[r].y & 0xffffffu)) * (unsigned)D, s1 = ((unsigned)T.ts[ta[r].w] * 256u + (unsigned)T.xo[(tb[r].x >> 24) * 32 + ta[r].w] + (tb[r].x & 0xffffffu)) * (unsigned)D;
            w0[r] = __uint_as_float(ta[r].z) * (1.0f / OUT8_SCALE); w1[r] = __uint_as_float(tb[r].y) * (1.0f / OUT8_SCALE);
            const unsigned short* hd = h16_row(F, l == DEPTH - 1, row);
#pragma unroll
            for (int j = 0; j < 4; ++j) { const int c = 4 * lane + 256 * j; z[r][j] = h4_to_f32(__builtin_nontemporal_load((const u32x2*)(hd + c)));
                if (!(KO_MASK & 8)) { ya[r][j] = __builtin_nontemporal_load((const unsigned*)(O2 + s0 + c)); yb[r][j] = __builtin_nontemporal_load((const unsigned*)(O2 + s1 + c)); } } }
#pragma unroll
        for (int j = 0; j < 4; ++j) { const int c = 4 * lane + 256 * j; gv[j] = *(const f32x4*)(g5 + c); scv[j] = *(const f32x4*)(sc + c); shv[j] = *(const f32x4*)(sh + c); }
        asm volatile("" ::: "memory");
        { const int rn = r0 + NGW * 4;
          if (rn < nrows) {
#pragma unroll
              for (int r = 0; r < 4; ++r) { const unsigned* ti = tinfo + (size_t)(rn + r) * 8; ta[r] = __builtin_nontemporal_load((const u32x4*)ti); tb[r] = __builtin_nontemporal_load((const u32x2*)(ti + 4)); }
          } }
        asm volatile("" ::: "memory");
#pragma unroll
        for (int j = 0; j < 4; ++j)
#pragma unroll
            for (int r = 0; r < 4; ++r) { f32x4 y = (f32x4){0.f, 0.f, 0.f, 0.f};
                if (!(KO_MASK & 8)) y = w0[r] * unpk4_fp8(ya[r][j]) + w1[r] * unpk4_fp8(yb[r][j]);
                z[r][j] = DN_ALPHA * z[r][j] + gv[j] * y; }
        float mean[4], rstd[4];
#pragma unroll
        for (int r = 0; r < 4; ++r) ln_stats(z[r], mean[r], rstd[r]);
#pragma unroll
        for (int j = 0; j < 4; ++j) { const int c = 4 * lane + 256 * j;
            const f32x4 lwv = *(const LAS f32x4*)(LW + c), lbv = *(const LAS f32x4*)(LB + c);
#pragma unroll
            for (int r = 0; r < 4; ++r) { const int row = r0 + r;
                const f32x4 zn = z[r][j] * rstd[r] * lwv + lbv;
                if (l == DEPTH - 1) { float* hd = dry ? (float*)(F.ws + WS_GATT) + (size_t)row * D : F.out + (size_t)row * D; __builtin_nontemporal_store(zn, (f32x4*)(hd + c)); }
                else { unsigned short* hd = dry ? (unsigned short*)(F.ws + WS_GATT) + (size_t)row * D : h16_row(F, false, row); __builtin_nontemporal_store(f32_to_h4(zn), (u32x2*)(hd + c)); }
                if (wu) { const f32x4 u = zn * (1.0f + scv[j]) + shv[j]; u32x2 hw; hw.x = pk2(u[0], u[1]); hw.y = pk2(u[2], u[3]); *(u32x2*)((bf16*)(F.ws + (dry ? WS_Q : WS_U)) + (size_t)row * D + c) = hw; } } }
    }
    __syncthreads();
}

__device__ __forceinline__ f32x4 ubf_lo(const u32x4 v) { return (f32x4){bflo(v.x), bfhi(v.x), bflo(v.y), bfhi(v.y)}; }
__device__ __forceinline__ f32x4 ubf_hi(const u32x4 v) { return (f32x4){bflo(v.z), bfhi(v.z), bflo(v.w), bfhi(v.w)}; }
__device__ __forceinline__ void ph_conv(const Frame& F0, int i, int nrows) {
    Frame F = relaunder(F0);
    const int gw = F.vcu * 8 + F.wave, NGW = F.G * 8, lane = F.lane;
    const float* cw = inptr(F, I_CONVW) + (size_t)i * 3 * D; const float* cb = inptr(F, I_CONVB) + (size_t)i * D;
    const bf16* P = (const bf16*)(F.ws + WS_P); bf16* Q = (bf16*)(F.ws + WS_Q);
    for (int r0 = gw * 4; r0 < nrows; r0 += NGW * 4) {
        const int s0 = r0 < NLAT ? (r0 & (SEQ - 1)) : ((r0 - NLAT) & (CTXL - 1)); const int slen = r0 < NLAT ? SEQ : CTXL;
        const bool hp = s0 > 0, hn = s0 + 4 < slen;
#pragma unroll
        for (int j = 0; j < 2; ++j) { const int c = 8 * lane + 512 * j;
            u32x4 p[6], gb[4];
            p[0] = (u32x4){0u, 0u, 0u, 0u}; p[5] = (u32x4){0u, 0u, 0u, 0u};
            if (hp) p[0] = __builtin_nontemporal_load((const u32x4*)(P + (size_t)(r0 - 1) * 2048 + 1024 + c));
            if (hn) p[5] = __builtin_nontemporal_load((const u32x4*)(P + (size_t)(r0 + 4) * 2048 + 1024 + c));
#pragma unroll
            for (int r = 0; r < 4; ++r) { p[r + 1] = __builtin_nontemporal_load((const u32x4*)(P + (size_t)(r0 + r) * 2048 + 1024 + c)); gb[r] = __builtin_nontemporal_load((const u32x4*)(P + (size_t)(r0 + r) * 2048 + c)); }
            const f32x4 w0a = *(const f32x4*)(cw + c), w0b = *(const f32x4*)(cw + c + 4), w1a = *(const f32x4*)(cw + D + c), w1b = *(const f32x4*)(cw + D + c + 4), w2a = *(const f32x4*)(cw + 2 * D + c), w2b = *(const f32x4*)(cw + 2 * D + c + 4);
            const f32x4 ba = *(const f32x4*)(cb + c), bb = *(const f32x4*)(cb + c + 4);
#pragma unroll
            for (int r = 0; r < 4; ++r) {
                const f32x4 ya = ubf_lo(gb[r]) * (ubf_lo(p[r]) * w0a + ubf_lo(p[r + 1]) * w1a + ubf_lo(p[r + 2]) * w2a + ba);
                const f32x4 yb = ubf_hi(gb[r]) * (ubf_hi(p[r]) * w0b + ubf_hi(p[r + 1]) * w1b + ubf_hi(p[r + 2]) * w2b + bb);
                *(u32x4*)(Q + (size_t)(r0 + r) * D + c) = pack8(ya, yb); } }
    }
}
#define MFMA32(a, b, c) __builtin_amdgcn_mfma_f32_32x32x16_bf16((a), (b), (c), 0, 0, 0)
#define MFMA16(a, b, c) __builtin_amdgcn_mfma_f32_16x16x32_bf16((a), (b), (c), 0, 0, 0)
constexpr int AK_STR = 144, AV_STR = 136, AK_BUF = 64 * AK_STR, AV_BUF = 64 * AV_STR;
__device__ __forceinline__ int crow32(int reg, int hh) { return (reg & 3) + 8 * (reg >> 2) + 4 * hh; }
__device__ __forceinline__ float xhalf_max(float v) { const unsigned u = __float_as_uint(v); const auto r = __builtin_amdgcn_permlane32_swap(u, u, false, false); return fmaxf(__uint_as_float(r[0]), __uint_as_float(r[1])); }
__device__ __forceinline__ float xhalf_sum(float v) { const unsigned u = __float_as_uint(v); const auto r = __builtin_amdgcn_permlane32_swap(u, u, false, false); return __uint_as_float(r[0]) + __uint_as_float(r[1]); }
constexpr float ATT_THR = 8.0f;
__device__ __forceinline__ void attn_unit(const Frame& F, int ie, int b, int g, int qb, bool ctxq) {
    const bf16* P = (const bf16*)(F.ws + WS_P); bf16* Q = (bf16*)(F.ws + WS_Q);
    LAS unsigned char* Ks = F.lds; LAS unsigned char* Vt = F.lds + 2 * AK_BUF;
    const int w = F.wave, lane = F.lane, r = w >> 1, qh = w & 1, h = 4 * g + r, n = lane & 31, hh = lane >> 5;
    const int qpos0 = qb * 128 + qh * 64;
    const int qrow0 = ctxq ? NLAT + b * CTXL + qpos0 : b * SEQ + qpos0;
    if (KO_MASK & 1) {
#pragma unroll
        for (int nt = 0; nt < 2; ++nt)
#pragma unroll
            for (int c = 0; c < 4; ++c) *(u32x4*)(Q + (size_t)(qrow0 + 32 * nt + n) * D + h * 64 + 16 * c + 8 * hh) = (u32x4){0u, 0u, 0u, 0u};
        return;
    }
    bf16x8 qf[2][4];
#pragma unroll
    for (int nt = 0; nt < 2; ++nt)
#pragma unroll
        for (int c = 0; c < 4; ++c) qf[nt][c] = *(const bf16x8*)(P + (size_t)(qrow0 + 32 * nt + n) * EN + PC_Q + h * 64 + 16 * c + 8 * hh);
    const float sk = inptr(F, I_SINK)[ie * 8 + h] * LOG2E;
    float mrun[2] = {sk, sk}, lsum[2] = {1.f, 1.f};
    f32x16 O[2][2];
#pragma unroll
    for (int a = 0; a < 2; ++a)
#pragma unroll
        for (int c = 0; c < 2; ++c)
#pragma unroll
            for (int e = 0; e < 16; ++e) O[a][c][e] = 0.f;
    const int tw0 = ctxq ? 4 : ((qb == 0) ? 6 : 4), tw1 = ctxq ? 4 : ((qb == 31) ? 8 : 10);
    const int ntile = 4 + (tw1 - tw0);
    const int skey = F.tid >> 3, sch = F.tid & 7;
    u32x4 kreg, vreg;
#define TILE_OF(i) ((i) < 4 ? (i) : tw0 + ((i) - 4))
#define KROW_OF(t) ((t) < 4 ? NLAT + b * CTXL + 64 * (t) : b * SEQ + (qb - 1) * 128 + 64 * ((t) - 4))
    { const int kr = KROW_OF(0) + skey; kreg = *(const u32x4*)(P + (size_t)kr * EN + PC_K + g * 64 + sch * 8); vreg = *(const u32x4*)(P + (size_t)kr * EN + PC_V + g * 64 + sch * 8); }
    __syncthreads();
    {
        *(LAS u32x4*)(Ks + skey * AK_STR + sch * 16) = kreg;
        LAS unsigned short* vt = (LAS unsigned short*)(Vt + (sch * 8) * AV_STR + skey * 2);
        const unsigned vv[4] = {vreg.x, vreg.y, vreg.z, vreg.w};
#pragma unroll
        for (int e = 0; e < 4; ++e) { vt[(2 * e) * (AV_STR / 2)] = (unsigned short)(vv[e] & 0xffffu); vt[(2 * e + 1) * (AV_STR / 2)] = (unsigned short)(vv[e] >> 16); }
    }
    __syncthreads();
    const float c2 = 0.125f * LOG2E;
    for (int i = 0; i < ntile; ++i) {
        const int buf = i & 1, t = TILE_OF(i);
        if (i + 1 < ntile) { const int t1 = TILE_OF(i + 1); const int kr = KROW_OF(t1) + skey; kreg = *(const u32x4*)(P + (size_t)kr * EN + PC_K + g * 64 + sch * 8); vreg = *(const u32x4*)(P + (size_t)kr * EN + PC_V + g * 64 + sch * 8); }
        const LAS unsigned char* kb = Ks + buf * AK_BUF; const LAS unsigned char* vb = Vt + buf * AV_BUF;
        const bool msk = (t >= 4) && (t != 6) && (t != 7);
        const int kp0 = (qb - 1) * 128 + 64 * (t - 4);
        const bool skip = (qh == 0 && t == 9) || (qh == 1 && t == 4);
#pragma unroll 1
        for (int kt = 0; kt < 2; ++kt) {
            if (skip) break;
            f32x16 S[2];
#pragma unroll
            for (int c = 0; c < 2; ++c)
#pragma unroll
                for (int e = 0; e < 16; ++e) S[c][e] = 0.f;
#pragma unroll
            for (int c = 0; c < 4; ++c) { const bf16x8 kf = *(const LAS bf16x8*)(kb + (32 * kt + n) * AK_STR + (16 * c + 8 * hh) * 2);
#pragma unroll
                for (int nt = 0; nt < 2; ++nt) S[nt] = MFMA32(kf, qf[nt][c], S[nt]); }
#pragma unroll
            for (int nt = 0; nt < 2; ++nt) {
                if (msk) { const int qp = qpos0 + 32 * nt + n;
#pragma unroll
                    for (int e = 0; e < 16; ++e) { const int dd = qp - (kp0 + 32 * kt + crow32(e, hh)); if (dd > 128 || dd < -128) S[nt][e] = -INFINITY; } }
                float mx = fmaxf(fmaxf(S[nt][0], S[nt][1]), fmaxf(S[nt][2], S[nt][3]));
#pragma unroll
                for (int e = 4; e < 16; e += 4) mx = fmaxf(mx, fmaxf(fmaxf(S[nt][e], S[nt][e + 1]), fmaxf(S[nt][e + 2], S[nt][e + 3])));
                mx = xhalf_max(mx) * c2;
                if (__builtin_amdgcn_ballot_w64(mx > mrun[nt] + ATT_THR) != 0ull) {
                    const float mnew_ = fmaxf(mrun[nt], mx); const float alpha = __builtin_amdgcn_exp2f(mrun[nt] - mnew_); mrun[nt] = mnew_; lsum[nt] *= alpha;
#pragma unroll
                    for (int dt = 0; dt < 2; ++dt)
#pragma unroll
                        for (int e = 0; e < 16; ++e) O[dt][nt][e] *= alpha;
                }
                const float mu = mrun[nt];
                float rs = 0.f;
#pragma unroll
                for (int e = 0; e < 16; ++e) { const float p = __builtin_amdgcn_exp2f(__builtin_fmaf(S[nt][e], c2, -mu)); S[nt][e] = p; rs += p; }
                lsum[nt] += xhalf_sum(rs);
            }
#pragma unroll
            for (int s = 0; s < 2; ++s) {
                bf16x8 pf[2];
#pragma unroll
                for (int nt = 0; nt < 2; ++nt) { u32x4 pw; pw.x = pk2(S[nt][8 * s + 0], S[nt][8 * s + 1]); pw.y = pk2(S[nt][8 * s + 2], S[nt][8 * s + 3]); pw.z = pk2(S[nt][8 * s + 4], S[nt][8 * s + 5]); pw.w = pk2(S[nt][8 * s + 6], S[nt][8 * s + 7]); pf[nt] = __builtin_bit_cast(bf16x8, pw); }
#pragma unroll
                for (int dt = 0; dt < 2; ++dt) {
                    const LAS unsigned char* va = vb + (32 * dt + n) * AV_STR + (32 * kt + 16 * s + 4 * hh) * 2;
                    const s16x4 lo = *(const LAS s16x4*)va, hi = *(const LAS s16x4*)(va + 16);
                    const bf16x8 vf = __builtin_shufflevector(lo, hi, 0, 1, 2, 3, 4, 5, 6, 7);
#pragma unroll
                    for (int nt = 0; nt < 2; ++nt) O[dt][nt] = MFMA32(vf, pf[nt], O[dt][nt]);
                }
            }
        }
        if (i + 1 < ntile) {
            LAS unsigned char* kb2 = Ks + (buf ^ 1) * AK_BUF; LAS unsigned char* vb2 = Vt + (buf ^ 1) * AV_BUF;
            *(LAS u32x4*)(kb2 + skey * AK_STR + sch * 16) = kreg;
            LAS unsigned short* vt = (LAS unsigned short*)(vb2 + (sch * 8) * AV_STR + skey * 2);
            const unsigned vv[4] = {vreg.x, vreg.y, vreg.z, vreg.w};
#pragma unroll
            for (int e = 0; e < 4; ++e) { vt[(2 * e) * (AV_STR / 2)] = (unsigned short)(vv[e] & 0xffffu); vt[(2 * e + 1) * (AV_STR / 2)] = (unsigned short)(vv[e] >> 16); }
        }
        __syncthreads();
    }
#pragma unroll
    for (int nt = 0; nt < 2; ++nt) { const float inv = 1.0f / lsum[nt]; bf16* orow = Q + (size_t)(qrow0 + 32 * nt + n) * D + h * 64 + (hh ? 8 : 0);
#pragma unroll
        for (int dt = 0; dt < 2; ++dt)
#pragma unroll
            for (int rg = 0; rg < 4; rg += 2) {
                u32x2 a, bq; a.x = pk2(O[dt][nt][4 * rg] * inv, O[dt][nt][4 * rg + 1] * inv); a.y = pk2(O[dt][nt][4 * rg + 2] * inv, O[dt][nt][4 * rg + 3] * inv);
                bq.x = pk2(O[dt][nt][4 * rg + 4] * inv, O[dt][nt][4 * rg + 5] * inv); bq.y = pk2(O[dt][nt][4 * rg + 6] * inv, O[dt][nt][4 * rg + 7] * inv);
                { const auto r0 = __builtin_amdgcn_permlane32_swap(a.x, bq.x, false, false); a.x = r0[0]; bq.x = r0[1]; }
                { const auto r1 = __builtin_amdgcn_permlane32_swap(a.y, bq.y, false, false); a.y = r1[0]; bq.y = r1[1]; }
                *(u32x4*)(orow + 32 * dt + 8 * rg) = (u32x4){a.x, a.y, bq.x, bq.y}; } }
}

template <int d> __device__ __forceinline__ void glaA_unit(const Frame& F, int ie, int b, int c, int h) {
    const bf16* P = (const bf16*)(F.ws + WS_P);
    LAS unsigned char* QS = F.lds + F.wave * 16384; LAS unsigned char* KS = QS + 8192;
    const int lane = F.lane;
    const int row0 = c < 4 ? NLAT + b * CTXL + c * 64 : b * SEQ + (c - 4) * 64;
    const size_t U = (size_t)(b * NCHUNK + c) * 4 + h;
    bf16* gq = (bf16*)(F.ws + WS_GQIN); bf16* gk = (bf16*)(F.ws + WS_GKST); bf16* ga = (bf16*)(F.ws + WS_GATT);
    {
        const size_t UD = U * 2 + d;
        {
            u32x4 qr[8], kr[8];
#pragma unroll
            for (int it = 0; it < 8; ++it) { const int tok = it * 8 + (lane >> 3), ch = lane & 7; const size_t ro = (size_t)(row0 + tok) * EN + h * 64 + ch * 8; qr[it] = *(const u32x4*)(P + ro + PC_QG); kr[it] = *(const u32x4*)(P + ro + PC_KG); }
#pragma unroll
            for (int it = 0; it < 8; ++it) { const int tok = it * 8 + (lane >> 3), ch = lane & 7; const int so = tok * 128 + ((ch ^ (tok & 7)) << 4); *(LAS u32x4*)(QS + so) = qr[it]; *(LAS u32x4*)(KS + so) = kr[it]; }
        }
        const int ln = lane & 31, hh = lane >> 5;
        bf16x8 afr[2], bhi[2], blo[2]; float bav[2];
#pragma unroll
        for (int tt = 0; tt < 2; ++tt) afr[tt] = *(const bf16x8*)(P + (size_t)(row0 + 32 * tt + ln) * EN + PC_GG + 16 * d + 8 * hh);
#pragma unroll
        for (int dt = 0; dt < 2; ++dt) { const float* wp = inptr(F, I_WA2) + (size_t)((ie * 2 + d) * 16 + 8 * hh) * 256 + h * 64 + 32 * dt + ln;
            unsigned hh_[8], ll_[8];
#pragma unroll
            for (int j = 0; j < 8; ++j) { const float v = wp[(size_t)j * 256]; const unsigned hb = pk2(v, 0.f) & 0xffffu; hh_[j] = hb; ll_[j] = pk2(v - __uint_as_float(hb << 16), 0.f) & 0xffffu; }
            bhi[dt] = __builtin_bit_cast(bf16x8, (u32x4){hh_[0] | (hh_[1] << 16), hh_[2] | (hh_[3] << 16), hh_[4] | (hh_[5] << 16), hh_[6] | (hh_[7] << 16)});
            blo[dt] = __builtin_bit_cast(bf16x8, (u32x4){ll_[0] | (ll_[1] << 16), ll_[2] | (ll_[3] << 16), ll_[4] | (ll_[5] << 16), ll_[6] | (ll_[7] << 16)});
            bav[dt] = inptr(F, I_BA)[(ie * 2 + d) * 256 + h * 64 + 32 * dt + ln]; }
        f32x16 G[2][2];
#pragma unroll
        for (int tt = 0; tt < 2; ++tt)
#pragma unroll
            for (int dt = 0; dt < 2; ++dt) { f32x16 z16;
#pragma unroll
                for (int e = 0; e < 16; ++e) z16[e] = 0.f;
                z16 = MFMA32(afr[tt], bhi[dt], z16); G[tt][dt] = MFMA32(afr[tt], blo[dt], z16); }
        asm volatile("s_waitcnt lgkmcnt(0)" ::: "memory");
        float base[2] = {0.f, 0.f};
        int lofs[2][4];
#pragma unroll
        for (int dt = 0; dt < 2; ++dt)
#pragma unroll
            for (int e4 = 0; e4 < 4; ++e4) lofs[dt][e4] = (4 * hh + e4) * 128 + (((4 * dt + (ln >> 3)) ^ (4 * hh + e4)) << 4) + (ln & 7) * 2;
#pragma unroll
        for (int tq = 0; tq < 2; ++tq) { constexpr int dd = d; const int tt = dd ? 1 - tq : tq;
#pragma unroll
            for (int gq_ = 0; gq_ < 4; ++gq_) { const int g4 = dd ? 3 - gq_ : gq_;
                const int tokg = 32 * tt + 8 * g4;
#pragma unroll
                for (int dt = 0; dt < 2; ++dt) {
                    float la[4];
#pragma unroll
                    for (int e4 = 0; e4 < 4; ++e4) { const float g = G[tt][dt][4 * g4 + e4] + bav[dt];
                        la[e4] = (fminf(g, 0.f) * LOG2E - __builtin_amdgcn_logf(1.0f + __builtin_amdgcn_exp2f(-fabsf(g) * LOG2E))) * (1.0f / 16.0f); }
                    float cs[4];
                    if (dd == 0) { cs[0] = la[0]; cs[1] = cs[0] + la[1]; cs[2] = cs[1] + la[2]; cs[3] = cs[2] + la[3]; }
                    else { cs[3] = la[3]; cs[2] = cs[3] + la[2]; cs[1] = cs[2] + la[1]; cs[0] = cs[1] + la[0]; }
                    const float t4 = dd == 0 ? cs[3] : cs[0];
                    const float pt = __shfl_xor(t4, 32);
                    const float off = base[dt] + ((dd == 0 ? hh == 1 : hh == 0) ? pt : 0.f);
                    base[dt] += t4 + pt;
#pragma unroll
                    for (int e4 = 0; e4 < 4; ++e4) { const int so = tokg * 128 + lofs[dt][e4];
                        const float e1 = __builtin_amdgcn_exp2f(off + cs[e4]);
                        const float qi = bf2f(*(const LAS unsigned short*)(QS + so)) * 0.125f * e1, ki = bf2f(*(const LAS unsigned short*)(KS + so)) * __builtin_amdgcn_rcpf(e1);
                        const unsigned short q16 = (unsigned short)(pk2(qi, 0.f) & 0xffffu), k16 = (unsigned short)(pk2(ki, 0.f) & 0xffffu);
                        *(LAS unsigned short*)(QS + so) = q16; *(LAS unsigned short*)(KS + so) = k16; }
                }
            }
        }
        if (hh == 0) { ((float*)(F.ws + WS_GDEC))[UD * 64 + ln] = __builtin_amdgcn_exp2f(base[0]); ((float*)(F.ws + WS_GDEC))[UD * 64 + 32 + ln] = __builtin_amdgcn_exp2f(base[1]); }
        asm volatile("s_waitcnt lgkmcnt(0)" ::: "memory");
        {
            const int cc = lane & 7, dk0 = 32 * (cc >> 2) + 4 * (cc & 3);
#pragma unroll
            for (int it = 0; it < 8; ++it) { const int tok = it * 8 + (lane >> 3);
                const u32x2 lo = *(const LAS u32x2*)(QS + tok * 128 + ((((dk0 >> 3)) ^ (tok & 7)) << 4) + (dk0 & 7) * 2);
                const u32x2 hi = *(const LAS u32x2*)(QS + tok * 128 + ((((dk0 + 16) >> 3) ^ (tok & 7)) << 4) + (dk0 & 7) * 2);
                *(u32x4*)(gq + (UD * 64 + tok) * 64 + 8 * cc) = (u32x4){lo.x, lo.y, hi.x, hi.y};
                *(u32x4*)(gk + (UD * 64 + tok) * 64 + 8 * cc) = *(const LAS u32x4*)(KS + tok * 128 + ((cc ^ (tok & 7)) << 4)); }
        }
        {
            const int n = lane & 15, kg = lane >> 4;
#pragma unroll 1
            for (int I = 0; I < 4; ++I) {
                const int ti = 16 * I + n;
                bf16x8 qf[2];
#pragma unroll
                for (int ks2 = 0; ks2 < 2; ++ks2) qf[ks2] = *(const LAS bf16x8*)(QS + ti * 128 + (((4 * ks2 + kg) ^ (ti & 7)) << 4));
#pragma unroll
                for (int J = 0; J < 4; ++J) { f32x4 acc = (f32x4){0.f, 0.f, 0.f, 0.f};
                    const bool live = d == 0 ? (J <= I) : (J >= I);
                    if (live) {
                        const int tjr = 16 * J + n;
#pragma unroll
                        for (int ks2 = 0; ks2 < 2; ++ks2) { const bf16x8 kf = *(const LAS bf16x8*)(KS + tjr * 128 + (((4 * ks2 + kg) ^ (tjr & 7)) << 4)); acc = MFMA16(kf, qf[ks2], acc); }
#pragma unroll
                        for (int r = 0; r < 4; ++r) { const int tj = 16 * J + 4 * kg + r; const bool keep = d == 0 ? (tj <= ti) : (tj >= ti); if (!keep) acc[r] = 0.f; }
                    }
                    u32x2 ow; ow.x = pk2(acc[0], acc[1]); ow.y = pk2(acc[2], acc[3]);
                    *(u32x2*)(ga + (UD * 64 + ti) * 64 + 16 * J + 4 * kg) = ow; }
            }
        }
        asm volatile("s_waitcnt lgkmcnt(0)" ::: "memory");
    }
}

constexpr int GB_STG = 43008;
__device__ __forceinline__ int glaB_chunk(int d, int step) { return d == 0 ? step : (step < 4 ? 3 - step : 4 + (NCHUNK - 1 - step)); }
__device__ __forceinline__ int swz_k(int r) { return (r & 3) | (((r >> 3) & 1) << 2); }
__device__ __forceinline__ int swz_v(int r) { return ((r & 3) << 2) | ((r >> 2) & 3); }
template <int STAGE> __device__ __forceinline__ void glaB_issue(const Frame& F, int b, int h, int d, int step) {
    const int c = glaB_chunk(d, step);
    const size_t U = (size_t)(b * NCHUNK + c) * 4 + h, UD = U * 2 + d;
    const int row0 = c < 4 ? NLAT + b * CTXL + c * 64 : b * SEQ + (c - 4) * 64;
    const int tid = F.tid, row = tid >> 3, gch = (tid & 7) ^ (row & 7), gchk = (tid & 7) ^ swz_k(row);
    const int vr0 = tid >> 4, vr1 = vr0 + 32, vc0 = (tid & 15) ^ swz_v(vr0), vc1 = (tid & 15) ^ swz_v(vr1);
    LAS unsigned char* st = F.lds + STAGE * GB_STG + F.wave * 1024;
    const char* gq = (const char*)(F.ws + WS_GQIN) + UD * 8192 + row * 128 + gch * 16;
    const char* ga = (const char*)(F.ws + WS_GATT) + UD * 8192 + row * 128 + gch * 16;
    const char* gk = (const char*)(F.ws + WS_GKST) + UD * 8192 + row * 128 + gchk * 16;
    const char* gv = (const char*)(F.ws + WS_P) + (size_t)row0 * (EN * 2) + (PC_VG + h * 128) * 2;
    const char* gdc = (const char*)(F.ws + WS_GDEC) + UD * 256 + F.lane * 4;
    __builtin_amdgcn_global_load_lds((const unsigned*)gq, (LAS unsigned*)(st), 16, 0, 2);
    __builtin_amdgcn_global_load_lds((const unsigned*)ga, (LAS unsigned*)(st + 8192), 16, 0, 2);
    __builtin_amdgcn_global_load_lds((const unsigned*)gk, (LAS unsigned*)(st + 16384), 16, 0, 2);
    __builtin_amdgcn_global_load_lds((const unsigned*)(gv + (size_t)vr0 * (EN * 2) + vc0 * 16), (LAS unsigned*)(st + 24576), 16, 0, 2);
    __builtin_amdgcn_global_load_lds((const unsigned*)(gv + (size_t)vr1 * (EN * 2) + vc1 * 16), (LAS unsigned*)(st + 24576 + 8192), 16, 0, 2);
    __builtin_amdgcn_global_load_lds((const unsigned*)gdc, (LAS unsigned*)(F.lds + STAGE * GB_STG + 40960 + F.wave * 256), 4, 0, 2);
}
template <int ROWB, class SWZ> __device__ __forceinline__ bf16x8 gb_frag_tr(const LAS unsigned char* tile, int lane, int c, int ks, SWZ swz) {
    const int g = lane >> 4, q = (lane & 15) >> 2, p = lane & 3;
    const int r0 = 32 * ks + 8 * g + q, r1 = r0 + 4;
    const s16x4 lo = __builtin_amdgcn_ds_read_tr16_b64_v4i16((LAS s16x4*)(tile + ROWB * r0 + 16 * ((2 * c + (p >> 1)) ^ swz(r0)) + 8 * (p & 1)));
    const s16x4 hi = __builtin_amdgcn_ds_read_tr16_b64_v4i16((LAS s16x4*)(tile + ROWB * r1 + 16 * ((2 * c + (p >> 1)) ^ swz(r1)) + 8 * (p & 1)));
    return __builtin_shufflevector(lo, hi, 0, 1, 2, 3, 4, 5, 6, 7);
}
__device__ __forceinline__ bf16x8 gb_frag(const LAS unsigned char* tile, int row, int ch) { return *(const LAS bf16x8*)(tile + (row * 8 + (ch ^ (row & 7))) * 16); }
template <int STAGE> __device__ __forceinline__ void glaB_step(const Frame& F, int b, int h, int d, int step, f32x4 (&S)[4], bf16* od) {
    const int lane = F.lane, n = lane & 15, kg = lane >> 4, sl = F.wave;
    if (step == 0) asm volatile("s_waitcnt vmcnt(6)" ::: "memory"); else if (step == 1) asm volatile("s_waitcnt vmcnt(10)" ::: "memory"); else asm volatile("s_waitcnt vmcnt(14)" ::: "memory");
    __builtin_amdgcn_s_barrier();
    asm volatile("" ::: "memory");
    glaB_issue<(STAGE + 2) % 3>(F, b, h, d, step + 2 < NCHUNK ? step + 2 : NCHUNK - 1);
    asm volatile("" ::: "memory");
    const int c = glaB_chunk(d, step);
    const int row0 = c < 4 ? NLAT + b * CTXL + c * 64 : b * SEQ + (c - 4) * 64;
    const LAS unsigned char* st = F.lds + STAGE * GB_STG;
    bf16x8 vf[2], qf[4][2], af[4][2], kf[4][2]; f32x4 dc[4];
#pragma unroll
    for (int I = 0; I < 4; ++I)
#pragma unroll
        for (int T = 0; T < 2; ++T) { qf[I][T] = gb_frag(st, 16 * I + n, 4 * T + kg); af[I][T] = gb_frag(st + 8192, 16 * I + n, 4 * T + kg); }
#pragma unroll
    for (int q = 0; q < 4; ++q) dc[q] = *(const LAS f32x4*)(st + 40960 + sl * 256 + (16 * q + 4 * kg) * 4);
    {
        const int g_ = lane >> 4, q_ = (lane & 15) >> 2, p_ = lane & 3, r0_ = 8 * g_ + q_;
        const unsigned sb_ = (unsigned)(size_t)(F.lds + STAGE * GB_STG);
        const unsigned av0 = sb_ + 24576u + 256u * r0_ + 16u * ((2 * sl + (p_ >> 1)) ^ swz_v(r0_)) + 8u * (p_ & 1), av1 = sb_ + 24576u + 256u * (r0_ + 4) + 16u * ((2 * sl + (p_ >> 1)) ^ swz_v(r0_ + 4)) + 8u * (p_ & 1);
        unsigned ak[4];
#pragma unroll
        for (int I = 0; I < 4; ++I) ak[I] = sb_ + 16384u + 128u * r0_ + 16u * ((2 * I + (p_ >> 1)) ^ swz_k(r0_)) + 8u * (p_ & 1);
        u32x2 t[20];
        asm volatile(
            "ds_read_b64_tr_b16 %0, %20\n\tds_read_b64_tr_b16 %1, %21\n\tds_read_b64_tr_b16 %2, %20 offset:8192\n\tds_read_b64_tr_b16 %3, %21 offset:8192\n\t"
            "ds_read_b64_tr_b16 %4, %22\n\tds_read_b64_tr_b16 %5, %22 offset:512\n\tds_read_b64_tr_b16 %6, %22 offset:4096\n\tds_read_b64_tr_b16 %7, %22 offset:4608\n\t"
            "ds_read_b64_tr_b16 %8, %23\n\tds_read_b64_tr_b16 %9, %23 offset:512\n\tds_read_b64_tr_b16 %10, %23 offset:4096\n\tds_read_b64_tr_b16 %11, %23 offset:4608\n\t"
            "ds_read_b64_tr_b16 %12, %24\n\tds_read_b64_tr_b16 %13, %24 offset:512\n\tds_read_b64_tr_b16 %14, %24 offset:4096\n\tds_read_b64_tr_b16 %15, %24 offset:4608\n\t"
            "ds_read_b64_tr_b16 %16, %25\n\tds_read_b64_tr_b16 %17, %25 offset:512\n\tds_read_b64_tr_b16 %18, %25 offset:4096\n\tds_read_b64_tr_b16 %19, %25 offset:4608\n\t"
            "s_waitcnt lgkmcnt(0)"
            : "=&v"(t[0]), "=&v"(t[1]), "=&v"(t[2]), "=&v"(t[3]), "=&v"(t[4]), "=&v"(t[5]), "=&v"(t[6]), "=&v"(t[7]), "=&v"(t[8]), "=&v"(t[9]),
              "=&v"(t[10]), "=&v"(t[11]), "=&v"(t[12]), "=&v"(t[13]), "=&v"(t[14]), "=&v"(t[15]), "=&v"(t[16]), "=&v"(t[17]), "=&v"(t[18]), "=&v"(t[19])
            : "v"(av0), "v"(av1), "v"(ak[0]), "v"(ak[1]), "v"(ak[2]), "v"(ak[3]) : "memory");
#pragma unroll
        for (int T = 0; T < 2; ++T) vf[T] = __builtin_bit_cast(bf16x8, (u32x4){t[2 * T].x, t[2 * T].y, t[2 * T + 1].x, t[2 * T + 1].y});
#pragma unroll
        for (int I = 0; I < 4; ++I)
#pragma unroll
            for (int T = 0; T < 2; ++T) kf[I][T] = __builtin_bit_cast(bf16x8, (u32x4){t[4 + 4 * I + 2 * T].x, t[4 + 4 * I + 2 * T].y, t[4 + 4 * I + 2 * T + 1].x, t[4 + 4 * I + 2 * T + 1].y});
    }
    bf16x8 sb[2];
#pragma unroll
    for (int G2 = 0; G2 < 2; ++G2) { u32x4 sw; sw.x = pk2(S[2 * G2][0], S[2 * G2][1]); sw.y = pk2(S[2 * G2][2], S[2 * G2][3]); sw.z = pk2(S[2 * G2 + 1][0], S[2 * G2 + 1][1]); sw.w = pk2(S[2 * G2 + 1][2], S[2 * G2 + 1][3]); sb[G2] = __builtin_bit_cast(bf16x8, sw); }
    asm volatile("s_waitcnt lgkmcnt(0)" ::: "memory");
    f32x4 o[4];
#pragma unroll
    for (int I = 0; I < 4; ++I) o[I] = (f32x4){0.f, 0.f, 0.f, 0.f};
#pragma unroll
    for (int I = 0; I < 4; ++I) o[I] = MFMA16(sb[0], qf[I][0], o[I]);
#pragma unroll
    for (int I = 0; I < 4; ++I) o[I] = MFMA16(sb[1], qf[I][1], o[I]);
#pragma unroll
    for (int q = 0; q < 4; ++q) S[q] = MFMA16(kf[q][0], vf[0], S[q]);
#pragma unroll
    for (int I = 0; I < 4; ++I) o[I] = MFMA16(vf[0], af[I][0], o[I]);
#pragma unroll
    for (int q = 0; q < 4; ++q) S[q] = MFMA16(kf[q][1], vf[1], S[q]);
#pragma unroll
    for (int I = 0; I < 4; ++I) o[I] = MFMA16(vf[1], af[I][1], o[I]);
#pragma unroll
    for (int q = 0; q < 4; ++q) S[q] = S[q] * dc[q];
    u32x2 ow[4];
#pragma unroll
    for (int I = 0; I < 4; ++I) { ow[I].x = pk2(o[I][0], o[I][1]); ow[I].y = pk2(o[I][2], o[I][3]); }
    asm volatile("s_waitcnt lgkmcnt(0)" ::: "memory");
#pragma unroll
    for (int I = 0; I < 4; ++I) *(u32x2*)(od + (size_t)(row0 + 16 * I + n) * 512 + h * 128 + 16 * sl + 4 * kg) = ow[I];
    asm volatile("" ::: "memory");
}
__device__ __forceinline__ void glaB_group(const Frame& F, int cg) {
    const int d = cg & 1, h = (cg >> 1) & 3, b = cg >> 3;
    bf16* od = (bf16*)(F.ws + WS_U) + (size_t)d * NTOK * 512;
    f32x4 S[4];
#pragma unroll
    for (int q = 0; q < 4; ++q) S[q] = (f32x4){0.f, 0.f, 0.f, 0.f};
    asm volatile("s_waitcnt vmcnt(0) lgkmcnt(0)" ::: "memory");
    __builtin_amdgcn_s_barrier();
    asm volatile("" ::: "memory");
    glaB_issue<0>(F, b, h, d, 0); glaB_issue<1>(F, b, h, d, 1);
    asm volatile("" ::: "memory");
    for (int s0 = 0; s0 + 2 < NCHUNK; s0 += 3) { glaB_step<0>(F, b, h, d, s0, S, od); glaB_step<1>(F, b, h, d, s0 + 1, S, od); glaB_step<2>(F, b, h, d, s0 + 2, S, od); }
    glaB_step<0>(F, b, h, d, 66, S, od); glaB_step<1>(F, b, h, d, 67, S, od);
    static_assert(NCHUNK == 68, "tail of the step loop");
    asm volatile("s_waitcnt vmcnt(0)" ::: "memory");
    __builtin_amdgcn_s_barrier();
}
__device__ __forceinline__ void conv_moe_dynamic(const Frame& F0, int l) {
    Frame F = relaunder(F0);
    LAS float* scr = (LAS float*)(F.lds + F.wave * 16384);
    unsigned* ctr = (unsigned*)(F.ws + WS_CTL) + CW_WQ + l * 64;
    constexpr int I_13 = 16 * 32, I_2 = 8 * 32, NIT = NEXP * (I_13 + I_2), CH = 8;
    for (;;) {
        unsigned t0 = 0; if (F.lane == 0) t0 = atomicAdd(ctr, (unsigned)CH);
        const int it0 = __builtin_amdgcn_readfirstlane((int)t0);
        if (it0 >= NIT) break;
        for (int it = it0; it < it0 + CH && it < NIT; ++it) conv_moe_item(F, l, it, scr);
    }
}

__device__ __forceinline__ void ph_combine(const Frame& F0, int ie, int nrows) {
    Frame F = relaunder(F0);
    const int gw = F.vcu * 8 + F.wave, NGW = F.G * 8, lane = F.lane;
    const bf16* P = (const bf16*)(F.ws + WS_P); bf16* Q = (bf16*)(F.ws + WS_Q);
    const bf16* o0 = (const bf16*)(F.ws + WS_U); const bf16* o1 = o0 + (size_t)NTOK * 512;
    const float* nw = inptr(F, I_NORMW) + (size_t)ie * 512;
    const int col = 8 * lane;
    const f32x4 nwa = *(const f32x4*)(nw + col), nwb = *(const f32x4*)(nw + col + 4);
    for (int r0 = gw * 4; r0 < nrows; r0 += NGW * 4) {
        if (KO_MASK & 2) {
#pragma unroll
            for (int r = 0; r < 4; ++r) *(u32x4*)(Q + (size_t)(r0 + r) * D + 512 + col) = (u32x4){0u, 0u, 0u, 0u};
            continue; }
        u32x4 a[4], bq[4], rr[4];
#pragma unroll
        for (int r = 0; r < 4; ++r) { const size_t row = r0 + r; a[r] = __builtin_nontemporal_load((const u32x4*)(o0 + row * 512 + col)); bq[r] = __builtin_nontemporal_load((const u32x4*)(o1 + row * 512 + col)); rr[r] = __builtin_nontemporal_load((const u32x4*)(P + row * EN + PC_RG + col)); }
#pragma unroll
        for (int r = 0; r < 4; ++r) {
            const f32x4 xa = ubf_lo(a[r]) + ubf_lo(bq[r]), xb = ubf_hi(a[r]) + ubf_hi(bq[r]);
            float ss = (xa[0] * xa[0] + xa[1] * xa[1]) + (xa[2] * xa[2] + xa[3] * xa[3]) + (xb[0] * xb[0] + xb[1] * xb[1]) + (xb[2] * xb[2] + xb[3] * xb[3]);
            ss = row16_sum(ss);
            const float rinv = 1.0f / sqrtf(ss * (1.0f / 128.0f) + RMS_EPS);
            f32x4 ra = ubf_lo(rr[r]), rb = ubf_hi(rr[r]);
#pragma unroll
            for (int j = 0; j < 4; ++j) { ra[j] = fast_silu(ra[j]); rb[j] = fast_silu(rb[j]); }
            *(u32x4*)(Q + (size_t)(r0 + r) * D + 512 + col) = pack8(xa * rinv * nwa * ra, xb * rinv * nwb * rb); }
    }
}

#if defined(FP8_PROBE)
typedef int i32x8 __attribute__((ext_vector_type(8)));
__device__ __forceinline__ unsigned fp8_of_int(int v) { const int a = v < 0 ? -v : v; const unsigned c = a == 0 ? 0x00u : a == 1 ? 0x38u : a == 2 ? 0x40u : 0x44u; return v < 0 ? (c | 0x80u) : c; }
__device__ __forceinline__ int fp8_kidx(int kg, int e) { return FP8_PROBE == 1 ? 32 * kg + e : (e < 16 ? 16 * kg + e : 64 + 16 * kg + (e - 16)); }
__device__ __forceinline__ bool fp8_layout_test(int lane) {
    const int r = lane & 15, kg = lane >> 4;
    i32x8 a, b;
#pragma unroll
    for (int w = 0; w < 8; ++w) { unsigned aw = 0, bw = 0;
#pragma unroll
        for (int by = 0; by < 4; ++by) { const int k = fp8_kidx(kg, 4 * w + by);
            const int av = (k == (7 * r + 3) % 128) ? 1 : 0; const int bv = ((k * 5 + r * 3) % 7) - 3;
            aw |= fp8_of_int(av) << (8 * by); bw |= fp8_of_int(bv) << (8 * by); }
        a[w] = (int)aw; b[w] = (int)bw; }
    f32x4 c = (f32x4){0.f, 0.f, 0.f, 0.f};
    c = __builtin_amdgcn_mfma_scale_f32_16x16x128_f8f6f4(a, b, c, 0, 0, 0, 0, 0, 0);
    bool bad = false;
#pragma unroll
    for (int q = 0; q < 4; ++q) { const int i = 4 * kg + q; const int kk = (7 * i + 3) % 128; const float ex = (float)(((kk * 5 + r * 3) % 7) - 3); if (c[q] != ex) bad = true; }
    return __builtin_amdgcn_ballot_w64(bad) != 0ull;
}
#endif
struct Args { const float* in[25]; float* out; unsigned char* ws; int ph_lo, ph_hi; };
constexpr int NPHASE = 2 + 9 * DEPTH;

__global__ void __launch_bounds__(512, 2) fwd(Args args) {
    extern __shared__ __attribute__((aligned(16))) unsigned char lds_raw[];
    Frame F;
    F.lds = (LAS unsigned char*)lds_raw;
    F.tid = threadIdx.x; F.lane = F.tid & 63; F.wave = __builtin_amdgcn_readfirstlane(F.tid >> 6);
    F.G = gridDim.x; { const int bx = blockIdx.x; F.vcu = (F.G % 8 == 0) ? (bx % 8) * (F.G / 8) + bx / 8 : bx; }
    F.out = args.out; F.ws = args.ws;
    volatile LAS unsigned* MISC = (volatile LAS unsigned*)(F.lds + MISC_OFF);
    if (F.tid < 64) MISC[F.tid] = 0u;
    if (F.tid < 25) ((LAS unsigned long long*)(F.lds + MISC_OFF + 256))[F.tid] = (unsigned long long)args.in[F.tid];
    __syncthreads();
    const int lo = args.ph_lo, hi = args.ph_hi;
    const bool multi = (hi - lo) > 1;
    XcdBarrier bar; bar.bar = (unsigned*)(F.ws + WS_CTL) + CW_BAR; bar.x = 0; bar.st = MISC + 8;
    if (multi) bar = xcd_barrier_post((unsigned*)(F.ws + WS_CTL) + CW_BAR, MISC + 8);
#ifndef PH_SEL
#define PH_SEL 0xffffffff
#endif
#define IN(k) (lo <= (k) && (k) < hi)
#define SEL(b) ((PH_SEL >> (b)) & 1)
#ifndef DUP_MASK
#define DUP_MASK 0
#endif
#define REP(bit) for (int rep_ = 0; rep_ < ((DUP_MASK & (bit)) ? 2 : 1); ++rep_)
#ifndef STAG_IN
#define STAG_IN 0
#endif
#define SKIPE (((DUP_MASK & 512) && rep_ > 0) ? launder_s(1) : 0)
#define SEAM(k) do { if ((k) + 1 < hi) xcd_barrier(bar); } while (0)

    if (SEL(0) && IN(0)) { REP(64) { ph_ada(F); __syncthreads(); conv_dense_weights(F); __syncthreads(); } SEAM(0); }
    if (SEL(1) && IN(1)) { REP(64) { ph_u0(F); __syncthreads(); } SEAM(1); }

    constexpr int ATT_S1 = NB * 2 * 32 * 3 / 4;
    for (int l = 0; l < DEPTH; ++l) {
        const int pb = 2 + 9 * l; const bool even = (l & 1) == 0; const int ie = l >> 1;
        const int m_in = (l < 3) ? NTOK : NLAT;
        const int m_out = (l < 2) ? NTOK : NLAT;
        if (SEL(2) && IN(pb + 0)) {
            REP(32) { if (even) {
                LinSched S; S.init(m_in, EN, 1024, F.G, (int)blockIdx.x);
                LAS float* rc = (LAS float*)(F.lds + LDSX_OFF + 3072); LAS float* rs = (LAS float*)(F.lds + MISC_OFF + 512);
                { const Frame Fm = relaunder(F); const float* rope = (const float*)(Fm.ws + WS_ROPE); if (Fm.tid < 256) { *(LAS f32x4*)(rc + 4 * Fm.tid) = *(const f32x4*)(rope + 4 * Fm.tid); *(LAS f32x4*)(rs + 4 * Fm.tid) = *(const f32x4*)(rope + 1024 + 4 * Fm.tid); } }
                __syncthreads();
                EpiEvenIn E{(bf16*)(F.ws + WS_P), rc, rs};
                pg8::gemm_phase(F.lds, (const char*)(F.ws + WS_U), (const char*)(F.ws + WS_WINE) + (size_t)ie * EN * 1024 * 2, 1024, S, E, SKIPE, STAG_IN);
            } else {
                LinSched S; S.init(m_in, ON, 1024, F.G, (int)blockIdx.x);
                EpiOddIn E{(bf16*)(F.ws + WS_P)};
                pg8::gemm_phase(F.lds, (const char*)(F.ws + WS_U), (const char*)(F.ws + WS_WINO) + (size_t)ie * ON * 1024 * 2, 1024, S, E, SKIPE, STAG_IN);
            } }
            SEAM(pb + 0);
        }
        if (SEL(3) && IN(pb + 1)) {
            if (even) {
                const Frame Fm = relaunder(F);
                const int nun = ATT_S1;
                REP(1) for (int u = Fm.vcu; u < nun; u += Fm.G) {
                    if (u < NB * 2 * 32) attn_unit(Fm, ie, u >> 6, (u >> 5) & 1, u & 31, false);
                    else { const int v = u - NB * 2 * 32; attn_unit(Fm, ie, v >> 2, (v >> 1) & 1, v & 1, true); }
                }
                __syncthreads();
                if (!(KO_MASK & 2)) REP(2) for (int u = Fm.vcu * 8 + Fm.wave; u < NB * NCHUNK * 8; u += Fm.G * 8) { if (u & 1) glaA_unit<1>(Fm, ie, u / (NCHUNK * 8), (u / 8) % NCHUNK, (u >> 1) & 3); else glaA_unit<0>(Fm, ie, u / (NCHUNK * 8), (u / 8) % NCHUNK, (u >> 1) & 3); }
                __syncthreads();
            } else {
                REP(16) { ph_conv(F, ie, m_out); __syncthreads(); }
                if (m_out == NLAT) { conv_moe_weights(F, l); __syncthreads(); }
            }
            SEAM(pb + 1);
        }
        if (even) {
            if (SEL(4) && IN(pb + 2)) {
                { const Frame Fm = relaunder(F);
                  if (!(KO_MASK & 2)) REP(4) for (int cg = Fm.vcu; cg < 128; cg += Fm.G) glaB_group(Fm, cg);
                  if (Fm.vcu >= 128) {
                      const int nun = NB * 2 * 32 + (l == 0 ? NB * 2 * 2 : 0);
                      for (int u = ATT_S1 + Fm.vcu - 128; u < nun; u += Fm.G - 128) {
                          if (u < NB * 2 * 32) attn_unit(Fm, ie, u >> 6, (u >> 5) & 1, u & 31, false);
                          else { const int v = u - NB * 2 * 32; attn_unit(Fm, ie, v >> 2, (v >> 1) & 1, v & 1, true); }
                      }
                  }
                  __syncthreads();
                  conv_moe_dynamic(Fm, l); }
                SEAM(pb + 2);
            }
            if (SEL(5) && IN(pb + 3)) { REP(16) { ph_combine(F, ie, m_out); __syncthreads(); } SEAM(pb + 3); }
        }
        if (SEL(6) && IN(pb + 4)) {
            REP(32) { LinSched S; S.init(m_out, 1024, 1024, F.G, (int)blockIdx.x);
            EpiPlain E{(bf16*)(F.ws + WS_P), 1024};
            pg8::gemm_phase(F.lds, (const char*)(F.ws + WS_Q), (const char*)(F.ws + (even ? WS_WOUTE : WS_WOUTO)) + (size_t)ie * 1024 * 1024 * 2, 1024, S, E, SKIPE); }
            if (!even && m_out != NLAT) { __syncthreads(); conv_moe_dynamic(F, l); __syncthreads(); }
            SEAM(pb + 4);
        }
        if (SEL(7) && IN(pb + 5)) { if (DUP_MASK & 128) { ph_ln1(F, l, m_out, true); __syncthreads(); } ph_ln1(F, l, m_out); SEAM(pb + 5); }
        if (SEL(8) && IN(pb + 6)) {
            if (!(KO_MASK & 8)) REP(32) {
                moe_tables(F.lds, (const unsigned*)(F.ws + WS_CTL) + CW_CNT + l * MOE_NG * MOE_CSTR);
                MoeSched<1> S; S.T = moe_tab(F.lds); S.rowtok = (const int*)(F.ws + WS_ROWTOK); S.G = F.G; S.c = F.vcu; S.bstride = (size_t)256 * 1024; S.estride = (size_t)1024 * 1024;
                EpiG1 E{(unsigned char*)(F.ws + WS_Q), 1.0f / W8_SCALE};
                pg8::gemm_phase<EpiG1, MoeSched<1>, 1>(F.lds, (const char*)(F.ws + WS_U8), (const char*)(F.ws + WS_W13), 1024, S, E, SKIPE);
            }
            SEAM(pb + 6);
        }
        if (SEL(9) && IN(pb + 7)) {
            if (!(KO_MASK & 8)) REP(32) {
                if (!IN(pb + 6) || (KO_MASK & 8)) moe_tables(F.lds, (const unsigned*)(F.ws + WS_CTL) + CW_CNT + l * MOE_NG * MOE_CSTR);
                MoeSched<0> S; S.T = moe_tab(F.lds); S.rowtok = nullptr; S.G = F.G; S.c = F.vcu; S.bstride = (size_t)256 * 512; S.estride = (size_t)1024 * 512;
                EpiOut8 E{(unsigned char*)(F.ws + WS_P), OUT8_SCALE / W8_SCALE};
                pg8::gemm_phase<EpiOut8, MoeSched<0>, 1>(F.lds, (const char*)(F.ws + WS_Q), (const char*)(F.ws + WS_W2), 512, S, E, SKIPE);
            }
            SEAM(pb + 7);
        }
        if (SEL(10) && IN(pb + 8)) {
            if (!IN(pb + 6) || (KO_MASK & 8)) moe_tables(F.lds, (const unsigned*)(F.ws + WS_CTL) + CW_CNT + l * MOE_NG * MOE_CSTR);
            if (DUP_MASK & 256) { ph_ln2(F, l, m_out, true); __syncthreads(); }
            ph_ln2(F, l, m_out);
            SEAM(pb + 8);
        }
    }
#if defined(FP8_PROBE)
    if (blockIdx.x == 0) { __syncthreads(); if (F.tid < 64) { const bool bad = fp8_layout_test(F.tid); if (bad && F.tid == 0) F.out[0] = __builtin_nanf(""); } }
#endif
#undef IN
#undef SEAM
}

extern "C" void kernel_launch(void* const* d_in, const int* in_sizes, int n_in, void* d_out, int out_size, void* d_ws, size_t ws_size, hipStream_t stream) {
    static int grid = 0;
    if (grid == 0) {
        if (n_in != 25 || in_sizes[0] != NLAT * D || out_size != NLAT * D || ws_size < WS_END) { fprintf(stderr, "kernel_launch: unexpected shapes (n_in %d in0 %d out %d ws %zu)\n", n_in, n_in > 0 ? in_sizes[0] : -1, out_size, ws_size); grid = -1; return; }
        int dev = 0, cus = 0, per_cu = 0;
        if (hipGetDevice(&dev) != hipSuccess || hipDeviceGetAttribute(&cus, hipDeviceAttributeMultiprocessorCount, dev) != hipSuccess) { grid = -1; return; }
        if (hipFuncSetAttribute((const void*)fwd, hipFuncAttributeMaxDynamicSharedMemorySize, LDS_BYTES) != hipSuccess) { fprintf(stderr, "kernel_launch: hipFuncSetAttribute failed\n"); grid = -1; return; }
        if (hipOccupancyMaxActiveBlocksPerMultiprocessor(&per_cu, (const void*)fwd, 512, LDS_BYTES) != hipSuccess || per_cu < 1) fprintf(stderr, "kernel_launch: occupancy query says %d\n", per_cu);
        (void)hipGetLastError();
        grid = cus;
        if (grid < 242 || grid > 1024) { fprintf(stderr, "kernel_launch: built for a 256-CU device (got %d CUs)\n", cus); grid = -1; return; }
    }
    if (grid < 0) return;
    if (hipMemsetAsync((char*)d_ws + WS_CTL, 0, CTL_BYTES, stream) != hipSuccess) return;
    Args a{};
    for (int i = 0; i < 25; ++i) a.in[i] = (const float*)d_in[i];
    a.out = (float*)d_out; a.ws = (unsigned char*)d_ws;
#if N_LAUNCH_MODE == 1
    a.ph_lo = 0; a.ph_hi = NPHASE;
    hipLaunchKernelGGL(fwd, dim3(grid), dim3(512), LDS_BYTES, stream, a);
#else
    for (int k = 0; k < NPHASE; ++k) {
        if (k >= 2) { const int l = (k - 2) / 9, s = (k - 2) % 9; if ((l & 1) && (s == 2 || s == 3)) continue; }
        a.ph_lo = k; a.ph_hi = k + 1;
        hipLaunchKernelGGL(fwd, dim3(grid), dim3(512), LDS_BYTES, stream, a);
    }
#endif
}
```
